# Optimizing an MI355X kernel written in HIP

```python
import jax, jax.numpy as jnp
from jax import lax
import numpy as np

D_MODEL = 1024
BATCH = 16
SEQ = 256
DEPTH = 4
DEC_BATCH = 8
DEC_SEQ = 1024
PAST_LEN = 256

GRID_W = 64
N_HEADS = 4
DM = 2 * D_MODEL
DV = DM // N_HEADS
DQK = DV // 2
N_FGROUPS = 4
DF = D_MODEL
DG = DF // N_FGROUPS
D_FF = ((8 * D_MODEL // 3 + 255) // 256) * 256
CHUNK = 64
N_GATES = 4 * N_HEADS
ALPHA = (2 * DEPTH) ** 0.25
BETA = (8 * DEPTH) ** -0.25
LN_EPS = 1e-5

Q_END = N_HEADS * DQK
K_END = Q_END + N_HEADS * DQK
V_END = K_END + DM
O_END = V_END + DM
G_END = O_END + N_GATES
F_END = G_END + DF
GA_END = F_END + D_MODEL
N_IN = GA_END + D_MODEL
SPLITS = [Q_END, K_END, V_END, O_END, G_END, F_END, GA_END]

kernel_name = 'hybrid_mlstm_fnet_diffusion_step'


def layer_norm(x, g, b):
    xf = x.astype(jnp.float32)
    mu = xf.mean(-1, keepdims=True)
    var = jnp.square(xf - mu).mean(-1, keepdims=True)
    return ((xf - mu) * lax.rsqrt(var + LN_EPS) * g + b).astype(x.dtype)


def mlstm_chunkwise(q, k, v, ig, lf, C0, n0, m0):
    B, H, S, _ = q.shape
    nc = S // CHUNK

    def to_chunks(t):
        return jnp.moveaxis(t.reshape(B, H, nc, CHUNK, *t.shape[3:]), 2, 0)

    causal = jnp.tril(jnp.ones((CHUNK, CHUNK), bool))

    def step(carry, xs):
        C, n, m = carry
        qc, kc, vc, ic, fc = xs
        b = jnp.cumsum(fc, axis=-1)
        a = b + m[..., None]
        d = jnp.where(causal, b[..., :, None] - b[..., None, :] + ic[..., None, :], -jnp.inf)
        mt = jnp.maximum(a, d.max(-1))
        w = jnp.exp(d - mt[..., None])
        inter = jnp.exp(a - mt)
        s = jnp.einsum('bhtd,bhsd->bhts', qc, kc) * w
        num = jnp.einsum('bhts,bhsv->bhtv', s, vc) + inter[..., None] * jnp.einsum('bhvd,bhtd->bhtv', C, qc)
        den = s.sum(-1) + inter * jnp.einsum('bhd,bhtd->bht', n, qc)
        h = num / jnp.maximum(jnp.abs(den), jnp.exp(-mt))[..., None]
        bl = b[..., -1]
        g = bl[..., None] - b + ic
        ml = jnp.maximum(bl + m, g.max(-1))
        decay = jnp.exp(bl + m - ml)
        wg = jnp.exp(g - ml[..., None])
        C_new = decay[..., None, None] * C + jnp.einsum('bhsv,bhsd->bhvd', vc * wg[..., None], kc)
        n_new = decay[..., None] * n + jnp.einsum('bhs,bhsd->bhd', wg, kc)
        return (C_new, n_new, ml), h

    (C, n, m), hs = lax.scan(step, (C0, n0, m0),
                             (to_chunks(q), to_chunks(k), to_chunks(v), to_chunks(ig), to_chunks(lf)))
    h = jnp.moveaxis(hs, 0, 2).reshape(B, H, S, DV)
    return h, (C, n, m)


def mlstm_bidir(q, k, v, gates, init):
    hs, finals = [], []
    for d in range(2):
        ig = gates[..., d, 0]
        lf = jax.nn.log_sigmoid(gates[..., d, 1])
        if d == 0:
            h, fin = mlstm_chunkwise(q, k, v, ig, lf, *init[d])
        else:
            h, fin = mlstm_chunkwise(jnp.flip(q, 2), jnp.flip(k, 2), jnp.flip(v, 2),
                                     jnp.flip(ig, 2), jnp.flip(lf, 2), *init[d])
            h = jnp.flip(h, 2)
        hs.append(h)
        finals.append(fin)
    return hs[0] + hs[1], finals


def fourier_seq(u):
    B, S, _ = u.shape
    ug = u.astype(jnp.float32).reshape(B, S, N_FGROUPS, DG)
    return jnp.fft.fftn(ug, axes=(1, 3), norm='ortho').real.reshape(B, S, DF).astype(u.dtype)


def fourier_grid(u):
    B, S, _ = u.shape
    rows = S // GRID_W
    ug = u.astype(jnp.float32).reshape(B, rows, GRID_W, N_FGROUPS, DG)
    return jnp.fft.fftn(ug, axes=(1, 2, 4), norm='ortho').real.reshape(B, S, DF).astype(u.dtype)


def mixer(h, l, p, init, fourier_fn):
    B, S, _ = h.shape
    proj = h @ p['w_in'][l]
    q, k, v, o, gt, uf, ga, gb = jnp.split(proj, SPLITS, axis=-1)

    def heads(t, dim):
        return t.reshape(B, S, N_HEADS, dim).transpose(0, 2, 1, 3).astype(jnp.float32)

    qh = heads(q, DQK)
    kh = heads(k, DQK) * DQK ** -0.5
    vh = heads(v, DV)
    gates = (gt + p['b_gate'][l]).astype(jnp.float32).reshape(B, S, 2, 2, N_HEADS).transpose(0, 4, 1, 2, 3)
    h_m, finals = mlstm_bidir(qh, kh, vh, gates, init)
    hf = h_m.transpose(0, 2, 1, 3)
    mu = hf.mean(-1, keepdims=True)
    var = jnp.square(hf - mu).mean(-1, keepdims=True)
    hn = (hf - mu) * lax.rsqrt(var + LN_EPS) * p['mh_gain'][l].reshape(N_HEADS, DV)
    og = jax.nn.sigmoid(o.reshape(B, S, N_HEADS, DV).astype(jnp.float32))
    y_a = (hn * og).reshape(B, S, DM).astype(h.dtype) @ p['w_branch_a'][l]
    y_b = fourier_fn(uf) @ p['w_branch_b'][l]
    merged = jax.nn.sigmoid(ga) * y_a + jax.nn.sigmoid(gb) * y_b
    return merged @ p['w_out'][l], finals


def trunk_layer(x, mod, l, p, init, fourier_fn):
    sh1, sc1, g1, sh2, sc2, g2 = jnp.split(mod, 6, axis=-1)
    h = x * (1 + sc1) + sh1
    out, finals = mixer(h, l, p, init, fourier_fn)
    x = layer_norm(ALPHA * x + g1 * out, p['ln_gain'][l, 0], p['ln_bias'][l, 0])
    h2 = x * (1 + sc2) + sh2
    a, u = jnp.split(h2 @ p['w_ffn_in'][l], 2, axis=-1)
    f = (jax.nn.silu(a) * u) @ p['w_ffn_out'][l]
    x = layer_norm(ALPHA * x + g2 * f, p['ln_gain'][l, 1], p['ln_bias'][l, 1])
    return x, finals


def setup_inputs(seed: int = 0) -> dict:
    key = jax.random.key(seed)
    ks = jax.random.split(key, 20)

    def nrm(k, shape, scale):
        return jax.random.normal(k, shape, jnp.float32) * scale

    x_prompt = nrm(ks[0], (BATCH, SEQ, D_MODEL), 1.0)
    x_sample = nrm(ks[1], (DEC_BATCH, DEC_SEQ, D_MODEL), 1.0)
    c = nrm(ks[2], (DEC_BATCH, D_MODEL), 1.0)
    state_C = nrm(ks[3], (DEC_BATCH, DEPTH, 2, N_HEADS, DV, DQK), 0.1)
    state_n = nrm(ks[4], (DEC_BATCH, DEPTH, 2, N_HEADS, DQK), 0.1)
    state_m = jax.random.uniform(ks[5], (DEC_BATCH, DEPTH, 2, N_HEADS), jnp.float32, 0.0, 2.0)
    c_ctx = nrm(ks[6], (D_MODEL,), 1.0)
    w_mod = nrm(ks[7], (DEPTH, D_MODEL, 6 * D_MODEL), D_MODEL ** -0.5)
    b_mod = nrm(ks[8], (DEPTH, 6 * D_MODEL), 0.02)
    w_in = nrm(ks[9], (DEPTH, D_MODEL, N_IN), D_MODEL ** -0.5)
    gate_base = jnp.array([0.0, 3.0], jnp.float32).reshape(1, 1, 2, 1)
    b_gate = (gate_base + nrm(ks[10], (DEPTH, 2, 2, N_HEADS), 0.1)).reshape(DEPTH, N_GATES)
    mh_gain = 1.0 + nrm(ks[11], (DEPTH, DM), 0.02)
    w_branch_a = nrm(ks[12], (DEPTH, DM, D_MODEL), DM ** -0.5)
    w_branch_b = nrm(ks[13], (DEPTH, DF, D_MODEL), DF ** -0.5)
    w_out = nrm(ks[14], (DEPTH, D_MODEL, D_MODEL), BETA * D_MODEL ** -0.5)
    ln_gain = 1.0 + nrm(ks[15], (DEPTH, 2, D_MODEL), 0.02)
    ln_bias = nrm(ks[16], (DEPTH, 2, D_MODEL), 0.02)
    w_ffn_in = nrm(ks[17], (DEPTH, D_MODEL, 2 * D_FF), D_MODEL ** -0.5)
    w_ffn_out = nrm(ks[18], (DEPTH, D_FF, D_MODEL), BETA * D_FF ** -0.5)
    return {'x_prompt': x_prompt, 'x_sample': x_sample, 'c': c,
            'state_C': state_C, 'state_n': state_n, 'state_m': state_m,
            'c_ctx': c_ctx, 'w_mod': w_mod, 'b_mod': b_mod, 'w_in': w_in, 'b_gate': b_gate,
            'mh_gain': mh_gain, 'w_branch_a': w_branch_a, 'w_branch_b': w_branch_b, 'w_out': w_out,
            'ln_gain': ln_gain, 'ln_bias': ln_bias, 'w_ffn_in': w_ffn_in, 'w_ffn_out': w_ffn_out}


def reference(x_prompt, x_sample, c, state_C, state_n, state_m, c_ctx, w_mod, b_mod, w_in, b_gate,
              mh_gain, w_branch_a, w_branch_b, w_out, ln_gain, ln_bias, w_ffn_in, w_ffn_out):
    p = {'w_in': w_in, 'b_gate': b_gate, 'mh_gain': mh_gain, 'w_branch_a': w_branch_a,
         'w_branch_b': w_branch_b, 'w_out': w_out, 'ln_gain': ln_gain, 'ln_bias': ln_bias,
         'w_ffn_in': w_ffn_in, 'w_ffn_out': w_ffn_out}
    f32 = jnp.float32
    bp = x_prompt.shape[0]
    zero_state = (jnp.zeros((bp, N_HEADS, DV, DQK), f32), jnp.zeros((bp, N_HEADS, DQK), f32),
                  jnp.zeros((bp, N_HEADS), f32))
    xp = x_prompt
    xs = x_sample
    new_C, new_n, new_m = [], [], []
    for l in range(DEPTH):
        mod_ctx = (jax.nn.silu(c_ctx) @ w_mod[l] + b_mod[l])[None, None, :]
        xp, fin = trunk_layer(xp, mod_ctx, l, p, (zero_state, zero_state), fourier_seq)
        new_C.append(jnp.stack([fin[0][0], fin[1][0]], axis=1))
        new_n.append(jnp.stack([fin[0][1], fin[1][1]], axis=1))
        new_m.append(jnp.stack([fin[0][2], fin[1][2]], axis=1))
        mod_lat = (jax.nn.silu(c) @ w_mod[l] + b_mod[l])[:, None, :]
        init_lat = tuple((state_C[:, l, d].astype(f32), state_n[:, l, d].astype(f32),
                          state_m[:, l, d].astype(f32)) for d in range(2))
        xs, _ = trunk_layer(xs, mod_lat, l, p, init_lat, fourier_grid)
    new_state_C = jnp.stack(new_C, axis=1)
    new_state_n = jnp.stack(new_n, axis=1)
    new_state_m = jnp.stack(new_m, axis=1)
    return (xp, xs, new_state_C, new_state_n, new_state_m)
```

```cpp
#include <hip/hip_runtime.h>
#include <hip/hip_cooperative_groups.h>
#include <cstdio>
#ifndef ONE_LAUNCH
#define ONE_LAUNCH 1
#endif
namespace cg = cooperative_groups;

typedef unsigned short bf16_t;
using bf16x8 = __attribute__((ext_vector_type(8))) short;
using f32x16 = __attribute__((ext_vector_type(16))) float;
using f32x4 = __attribute__((ext_vector_type(4))) float;
#define DI __device__ __forceinline__
#define MFMA32(a, b, c) __builtin_amdgcn_mfma_f32_32x32x16_bf16((a), (b), (c), 0, 0, 0)
#define MFMA16(a, b, c) __builtin_amdgcn_mfma_f32_16x16x32_bf16((a), (b), (c), 0, 0, 0)

constexpr int NTOK = 12288, NCTX = 4096;
constexpr int NINP = 9344;
constexpr int DFF = 2816;
constexpr float ALPHA = 1.6817928305074290f;
constexpr float LN_EPS = 1e-5f;

constexpr size_t SZ_WIN = (size_t)NINP * 1024 * 2, SZ_WA = 1024ull * 2048 * 2, SZ_WB = 1024ull * 1024 * 2, SZ_WO = SZ_WB,
                 SZ_WF1 = 5632ull * 1024 * 2, SZ_WF2 = 1024ull * 2816 * 2;
constexpr size_t WS_WIN = 0, WS_WA = WS_WIN + SZ_WIN, WS_WB = WS_WA + SZ_WA, WS_WO = WS_WB + SZ_WB, WS_WF1 = WS_WO + SZ_WO,
                 WS_WF2 = WS_WF1 + SZ_WF1, SZ_SLOT = WS_WF2 + SZ_WF2;
constexpr size_t OFF_BC = 2 * SZ_SLOT;
constexpr size_t OFF_A256 = OFF_BC + 512 * 256 * 2;
constexpr size_t OFF_A1024 = OFF_A256 + 256 * 512 * 2;
constexpr size_t OFF_MODP = OFF_A1024 + 1024ull * 2048 * 2;
constexpr size_t OFF_MOD = OFF_MODP + 8ull * 4 * 9 * 6144 * 4;
constexpr size_t OFF_XRES = OFF_MOD + 4ull * 9 * 6144 * 4;
constexpr size_t OFF_HMOD = OFF_XRES + (size_t)NTOK * 1024 * 4;
constexpr size_t OFF_FB = OFF_HMOD;
constexpr size_t OFF_Q = OFF_HMOD + (size_t)NTOK * 1024 * 2;
constexpr size_t OFF_MERGED = OFF_Q;
constexpr size_t OFF_K = OFF_Q + (size_t)NTOK * 1024 * 2;
constexpr size_t OFF_KT = OFF_K + (size_t)NTOK * 1024 * 2;
constexpr size_t OFF_VT = OFF_KT + 16ull * 4 * 256 * 256 * 2;
constexpr size_t OFF_OG = OFF_VT + (size_t)NTOK * 2048 * 2;
constexpr size_t OFF_FF = OFF_OG;
constexpr size_t OFF_UF = OFF_OG + (size_t)NTOK * 2048 * 2;
constexpr size_t OFF_GA = OFF_UF + (size_t)NTOK * 1024 * 2;
constexpr size_t OFF_GB = OFF_GA + (size_t)NTOK * 1024 * 2;
constexpr size_t OFF_GATES = OFF_GB + (size_t)NTOK * 1024 * 2;
constexpr size_t SZ_SC = 2ull * 4 * NTOK * 4;
constexpr size_t OFF_BETA = OFF_GATES + (size_t)NTOK * 16 * 4;
constexpr size_t OFF_MM = OFF_BETA + SZ_SC;
constexpr size_t OFF_EMT = OFF_MM + SZ_SC;
constexpr size_t OFF_WFIN = OFF_EMT + SZ_SC;
constexpr size_t OFF_H0 = OFF_WFIN + SZ_SC;
constexpr size_t OFF_TT = OFF_H0 + (size_t)NTOK * 2048 * 2;
constexpr size_t OFF_PRELN = OFF_TT;
constexpr size_t OFF_HN = OFF_TT + (size_t)NTOK * 2048 * 2;
constexpr size_t OFF_VTC = OFF_HN + (size_t)NTOK * 2048 * 2;
constexpr size_t OFF_C0T = OFF_VTC + 16ull * 2048 * 256 * 2;
constexpr size_t OFF_BAR = OFF_C0T + 64ull * 512 * 256 * 2;
constexpr size_t WS_TOTAL = OFF_BAR + 16384;
constexpr size_t VT_LAT = 16ull * 2048 * 256;
constexpr size_t TT_LAT = 16ull * 4 * 256 * 512;

constexpr size_t OUT_NEWC = (size_t)NTOK * 1024;
constexpr size_t OUT_NEWN = OUT_NEWC + 16ull * 4 * 2 * 4 * 512 * 256;
constexpr size_t OUT_NEWM = OUT_NEWN + 16ull * 4 * 2 * 4 * 256;

constexpr int SMEM_BYTES = 73728;

struct Params {
  const float *x_prompt, *x_sample, *c, *state_C, *state_n, *state_m, *c_ctx, *w_mod, *b_mod, *w_in, *b_gate, *mh_gain,
      *w_a, *w_b, *w_out, *ln_gain, *ln_bias, *w_f1, *w_f2;
  float* out;
  unsigned char* ws;
};

typedef unsigned u32x4 __attribute__((ext_vector_type(4)));
DI u32x4 gld16(const void* p) { u32x4 r; asm volatile("global_load_dwordx4 %0, %1, off" : "=&v"(r) : "v"(p) : "memory"); return r; }
DI unsigned f2bf(float x) { unsigned r; asm("v_cvt_pk_bf16_f32 %0, %1, %1" : "=v"(r) : "v"(x)); return r & 0xffffu; }
DI unsigned pack2(float a, float b) { unsigned r; asm("v_cvt_pk_bf16_f32 %0, %1, %2\n\ts_nop 1" : "=v"(r) : "v"(a), "v"(b)); return r; }
DI float bf2f(unsigned h) { return __uint_as_float(h << 16); }
DI float sigmoidf_(float x) { return 1.f / (1.f + __expf(-x)); }
DI float logsigmoidf_(float x) { return fminf(x, 0.f) - log1pf(__expf(-fabsf(x))); }
DI int mod_index(int tok) { return tok < NCTX ? 0 : 1 + ((tok - NCTX) >> 10); }
DI int tid_() { int t = threadIdx.x; asm volatile("" : "+v"(t)); return t; }
DI int bid_() { int b = blockIdx.x; asm volatile("" : "+s"(b)); return b; }
DI int vblock() { return bid_(); }

DI void tile_decode(int t, int MT, int NT, int& mt, int& nt) {
  const int per_sc = MT * 8;
  const int sc = t / per_sc;
  const int w = t - sc * per_sc;
  int ncols = NT - sc * 8; ncols = ncols > 8 ? 8 : ncols;
  const int per_sr = 8 * ncols;
  const int sr = w / per_sr;
  const int j = w - sr * per_sr;
  mt = sr * 8 + (j & 7);
  nt = sc * 8 + (j >> 3);
}

template <bool KSCALE>
DI void gemm_mainloop(f32x16 (&acc)[2][2], const bf16_t* __restrict__ A, int lda, const bf16_t* __restrict__ B, int ldb, int K,
                      const float* __restrict__ kscale, unsigned char* smem) {
  const int tid = tid_(), lane = tid & 63, wave = tid >> 6;
  const int wm = wave >> 1, wn = wave & 1, r = lane & 31, h = lane >> 5;
  const int lrow = tid >> 3, lkc = tid & 7;
  const bf16_t* ga = A + (size_t)lrow * lda + lkc * 8;
  const bf16_t* gb = B + (size_t)lrow * ldb + lkc * 8;
  u32x4 a0[4], b0[4], a1[4], b1[4];
  const int KT = K >> 6;
#define GL(sa_, sb_, k0)                                                                            \
  {                                                                                                 \
    _Pragma("unroll") for (int i = 0; i < 4; ++i) {                                                 \
      sa_[i] = gld16(ga + (size_t)(32 * i) * lda + (k0));                                           \
      sb_[i] = gld16(gb + (size_t)(32 * i) * ldb + (k0));                                           \
    }                                                                                               \
  }
#define GW8(sa_, sb_) asm volatile("s_waitcnt vmcnt(8)" : "+v"(sa_[0]), "+v"(sa_[1]), "+v"(sa_[2]), "+v"(sa_[3]), "+v"(sb_[0]), "+v"(sb_[1]), "+v"(sb_[2]), "+v"(sb_[3]) : : "memory")
#define GW0(sa_, sb_) asm volatile("s_waitcnt vmcnt(0)" : "+v"(sa_[0]), "+v"(sa_[1]), "+v"(sa_[2]), "+v"(sa_[3]), "+v"(sb_[0]), "+v"(sb_[1]), "+v"(sb_[2]), "+v"(sb_[3]) : : "memory")
#define ST(sa_, sb_, buf, k0)                                                                       \
  {                                                                                                 \
    if (KSCALE) {                                                                                   \
      const float4 s0 = *(const float4*)(kscale + (k0) + lkc * 8);                                  \
      const float4 s1 = *(const float4*)(kscale + (k0) + lkc * 8 + 4);                              \
      _Pragma("unroll") for (int i = 0; i < 4; ++i) {                                               \
        u32x4 v = sb_[i];                                                                           \
        v.x = pack2(bf2f(v.x & 0xffffu) * s0.x, bf2f(v.x >> 16) * s0.y);                            \
        v.y = pack2(bf2f(v.y & 0xffffu) * s0.z, bf2f(v.y >> 16) * s0.w);                            \
        v.z = pack2(bf2f(v.z & 0xffffu) * s1.x, bf2f(v.z >> 16) * s1.y);                            \
        v.w = pack2(bf2f(v.w & 0xffffu) * s1.z, bf2f(v.w >> 16) * s1.w);                            \
        sb_[i] = v;                                                                                 \
      }                                                                                             \
    }                                                                                               \
    unsigned char* sa__ = smem + (buf) * 36864;                                                     \
    unsigned char* sb__ = sa__ + 18432;                                                             \
    _Pragma("unroll") for (int i = 0; i < 4; ++i) {                                                 \
      *(u32x4*)(sa__ + (lrow + 32 * i) * 144 + lkc * 16) = sa_[i];                                  \
      *(u32x4*)(sb__ + (lrow + 32 * i) * 144 + lkc * 16) = sb_[i];                                  \
    }                                                                                               \
  }
#define COMPUTE(buf)                                                                                                          \
  {                                                                                                                           \
    const unsigned char* sa = smem + (buf) * 36864;                                                                           \
    const unsigned char* sb = sa + 18432;                                                                                     \
    _Pragma("unroll") for (int ks = 0; ks < 4; ++ks) {                                                                        \
      bf16x8 af[2], bfr[2];                                                                                                   \
      _Pragma("unroll") for (int mt = 0; mt < 2; ++mt) af[mt] = *(const bf16x8*)(sa + (wm * 64 + mt * 32 + r) * 144 + ks * 32 + h * 16);  \
      _Pragma("unroll") for (int nt = 0; nt < 2; ++nt) bfr[nt] = *(const bf16x8*)(sb + (wn * 64 + nt * 32 + r) * 144 + ks * 32 + h * 16); \
      _Pragma("unroll") for (int mt = 0; mt < 2; ++mt)                                                                        \
        _Pragma("unroll") for (int nt = 0; nt < 2; ++nt) acc[mt][nt] = MFMA32(af[mt], bfr[nt], acc[mt][nt]);                  \
    }                                                                                                                         \
  }
  GL(a0, b0, 0);
  GL(a1, b1, 64);
  GW8(a0, b0);
  ST(a0, b0, 0, 0);
  __syncthreads();
  for (int kt = 0; kt < KT; kt += 2) {
    { const int kn = kt + 2 < KT ? kt + 2 : KT - 1; GL(a0, b0, kn * 64); }
    COMPUTE(0);
    GW8(a1, b1);
    ST(a1, b1, 1, (kt + 1) * 64);
    __syncthreads();
    { const int kn = kt + 3 < KT ? kt + 3 : KT - 1; GL(a1, b1, kn * 64); }
    COMPUTE(1);
    GW8(a0, b0);
    { const int kn = kt + 2 < KT ? kt + 2 : KT - 1; ST(a0, b0, 0, kn * 64); }
    __syncthreads();
  }
  GW0(a1, b1);
#undef GL
#undef GW8
#undef GW0
#undef ST
#undef COMPUTE
}

DI void gemm192_mainloop(f32x16 (&acc)[3][2], const bf16_t* __restrict__ A, int lda, const bf16_t* __restrict__ B, int ldb, int K,
                         unsigned char* smem) {
  const int tid = tid_(), lane = tid & 63, wave = tid >> 6;
  const int wm = wave >> 1, wn = wave & 1, r = lane & 31, h = lane >> 5;
  const int lrow = tid >> 2, lkc = tid & 3;
  const bf16_t* ga = A + (size_t)lrow * lda + lkc * 8;
  const bf16_t* gb = B + (size_t)lrow * ldb + lkc * 8;
  u32x4 a0[3], b0[2], a1[3], b1[2];
  const int KT = K >> 5;
#define GL(sa_, sb_, k0)                                                                            \
  {                                                                                                 \
    _Pragma("unroll") for (int i = 0; i < 3; ++i) sa_[i] = gld16(ga + (size_t)(64 * i) * lda + (k0));  \
    _Pragma("unroll") for (int i = 0; i < 2; ++i) sb_[i] = gld16(gb + (size_t)(64 * i) * ldb + (k0));  \
  }
#define GW5(sa_, sb_) asm volatile("s_waitcnt vmcnt(5)" : "+v"(sa_[0]), "+v"(sa_[1]), "+v"(sa_[2]), "+v"(sb_[0]), "+v"(sb_[1]) : : "memory")
#define GW0(sa_, sb_) asm volatile("s_waitcnt vmcnt(0)" : "+v"(sa_[0]), "+v"(sa_[1]), "+v"(sa_[2]), "+v"(sb_[0]), "+v"(sb_[1]) : : "memory")
#define ST(sa_, sb_, buf)                                                                           \
  {                                                                                                 \
    unsigned char* sa__ = smem + (buf) * 25600;                                                     \
    unsigned char* sb__ = sa__ + 15360;                                                             \
    _Pragma("unroll") for (int i = 0; i < 3; ++i) *(u32x4*)(sa__ + (lrow + 64 * i) * 80 + lkc * 16) = sa_[i];  \
    _Pragma("unroll") for (int i = 0; i < 2; ++i) *(u32x4*)(sb__ + (lrow + 64 * i) * 80 + lkc * 16) = sb_[i];  \
  }
#define COMPUTE(buf)                                                                                                          \
  {                                                                                                                           \
    const unsigned char* sa = smem + (buf) * 25600;                                                                           \
    const unsigned char* sb = sa + 15360;                                                                                     \
    _Pragma("unroll") for (int ks = 0; ks < 2; ++ks) {                                                                        \
      bf16x8 af[3], bfr[2];                                                                                                   \
      _Pragma("unroll") for (int mt = 0; mt < 3; ++mt) af[mt] = *(const bf16x8*)(sa + (wm * 96 + mt * 32 + r) * 80 + ks * 32 + h * 16);   \
      _Pragma("unroll") for (int nt = 0; nt < 2; ++nt) bfr[nt] = *(const bf16x8*)(sb + (wn * 64 + nt * 32 + r) * 80 + ks * 32 + h * 16);  \
      _Pragma("unroll") for (int mt = 0; mt < 3; ++mt)                                                                        \
        _Pragma("unroll") for (int nt = 0; nt < 2; ++nt) acc[mt][nt] = MFMA32(af[mt], bfr[nt], acc[mt][nt]);                  \
    }                                                                                                                         \
  }
  GL(a0, b0, 0);
  GL(a1, b1, 32);
  GW5(a0, b0);
  ST(a0, b0, 0);
  __syncthreads();
  for (int kt = 0; kt < KT; kt += 2) {
    { const int kn = kt + 2 < KT ? kt + 2 : KT - 1; GL(a0, b0, kn * 32); }
    COMPUTE(0);
    GW5(a1, b1);
    ST(a1, b1, 1);
    __syncthreads();
    { const int kn = kt + 3 < KT ? kt + 3 : KT - 1; GL(a1, b1, kn * 32); }
    COMPUTE(1);
    GW5(a0, b0);
    ST(a0, b0, 0);
    __syncthreads();
  }
  GW0(a1, b1);
#undef GL
#undef GW5
#undef GW0
#undef ST
#undef COMPUTE
}
DI void acc_zero3(f32x16 (&acc)[3][2]) {
#pragma unroll
  for (int a = 0; a < 3; ++a)
#pragma unroll
    for (int b = 0; b < 2; ++b)
#pragma unroll
      for (int i = 0; i < 16; ++i) acc[a][b][i] = 0.f;
}
#define RW3(mt, i) (wm_ * 96 + (mt) * 32 + ((i) & 3) + 8 * ((i) >> 2) + 4 * hh_)

DI void acc_zero(f32x16 (&acc)[2][2]) {
#pragma unroll
  for (int a = 0; a < 2; ++a)
#pragma unroll
    for (int b = 0; b < 2; ++b)
#pragma unroll
      for (int i = 0; i < 16; ++i) acc[a][b][i] = 0.f;
}

#define EPI_VARS const int tid_e_ = tid_(), lane_ = tid_e_ & 63, wave_ = tid_e_ >> 6, wm_ = wave_ >> 1, wn_ = wave_ & 1, rr_ = lane_ & 31, hh_ = lane_ >> 5
#define RW(mt, i) (wm_ * 64 + (mt) * 32 + ((i) & 3) + 8 * ((i) >> 2) + 4 * hh_)
#define CL(nt) (wn_ * 64 + (nt) * 32 + rr_)

DI void convert_tile(const float* __restrict__ src, int nsrc, int K, bf16_t* __restrict__ dst, int kt, int ntile, int maptype, unsigned char* smem) {
  float* tile = (float*)smem;
  const int tid = tid_(), tx = tid & 63, ty = tid >> 6;
  const int np = ntile * 64 + tx;
  int sc;
  if (maptype == 0) sc = np;
  else if (maptype == 1) sc = np < 6144 ? np : (np < 9216 ? np + 16 : (np < 9232 ? 6144 + (np - 9216) : -1));
  else { const int g = np >> 6, w = np & 63; sc = w < 32 ? g * 32 + w : 2816 + g * 32 + (w - 32); }
  __syncthreads();
#pragma unroll
  for (int i = 0; i < 16; ++i) {
    const int ky = ty + 4 * i;
    tile[ky * 65 + tx] = sc >= 0 ? src[(size_t)(kt * 64 + ky) * nsrc + sc] : 0.f;
  }
  __syncthreads();
#pragma unroll
  for (int i = 0; i < 2; ++i) {
    const int id = tid + 256 * i, nrow = id >> 3, kc = id & 7;
    uint4 v;
    v.x = pack2(tile[(kc * 8 + 0) * 65 + nrow], tile[(kc * 8 + 1) * 65 + nrow]);
    v.y = pack2(tile[(kc * 8 + 2) * 65 + nrow], tile[(kc * 8 + 3) * 65 + nrow]);
    v.z = pack2(tile[(kc * 8 + 4) * 65 + nrow], tile[(kc * 8 + 5) * 65 + nrow]);
    v.w = pack2(tile[(kc * 8 + 6) * 65 + nrow], tile[(kc * 8 + 7) * 65 + nrow]);
    *(uint4*)(dst + (size_t)(ntile * 64 + nrow) * K + kt * 64 + kc * 8) = v;
  }
}

DI void convert_layer(const Params& P, int l, unsigned char* smem) {
  unsigned char* slot = P.ws + (size_t)(l & 1) * SZ_SLOT;
  constexpr int T0 = 146 * 16, T1 = T0 + 16 * 32, T2 = T1 + 16 * 16, T3 = T2 + 16 * 16, T4 = T3 + 88 * 16, T5 = T4 + 16 * 44;
  for (int it = bid_(); it < T5; it += gridDim.x) {
    if (it < T0) convert_tile(P.w_in + (size_t)l * 1024 * 9232, 9232, 1024, (bf16_t*)(slot + WS_WIN), it & 15, it >> 4, 1, smem);
    else if (it < T1) { const int j = it - T0; convert_tile(P.w_a + (size_t)l * 2048 * 1024, 1024, 2048, (bf16_t*)(slot + WS_WA), j & 31, j >> 5, 0, smem); }
    else if (it < T2) { const int j = it - T1; convert_tile(P.w_b + (size_t)l * 1024 * 1024, 1024, 1024, (bf16_t*)(slot + WS_WB), j & 15, j >> 4, 0, smem); }
    else if (it < T3) { const int j = it - T2; convert_tile(P.w_out + (size_t)l * 1024 * 1024, 1024, 1024, (bf16_t*)(slot + WS_WO), j & 15, j >> 4, 0, smem); }
    else if (it < T4) { const int j = it - T3; convert_tile(P.w_f1 + (size_t)l * 1024 * 5632, 5632, 1024, (bf16_t*)(slot + WS_WF1), j & 15, j >> 4, 2, smem); }
    else { const int j = it - T4; convert_tile(P.w_f2 + (size_t)l * 2816 * 1024, 1024, 2816, (bf16_t*)(slot + WS_WF2), j % 44, j / 44, 0, smem); }
  }
}

DI void phase_setup(const Params& P, unsigned char* smem) {
  const int tid = tid_();
  convert_layer(P, 0, smem);
  {
    bf16_t* BC = (bf16_t*)(P.ws + OFF_BC);
    bf16_t* A256 = (bf16_t*)(P.ws + OFF_A256);
    bf16_t* A1024 = (bf16_t*)(P.ws + OFF_A1024);
    const int total = 131072 + 131072 + 2097152;
    for (int e = bid_() * 256 + tid; e < total; e += gridDim.x * 256) {
      if (e < 131072) {
        const int n = e >> 8, k = e & 255, cs = n >> 8, ch = n & 255;
        const float ph = (float)((ch * k) & 255) * (1.f / 128.f);
        BC[e] = (bf16_t)f2bf(cs ? sinpif(ph) : cospif(ph));
      } else if (e < 262144) {
        const int e2 = e - 131072, m = e2 >> 9, k = e2 & 511, cs = k >> 8, p = k & 255;
        const float ph = (float)((m * p) & 255) * (1.f / 128.f);
        A256[e2] = (bf16_t)f2bf(cs ? -sinpif(ph) : cospif(ph));
      } else {
        const int e2 = e - 262144, m = e2 >> 11, k = e2 & 2047, cs = k >> 10, p = k & 1023;
        const int r1 = m >> 6, c1 = m & 63, r2 = p >> 6, c2 = p & 63;
        const float ph = (float)((4 * r1 * r2 + c1 * c2) & 63) * (1.f / 32.f);
        A1024[e2] = (bf16_t)f2bf(cs ? -sinpif(ph) : cospif(ph));
      }
    }
  }
  {
    float4* X = (float4*)(P.ws + OFF_XRES);
    const float4* xp = (const float4*)P.x_prompt;
    const float4* xs = (const float4*)P.x_sample;
    const int n4p = NCTX * 256, n4 = NTOK * 256;
    for (int e = bid_() * 256 + tid; e < n4; e += gridDim.x * 256) X[e] = e < n4p ? xp[e] : xs[e - n4p];
  }
  {
    float* MODP = (float*)(P.ws + OFF_MODP);
    float* red = (float*)smem;
    const int lane = tid & 63, w = tid >> 6;
    for (int it = bid_(); it < 8 * 4 * 24; it += gridDim.x) {
      const int nc = it % 24, l = (it / 24) & 3, ks = it / 96;
      float4 a[9];
#pragma unroll
      for (int j = 0; j < 9; ++j) a[j] = make_float4(0.f, 0.f, 0.f, 0.f);
      const int kb = ks * 128 + w * 32;
      const float* wp = P.w_mod + ((size_t)l * 1024 + kb) * 6144 + nc * 256 + lane * 4;
      for (int k = 0; k < 32; ++k) {
        const float4 wv = *(const float4*)(wp + (size_t)k * 6144);
#pragma unroll
        for (int j = 0; j < 9; ++j) {
          float cv = j == 0 ? P.c_ctx[kb + k] : P.c[(j - 1) * 1024 + kb + k];
          cv = cv * sigmoidf_(cv);
          a[j].x += cv * wv.x; a[j].y += cv * wv.y; a[j].z += cv * wv.z; a[j].w += cv * wv.w;
        }
      }
      __syncthreads();
#pragma unroll
      for (int j = 0; j < 9; ++j) *(float4*)(red + (w * 9 + j) * 256 + lane * 4) = a[j];
      __syncthreads();
      for (int e = tid; e < 9 * 256; e += 256) {
        const int j = e >> 8, n = e & 255;
        const float s = red[(0 * 9 + j) * 256 + n] + red[(1 * 9 + j) * 256 + n] + red[(2 * 9 + j) * 256 + n] + red[(3 * 9 + j) * 256 + n];
        MODP[((size_t)(ks * 4 + l) * 9 + j) * 6144 + nc * 256 + n] = s;
      }
    }
  }
}

DI void phase_modreduce(const Params& P) {
  const float* MODP = (const float*)(P.ws + OFF_MODP);
  float* MOD = (float*)(P.ws + OFF_MOD);
  const int total = 4 * 9 * 6144;
  for (int e = bid_() * 256 + tid_(); e < total; e += gridDim.x * 256) {
    const int n = e % 6144, l = e / (9 * 6144);
    float s = P.b_mod[l * 6144 + n];
#pragma unroll
    for (int ks = 0; ks < 8; ++ks) s += MODP[(size_t)ks * total + e];
    MOD[e] = s;
  }
}

DI void phase_modulate0(const Params& P) {
  const float* MOD = (const float*)(P.ws + OFF_MOD);
  const float4* X = (const float4*)(P.ws + OFF_XRES);
  uint2* H = (uint2*)(P.ws + OFF_HMOD);
  for (int e = bid_() * 256 + tid_(); e < NTOK * 256; e += gridDim.x * 256) {
    const int tok = e >> 8, n = (e & 255) * 4;
    const float* m = MOD + (size_t)mod_index(tok) * 6144;
    const float4 x = X[e];
    const float4 sh = *(const float4*)(m + n), sc = *(const float4*)(m + 1024 + n);
    uint2 o;
    o.x = pack2(x.x * (1.f + sc.x) + sh.x, x.y * (1.f + sc.y) + sh.y);
    o.y = pack2(x.z * (1.f + sc.z) + sh.z, x.w * (1.f + sc.w) + sh.w);
    H[e] = o;
  }
}

DI void phase_gemm_in(const Params& P, int l, unsigned char* smem) {
  const bf16_t* H = (const bf16_t*)(P.ws + OFF_HMOD);
  const bf16_t* W = (const bf16_t*)(P.ws + (size_t)(l & 1) * SZ_SLOT + WS_WIN);
  bf16_t* Q = (bf16_t*)(P.ws + OFF_Q);
  bf16_t* Kn = (bf16_t*)(P.ws + OFF_K);
  bf16_t* KT = (bf16_t*)(P.ws + OFF_KT);
  bf16_t* VT = (bf16_t*)(P.ws + OFF_VT);
  bf16_t* VTC = (bf16_t*)(P.ws + OFF_VTC);
  bf16_t* OG = (bf16_t*)(P.ws + OFF_OG);
  bf16_t* UF = (bf16_t*)(P.ws + OFF_UF);
  bf16_t* GA = (bf16_t*)(P.ws + OFF_GA);
  bf16_t* GB = (bf16_t*)(P.ws + OFF_GB);
  float* GATES = (float*)(P.ws + OFF_GATES);
  for (int t = vblock(); t < 96 * 73; t += gridDim.x) {
    int mtile, ntile;
    tile_decode(t, 96, 73, mtile, ntile);
    const int m0 = mtile * 128, n0 = ntile * 128;
    f32x16 acc[2][2];
    acc_zero(acc);
    gemm_mainloop<false>(acc, H + (size_t)m0 * 1024, 1024, W + (size_t)n0 * 1024, 1024, 1024, nullptr, smem);
    EPI_VARS;
    if (ntile < 8 || (ntile >= 32 && ntile < 72)) {
      bf16_t* dst; int ld, cb; bool sg;
      if (ntile < 8) { dst = Q; ld = 1024; cb = n0; sg = false; }
      else if (ntile < 48) { dst = OG; ld = 2048; cb = n0 - 4096; sg = true; }
      else if (ntile < 56) { dst = UF; ld = 1024; cb = n0 - 6144; sg = false; }
      else if (ntile < 64) { dst = GA; ld = 1024; cb = n0 - 7168; sg = true; }
      else { dst = GB; ld = 1024; cb = n0 - 8192; sg = true; }
#pragma unroll
      for (int mt = 0; mt < 2; ++mt)
#pragma unroll
        for (int nt = 0; nt < 2; ++nt)
#pragma unroll
          for (int i = 0; i < 16; ++i) {
            float v = acc[mt][nt][i];
            if (sg) v = sigmoidf_(v);
            dst[(size_t)(m0 + RW(mt, i)) * ld + cb + CL(nt)] = (bf16_t)f2bf(v);
          }
    } else if (ntile < 16) {
      const int cb = n0 - 1024;
#pragma unroll
      for (int mt = 0; mt < 2; ++mt)
#pragma unroll
        for (int nt = 0; nt < 2; ++nt) {
#pragma unroll
          for (int i = 0; i < 16; ++i) { const int tk = m0 + RW(mt, i), kc2 = cb + CL(nt); Kn[((size_t)(tk >> 5) * 4 + (kc2 >> 8)) * 8192 + (tk & 31) * 256 + (kc2 & 255)] = (bf16_t)f2bf(acc[mt][nt][i] * 0.0625f); }
          if (m0 < NCTX) {
            const int kc = cb + CL(nt), hd = kc >> 8, d = kc & 255;
#pragma unroll
            for (int i4 = 0; i4 < 4; ++i4) {
              const int tok0 = m0 + RW(mt, 4 * i4), b = tok0 >> 8, s = tok0 & 255;
              uint2 v;
              v.x = pack2(acc[mt][nt][4 * i4] * 0.0625f, acc[mt][nt][4 * i4 + 1] * 0.0625f);
              v.y = pack2(acc[mt][nt][4 * i4 + 2] * 0.0625f, acc[mt][nt][4 * i4 + 3] * 0.0625f);
              *(uint2*)(KT + ((size_t)((b * 4 + hd) * 256 + d)) * 256 + s) = v;
            }
          }
        }
    } else if (ntile < 32) {
      const int cb = n0 - 2048;
#pragma unroll
      for (int mt = 0; mt < 2; ++mt)
#pragma unroll
        for (int nt = 0; nt < 2; ++nt) {
          const int vc = cb + CL(nt);
#pragma unroll
          for (int i4 = 0; i4 < 4; ++i4) {
            const int tok0 = m0 + RW(mt, 4 * i4);
            uint2 v;
            v.x = pack2(acc[mt][nt][4 * i4], acc[mt][nt][4 * i4 + 1]);
            v.y = pack2(acc[mt][nt][4 * i4 + 2], acc[mt][nt][4 * i4 + 3]);
            *(uint2*)(VT + ((size_t)(tok0 >> 5) * 2048 + vc) * 32 + (tok0 & 31)) = v;
            if (tok0 < NCTX) *(uint2*)(VTC + ((size_t)(tok0 >> 8) * 2048 + vc) * 256 + (tok0 & 255)) = v;
          }
        }
    } else {
      if (wn_ == 0 && rr_ < 16) {
        const int g = rr_;
        const float bg = P.b_gate[l * 16 + g];
        const bool isf = (g >> 2) & 1;
#pragma unroll
        for (int mt = 0; mt < 2; ++mt)
#pragma unroll
          for (int i = 0; i < 16; ++i) {
            float v = acc[mt][0][i] + bg;
            if (isf) v = logsigmoidf_(v);
            GATES[(size_t)(m0 + RW(mt, i)) * 16 + g] = v;
          }
      }
    }
  }
}

DI float wave_excl_sum(float v, int lane) {
  float x = v;
#pragma unroll
  for (int o = 1; o < 64; o <<= 1) { const float y = __shfl_up(x, o, 64); if (lane >= o) x += y; }
  return x - v;
}
DI float wave_excl_max(float v, int lane, float init) {
  float x = v;
#pragma unroll
  for (int o = 1; o < 64; o <<= 1) { const float y = __shfl_up(x, o, 64); if (lane >= o) x = fmaxf(x, y); }
  const float p = __shfl_up(x, 1, 64);
  return lane == 0 ? init : fmaxf(init, p);
}

template <int E>
DI void scan_wave(const Params& P, int l, int sid) {
  const int lane = tid_() & 63;
  const int dir = sid & 1, hd = (sid >> 1) & 3, seq = sid >> 3;
  const bool lat = seq >= 16;
  const int S = E * 64;
  const int tok0 = lat ? NCTX + (seq - 16) * 1024 : seq * 256;
  const float* G = (const float*)(P.ws + OFF_GATES);
  const size_t gi = (size_t)(dir * 4 + hd) * NTOK;
  float* BETA = (float*)(P.ws + OFF_BETA) + gi;
  float* MM = (float*)(P.ws + OFF_MM) + gi;
  float* EMT = (float*)(P.ws + OFF_EMT) + gi;
  float* WFIN = (float*)(P.ws + OFF_WFIN) + gi;
  const int gi_i = dir * 8 + hd, gi_f = dir * 8 + 4 + hd;
  const float m0 = lat ? P.state_m[(((seq - 16) * 4 + l) * 2 + dir) * 4 + hd] : 0.f;
  float tot = 0.f;
#pragma unroll
  for (int e = 0; e < E; ++e) {
    const int j = lane * E + e, tok = dir == 0 ? tok0 + j : tok0 + S - 1 - j;
    tot += G[(size_t)tok * 16 + gi_f];
  }
  const float boff = wave_excl_sum(tot, lane);
  float b = boff, cmax = -3.0e38f;
#pragma unroll
  for (int e = 0; e < E; ++e) {
    const int j = lane * E + e, tok = dir == 0 ? tok0 + j : tok0 + S - 1 - j;
    b += G[(size_t)tok * 16 + gi_f];
    const float be = G[(size_t)tok * 16 + gi_i] - b;
    BETA[tok] = be;
    cmax = fmaxf(cmax, be);
  }
  float M = wave_excl_max(cmax, lane, m0);
  b = boff;
#pragma unroll
  for (int e = 0; e < E; ++e) {
    const int j = lane * E + e, tok = dir == 0 ? tok0 + j : tok0 + S - 1 - j;
    b += G[(size_t)tok * 16 + gi_f];
    const float be = G[(size_t)tok * 16 + gi_i] - b;
    M = fmaxf(M, be);
    MM[tok] = M;
    EMT[tok] = __expf(-b - M);
  }
  if (!lat) {
    const float Mlast = __shfl(M, 63, 64);
    const float Blast = __shfl(b, 63, 64);
    if (lane == 0) P.out[OUT_NEWM + (((seq * 4 + l) * 2 + dir) * 4 + hd)] = Blast + Mlast;
    b = boff;
  #pragma unroll
  for (int e = 0; e < E; ++e) {
      const int j = lane * E + e, tok = dir == 0 ? tok0 + j : tok0 + S - 1 - j;
      b += G[(size_t)tok * 16 + gi_f];
      const float be = G[(size_t)tok * 16 + gi_i] - b;
      WFIN[tok] = __expf(be - Mlast);
    }
  }
}

DI void convert_c0(const Params& P, int l) {
  bf16_t* C0T = (bf16_t*)(P.ws + OFF_C0T);
  const int total = 64 * 512 * 32;
  for (int e = bid_() * 256 + tid_(); e < total; e += gridDim.x * 256) {
    const int j = e & 31, v = (e >> 5) & 511, sp = e >> 14;
    const int b = sp >> 3, dir = (sp >> 2) & 1, hd = sp & 3;
    const float* src = P.state_C + ((size_t)((((b * 4 + l) * 2 + dir) * 4 + hd) * 512 + v)) * 256 + j * 8;
    const float4 x0 = *(const float4*)src, x1 = *(const float4*)(src + 4);
    uint4 o;
    o.x = pack2(x0.x, x0.y); o.y = pack2(x0.z, x0.w); o.z = pack2(x1.x, x1.y); o.w = pack2(x1.z, x1.w);
    *(uint4*)(C0T + ((size_t)((sp * 2 + (v >> 8)) * 8 + (j >> 2)) * 256 + (v & 255)) * 32 + (j & 3) * 8) = o;
  }
}

DI void phase_scan_four1(const Params& P, int l, unsigned char* smem) {
  convert_c0(P, l);
  const bf16_t* UF = (const bf16_t*)(P.ws + OFF_UF);
  const bf16_t* BC = (const bf16_t*)(P.ws + OFF_BC);
  bf16_t* TT = (bf16_t*)(P.ws + OFF_TT);
  for (int it = bid_(); it < 48 + 1536; it += gridDim.x) {
    if (it < 48) { const int sid = it * 4 + (tid_() >> 6); if (sid < 128) scan_wave<4>(P, l, sid); else scan_wave<16>(P, l, sid); continue; }
    const int t = it - 48, g = t / 384, rem = t - g * 384;
    int mtile, ntile;
    tile_decode(rem, 96, 4, mtile, ntile);
    const int m0 = mtile * 128, n0 = ntile * 128;
    f32x16 acc[2][2];
    acc_zero(acc);
    gemm_mainloop<false>(acc, UF + (size_t)m0 * 1024 + g * 256, 1024, BC + (size_t)n0 * 256, 256, 256, nullptr, smem);
    EPI_VARS;
#pragma unroll
    for (int mt = 0; mt < 2; ++mt)
#pragma unroll
      for (int nt = 0; nt < 2; ++nt) {
        const int n = n0 + CL(nt), cs = n >> 8, ch = n & 255;
#pragma unroll
        for (int i4 = 0; i4 < 4; ++i4) {
          const int tok0 = m0 + RW(mt, 4 * i4);
          uint2 v;
          v.x = pack2(acc[mt][nt][4 * i4], acc[mt][nt][4 * i4 + 1]);
          v.y = pack2(acc[mt][nt][4 * i4 + 2], acc[mt][nt][4 * i4 + 3]);
          size_t idx;
          if (tok0 < NCTX) idx = ((size_t)(((tok0 >> 8) * 4 + g) * 256 + ch)) * 512 + cs * 256 + (tok0 & 255);
          else { const int tl = tok0 - NCTX; idx = TT_LAT + ((size_t)(((tl >> 10) * 4 + g) * 256 + ch)) * 2048 + cs * 1024 + (tl & 1023); }
          *(uint2*)(TT + idx) = v;
        }
      }
  }
}

DI void mlstm_item(const Params& P, int l, int seq, int hd, int qb, int vh, unsigned char* smem) {
  const int tid = tid_(), lane = tid & 63, w = tid >> 6, c = lane & 15, q = lane >> 4;
  const bool lat = seq >= 16;
  const int S = lat ? 1024 : 256;
  const int tok0 = lat ? NCTX + (seq - 16) * 1024 : seq * 256;
  const int bl = seq - 16;
  const bf16_t* Qg = (const bf16_t*)(P.ws + OFF_Q);
  const bf16_t* Kg = (const bf16_t*)(P.ws + OFF_K);
  const bf16_t* VT = (const bf16_t*)(P.ws + OFF_VT) + ((size_t)(tok0 >> 5) * 2048 + hd * 512 + vh * 256) * 32;
  unsigned char* sK = smem;
  unsigned char* sV = smem + 16896;
  const int t_loc = qb * 64 + w * 16 + c;
  const int tokq = tok0 + t_loc;
  bf16x8 qf[8];
  {
    const bf16_t* qp = Qg + (size_t)tokq * 1024 + hd * 256 + q * 8;
#pragma unroll
    for (int kk = 0; kk < 8; ++kk) qf[kk] = *(const bf16x8*)(qp + kk * 32);
#pragma unroll
    for (int kk = 0; kk < 8; ++kk) asm volatile("" : "+v"(qf[kk]));
  }
  __syncthreads();
  const int nkb = S >> 5;
  const size_t rowbase = (size_t)(tok0 + qb * 64 + w * 16 + 4 * q) * 2048 + hd * 512 + vh * 256 + c;
  const bf16_t* kld = Kg + ((size_t)(tok0 >> 5) * 4 + hd) * 8192 + tid * 8;
  unsigned char* ksd = sK + (tid >> 5) * 528 + (tid & 31) * 16;
  const bf16_t* vld = VT + tid * 8;
  unsigned char* vsd = sV + (tid >> 2) * 80 + (tid & 3) * 16;
  u32x4 st[8], bt[2], btn[2];
#define STWAIT() asm volatile("s_waitcnt vmcnt(0)" : "+v"(st[0]), "+v"(st[1]), "+v"(st[2]), "+v"(st[3]), "+v"(st[4]), "+v"(st[5]), "+v"(st[6]), "+v"(st[7]), "+v"(btn[0]), "+v"(btn[1]) : : "memory")
#define ISSUE_KV(kb_)                                                                      \
  {                                                                                        \
    const bf16_t* kp_ = kld + (size_t)(kb_) * 4 * 8192;                                    \
    const bf16_t* vp_ = vld + (size_t)(kb_) * 2048 * 32;                                   \
    _Pragma("unroll") for (int i = 0; i < 4; ++i) st[i] = gld16(kp_ + i * 2048);           \
    _Pragma("unroll") for (int i = 0; i < 4; ++i) st[4 + i] = gld16(vp_ + i * 2048);       \
    btn[0] = gld16(BETA + (kb_) * 32);                                                     \
    btn[1] = gld16(BETA + (kb_) * 32 + 16);                                                \
  }
#define STORE_KV()                                                                         \
  {                                                                                        \
    _Pragma("unroll") for (int i = 0; i < 4; ++i) *(u32x4*)(ksd + i * 8 * 528) = st[i];    \
    _Pragma("unroll") for (int i = 0; i < 4; ++i) *(u32x4*)(vsd + i * 64 * 80) = st[4 + i];\
    bt[0] = btn[0]; bt[1] = btn[1];                                                        \
  }
#define ISSUE_C0(kk_) { _Pragma("unroll") for (int i = 0; i < 4; ++i) st[4 + i] = gld16(C0 + (kk_) * 8192 + i * 2048); }
#define STORE_C0() { _Pragma("unroll") for (int i = 0; i < 4; ++i) *(u32x4*)(vsd + i * 64 * 80) = st[4 + i]; }
#pragma unroll 1
  for (int dir = 0; dir < 2; ++dir) {
    f32x4 acc[16];
#pragma unroll
    for (int n = 0; n < 16; ++n) acc[n] = (f32x4){0.f, 0.f, 0.f, 0.f};
    float den = 0.f;
    const size_t gi = (size_t)(dir * 4 + hd) * NTOK;
    const float* BETA = (const float*)(P.ws + OFF_BETA) + gi + tok0 + 4 * q;
    const float Mt = ((const float*)(P.ws + OFF_MM))[gi + tokq];
    const float emt = ((const float*)(P.ws + OFF_EMT))[gi + tokq];
    const int kb_lo = dir == 0 ? 0 : 2 * qb;
    const int kb_hi = dir == 0 ? 2 * qb + 1 : nkb - 1;
    asm volatile("" : : "v"(Mt), "v"(emt));
    btn[0] = btn[1] = (u32x4){0u, 0u, 0u, 0u};
    st[0] = st[1] = st[2] = st[3] = (u32x4){0u, 0u, 0u, 0u};
    if (lat) {
      const int sidx = ((bl * 4 + l) * 2 + dir) * 4 + hd;
      const float inter = __expf(P.state_m[sidx] - Mt);
      const bf16_t* C0 = (const bf16_t*)(P.ws + OFF_C0T) + ((size_t)(((bl * 2 + dir) * 4 + hd) * 2 + vh) * 8) * 8192 + tid * 8;
      float* sN = (float*)(smem + 71168);
      float sdot = 0.f;
      __syncthreads();
      {
        const float nv = P.state_n[(size_t)sidx * 256 + tid];
        sN[tid] = nv;
      }
      asm volatile("" : : "v"(inter));
      const float* n0p = sN + q * 8;
      ISSUE_C0(0);
      STWAIT();
      STORE_C0();
      __syncthreads();
#pragma unroll
      for (int kk = 0; kk < 8; ++kk) {
        const int kn = kk < 7 ? kk + 1 : 7;
        ISSUE_C0(kn);
        const bf16x8 qk = qf[kk];
#pragma unroll
        for (int e = 0; e < 8; ++e) sdot += bf2f((unsigned)(unsigned short)qk[e]) * n0p[kk * 32 + e];
        {
          bf16x8 fb[2][4];
          const unsigned char* vb_ = sV + c * 80 + q * 16;
#pragma unroll
          for (int j = 0; j < 4; ++j) fb[0][j] = *(const bf16x8*)(vb_ + j * 16 * 80);
#pragma unroll
          for (int g = 0; g < 4; ++g) {
            if (g < 3) {
#pragma unroll
              for (int j = 0; j < 4; ++j) fb[(g + 1) & 1][j] = *(const bf16x8*)(vb_ + ((g + 1) * 4 + j) * 16 * 80);
            }
#pragma unroll
            for (int j = 0; j < 4; ++j) acc[g * 4 + j] = MFMA16(qk, fb[g & 1][j], acc[g * 4 + j]);
            __builtin_amdgcn_sched_barrier(0);
          }
        }
        STWAIT();
        __syncthreads();
        STORE_C0();
        __syncthreads();
      }
      float it_[4];
#pragma unroll
      for (int j = 0; j < 4; ++j) it_[j] = __shfl(inter, 4 * q + j, 64);
#pragma unroll
      for (int n = 0; n < 16; ++n)
#pragma unroll
        for (int j = 0; j < 4; ++j) acc[n][j] *= it_[j];
      den = inter * sdot;
    }
    __syncthreads();
    ISSUE_KV(kb_lo);
    STWAIT();
    STORE_KV();
    __syncthreads();
#pragma unroll 1
    for (int kb = kb_lo; kb <= kb_hi; ++kb) {
      const int kbn = kb < kb_hi ? kb + 1 : kb_hi;
      ISSUE_KV(kbn);
      const float bb0[4] = {__uint_as_float(bt[0].x), __uint_as_float(bt[0].y), __uint_as_float(bt[0].z), __uint_as_float(bt[0].w)};
      const float bb1[4] = {__uint_as_float(bt[1].x), __uint_as_float(bt[1].y), __uint_as_float(bt[1].z), __uint_as_float(bt[1].w)};
      f32x4 x0 = (f32x4){0.f, 0.f, 0.f, 0.f}, x1 = (f32x4){0.f, 0.f, 0.f, 0.f};
      {
        bf16x8 fa0[2], fa1[2];
        const unsigned char* k0_ = sK + c * 528 + q * 16;
        fa0[0] = *(const bf16x8*)(k0_); fa1[0] = *(const bf16x8*)(k0_ + 16 * 528);
#pragma unroll
        for (int kk = 0; kk < 8; ++kk) {
          if (kk < 7) {
            fa0[(kk + 1) & 1] = *(const bf16x8*)(k0_ + (kk + 1) * 64);
            fa1[(kk + 1) & 1] = *(const bf16x8*)(k0_ + 16 * 528 + (kk + 1) * 64);
          }
          x0 = MFMA16(fa0[kk & 1], qf[kk], x0);
          x1 = MFMA16(fa1[kk & 1], qf[kk], x1);
          __builtin_amdgcn_sched_barrier(0);
        }
      }
      float p0[4], p1[4];
      const bool diag = (kb >> 1) == qb;
      if (diag) {
#pragma unroll
        for (int j = 0; j < 4; ++j) {
          const int s0 = kb * 32 + 4 * q + j, s1 = s0 + 16;
          const bool ok0 = dir == 0 ? (s0 <= t_loc) : (s0 >= t_loc);
          const bool ok1 = dir == 0 ? (s1 <= t_loc) : (s1 >= t_loc);
          p0[j] = ok0 ? x0[j] * __expf(bb0[j] - Mt) : 0.f;
          p1[j] = ok1 ? x1[j] * __expf(bb1[j] - Mt) : 0.f;
          den += p0[j] + p1[j];
        }
      } else {
#pragma unroll
        for (int j = 0; j < 4; ++j) {
          p0[j] = x0[j] * __expf(bb0[j] - Mt);
          p1[j] = x1[j] * __expf(bb1[j] - Mt);
          den += p0[j] + p1[j];
        }
      }
      uint4 pu;
      pu.x = pack2(p0[0], p0[1]); pu.y = pack2(p0[2], p0[3]); pu.z = pack2(p1[0], p1[1]); pu.w = pack2(p1[2], p1[3]);
      const bf16x8 pa = __builtin_bit_cast(bf16x8, pu);
      {
        uint2 lo[2][4], hi[2][4];
        const unsigned char* vb_ = sV + c * 80 + q * 8;
#pragma unroll
        for (int j = 0; j < 4; ++j) { lo[0][j] = *(const uint2*)(vb_ + j * 16 * 80); hi[0][j] = *(const uint2*)(vb_ + j * 16 * 80 + 32); }
#pragma unroll
        for (int g = 0; g < 4; ++g) {
          if (g < 3) {
#pragma unroll
            for (int j = 0; j < 4; ++j) {
              lo[(g + 1) & 1][j] = *(const uint2*)(vb_ + ((g + 1) * 4 + j) * 16 * 80);
              hi[(g + 1) & 1][j] = *(const uint2*)(vb_ + ((g + 1) * 4 + j) * 16 * 80 + 32);
            }
          }
#pragma unroll
          for (int j = 0; j < 4; ++j) {
            uint4 vu;
            vu.x = lo[g & 1][j].x; vu.y = lo[g & 1][j].y; vu.z = hi[g & 1][j].x; vu.w = hi[g & 1][j].y;
            acc[g * 4 + j] = MFMA16(pa, __builtin_bit_cast(bf16x8, vu), acc[g * 4 + j]);
          }
          __builtin_amdgcn_sched_barrier(0);
        }
      }
      STWAIT();
      __syncthreads();
      STORE_KV();
      __syncthreads();
    }
    den += __shfl_xor(den, 16, 64);
    den += __shfl_xor(den, 32, 64);
    const float rinv = 1.f / fmaxf(fabsf(den), emt);
    float rj[4];
#pragma unroll
    for (int j = 0; j < 4; ++j) rj[j] = __shfl(rinv, 4 * q + j, 64);
    bf16_t* HS = (bf16_t*)(P.ws + OFF_H0) + rowbase;
    asm volatile("" : "+v"(HS));
    bf16_t* h0p = HS; bf16_t* h1p = HS + 2048; bf16_t* h2p = HS + 4096; bf16_t* h3p = HS + 6144;
    asm volatile("" : "+v"(h1p));
    asm volatile("" : "+v"(h2p));
    asm volatile("" : "+v"(h3p));
    if (dir == 0) {
#pragma unroll
      for (int n = 0; n < 16; ++n) {
        h0p[n * 16] = (bf16_t)f2bf(acc[n][0] * rj[0]);
        h1p[n * 16] = (bf16_t)f2bf(acc[n][1] * rj[1]);
        h2p[n * 16] = (bf16_t)f2bf(acc[n][2] * rj[2]);
        h3p[n * 16] = (bf16_t)f2bf(acc[n][3] * rj[3]);
      }
    } else {
#pragma unroll
      for (int n = 0; n < 16; ++n) {
        h0p[n * 16] = (bf16_t)f2bf(acc[n][0] * rj[0] + bf2f(h0p[n * 16]));
        h1p[n * 16] = (bf16_t)f2bf(acc[n][1] * rj[1] + bf2f(h1p[n * 16]));
        h2p[n * 16] = (bf16_t)f2bf(acc[n][2] * rj[2] + bf2f(h2p[n * 16]));
        h3p[n * 16] = (bf16_t)f2bf(acc[n][3] * rj[3] + bf2f(h3p[n * 16]));
        if ((n & 3) == 3) __builtin_amdgcn_sched_barrier(0);
      }
    }
  }
}

#undef STWAIT
#undef ISSUE_KV
#undef ISSUE_C0
#undef STORE_KV
#undef STORE_C0

DI void phase_hn(const Params& P, int l) {
  const bf16_t* HS = (const bf16_t*)(P.ws + OFF_H0);
  const bf16_t* OG = (const bf16_t*)(P.ws + OFF_OG);
  bf16_t* HN = (bf16_t*)(P.ws + OFF_HN);
  const int tidl_ = tid_(), lane = tidl_ & 63, w = tidl_ >> 6;
  for (int pr = bid_() * 4 + w; pr < NTOK * 4; pr += gridDim.x * 4) {
    const size_t base = (size_t)pr * 512 + lane * 8;
    const uint4 hv = *(const uint4*)(HS + base);
    const uint4 ov = *(const uint4*)(OG + base);
    const unsigned hu[4] = {hv.x, hv.y, hv.z, hv.w}, ou[4] = {ov.x, ov.y, ov.z, ov.w};
    float x[8];
    float s = 0.f;
#pragma unroll
    for (int i = 0; i < 4; ++i) { x[2 * i] = bf2f(hu[i] & 0xffffu); x[2 * i + 1] = bf2f(hu[i] >> 16); s += x[2 * i] + x[2 * i + 1]; }
#pragma unroll
    for (int o = 1; o < 64; o <<= 1) s += __shfl_xor(s, o, 64);
    const float mu = s * (1.f / 512.f);
    float vs = 0.f;
#pragma unroll
    for (int i = 0; i < 8; ++i) { const float d = x[i] - mu; vs += d * d; }
#pragma unroll
    for (int o = 1; o < 64; o <<= 1) vs += __shfl_xor(vs, o, 64);
    const float rs = rsqrtf(vs * (1.f / 512.f) + LN_EPS);
    const float* gp = P.mh_gain + l * 2048 + (pr & 3) * 512 + lane * 8;
    const float4 g0 = *(const float4*)gp, g1 = *(const float4*)(gp + 4);
    const float g[8] = {g0.x, g0.y, g0.z, g0.w, g1.x, g1.y, g1.z, g1.w};
    unsigned r[4];
#pragma unroll
    for (int i = 0; i < 4; ++i)
      r[i] = pack2((x[2 * i] - mu) * rs * g[2 * i] * bf2f(ou[i] & 0xffffu), (x[2 * i + 1] - mu) * rs * g[2 * i + 1] * bf2f(ou[i] >> 16));
    *(uint4*)(HN + base) = make_uint4(r[0], r[1], r[2], r[3]);
  }
}

DI void phase_mixers(const Params& P, int l, unsigned char* smem) {
  const bf16_t* VTC = (const bf16_t*)(P.ws + OFF_VTC);
  const bf16_t* KT = (const bf16_t*)(P.ws + OFF_KT);
  const bf16_t* Kn = (const bf16_t*)(P.ws + OFF_K);
  const bf16_t* TT = (const bf16_t*)(P.ws + OFF_TT);
  const bf16_t* A256 = (const bf16_t*)(P.ws + OFF_A256);
  const bf16_t* A1024 = (const bf16_t*)(P.ws + OFF_A1024);
  const float* WFIN = (const float*)(P.ws + OFF_WFIN);
  bf16_t* FB = (bf16_t*)(P.ws + OFF_FB);
  for (int it0 = bid_(); it0 < 1024 + 2304; it0 += gridDim.x) {
    if (it0 < 1024) { mlstm_item(P, l, 16 + (it0 >> 7), (it0 >> 5) & 3, (it0 >> 1) & 15, it0 & 1, smem); continue; }
    const int r = it0 - 1024;
    if (r >= 512 && r < 1024) { const int j = r - 512; mlstm_item(P, l, j >> 5, (j >> 3) & 3, (j >> 1) & 3, j & 1, smem); continue; }
    f32x16 acc[2][2];
    acc_zero(acc);
    if (r < 512) {
      const int j = r, sg = j >> 4, mtile = (j >> 1) & 7, ntile = j & 1;
      gemm_mainloop<false>(acc, A1024 + (size_t)mtile * 128 * 2048, 2048, TT + TT_LAT + ((size_t)sg * 256 + ntile * 128) * 2048, 2048, 2048, nullptr, smem);
      EPI_VARS;
      const int seq = sg >> 2, g = sg & 3;
#pragma unroll
      for (int mt = 0; mt < 2; ++mt)
#pragma unroll
        for (int nt = 0; nt < 2; ++nt)
#pragma unroll
          for (int i = 0; i < 16; ++i)
            FB[(size_t)(NCTX + seq * 1024 + mtile * 128 + RW(mt, i)) * 1024 + g * 256 + ntile * 128 + CL(nt)] = (bf16_t)f2bf(acc[mt][nt][i] * (1.f / 512.f));
    } else if (r >= 2048) {
      const int j = r - 2048, sg = j >> 2, mtile = (j >> 1) & 1, ntile = j & 1;
      gemm_mainloop<false>(acc, A256 + (size_t)mtile * 128 * 512, 512, TT + ((size_t)sg * 256 + ntile * 128) * 512, 512, 512, nullptr, smem);
      EPI_VARS;
      const int seq = sg >> 2, g = sg & 3;
#pragma unroll
      for (int mt = 0; mt < 2; ++mt)
#pragma unroll
        for (int nt = 0; nt < 2; ++nt)
#pragma unroll
          for (int i = 0; i < 16; ++i)
            FB[(size_t)(seq * 256 + mtile * 128 + RW(mt, i)) * 1024 + g * 256 + ntile * 128 + CL(nt)] = (bf16_t)f2bf(acc[mt][nt][i] * (1.f / 256.f));
    } else {
      const int j = r - 1024, bhd = j >> 3, mtile = (j >> 1) & 3, ntile = j & 1;
      const int b = bhd >> 3, hd = (bhd >> 1) & 3, dir = bhd & 1;
      const float* wf = WFIN + (size_t)(dir * 4 + hd) * NTOK + b * 256;
      gemm_mainloop<true>(acc, VTC + ((size_t)b * 2048 + hd * 512 + mtile * 128) * 256, 256, KT + ((size_t)(b * 4 + hd) * 256 + ntile * 128) * 256, 256, 256, wf, smem);
      EPI_VARS;
      const size_t sidx = (size_t)(((b * 4 + l) * 2 + dir) * 4 + hd);
      float* Co = P.out + OUT_NEWC + sidx * 512 * 256;
#pragma unroll
      for (int mt = 0; mt < 2; ++mt)
#pragma unroll
        for (int nt = 0; nt < 2; ++nt)
#pragma unroll
          for (int i = 0; i < 16; ++i) Co[(size_t)(mtile * 128 + RW(mt, i)) * 256 + ntile * 128 + CL(nt)] = acc[mt][nt][i];
      if (mtile == 0 && tid_e_ < 128) {
        const int d = ntile * 128 + tid_e_;
        float s = 0.f;
        for (int sp = 0; sp < 256; ++sp) s += wf[sp] * bf2f(Kn[((size_t)((b * 256 + sp) >> 5) * 4 + hd) * 8192 + (sp & 31) * 256 + d]);
        P.out[OUT_NEWN + sidx * 256 + d] = s;
      }
    }
  }
}

DI void phase_branch(const Params& P, int l, unsigned char* smem) {
  const unsigned char* slot = P.ws + (size_t)(l & 1) * SZ_SLOT;
  const bf16_t* HN = (const bf16_t*)(P.ws + OFF_HN);
  const bf16_t* FB = (const bf16_t*)(P.ws + OFF_FB);
  const bf16_t* WA = (const bf16_t*)(slot + WS_WA);
  const bf16_t* WB = (const bf16_t*)(slot + WS_WB);
  const bf16_t* GA = (const bf16_t*)(P.ws + OFF_GA);
  const bf16_t* GB = (const bf16_t*)(P.ws + OFF_GB);
  bf16_t* MG = (bf16_t*)(P.ws + OFF_MERGED);
  for (int t = vblock(); t < 64 * 8; t += gridDim.x) {
    int mtile, ntile;
    tile_decode(t, 64, 8, mtile, ntile);
    const int m0 = mtile * 192, n0 = ntile * 128;
    f32x16 acc[3][2];
    acc_zero3(acc);
    gemm192_mainloop(acc, HN + (size_t)m0 * 2048, 2048, WA + (size_t)n0 * 2048, 2048, 2048, smem);
    const bf16_t* GAb = GA + (size_t)m0 * 1024 + n0;
    const bf16_t* GBb = GB + (size_t)m0 * 1024 + n0;
    bf16_t* MGb = MG + (size_t)m0 * 1024 + n0;
    {
      EPI_VARS;
#pragma unroll
      for (int mt = 0; mt < 3; ++mt)
#pragma unroll
        for (int nt = 0; nt < 2; ++nt)
#pragma unroll
          for (int i = 0; i < 16; ++i) {
            const unsigned o = (unsigned)RW3(mt, i) * 1024u + CL(nt);
            MGb[o] = (bf16_t)f2bf(bf2f(GAb[o]) * acc[mt][nt][i]);
          }
    }
    acc_zero3(acc);
    gemm192_mainloop(acc, FB + (size_t)m0 * 1024, 1024, WB + (size_t)n0 * 1024, 1024, 1024, smem);
    EPI_VARS;
#pragma unroll
    for (int mt = 0; mt < 3; ++mt)
#pragma unroll
      for (int nt = 0; nt < 2; ++nt)
#pragma unroll
        for (int i = 0; i < 16; ++i) {
          const unsigned o = (unsigned)RW3(mt, i) * 1024u + CL(nt);
          MGb[o] = (bf16_t)f2bf(bf2f(MGb[o]) + bf2f(GBb[o]) * acc[mt][nt][i]);
        }
  }
}

DI void phase_resid_gemm(const Params& P, int l, const bf16_t* A, int K, const bf16_t* W, int goff, unsigned char* smem) {
  const float* X = (const float*)(P.ws + OFF_XRES);
  const float* MOD = (const float*)(P.ws + OFF_MOD) + (size_t)l * 9 * 6144;
  float* PRE = (float*)(P.ws + OFF_PRELN);
  for (int t = vblock(); t < 64 * 8; t += gridDim.x) {
    int mtile, ntile;
    tile_decode(t, 64, 8, mtile, ntile);
    const int m0 = mtile * 192, n0 = ntile * 128;
    f32x16 acc[3][2];
    acc_zero3(acc);
    gemm192_mainloop(acc, A + (size_t)m0 * K, K, W + (size_t)n0 * K, K, K, smem);
    EPI_VARS;
    const float* Xb = X + (size_t)m0 * 1024 + n0;
    float* PREb = PRE + (size_t)m0 * 1024 + n0;
#pragma unroll
    for (int mt = 0; mt < 3; ++mt)
#pragma unroll
      for (int nt = 0; nt < 2; ++nt)
#pragma unroll
        for (int i = 0; i < 16; ++i) {
          const int row = RW3(mt, i);
          const unsigned o = (unsigned)row * 1024u + CL(nt);
          const float gv = MOD[(size_t)mod_index(m0 + row) * 6144 + goff + n0 + CL(nt)];
          PREb[o] = ALPHA * Xb[o] + gv * acc[mt][nt][i];
        }
  }
}

DI void phase_ln(const Params& P, const float* gain, const float* bias, float* xdst, const float* modn, int shoff, int scoff) {
  const float* PRE = (const float*)(P.ws + OFF_PRELN);
  bf16_t* H = (bf16_t*)(P.ws + OFF_HMOD);
  const int tidl_ = tid_(), lane = tidl_ & 63, w = tidl_ >> 6;
  for (int tok = bid_() * 4 + w; tok < NTOK; tok += gridDim.x * 4) {
    float4 v[4];
    float s = 0.f;
#pragma unroll
    for (int i = 0; i < 4; ++i) {
      v[i] = *(const float4*)(PRE + (size_t)tok * 1024 + (i * 64 + lane) * 4);
      s += v[i].x + v[i].y + v[i].z + v[i].w;
    }
#pragma unroll
    for (int o = 1; o < 64; o <<= 1) s += __shfl_xor(s, o, 64);
    const float mu = s * (1.f / 1024.f);
    float vs = 0.f;
#pragma unroll
    for (int i = 0; i < 4; ++i) {
      const float a = v[i].x - mu, b = v[i].y - mu, c = v[i].z - mu, d = v[i].w - mu;
      vs += a * a + b * b + c * c + d * d;
    }
#pragma unroll
    for (int o = 1; o < 64; o <<= 1) vs += __shfl_xor(vs, o, 64);
    const float rs = rsqrtf(vs * (1.f / 1024.f) + LN_EPS);
    const float* m = modn ? modn + (size_t)mod_index(tok) * 6144 : nullptr;
#pragma unroll
    for (int i = 0; i < 4; ++i) {
      const int n = (i * 64 + lane) * 4;
      const float4 g = *(const float4*)(gain + n), b = *(const float4*)(bias + n);
      float4 x;
      x.x = (v[i].x - mu) * rs * g.x + b.x; x.y = (v[i].y - mu) * rs * g.y + b.y;
      x.z = (v[i].z - mu) * rs * g.z + b.z; x.w = (v[i].w - mu) * rs * g.w + b.w;
      *(float4*)(xdst + (size_t)tok * 1024 + n) = x;
      if (m) {
        const float4 sh = *(const float4*)(m + shoff + n), sc = *(const float4*)(m + scoff + n);
        uint2 o;
        o.x = pack2(x.x * (1.f + sc.x) + sh.x, x.y * (1.f + sc.y) + sh.y);
        o.y = pack2(x.z * (1.f + sc.z) + sh.z, x.w * (1.f + sc.w) + sh.w);
        *(uint2*)(H + (size_t)tok * 1024 + n) = o;
      }
    }
  }
}

DI void phase_ffn_in(const Params& P, int l, unsigned char* smem) {
  const bf16_t* H = (const bf16_t*)(P.ws + OFF_HMOD);
  const bf16_t* W = (const bf16_t*)(P.ws + (size_t)(l & 1) * SZ_SLOT + WS_WF1);
  bf16_t* FF = (bf16_t*)(P.ws + OFF_FF);
  for (int t = vblock(); t < 96 * 44; t += gridDim.x) {
    int mtile, ntile;
    tile_decode(t, 96, 44, mtile, ntile);
    const int m0 = mtile * 128, n0 = ntile * 128;
    f32x16 acc[2][2];
    acc_zero(acc);
    gemm_mainloop<false>(acc, H + (size_t)m0 * 1024, 1024, W + (size_t)n0 * 1024, 1024, 1024, nullptr, smem);
    EPI_VARS;
    const int jc = (ntile * 2 + wn_) * 32 + rr_;
#pragma unroll
    for (int mt = 0; mt < 2; ++mt)
#pragma unroll
      for (int i = 0; i < 16; ++i) {
        const float a = acc[mt][0][i], u = acc[mt][1][i];
        FF[(size_t)(m0 + RW(mt, i)) * DFF + jc] = (bf16_t)f2bf(a * sigmoidf_(a) * u);
      }
  }
}

template <int S>
DI void run_phase(const Params& P, int l, unsigned char* smem) {
  const unsigned char* slot = P.ws + (size_t)(l & 1) * SZ_SLOT;
  const float* MOD = (const float*)(P.ws + OFF_MOD);
  if constexpr (S == 0) phase_setup(P, smem);
  else if constexpr (S == 1) phase_modreduce(P);
  else if constexpr (S == 2) phase_modulate0(P);
  else if constexpr (S == 3) phase_gemm_in(P, l, smem);
  else if constexpr (S == 4) phase_scan_four1(P, l, smem);
  else if constexpr (S == 5) phase_mixers(P, l, smem);
  else if constexpr (S == 6) phase_hn(P, l);
  else if constexpr (S == 7) phase_branch(P, l, smem);
  else if constexpr (S == 8) phase_resid_gemm(P, l, (const bf16_t*)(P.ws + OFF_MERGED), 1024, (const bf16_t*)(slot + WS_WO), 2048, smem);
  else if constexpr (S == 9) {
    phase_ln(P, P.ln_gain + (l * 2 + 0) * 1024, P.ln_bias + (l * 2 + 0) * 1024, (float*)(P.ws + OFF_XRES), MOD + (size_t)l * 9 * 6144, 3072, 4096);
    if (l + 1 < 4) convert_layer(P, l + 1, smem);
  } else if constexpr (S == 10) phase_ffn_in(P, l, smem);
  else if constexpr (S == 11) phase_resid_gemm(P, l, (const bf16_t*)(P.ws + OFF_FF), DFF, (const bf16_t*)(slot + WS_WF2), 5120, smem);
  else {
    if (l == 3) phase_ln(P, P.ln_gain + (l * 2 + 1) * 1024, P.ln_bias + (l * 2 + 1) * 1024, P.out, nullptr, 0, 0);
    else phase_ln(P, P.ln_gain + (l * 2 + 1) * 1024, P.ln_bias + (l * 2 + 1) * 1024, (float*)(P.ws + OFF_XRES), MOD + (size_t)(l + 1) * 9 * 6144, 0, 1024);
  }
}

#if !ONE_LAUNCH
template <int S>
__global__ void __launch_bounds__(256, 2) k_phase(Params P, int l) {
  __shared__ __attribute__((aligned(16))) unsigned char smem[SMEM_BYTES];
  run_phase<S>(P, l, smem);
}

#endif
#define XB_TMO      128
#define XB_XCNT(j)  (256  + 64 * (j))
#define XB_XSUB(j)  (1280 + 64 * (j))
#define XB_XGEN(j)  (2304 + 64 * (j))
#define XB_TOP      3328
#define XB_TOPGEN   3392
#define XCD_BAR_WORDS 3456
#define XB_SPIN_CAP (1u << 20)
#define LAS __attribute__((address_space(3)))
DI unsigned xb_ld(unsigned* p) { return __hip_atomic_load(p, __ATOMIC_RELAXED, __HIP_MEMORY_SCOPE_AGENT); }
DI unsigned xb_add(unsigned* p, unsigned v) { return __hip_atomic_fetch_add(p, v, __ATOMIC_RELAXED, __HIP_MEMORY_SCOPE_AGENT); }
DI unsigned xb_xcc_id() { return (unsigned)__builtin_amdgcn_s_getreg((3 << 11) | 20) & 0xFu; }
#define XB_SPIN(cond, bar) do { unsigned _sp = 0; while (cond) { __builtin_amdgcn_s_sleep(1); \
    if ((++_sp & 255u) == 0u) { if (xb_ld(&(bar)[XB_TMO])) break; if (_sp > XB_SPIN_CAP) { atomicAdd(&(bar)[XB_TMO], 1u); break; } } } } while (0)
DI void xcd_barrier_complete(unsigned* bar, unsigned x, unsigned& nloc, unsigned& nx) {
  const unsigned G = gridDim.x;
  unsigned sum, cnt, mine, sp = 0u;
  for (;;) {
    sum = 0u; cnt = 0u; mine = 0u;
#pragma unroll
    for (unsigned j = 0; j < 16; ++j) { const unsigned c = xb_ld(&bar[XB_XCNT(j)]); sum += c; cnt += (c > 0u) ? 1u : 0u; mine = (j == x) ? c : mine; }
    if (sum == G) break;
    __builtin_amdgcn_s_sleep(1);
    if ((++sp & 255u) == 0u) { if (xb_ld(&bar[XB_TMO])) break; if (sp > XB_SPIN_CAP) { atomicAdd(&bar[XB_TMO], 1u); break; } }
  }
  nloc = mine > 0u ? mine : 1u; nx = cnt > 0u ? cnt : 1u;
}
DI void xcd_barrier(unsigned* bar, volatile LAS unsigned* st) {
  asm volatile("s_waitcnt vmcnt(0)" ::: "memory");
  __syncthreads();
  if (threadIdx.x == 0) {
    const unsigned x = xb_xcc_id();
    __builtin_amdgcn_s_waitcnt(0);
    unsigned nloc = st[0], nx = st[1];
    if (nloc == 0u) { xcd_barrier_complete(bar, x, nloc, nx); st[0] = nloc; st[1] = nx; }
    const unsigned old = xb_add(&bar[XB_XSUB(x)], 1u);
    const unsigned gen = old / nloc;
    if (old + 1u == (gen + 1u) * nloc) {
      __builtin_amdgcn_fence(__ATOMIC_RELEASE, "agent");
      asm volatile("s_waitcnt vmcnt(0)" ::: "memory");
      const unsigned og = xb_add(&bar[XB_TOP], 1u);
      const unsigned tg = og / nx;
      if (og + 1u == (tg + 1u) * nx) xb_add(&bar[XB_TOPGEN], 1u);
      else XB_SPIN(xb_ld(&bar[XB_TOPGEN]) == tg, bar);
      __builtin_amdgcn_fence(__ATOMIC_ACQUIRE, "agent");
      xb_add(&bar[XB_XGEN(x)], 1u);
      asm volatile("s_waitcnt vmcnt(0)" ::: "memory");
    } else {
      XB_SPIN(xb_ld(&bar[XB_XGEN(x)]) == gen, bar);
      __builtin_amdgcn_fence(__ATOMIC_ACQUIRE, "agent");
      asm volatile("s_waitcnt vmcnt(0)" ::: "memory");
    }
  }
  __syncthreads();
}

#define GSYNC() xcd_barrier((unsigned*)(load_params().ws + OFF_BAR), xb_st)
DI Params load_params() {
  Params P{};
#if defined(__HIP_DEVICE_COMPILE__)
  typedef const unsigned long long __attribute__((address_space(4)))* KP;
  typedef float __attribute__((address_space(1)))* GF;
  KP kp = (KP)__builtin_amdgcn_kernarg_segment_ptr();
  asm volatile("" : "+s"(kp));
  P.x_prompt = (const float*)(GF)kp[0];
  P.x_sample = (const float*)(GF)kp[1];
  P.c = (const float*)(GF)kp[2];
  P.state_C = (const float*)(GF)kp[3];
  P.state_n = (const float*)(GF)kp[4];
  P.state_m = (const float*)(GF)kp[5];
  P.c_ctx = (const float*)(GF)kp[6];
  P.w_mod = (const float*)(GF)kp[7];
  P.b_mod = (const float*)(GF)kp[8];
  P.w_in = (const float*)(GF)kp[9];
  P.b_gate = (const float*)(GF)kp[10];
  P.mh_gain = (const float*)(GF)kp[11];
  P.w_a = (const float*)(GF)kp[12];
  P.w_b = (const float*)(GF)kp[13];
  P.w_out = (const float*)(GF)kp[14];
  P.ln_gain = (const float*)(GF)kp[15];
  P.ln_bias = (const float*)(GF)kp[16];
  P.w_f1 = (const float*)(GF)kp[17];
  P.w_f2 = (const float*)(GF)kp[18];
  P.out = (float*)(GF)kp[19];
  P.ws = (unsigned char*)(GF)kp[20];
#endif
  return P;
}
__global__ void __launch_bounds__(256, 2) fwd_kernel(Params Pk) {
  __shared__ __attribute__((aligned(16))) unsigned char smem[SMEM_BYTES];
  __shared__ uint4 xb_words;
  {
    unsigned* bar0 = (unsigned*)(load_params().ws + OFF_BAR);
    const unsigned x0 = xb_xcc_id();
    if (threadIdx.x == 0) {
      xb_words = make_uint4(0u, 0u, 0u, 0u);
      (void)xb_add(&bar0[XB_XCNT(x0)], 1u);
    }
  }
  __syncthreads();
  volatile LAS unsigned* xb_st = (volatile LAS unsigned*)&xb_words;
  run_phase<0>(load_params(), 0, smem);
  cg::this_grid().sync();
  run_phase<1>(load_params(), 0, smem); GSYNC();
  run_phase<2>(load_params(), 0, smem); GSYNC();
#pragma unroll 1
  for (int l = 0; l < 4; ++l) {
    run_phase<3>(load_params(), l, smem); GSYNC();
    run_phase<4>(load_params(), l, smem); GSYNC();
    run_phase<5>(load_params(), l, smem); GSYNC();
    run_phase<6>(load_params(), l, smem); GSYNC();
    run_phase<7>(load_params(), l, smem); GSYNC();
    run_phase<8>(load_params(), l, smem); GSYNC();
    run_phase<9>(load_params(), l, smem); GSYNC();
    run_phase<10>(load_params(), l, smem); GSYNC();
    run_phase<11>(load_params(), l, smem); GSYNC();
    run_phase<12>(load_params(), l, smem);
    if (l < 3) GSYNC();
  }
}

#if !ONE_LAUNCH
template <int S>
static void launch_phase(const Params& P, int l, int cus, hipStream_t stream) {
  int per_cu = 0;
  if (hipOccupancyMaxActiveBlocksPerMultiprocessor(&per_cu, k_phase<S>, 256, 0) != hipSuccess) per_cu = 1;
  if (per_cu > 2) per_cu = 2;
  if (per_cu < 1) per_cu = 1;
  int grid = cus * per_cu;
  grid -= grid % 8;
  hipLaunchKernelGGL(k_phase<S>, dim3(grid), dim3(256), 0, stream, P, l);
}

#endif
extern "C" void kernel_launch(void* const* d_in, const int* in_sizes, int n_in, void* d_out, int out_size, void* d_ws, size_t ws_size,
                              hipStream_t stream) {
  if (ws_size < WS_TOTAL) { fprintf(stderr, "workspace too small: %zu < %zu\n", ws_size, (size_t)WS_TOTAL); return; }
  Params P{};
  const float** pp = (const float**)&P;
  for (int i = 0; i < 19; ++i) pp[i] = (const float*)d_in[i];
  P.out = (float*)d_out;
  P.ws = (unsigned char*)d_ws;
  int dev = 0, cus = 256;
  if (hipGetDevice(&dev) != hipSuccess) dev = 0;
  if (hipDeviceGetAttribute(&cus, hipDeviceAttributeMultiprocessorCount, dev) != hipSuccess) cus = 256;
#if ONE_LAUNCH
  {
    static int grid_blocks = 0;
    if (!grid_blocks) {
      int per_cu = 0;
      if (hipOccupancyMaxActiveBlocksPerMultiprocessor(&per_cu, fwd_kernel, 256, 0) != hipSuccess) per_cu = 1;
      if (per_cu > 2) per_cu = 2;
      if (per_cu < 1) per_cu = 1;
      grid_blocks = cus * per_cu;
      grid_blocks -= grid_blocks % 8;
    }
    if (hipMemsetAsync((unsigned char*)d_ws + OFF_BAR, 0, 16384, stream) != hipSuccess) { fprintf(stderr, "memset of barrier words failed\n"); return; }
    void* args[] = {&P};
    hipError_t err = hipLaunchCooperativeKernel((void*)fwd_kernel, dim3(grid_blocks), dim3(256), args, 0, stream);
    if (err != hipSuccess) fprintf(stderr, "cooperative launch failed: %s (grid %d)\n", hipGetErrorString(err), grid_blocks);
    return;
  }
#endif
#if !ONE_LAUNCH
  launch_phase<0>(P, 0, cus, stream);
  launch_phase<1>(P, 0, cus, stream);
  launch_phase<2>(P, 0, cus, stream);
  for (int l = 0; l < 4; ++l) {
    launch_phase<3>(P, l, cus, stream);
    launch_phase<4>(P, l, cus, stream);
    launch_phase<5>(P, l, cus, stream);
    launch_phase<6>(P, l, cus, stream);
    launch_phase<7>(P, l, cus, stream);
    launch_phase<8>(P, l, cus, stream);
    launch_phase<9>(P, l, cus, stream);
    launch_phase<10>(P, l, cus, stream);
    launch_phase<11>(P, l, cus, stream);
    launch_phase<12>(P, l, cus, stream);
  }
#endif
}
```

```cpp
#include <hip/hip_runtime.h>
#include <hip/hip_cooperative_groups.h>
#include <cstdio>
#ifndef ONE_LAUNCH
#define ONE_LAUNCH 1
#endif
namespace cg = cooperative_groups;

typedef unsigned short bf16_t;
using bf16x8 = __attribute__((ext_vector_type(8))) short;
using f32x16 = __attribute__((ext_vector_type(16))) float;
using f32x4 = __attribute__((ext_vector_type(4))) float;
#define DI __device__ __forceinline__
#define MFMA32(a, b, c) __builtin_amdgcn_mfma_f32_32x32x16_bf16((a), (b), (c), 0, 0, 0)
#define MFMA16(a, b, c) __builtin_amdgcn_mfma_f32_16x16x32_bf16((a), (b), (c), 0, 0, 0)

constexpr int NTOK = 12288, NCTX = 4096;
constexpr int NINP = 9344;
constexpr int DFF = 2816;
constexpr float ALPHA = 1.6817928305074290f;
constexpr float LN_EPS = 1e-5f;

constexpr size_t SZ_WIN = (size_t)NINP * 1024 * 2, SZ_WA = 1024ull * 2048 * 2, SZ_WB = 1024ull * 1024 * 2, SZ_WO = SZ_WB,
                 SZ_WF1 = 5632ull * 1024 * 2, SZ_WF2 = 1024ull * 2816 * 2;
constexpr size_t WS_WIN = 0, WS_WA = WS_WIN + SZ_WIN, WS_WB = WS_WA + SZ_WA, WS_WO = WS_WB + SZ_WB, WS_WF1 = WS_WO + SZ_WO,
                 WS_WF2 = WS_WF1 + SZ_WF1, SZ_SLOT = WS_WF2 + SZ_WF2;
constexpr size_t OFF_BC = 2 * SZ_SLOT;
constexpr size_t OFF_A256 = OFF_BC + 512 * 256 * 2;
constexpr size_t OFF_A1024 = OFF_A256 + 256 * 512 * 2;
constexpr size_t OFF_MODP = OFF_A1024 + 1024ull * 2048 * 2;
constexpr size_t OFF_MOD = OFF_MODP + 8ull * 4 * 9 * 6144 * 4;
constexpr size_t OFF_XRES = OFF_MOD + 4ull * 9 * 6144 * 4;
constexpr size_t OFF_HMOD = OFF_XRES + (size_t)NTOK * 1024 * 4;
constexpr size_t OFF_FB = OFF_HMOD;
constexpr size_t OFF_Q = OFF_HMOD + (size_t)NTOK * 1024 * 2;
constexpr size_t OFF_MERGED = OFF_Q;
constexpr size_t OFF_K = OFF_Q + (size_t)NTOK * 1024 * 2;
constexpr size_t OFF_KT = OFF_K + (size_t)NTOK * 1024 * 2;
constexpr size_t OFF_VT = OFF_KT + 16ull * 4 * 256 * 256 * 2;
constexpr size_t OFF_OG = OFF_VT + (size_t)NTOK * 2048 * 2;
constexpr size_t OFF_FF = OFF_OG;
constexpr size_t OFF_UF = OFF_OG + (size_t)NTOK * 2048 * 2;
constexpr size_t OFF_GA = OFF_UF + (size_t)NTOK * 1024 * 2;
constexpr size_t OFF_GB = OFF_GA + (size_t)NTOK * 1024 * 2;
constexpr size_t OFF_GATES = OFF_GB + (size_t)NTOK * 1024 * 2;
constexpr size_t SZ_SC = 2ull * 4 * NTOK * 4;
constexpr size_t OFF_BETA = OFF_GATES + (size_t)NTOK * 16 * 4;
constexpr size_t OFF_MM = OFF_BETA + SZ_SC;
constexpr size_t OFF_EMT = OFF_MM + SZ_SC;
constexpr size_t OFF_WFIN = OFF_EMT + SZ_SC;
constexpr size_t OFF_H0 = OFF_WFIN + SZ_SC;
constexpr size_t OFF_TT = OFF_H0 + (size_t)NTOK * 2048 * 2;
constexpr size_t OFF_PRELN = OFF_TT;
constexpr size_t OFF_HN = OFF_TT + (size_t)NTOK * 2048 * 2;
constexpr size_t OFF_VTC = OFF_HN + (size_t)NTOK * 2048 * 2;
constexpr size_t OFF_C0T = OFF_VTC + 16ull * 2048 * 256 * 2;
constexpr size_t OFF_BAR = OFF_C0T + 64ull * 512 * 256 * 2;
constexpr size_t WS_TOTAL = OFF_BAR + 16384;
constexpr size_t VT_LAT = 16ull * 2048 * 256;
constexpr size_t TT_LAT = 16ull * 4 * 256 * 512;

constexpr size_t OUT_NEWC = (size_t)NTOK * 1024;
constexpr size_t OUT_NEWN = OUT_NEWC + 16ull * 4 * 2 * 4 * 512 * 256;
constexpr size_t OUT_NEWM = OUT_NEWN + 16ull * 4 * 2 * 4 * 256;

constexpr int SMEM_BYTES = 73728;

struct Params {
  const float *x_prompt, *x_sample, *c, *state_C, *state_n, *state_m, *c_ctx, *w_mod, *b_mod, *w_in, *b_gate, *mh_gain,
      *w_a, *w_b, *w_out, *ln_gain, *ln_bias, *w_f1, *w_f2;
  float* out;
  unsigned char* ws;
};

typedef unsigned u32x4 __attribute__((ext_vector_type(4)));
DI u32x4 gld16(const void* p) { u32x4 r; asm volatile("global_load_dwordx4 %0, %1, off" : "=&v"(r) : "v"(p) : "memory"); return r; }
DI unsigned f2bf(float x) { unsigned r; asm("v_cvt_pk_bf16_f32 %0, %1, %1" : "=v"(r) : "v"(x)); return r & 0xffffu; }
DI unsigned pack2(float a, float b) { unsigned r; asm("v_cvt_pk_bf16_f32 %0, %1, %2\n\ts_nop 1" : "=v"(r) : "v"(a), "v"(b)); return r; }
DI float bf2f(unsigned h) { return __uint_as_float(h << 16); }
DI float sigmoidf_(float x) { return 1.f / (1.f + __expf(-x)); }
DI float logsigmoidf_(float x) { return fminf(x, 0.f) - log1pf(__expf(-fabsf(x))); }
DI int mod_index(int tok) { return tok < NCTX ? 0 : 1 + ((tok - NCTX) >> 10); }
DI int tid_() { int t = threadIdx.x; asm volatile("" : "+v"(t)); return t; }
DI int bid_() { int b = blockIdx.x; asm volatile("" : "+s"(b)); return b; }
DI int vblock() { return bid_(); }

DI void tile_decode(int t, int MT, int NT, int& mt, int& nt) {
  const int per_sc = MT * 8;
  const int sc = t / per_sc;
  const int w = t - sc * per_sc;
  int ncols = NT - sc * 8; ncols = ncols > 8 ? 8 : ncols;
  const int per_sr = 8 * ncols;
  const int sr = w / per_sr;
  const int j = w - sr * per_sr;
  mt = sr * 8 + (j & 7);
  nt = sc * 8 + (j >> 3);
}

template <bool KSCALE>
DI void gemm_mainloop(f32x16 (&acc)[2][2], const bf16_t* __restrict__ A, int lda, const bf16_t* __restrict__ B, int ldb, int K,
                      const float* __restrict__ kscale, unsigned char* smem) {
  const int tid = tid_(), lane = tid & 63, wave = tid >> 6;
  const int wm = wave >> 1, wn = wave & 1, r = lane & 31, h = lane >> 5;
  const int lrow = tid >> 3, lkc = tid & 7;
  const bf16_t* ga = A + (size_t)lrow * lda + lkc * 8;
  const bf16_t* gb = B + (size_t)lrow * ldb + lkc * 8;
  u32x4 a0[4], b0[4], a1[4], b1[4];
  const int KT = K >> 6;
#define GL(sa_, sb_, k0)                                                                            \
  {                                                                                                 \
    _Pragma("unroll") for (int i = 0; i < 4; ++i) {                                                 \
      sa_[i] = gld16(ga + (size_t)(32 * i) * lda + (k0));                                           \
      sb_[i] = gld16(gb + (size_t)(32 * i) * ldb + (k0));                                           \
    }                                                                                               \
  }
#define GW8(sa_, sb_) asm volatile("s_waitcnt vmcnt(8)" : "+v"(sa_[0]), "+v"(sa_[1]), "+v"(sa_[2]), "+v"(sa_[3]), "+v"(sb_[0]), "+v"(sb_[1]), "+v"(sb_[2]), "+v"(sb_[3]) : : "memory")
#define GW0(sa_, sb_) asm volatile("s_waitcnt vmcnt(0)" : "+v"(sa_[0]), "+v"(sa_[1]), "+v"(sa_[2]), "+v"(sa_[3]), "+v"(sb_[0]), "+v"(sb_[1]), "+v"(sb_[2]), "+v"(sb_[3]) : : "memory")
#define ST(sa_, sb_, buf, k0)                                                                       \
  {                                                                                                 \
    if (KSCALE) {                                                                                   \
      const float4 s0 = *(const float4*)(kscale + (k0) + lkc * 8);                                  \
      const float4 s1 = *(const float4*)(kscale + (k0) + lkc * 8 + 4);                              \
      _Pragma("unroll") for (int i = 0; i < 4; ++i) {                                               \
        u32x4 v = sb_[i];                                                                           \
        v.x = pack2(bf2f(v.x & 0xffffu) * s0.x, bf2f(v.x >> 16) * s0.y);                            \
        v.y = pack2(bf2f(v.y & 0xffffu) * s0.z, bf2f(v.y >> 16) * s0.w);                            \
        v.z = pack2(bf2f(v.z & 0xffffu) * s1.x, bf2f(v.z >> 16) * s1.y);                            \
        v.w = pack2(bf2f(v.w & 0xffffu) * s1.z, bf2f(v.w >> 16) * s1.w);                            \
        sb_[i] = v;                                                                                 \
      }                                                                                             \
    }                                                                                               \
    unsigned char* sa__ = smem + (buf) * 36864;                                                     \
    unsigned char* sb__ = sa__ + 18432;                                                             \
    _Pragma("unroll") for (int i = 0; i < 4; ++i) {                                                 \
      *(u32x4*)(sa__ + (lrow + 32 * i) * 144 + lkc * 16) = sa_[i];                                  \
      *(u32x4*)(sb__ + (lrow + 32 * i) * 144 + lkc * 16) = sb_[i];                                  \
    }                                                                                               \
  }
#define COMPUTE(buf)                                                                                                          \
  {                                                                                                                           \
    const unsigned char* sa = smem + (buf) * 36864;                                                                           \
    const unsigned char* sb = sa + 18432;                                                                                     \
    _Pragma("unroll") for (int ks = 0; ks < 4; ++ks) {                                                                        \
      bf16x8 af[2], bfr[2];                                                                                                   \
      _Pragma("unroll") for (int mt = 0; mt < 2; ++mt) af[mt] = *(const bf16x8*)(sa + (wm * 64 + mt * 32 + r) * 144 + ks * 32 + h * 16);  \
      _Pragma("unroll") for (int nt = 0; nt < 2; ++nt) bfr[nt] = *(const bf16x8*)(sb + (wn * 64 + nt * 32 + r) * 144 + ks * 32 + h * 16); \
      _Pragma("unroll") for (int mt = 0; mt < 2; ++mt)                                                                        \
        _Pragma("unroll") for (int nt = 0; nt < 2; ++nt) acc[mt][nt] = MFMA32(af[mt], bfr[nt], acc[mt][nt]);                  \
    }                                                                                                                         \
  }
  GL(a0, b0, 0);
  GL(a1, b1, 64);
  GW8(a0, b0);
  ST(a0, b0, 0, 0);
  __syncthreads();
  for (int kt = 0; kt < KT; kt += 2) {
    { const int kn = kt + 2 < KT ? kt + 2 : KT - 1; GL(a0, b0, kn * 64); }
    COMPUTE(0);
    GW8(a1, b1);
    ST(a1, b1, 1, (kt + 1) * 64);
    __syncthreads();
    { const int kn = kt + 3 < KT ? kt + 3 : KT - 1; GL(a1, b1, kn * 64); }
    COMPUTE(1);
    GW8(a0, b0);
    { const int kn = kt + 2 < KT ? kt + 2 : KT - 1; ST(a0, b0, 0, kn * 64); }
    __syncthreads();
  }
  GW0(a1, b1);
#undef GL
#undef GW8
#undef GW0
#undef ST
#undef COMPUTE
}

DI void gemm192_mainloop(f32x16 (&acc)[3][2], const bf16_t* __restrict__ A, int lda, const bf16_t* __restrict__ B, int ldb, int K,
                         unsigned char* smem) {
  const int tid = tid_(), lane = tid & 63, wave = tid >> 6;
  const int wm = wave >> 1, wn = wave & 1, r = lane & 31, h = lane >> 5;
  const int lrow = tid >> 2, lkc = tid & 3;
  const bf16_t* ga = A + (size_t)lrow * lda + lkc * 8;
  const bf16_t* gb = B + (size_t)lrow * ldb + lkc * 8;
  u32x4 a0[3], b0[2], a1[3], b1[2];
  const int KT = K >> 5;
#define GL(sa_, sb_, k0)                                                                            \
  {                                                                                                 \
    _Pragma("unroll") for (int i = 0; i < 3; ++i) sa_[i] = gld16(ga + (size_t)(64 * i) * lda + (k0));  \
    _Pragma("unroll") for (int i = 0; i < 2; ++i) sb_[i] = gld16(gb + (size_t)(64 * i) * ldb + (k0));  \
  }
#define GW5(sa_, sb_) asm volatile("s_waitcnt vmcnt(5)" : "+v"(sa_[0]), "+v"(sa_[1]), "+v"(sa_[2]), "+v"(sb_[0]), "+v"(sb_[1]) : : "memory")
#define GW0(sa_, sb_) asm volatile("s_waitcnt vmcnt(0)" : "+v"(sa_[0]), "+v"(sa_[1]), "+v"(sa_[2]), "+v"(sb_[0]), "+v"(sb_[1]) : : "memory")
#define ST(sa_, sb_, buf)                                                                           \
  {                                                                                                 \
    unsigned char* sa__ = smem + (buf) * 25600;                                                     \
    unsigned char* sb__ = sa__ + 15360;                                                             \
    _Pragma("unroll") for (int i = 0; i < 3; ++i) *(u32x4*)(sa__ + (lrow + 64 * i) * 80 + lkc * 16) = sa_[i];  \
    _Pragma("unroll") for (int i = 0; i < 2; ++i) *(u32x4*)(sb__ + (lrow + 64 * i) * 80 + lkc * 16) = sb_[i];  \
  }
#define COMPUTE(buf)                                                                                                          \
  {                                                                                                                           \
    const unsigned char* sa = smem + (buf) * 25600;                                                                           \
    const unsigned char* sb = sa + 15360;                                                                                     \
    _Pragma("unroll") for (int ks = 0; ks < 2; ++ks) {                                                                        \
      bf16x8 af[3], bfr[2];                                                                                                   \
      _Pragma("unroll") for (int mt = 0; mt < 3; ++mt) af[mt] = *(const bf16x8*)(sa + (wm * 96 + mt * 32 + r) * 80 + ks * 32 + h * 16);   \
      _Pragma("unroll") for (int nt = 0; nt < 2; ++nt) bfr[nt] = *(const bf16x8*)(sb + (wn * 64 + nt * 32 + r) * 80 + ks * 32 + h * 16);  \
      _Pragma("unroll") for (int mt = 0; mt < 3; ++mt)                                                                        \
        _Pragma("unroll") for (int nt = 0; nt < 2; ++nt) acc[mt][nt] = MFMA32(af[mt], bfr[nt], acc[mt][nt]);                  \
    }                                                                                                                         \
  }
  GL(a0, b0, 0);
  GL(a1, b1, 32);
  GW5(a0, b0);
  ST(a0, b0, 0);
  __syncthreads();
  for (int kt = 0; kt < KT; kt += 2) {
    { const int kn = kt + 2 < KT ? kt + 2 : KT - 1; GL(a0, b0, kn * 32); }
    COMPUTE(0);
    GW5(a1, b1);
    ST(a1, b1, 1);
    __syncthreads();
    { const int kn = kt + 3 < KT ? kt + 3 : KT - 1; GL(a1, b1, kn * 32); }
    COMPUTE(1);
    GW5(a0, b0);
    ST(a0, b0, 0);
    __syncthreads();
  }
  GW0(a1, b1);
#undef GL
#undef GW5
#undef GW0
#undef ST
#undef COMPUTE
}
DI void acc_zero3(f32x16 (&acc)[3][2]) {
#pragma unroll
  for (int a = 0; a < 3; ++a)
#pragma unroll
    for (int b = 0; b < 2; ++b)
#pragma unroll
      for (int i = 0; i < 16; ++i) acc[a][b][i] = 0.f;
}
#define RW3(mt, i) (wm_ * 96 + (mt) * 32 + ((i) & 3) + 8 * ((i) >> 2) + 4 * hh_)

DI void acc_zero(f32x16 (&acc)[2][2]) {
#pragma unroll
  for (int a = 0; a < 2; ++a)
#pragma unroll
    for (int b = 0; b < 2; ++b)
#pragma unroll
      for (int i = 0; i < 16; ++i) acc[a][b][i] = 0.f;
}

#define EPI_VARS const int tid_e_ = tid_(), lane_ = tid_e_ & 63, wave_ = tid_e_ >> 6, wm_ = wave_ >> 1, wn_ = wave_ & 1, rr_ = lane_ & 31, hh_ = lane_ >> 5
#define RW(mt, i) (wm_ * 64 + (mt) * 32 + ((i) & 3) + 8 * ((i) >> 2) + 4 * hh_)
#define CL(nt) (wn_ * 64 + (nt) * 32 + rr_)

template <int MODE>
DI void store_tile_bf16(const f32x16 (&acc)[2][2], bf16_t* __restrict__ dst, int ld, unsigned char* smem) {
  EPI_VARS;
#pragma unroll
  for (int mt = 0; mt < 2; ++mt)
#pragma unroll
    for (int nt = 0; nt < 2; ++nt)
#pragma unroll
      for (int i = 0; i < 16; ++i) {
        float v = acc[mt][nt][i];
        if (MODE == 1) v = sigmoidf_(v);
        *(unsigned short*)(smem + RW(mt, i) * 272 + CL(nt) * 2) = (unsigned short)f2bf(v);
      }
  __syncthreads();
#pragma unroll
  for (int i = 0; i < 8; ++i) {
    const int row = (tid_e_ >> 4) + 16 * i, ch = tid_e_ & 15;
    const u32x4 x = *(const u32x4*)(smem + row * 272 + ch * 16);
    *(u32x4*)(dst + (size_t)row * ld + ch * 8) = x;
  }
  __syncthreads();
}

DI void convert_tile(const float* __restrict__ src, int nsrc, int K, bf16_t* __restrict__ dst, int kt, int ntile, int maptype, unsigned char* smem) {
  float* tile = (float*)smem;
  const int tid = tid_(), tx = tid & 63, ty = tid >> 6;
  const int np = ntile * 64 + tx;
  int sc;
  if (maptype == 0) sc = np;
  else if (maptype == 1) sc = np < 6144 ? np : (np < 9216 ? np + 16 : (np < 9232 ? 6144 + (np - 9216) : -1));
  else { const int g = np >> 6, w = np & 63; sc = w < 32 ? g * 32 + w : 2816 + g * 32 + (w - 32); }
  __syncthreads();
#pragma unroll
  for (int i = 0; i < 16; ++i) {
    const int ky = ty + 4 * i;
    tile[ky * 65 + tx] = sc >= 0 ? src[(size_t)(kt * 64 + ky) * nsrc + sc] : 0.f;
  }
  __syncthreads();
#pragma unroll
  for (int i = 0; i < 2; ++i) {
    const int id = tid + 256 * i, nrow = id >> 3, kc = id & 7;
    uint4 v;
    v.x = pack2(tile[(kc * 8 + 0) * 65 + nrow], tile[(kc * 8 + 1) * 65 + nrow]);
    v.y = pack2(tile[(kc * 8 + 2) * 65 + nrow], tile[(kc * 8 + 3) * 65 + nrow]);
    v.z = pack2(tile[(kc * 8 + 4) * 65 + nrow], tile[(kc * 8 + 5) * 65 + nrow]);
    v.w = pack2(tile[(kc * 8 + 6) * 65 + nrow], tile[(kc * 8 + 7) * 65 + nrow]);
    *(uint4*)(dst + (size_t)(ntile * 64 + nrow) * K + kt * 64 + kc * 8) = v;
  }
}

DI void convert_layer(const Params& P, int l, unsigned char* smem) {
  unsigned char* slot = P.ws + (size_t)(l & 1) * SZ_SLOT;
  constexpr int T0 = 146 * 16, T1 = T0 + 16 * 32, T2 = T1 + 16 * 16, T3 = T2 + 16 * 16, T4 = T3 + 88 * 16, T5 = T4 + 16 * 44;
  for (int it = bid_(); it < T5; it += gridDim.x) {
    if (it < T0) convert_tile(P.w_in + (size_t)l * 1024 * 9232, 9232, 1024, (bf16_t*)(slot + WS_WIN), it & 15, it >> 4, 1, smem);
    else if (it < T1) { const int j = it - T0; convert_tile(P.w_a + (size_t)l * 2048 * 1024, 1024, 2048, (bf16_t*)(slot + WS_WA), j & 31, j >> 5, 0, smem); }
    else if (it < T2) { const int j = it - T1; convert_tile(P.w_b + (size_t)l * 1024 * 1024, 1024, 1024, (bf16_t*)(slot + WS_WB), j & 15, j >> 4, 0, smem); }
    else if (it < T3) { const int j = it - T2; convert_tile(P.w_out + (size_t)l * 1024 * 1024, 1024, 1024, (bf16_t*)(slot + WS_WO), j & 15, j >> 4, 0, smem); }
    else if (it < T4) { const int j = it - T3; convert_tile(P.w_f1 + (size_t)l * 1024 * 5632, 5632, 1024, (bf16_t*)(slot + WS_WF1), j & 15, j >> 4, 2, smem); }
    else { const int j = it - T4; convert_tile(P.w_f2 + (size_t)l * 2816 * 1024, 1024, 2816, (bf16_t*)(slot + WS_WF2), j % 44, j / 44, 0, smem); }
  }
}

DI void phase_setup(const Params& P, unsigned char* smem) {
  const int tid = tid_();
  convert_layer(P, 0, smem);
  {
    bf16_t* BC = (bf16_t*)(P.ws + OFF_BC);
    bf16_t* A256 = (bf16_t*)(P.ws + OFF_A256);
    bf16_t* A1024 = (bf16_t*)(P.ws + OFF_A1024);
    const int total = 131072 + 131072 + 2097152;
    for (int e = bid_() * 256 + tid; e < total; e += gridDim.x * 256) {
      if (e < 131072) {
        const int n = e >> 8, k = e & 255, cs = n >> 8, ch = n & 255;
        const float ph = (float)((ch * k) & 255) * (1.f / 128.f);
        BC[e] = (bf16_t)f2bf(cs ? sinpif(ph) : cospif(ph));
      } else if (e < 262144) {
        const int e2 = e - 131072, m = e2 >> 9, k = e2 & 511, cs = k >> 8, p = k & 255;
        const float ph = (float)((m * p) & 255) * (1.f / 128.f);
        A256[e2] = (bf16_t)f2bf(cs ? -sinpif(ph) : cospif(ph));
      } else {
        const int e2 = e - 262144, m = e2 >> 11, k = e2 & 2047, cs = k >> 10, p = k & 1023;
        const int r1 = m >> 6, c1 = m & 63, r2 = p >> 6, c2 = p & 63;
        const float ph = (float)((4 * r1 * r2 + c1 * c2) & 63) * (1.f / 32.f);
        A1024[e2] = (bf16_t)f2bf(cs ? -sinpif(ph) : cospif(ph));
      }
    }
  }
  {
    float4* X = (float4*)(P.ws + OFF_XRES);
    const float4* xp = (const float4*)P.x_prompt;
    const float4* xs = (const float4*)P.x_sample;
    const int n4p = NCTX * 256, n4 = NTOK * 256;
    for (int e = bid_() * 256 + tid; e < n4; e += gridDim.x * 256) X[e] = e < n4p ? xp[e] : xs[e - n4p];
  }
  {
    float* MODP = (float*)(P.ws + OFF_MODP);
    float* red = (float*)smem;
    const int lane = tid & 63, w = tid >> 6;
    for (int it = bid_(); it < 8 * 4 * 24; it += gridDim.x) {
      const int nc = it % 24, l = (it / 24) & 3, ks = it / 96;
      float4 a[9];
#pragma unroll
      for (int j = 0; j < 9; ++j) a[j] = make_float4(0.f, 0.f, 0.f, 0.f);
      const int kb = ks * 128 + w * 32;
      const float* wp = P.w_mod + ((size_t)l * 1024 + kb) * 6144 + nc * 256 + lane * 4;
      for (int k = 0; k < 32; ++k) {
        const float4 wv = *(const float4*)(wp + (size_t)k * 6144);
#pragma unroll
        for (int j = 0; j < 9; ++j) {
          float cv = j == 0 ? P.c_ctx[kb + k] : P.c[(j - 1) * 1024 + kb + k];
          cv = cv * sigmoidf_(cv);
          a[j].x += cv * wv.x; a[j].y += cv * wv.y; a[j].z += cv * wv.z; a[j].w += cv * wv.w;
        }
      }
      __syncthreads();
#pragma unroll
      for (int j = 0; j < 9; ++j) *(float4*)(red + (w * 9 + j) * 256 + lane * 4) = a[j];
      __syncthreads();
      for (int e = tid; e < 9 * 256; e += 256) {
        const int j = e >> 8, n = e & 255;
        const float s = red[(0 * 9 + j) * 256 + n] + red[(1 * 9 + j) * 256 + n] + red[(2 * 9 + j) * 256 + n] + red[(3 * 9 + j) * 256 + n];
        MODP[((size_t)(ks * 4 + l) * 9 + j) * 6144 + nc * 256 + n] = s;
      }
    }
  }
}

DI void phase_modreduce(const Params& P) {
  const float* MODP = (const float*)(P.ws + OFF_MODP);
  float* MOD = (float*)(P.ws + OFF_MOD);
  const int total = 4 * 9 * 6144;
  for (int e = bid_() * 256 + tid_(); e < total; e += gridDim.x * 256) {
    const int n = e % 6144, l = e / (9 * 6144);
    float s = P.b_mod[l * 6144 + n];
#pragma unroll
    for (int ks = 0; ks < 8; ++ks) s += MODP[(size_t)ks * total + e];
    MOD[e] = s;
  }
}

DI void phase_modulate0(const Params& P) {
  const float* MOD = (const float*)(P.ws + OFF_MOD);
  const float4* X = (const float4*)(P.ws + OFF_XRES);
  uint2* H = (uint2*)(P.ws + OFF_HMOD);
  for (int e = bid_() * 256 + tid_(); e < NTOK * 256; e += gridDim.x * 256) {
    const int tok = e >> 8, n = (e & 255) * 4;
    const float* m = MOD + (size_t)mod_index(tok) * 6144;
    const float4 x = X[e];
    const float4 sh = *(const float4*)(m + n), sc = *(const float4*)(m + 1024 + n);
    uint2 o;
    o.x = pack2(x.x * (1.f + sc.x) + sh.x, x.y * (1.f + sc.y) + sh.y);
    o.y = pack2(x.z * (1.f + sc.z) + sh.z, x.w * (1.f + sc.w) + sh.w);
    H[e] = o;
  }
}

DI void phase_gemm_in(const Params& P, int l, unsigned char* smem) {
  const bf16_t* H = (const bf16_t*)(P.ws + OFF_HMOD);
  const bf16_t* W = (const bf16_t*)(P.ws + (size_t)(l & 1) * SZ_SLOT + WS_WIN);
  bf16_t* Q = (bf16_t*)(P.ws + OFF_Q);
  bf16_t* Kn = (bf16_t*)(P.ws + OFF_K);
  bf16_t* KT = (bf16_t*)(P.ws + OFF_KT);
  bf16_t* VT = (bf16_t*)(P.ws + OFF_VT);
  bf16_t* VTC = (bf16_t*)(P.ws + OFF_VTC);
  bf16_t* OG = (bf16_t*)(P.ws + OFF_OG);
  bf16_t* UF = (bf16_t*)(P.ws + OFF_UF);
  bf16_t* GA = (bf16_t*)(P.ws + OFF_GA);
  bf16_t* GB = (bf16_t*)(P.ws + OFF_GB);
  float* GATES = (float*)(P.ws + OFF_GATES);
  for (int t = vblock(); t < 96 * 73; t += gridDim.x) {
    int mtile, ntile;
    tile_decode(t, 96, 73, mtile, ntile);
    const int m0 = mtile * 128, n0 = ntile * 128;
    f32x16 acc[2][2];
    acc_zero(acc);
    gemm_mainloop<false>(acc, H + (size_t)m0 * 1024, 1024, W + (size_t)n0 * 1024, 1024, 1024, nullptr, smem);
    EPI_VARS;
    if (ntile < 8 || (ntile >= 32 && ntile < 72)) {
      bf16_t* dst; int ld, cb; bool sg;
      if (ntile < 8) { dst = Q; ld = 1024; cb = n0; sg = false; }
      else if (ntile < 48) { dst = OG; ld = 2048; cb = n0 - 4096; sg = true; }
      else if (ntile < 56) { dst = UF; ld = 1024; cb = n0 - 6144; sg = false; }
      else if (ntile < 64) { dst = GA; ld = 1024; cb = n0 - 7168; sg = true; }
      else { dst = GB; ld = 1024; cb = n0 - 8192; sg = true; }
      if (sg) store_tile_bf16<1>(acc, dst + (size_t)m0 * ld + cb, ld, smem);
      else store_tile_bf16<0>(acc, dst + (size_t)m0 * ld + cb, ld, smem);
    } else if (ntile < 16) {
      const int cb = n0 - 1024;
#pragma unroll
      for (int mt = 0; mt < 2; ++mt)
#pragma unroll
        for (int nt = 0; nt < 2; ++nt) {
#pragma unroll
          for (int i = 0; i < 16; ++i) { const int tk = m0 + RW(mt, i), kc2 = cb + CL(nt); Kn[((size_t)(tk >> 5) * 4 + (kc2 >> 8)) * 8192 + (tk & 31) * 256 + (kc2 & 255)] = (bf16_t)f2bf(acc[mt][nt][i] * 0.0625f); }
          if (m0 < NCTX) {
            const int kc = cb + CL(nt), hd = kc >> 8, d = kc & 255;
#pragma unroll
            for (int i4 = 0; i4 < 4; ++i4) {
              const int tok0 = m0 + RW(mt, 4 * i4), b = tok0 >> 8, s = tok0 & 255;
              uint2 v;
              v.x = pack2(acc[mt][nt][4 * i4] * 0.0625f, acc[mt][nt][4 * i4 + 1] * 0.0625f);
              v.y = pack2(acc[mt][nt][4 * i4 + 2] * 0.0625f, acc[mt][nt][4 * i4 + 3] * 0.0625f);
              *(uint2*)(KT + ((size_t)((b * 4 + hd) * 256 + d)) * 256 + s) = v;
            }
          }
        }
    } else if (ntile < 32) {
      const int cb = n0 - 2048;
#pragma unroll
      for (int mt = 0; mt < 2; ++mt)
#pragma unroll
        for (int nt = 0; nt < 2; ++nt) {
          const int vc = cb + CL(nt);
#pragma unroll
          for (int i4 = 0; i4 < 4; ++i4) {
            const int tok0 = m0 + RW(mt, 4 * i4);
            uint2 v;
            v.x = pack2(acc[mt][nt][4 * i4], acc[mt][nt][4 * i4 + 1]);
            v.y = pack2(acc[mt][nt][4 * i4 + 2], acc[mt][nt][4 * i4 + 3]);
            *(uint2*)(VT + ((size_t)(tok0 >> 5) * 2048 + vc) * 32 + (tok0 & 31)) = v;
            if (tok0 < NCTX) *(uint2*)(VTC + ((size_t)(tok0 >> 8) * 2048 + vc) * 256 + (tok0 & 255)) = v;
          }
        }
    } else {
      if (wn_ == 0 && rr_ < 16) {
        const int g = rr_;
        const float bg = P.b_gate[l * 16 + g];
        const bool isf = (g >> 2) & 1;
#pragma unroll
        for (int mt = 0; mt < 2; ++mt)
#pragma unroll
          for (int i = 0; i < 16; ++i) {
            float v = acc[mt][0][i] + bg;
            if (isf) v = logsigmoidf_(v);
            GATES[(size_t)(m0 + RW(mt, i)) * 16 + g] = v;
          }
      }
    }
  }
}

DI float wave_excl_sum(float v, int lane) {
  float x = v;
#pragma unroll
  for (int o = 1; o < 64; o <<= 1) { const float y = __shfl_up(x, o, 64); if (lane >= o) x += y; }
  return x - v;
}
DI float wave_excl_max(float v, int lane, float init) {
  float x = v;
#pragma unroll
  for (int o = 1; o < 64; o <<= 1) { const float y = __shfl_up(x, o, 64); if (lane >= o) x = fmaxf(x, y); }
  const float p = __shfl_up(x, 1, 64);
  return lane == 0 ? init : fmaxf(init, p);
}

template <int E>
DI void scan_wave(const Params& P, int l, int sid) {
  const int lane = tid_() & 63;
  const int dir = sid & 1, hd = (sid >> 1) & 3, seq = sid >> 3;
  const bool lat = seq >= 16;
  const int S = E * 64;
  const int tok0 = lat ? NCTX + (seq - 16) * 1024 : seq * 256;
  const float* G = (const float*)(P.ws + OFF_GATES);
  const size_t gi = (size_t)(dir * 4 + hd) * NTOK;
  float* BETA = (float*)(P.ws + OFF_BETA) + gi;
  float* MM = (float*)(P.ws + OFF_MM) + gi;
  float* EMT = (float*)(P.ws + OFF_EMT) + gi;
  float* WFIN = (float*)(P.ws + OFF_WFIN) + gi;
  const int gi_i = dir * 8 + hd, gi_f = dir * 8 + 4 + hd;
  const float m0 = lat ? P.state_m[(((seq - 16) * 4 + l) * 2 + dir) * 4 + hd] : 0.f;
  float tot = 0.f;
#pragma unroll
  for (int e = 0; e < E; ++e) {
    const int j = lane * E + e, tok = dir == 0 ? tok0 + j : tok0 + S - 1 - j;
    tot += G[(size_t)tok * 16 + gi_f];
  }
  const float boff = wave_excl_sum(tot, lane);
  float b = boff, cmax = -3.0e38f;
#pragma unroll
  for (int e = 0; e < E; ++e) {
    const int j = lane * E + e, tok = dir == 0 ? tok0 + j : tok0 + S - 1 - j;
    b += G[(size_t)tok * 16 + gi_f];
    const float be = G[(size_t)tok * 16 + gi_i] - b;
    BETA[tok] = be;
    cmax = fmaxf(cmax, be);
  }
  float M = wave_excl_max(cmax, lane, m0);
  b = boff;
#pragma unroll
  for (int e = 0; e < E; ++e) {
    const int j = lane * E + e, tok = dir == 0 ? tok0 + j : tok0 + S - 1 - j;
    b += G[(size_t)tok * 16 + gi_f];
    const float be = G[(size_t)tok * 16 + gi_i] - b;
    M = fmaxf(M, be);
    MM[tok] = M;
    EMT[tok] = __expf(-b - M);
  }
  if (!lat) {
    const float Mlast = __shfl(M, 63, 64);
    const float Blast = __shfl(b, 63, 64);
    if (lane == 0) P.out[OUT_NEWM + (((seq * 4 + l) * 2 + dir) * 4 + hd)] = Blast + Mlast;
    b = boff;
  #pragma unroll
  for (int e = 0; e < E; ++e) {
      const int j = lane * E + e, tok = dir == 0 ? tok0 + j : tok0 + S - 1 - j;
      b += G[(size_t)tok * 16 + gi_f];
      const float be = G[(size_t)tok * 16 + gi_i] - b;
      WFIN[tok] = __expf(be - Mlast);
    }
  }
}

DI void convert_c0(const Params& P, int l) {
  bf16_t* C0T = (bf16_t*)(P.ws + OFF_C0T);
  const int total = 64 * 512 * 32;
  for (int e = bid_() * 256 + tid_(); e < total; e += gridDim.x * 256) {
    const int j = e & 31, v = (e >> 5) & 511, sp = e >> 14;
    const int b = sp >> 3, dir = (sp >> 2) & 1, hd = sp & 3;
    const float* src = P.state_C + ((size_t)((((b * 4 + l) * 2 + dir) * 4 + hd) * 512 + v)) * 256 + j * 8;
    const float4 x0 = *(const float4*)src, x1 = *(const float4*)(src + 4);
    uint4 o;
    o.x = pack2(x0.x, x0.y); o.y = pack2(x0.z, x0.w); o.z = pack2(x1.x, x1.y); o.w = pack2(x1.z, x1.w);
    *(uint4*)(C0T + ((size_t)((sp * 2 + (v >> 8)) * 8 + (j >> 2)) * 256 + (v & 255)) * 32 + (j & 3) * 8) = o;
  }
}

DI void phase_scan_four1(const Params& P, int l, unsigned char* smem) {
  convert_c0(P, l);
  const bf16_t* UF = (const bf16_t*)(P.ws + OFF_UF);
  const bf16_t* BC = (const bf16_t*)(P.ws + OFF_BC);
  bf16_t* TT = (bf16_t*)(P.ws + OFF_TT);
  for (int it = bid_(); it < 48 + 1536; it += gridDim.x) {
    if (it < 48) { const int sid = it * 4 + (tid_() >> 6); if (sid < 128) scan_wave<4>(P, l, sid); else scan_wave<16>(P, l, sid); continue; }
    const int t = it - 48, g = t / 384, rem = t - g * 384;
    int mtile, ntile;
    tile_decode(rem, 96, 4, mtile, ntile);
    const int m0 = mtile * 128, n0 = ntile * 128;
    f32x16 acc[2][2];
    acc_zero(acc);
    gemm_mainloop<false>(acc, UF + (size_t)m0 * 1024 + g * 256, 1024, BC + (size_t)n0 * 256, 256, 256, nullptr, smem);
    EPI_VARS;
#pragma unroll
    for (int mt = 0; mt < 2; ++mt)
#pragma unroll
      for (int nt = 0; nt < 2; ++nt) {
        const int n = n0 + CL(nt), cs = n >> 8, ch = n & 255;
#pragma unroll
        for (int i4 = 0; i4 < 4; ++i4) {
          const int tok0 = m0 + RW(mt, 4 * i4);
          uint2 v;
          v.x = pack2(acc[mt][nt][4 * i4], acc[mt][nt][4 * i4 + 1]);
          v.y = pack2(acc[mt][nt][4 * i4 + 2], acc[mt][nt][4 * i4 + 3]);
          size_t idx;
          if (tok0 < NCTX) idx = ((size_t)(((tok0 >> 8) * 4 + g) * 256 + ch)) * 512 + cs * 256 + (tok0 & 255);
          else { const int tl = tok0 - NCTX; idx = TT_LAT + ((size_t)(((tl >> 10) * 4 + g) * 256 + ch)) * 2048 + cs * 1024 + (tl & 1023); }
          *(uint2*)(TT + idx) = v;
        }
      }
  }
}

DI void mlstm_item(const Params& P, int l, int seq, int hd, int qb, int vh, unsigned char* smem) {
  const int tid = tid_(), lane = tid & 63, w = tid >> 6, c = lane & 15, q = lane >> 4;
  const bool lat = seq >= 16;
  const int S = lat ? 1024 : 256;
  const int tok0 = lat ? NCTX + (seq - 16) * 1024 : seq * 256;
  const int bl = seq - 16;
  const bf16_t* Qg = (const bf16_t*)(P.ws + OFF_Q);
  const bf16_t* Kg = (const bf16_t*)(P.ws + OFF_K);
  const bf16_t* VT = (const bf16_t*)(P.ws + OFF_VT) + ((size_t)(tok0 >> 5) * 2048 + hd * 512 + vh * 256) * 32;
  unsigned char* sK = smem;
  unsigned char* sV = smem + 16896;
  const int t_loc = qb * 64 + w * 16 + c;
  const int tokq = tok0 + t_loc;
  bf16x8 qf[8];
  {
    const bf16_t* qp = Qg + (size_t)tokq * 1024 + hd * 256 + q * 8;
#pragma unroll
    for (int kk = 0; kk < 8; ++kk) qf[kk] = *(const bf16x8*)(qp + kk * 32);
#pragma unroll
    for (int kk = 0; kk < 8; ++kk) asm volatile("" : "+v"(qf[kk]));
  }
  __syncthreads();
  const int nkb = S >> 5;
  const size_t rowbase = (size_t)(tok0 + qb * 64 + w * 16 + 4 * q) * 2048 + hd * 512 + vh * 256 + c;
  const bf16_t* kld = Kg + ((size_t)(tok0 >> 5) * 4 + hd) * 8192 + tid * 8;
  unsigned char* ksd = sK + (tid >> 5) * 528 + (tid & 31) * 16;
  const bf16_t* vld = VT + tid * 8;
  unsigned char* vsd = sV + (tid >> 2) * 80 + (tid & 3) * 16;
  u32x4 st[8], bt[2], btn[2];
#define STWAIT() asm volatile("s_waitcnt vmcnt(0)" : "+v"(st[0]), "+v"(st[1]), "+v"(st[2]), "+v"(st[3]), "+v"(st[4]), "+v"(st[5]), "+v"(st[6]), "+v"(st[7]), "+v"(btn[0]), "+v"(btn[1]) : : "memory")
#define ISSUE_KV(kb_)                                                                      \
  {                                                                                        \
    const bf16_t* kp_ = kld + (size_t)(kb_) * 4 * 8192;                                    \
    const bf16_t* vp_ = vld + (size_t)(kb_) * 2048 * 32;                                   \
    _Pragma("unroll") for (int i = 0; i < 4; ++i) st[i] = gld16(kp_ + i * 2048);           \
    _Pragma("unroll") for (int i = 0; i < 4; ++i) st[4 + i] = gld16(vp_ + i * 2048);       \
    btn[0] = gld16(BETA + (kb_) * 32);                                                     \
    btn[1] = gld16(BETA + (kb_) * 32 + 16);                                                \
  }
#define STORE_KV()                                                                         \
  {                                                                                        \
    _Pragma("unroll") for (int i = 0; i < 4; ++i) *(u32x4*)(ksd + i * 8 * 528) = st[i];    \
    _Pragma("unroll") for (int i = 0; i < 4; ++i) *(u32x4*)(vsd + i * 64 * 80) = st[4 + i];\
    bt[0] = btn[0]; bt[1] = btn[1];                                                        \
  }
#define ISSUE_C0(kk_) { _Pragma("unroll") for (int i = 0; i < 4; ++i) st[4 + i] = gld16(C0 + (kk_) * 8192 + i * 2048); }
#define STORE_C0() { _Pragma("unroll") for (int i = 0; i < 4; ++i) *(u32x4*)(vsd + i * 64 * 80) = st[4 + i]; }
#pragma unroll 1
  for (int dir = 0; dir < 2; ++dir) {
    f32x4 acc[16];
#pragma unroll
    for (int n = 0; n < 16; ++n) acc[n] = (f32x4){0.f, 0.f, 0.f, 0.f};
    float den = 0.f;
    const size_t gi = (size_t)(dir * 4 + hd) * NTOK;
    const float* BETA = (const float*)(P.ws + OFF_BETA) + gi + tok0 + 4 * q;
    const float Mt = ((const float*)(P.ws + OFF_MM))[gi + tokq];
    const float emt = ((const float*)(P.ws + OFF_EMT))[gi + tokq];
    const int kb_lo = dir == 0 ? 0 : 2 * qb;
    const int kb_hi = dir == 0 ? 2 * qb + 1 : nkb - 1;
    asm volatile("" : : "v"(Mt), "v"(emt));
    btn[0] = btn[1] = (u32x4){0u, 0u, 0u, 0u};
    st[0] = st[1] = st[2] = st[3] = (u32x4){0u, 0u, 0u, 0u};
    if (lat) {
      const int sidx = ((bl * 4 + l) * 2 + dir) * 4 + hd;
      const float inter = __expf(P.state_m[sidx] - Mt);
      const bf16_t* C0 = (const bf16_t*)(P.ws + OFF_C0T) + ((size_t)(((bl * 2 + dir) * 4 + hd) * 2 + vh) * 8) * 8192 + tid * 8;
      float* sN = (float*)(smem + 71168);
      float sdot = 0.f;
      __syncthreads();
      {
        const float nv = P.state_n[(size_t)sidx * 256 + tid];
        sN[tid] = nv;
      }
      asm volatile("" : : "v"(inter));
      const float* n0p = sN + q * 8;
      ISSUE_C0(0);
      STWAIT();
      STORE_C0();
      __syncthreads();
#pragma unroll
      for (int kk = 0; kk < 8; ++kk) {
        const int kn = kk < 7 ? kk + 1 : 7;
        ISSUE_C0(kn);
        const bf16x8 qk = qf[kk];
#pragma unroll
        for (int e = 0; e < 8; ++e) sdot += bf2f((unsigned)(unsigned short)qk[e]) * n0p[kk * 32 + e];
        {
          bf16x8 fb[2][4];
          const unsigned char* vb_ = sV + c * 80 + q * 16;
#pragma unroll
          for (int j = 0; j < 4; ++j) fb[0][j] = *(const bf16x8*)(vb_ + j * 16 * 80);
#pragma unroll
          for (int g = 0; g < 4; ++g) {
            if (g < 3) {
#pragma unroll
              for (int j = 0; j < 4; ++j) fb[(g + 1) & 1][j] = *(const bf16x8*)(vb_ + ((g + 1) * 4 + j) * 16 * 80);
            }
#pragma unroll
            for (int j = 0; j < 4; ++j) acc[g * 4 + j] = MFMA16(qk, fb[g & 1][j], acc[g * 4 + j]);
            __builtin_amdgcn_sched_barrier(0);
          }
        }
        STWAIT();
        __syncthreads();
        STORE_C0();
        __syncthreads();
      }
      float it_[4];
#pragma unroll
      for (int j = 0; j < 4; ++j) it_[j] = __shfl(inter, 4 * q + j, 64);
#pragma unroll
      for (int n = 0; n < 16; ++n)
#pragma unroll
        for (int j = 0; j < 4; ++j) acc[n][j] *= it_[j];
      den = inter * sdot;
    }
    __syncthreads();
    ISSUE_KV(kb_lo);
    STWAIT();
    STORE_KV();
    __syncthreads();
#pragma unroll 1
    for (int kb = kb_lo; kb <= kb_hi; ++kb) {
      const int kbn = kb < kb_hi ? kb + 1 : kb_hi;
      ISSUE_KV(kbn);
      const float bb0[4] = {__uint_as_float(bt[0].x), __uint_as_float(bt[0].y), __uint_as_float(bt[0].z), __uint_as_float(bt[0].w)};
      const float bb1[4] = {__uint_as_float(bt[1].x), __uint_as_float(bt[1].y), __uint_as_float(bt[1].z), __uint_as_float(bt[1].w)};
      f32x4 x0 = (f32x4){0.f, 0.f, 0.f, 0.f}, x1 = (f32x4){0.f, 0.f, 0.f, 0.f};
      {
        bf16x8 fa0[2], fa1[2];
        const unsigned char* k0_ = sK + c * 528 + q * 16;
        fa0[0] = *(const bf16x8*)(k0_); fa1[0] = *(const bf16x8*)(k0_ + 16 * 528);
#pragma unroll
        for (int kk = 0; kk < 8; ++kk) {
          if (kk < 7) {
            fa0[(kk + 1) & 1] = *(const bf16x8*)(k0_ + (kk + 1) * 64);
            fa1[(kk + 1) & 1] = *(const bf16x8*)(k0_ + 16 * 528 + (kk + 1) * 64);
          }
          x0 = MFMA16(fa0[kk & 1], qf[kk], x0);
          x1 = MFMA16(fa1[kk & 1], qf[kk], x1);
          __builtin_amdgcn_sched_barrier(0);
        }
      }
      float p0[4], p1[4];
      const bool diag = (kb >> 1) == qb;
      if (diag) {
#pragma unroll
        for (int j = 0; j < 4; ++j) {
          const int s0 = kb * 32 + 4 * q + j, s1 = s0 + 16;
          const bool ok0 = dir == 0 ? (s0 <= t_loc) : (s0 >= t_loc);
          const bool ok1 = dir == 0 ? (s1 <= t_loc) : (s1 >= t_loc);
          p0[j] = ok0 ? x0[j] * __expf(bb0[j] - Mt) : 0.f;
          p1[j] = ok1 ? x1[j] * __expf(bb1[j] - Mt) : 0.f;
          den += p0[j] + p1[j];
        }
      } else {
#pragma unroll
        for (int j = 0; j < 4; ++j) {
          p0[j] = x0[j] * __expf(bb0[j] - Mt);
          p1[j] = x1[j] * __expf(bb1[j] - Mt);
          den += p0[j] + p1[j];
        }
      }
      uint4 pu;
      pu.x = pack2(p0[0], p0[1]); pu.y = pack2(p0[2], p0[3]); pu.z = pack2(p1[0], p1[1]); pu.w = pack2(p1[2], p1[3]);
      const bf16x8 pa = __builtin_bit_cast(bf16x8, pu);
      {
        uint2 lo[2][4], hi[2][4];
        const unsigned char* vb_ = sV + c * 80 + q * 8;
#pragma unroll
        for (int j = 0; j < 4; ++j) { lo[0][j] = *(const uint2*)(vb_ + j * 16 * 80); hi[0][j] = *(const uint2*)(vb_ + j * 16 * 80 + 32); }
#pragma unroll
        for (int g = 0; g < 4; ++g) {
          if (g < 3) {
#pragma unroll
            for (int j = 0; j < 4; ++j) {
              lo[(g + 1) & 1][j] = *(const uint2*)(vb_ + ((g + 1) * 4 + j) * 16 * 80);
              hi[(g + 1) & 1][j] = *(const uint2*)(vb_ + ((g + 1) * 4 + j) * 16 * 80 + 32);
            }
          }
#pragma unroll
          for (int j = 0; j < 4; ++j) {
            uint4 vu;
            vu.x = lo[g & 1][j].x; vu.y = lo[g & 1][j].y; vu.z = hi[g & 1][j].x; vu.w = hi[g & 1][j].y;
            acc[g * 4 + j] = MFMA16(pa, __builtin_bit_cast(bf16x8, vu), acc[g * 4 + j]);
          }
          __builtin_amdgcn_sched_barrier(0);
        }
      }
      STWAIT();
      __syncthreads();
      STORE_KV();
      __syncthreads();
    }
    den += __shfl_xor(den, 16, 64);
    den += __shfl_xor(den, 32, 64);
    const float rinv = 1.f / fmaxf(fabsf(den), emt);
    float rj[4];
#pragma unroll
    for (int j = 0; j < 4; ++j) rj[j] = __shfl(rinv, 4 * q + j, 64);
    bf16_t* HS = (bf16_t*)(P.ws + OFF_H0) + rowbase;
    asm volatile("" : "+v"(HS));
    bf16_t* h0p = HS; bf16_t* h1p = HS + 2048; bf16_t* h2p = HS + 4096; bf16_t* h3p = HS + 6144;
    asm volatile("" : "+v"(h1p));
    asm volatile("" : "+v"(h2p));
    asm volatile("" : "+v"(h3p));
    if (dir == 0) {
#pragma unroll
      for (int n = 0; n < 16; ++n) {
        h0p[n * 16] = (bf16_t)f2bf(acc[n][0] * rj[0]);
        h1p[n * 16] = (bf16_t)f2bf(acc[n][1] * rj[1]);
        h2p[n * 16] = (bf16_t)f2bf(acc[n][2] * rj[2]);
        h3p[n * 16] = (bf16_t)f2bf(acc[n][3] * rj[3]);
      }
    } else {
#pragma unroll
      for (int n = 0; n < 16; ++n) {
        h0p[n * 16] = (bf16_t)f2bf(acc[n][0] * rj[0] + bf2f(h0p[n * 16]));
        h1p[n * 16] = (bf16_t)f2bf(acc[n][1] * rj[1] + bf2f(h1p[n * 16]));
        h2p[n * 16] = (bf16_t)f2bf(acc[n][2] * rj[2] + bf2f(h2p[n * 16]));
        h3p[n * 16] = (bf16_t)f2bf(acc[n][3] * rj[3] + bf2f(h3p[n * 16]));
        if ((n & 3) == 3) __builtin_amdgcn_sched_barrier(0);
      }
    }
  }
}

#undef STWAIT
#undef ISSUE_KV
#undef ISSUE_C0
#undef STORE_KV
#undef STORE_C0

DI void phase_hn(const Params& P, int l) {
  const bf16_t* HS = (const bf16_t*)(P.ws + OFF_H0);
  const bf16_t* OG = (const bf16_t*)(P.ws + OFF_OG);
  bf16_t* HN = (bf16_t*)(P.ws + OFF_HN);
  const int tidl_ = tid_(), lane = tidl_ & 63, w = tidl_ >> 6;
  for (int pr = bid_() * 4 + w; pr < NTOK * 4; pr += gridDim.x * 4) {
    const size_t base = (size_t)pr * 512 + lane * 8;
    const uint4 hv = *(const uint4*)(HS + base);
    const uint4 ov = *(const uint4*)(OG + base);
    const unsigned hu[4] = {hv.x, hv.y, hv.z, hv.w}, ou[4] = {ov.x, ov.y, ov.z, ov.w};
    float x[8];
    float s = 0.f;
#pragma unroll
    for (int i = 0; i < 4; ++i) { x[2 * i] = bf2f(hu[i] & 0xffffu); x[2 * i + 1] = bf2f(hu[i] >> 16); s += x[2 * i] + x[2 * i + 1]; }
#pragma unroll
    for (int o = 1; o < 64; o <<= 1) s += __shfl_xor(s, o, 64);
    const float mu = s * (1.f / 512.f);
    float vs = 0.f;
#pragma unroll
    for (int i = 0; i < 8; ++i) { const float d = x[i] - mu; vs += d * d; }
#pragma unroll
    for (int o = 1; o < 64; o <<= 1) vs += __shfl_xor(vs, o, 64);
    const float rs = rsqrtf(vs * (1.f / 512.f) + LN_EPS);
    const float* gp = P.mh_gain + l * 2048 + (pr & 3) * 512 + lane * 8;
    const float4 g0 = *(const float4*)gp, g1 = *(const float4*)(gp + 4);
    const float g[8] = {g0.x, g0.y, g0.z, g0.w, g1.x, g1.y, g1.z, g1.w};
    unsigned r[4];
#pragma unroll
    for (int i = 0; i < 4; ++i)
      r[i] = pack2((x[2 * i] - mu) * rs * g[2 * i] * bf2f(ou[i] & 0xffffu), (x[2 * i + 1] - mu) * rs * g[2 * i + 1] * bf2f(ou[i] >> 16));
    *(uint4*)(HN + base) = make_uint4(r[0], r[1], r[2], r[3]);
  }
}

DI void phase_mixers(const Params& P, int l, unsigned char* smem) {
  const bf16_t* VTC = (const bf16_t*)(P.ws + OFF_VTC);
  const bf16_t* KT = (const bf16_t*)(P.ws + OFF_KT);
  const bf16_t* Kn = (const bf16_t*)(P.ws + OFF_K);
  const bf16_t* TT = (const bf16_t*)(P.ws + OFF_TT);
  const bf16_t* A256 = (const bf16_t*)(P.ws + OFF_A256);
  const bf16_t* A1024 = (const bf16_t*)(P.ws + OFF_A1024);
  const float* WFIN = (const float*)(P.ws + OFF_WFIN);
  bf16_t* FB = (bf16_t*)(P.ws + OFF_FB);
  for (int it0 = bid_(); it0 < 1024 + 2304; it0 += gridDim.x) {
    if (it0 < 1024) { mlstm_item(P, l, 16 + (it0 >> 7), (it0 >> 5) & 3, (it0 >> 1) & 15, it0 & 1, smem); continue; }
    const int r = it0 - 1024;
    if (r >= 512 && r < 1024) { const int j = r - 512; mlstm_item(P, l, j >> 5, (j >> 3) & 3, (j >> 1) & 3, j & 1, smem); continue; }
    f32x16 acc[2][2];
    acc_zero(acc);
    if (r < 512) {
      const int j = r, sg = j >> 4, mtile = (j >> 1) & 7, ntile = j & 1;
      gemm_mainloop<false>(acc, A1024 + (size_t)mtile * 128 * 2048, 2048, TT + TT_LAT + ((size_t)sg * 256 + ntile * 128) * 2048, 2048, 2048, nullptr, smem);
      EPI_VARS;
      const int seq = sg >> 2, g = sg & 3;
#pragma unroll
      for (int mt = 0; mt < 2; ++mt)
#pragma unroll
        for (int nt = 0; nt < 2; ++nt)
#pragma unroll
          for (int i = 0; i < 16; ++i)
            FB[(size_t)(NCTX + seq * 1024 + mtile * 128 + RW(mt, i)) * 1024 + g * 256 + ntile * 128 + CL(nt)] = (bf16_t)f2bf(acc[mt][nt][i] * (1.f / 512.f));
    } else if (r >= 2048) {
      const int j = r - 2048, sg = j >> 2, mtile = (j >> 1) & 1, ntile = j & 1;
      gemm_mainloop<false>(acc, A256 + (size_t)mtile * 128 * 512, 512, TT + ((size_t)sg * 256 + ntile * 128) * 512, 512, 512, nullptr, smem);
      EPI_VARS;
      const int seq = sg >> 2, g = sg & 3;
#pragma unroll
      for (int mt = 0; mt < 2; ++mt)
#pragma unroll
        for (int nt = 0; nt < 2; ++nt)
#pragma unroll
          for (int i = 0; i < 16; ++i)
            FB[(size_t)(seq * 256 + mtile * 128 + RW(mt, i)) * 1024 + g * 256 + ntile * 128 + CL(nt)] = (bf16_t)f2bf(acc[mt][nt][i] * (1.f / 256.f));
    } else {
      const int j = r - 1024, bhd = j >> 3, mtile = (j >> 1) & 3, ntile = j & 1;
      const int b = bhd >> 3, hd = (bhd >> 1) & 3, dir = bhd & 1;
      const float* wf = WFIN + (size_t)(dir * 4 + hd) * NTOK + b * 256;
      gemm_mainloop<true>(acc, VTC + ((size_t)b * 2048 + hd * 512 + mtile * 128) * 256, 256, KT + ((size_t)(b * 4 + hd) * 256 + ntile * 128) * 256, 256, 256, wf, smem);
      EPI_VARS;
      const size_t sidx = (size_t)(((b * 4 + l) * 2 + dir) * 4 + hd);
      float* Co = P.out + OUT_NEWC + sidx * 512 * 256;
#pragma unroll
      for (int mt = 0; mt < 2; ++mt)
#pragma unroll
        for (int nt = 0; nt < 2; ++nt)
#pragma unroll
          for (int i = 0; i < 16; ++i) Co[(size_t)(mtile * 128 + RW(mt, i)) * 256 + ntile * 128 + CL(nt)] = acc[mt][nt][i];
      if (mtile == 0 && tid_e_ < 128) {
        const int d = ntile * 128 + tid_e_;
        float s = 0.f;
        for (int sp = 0; sp < 256; ++sp) s += wf[sp] * bf2f(Kn[((size_t)((b * 256 + sp) >> 5) * 4 + hd) * 8192 + (sp & 31) * 256 + d]);
        P.out[OUT_NEWN + sidx * 256 + d] = s;
      }
    }
  }
}

DI void phase_branch(const Params& P, int l, unsigned char* smem) {
  const unsigned char* slot = P.ws + (size_t)(l & 1) * SZ_SLOT;
  const bf16_t* HN = (const bf16_t*)(P.ws + OFF_HN);
  const bf16_t* FB = (const bf16_t*)(P.ws + OFF_FB);
  const bf16_t* WA = (const bf16_t*)(slot + WS_WA);
  const bf16_t* WB = (const bf16_t*)(slot + WS_WB);
  const bf16_t* GA = (const bf16_t*)(P.ws + OFF_GA);
  const bf16_t* GB = (const bf16_t*)(P.ws + OFF_GB);
  bf16_t* MG = (bf16_t*)(P.ws + OFF_MERGED);
  for (int t = vblock(); t < 64 * 8; t += gridDim.x) {
    int mtile, ntile;
    tile_decode(t, 64, 8, mtile, ntile);
    const int m0 = mtile * 192, n0 = ntile * 128;
    f32x16 acc[3][2];
    acc_zero3(acc);
    gemm192_mainloop(acc, HN + (size_t)m0 * 2048, 2048, WA + (size_t)n0 * 2048, 2048, 2048, smem);
    const bf16_t* GAb = GA + (size_t)m0 * 1024 + n0;
    const bf16_t* GBb = GB + (size_t)m0 * 1024 + n0;
    bf16_t* MGb = MG + (size_t)m0 * 1024 + n0;
    {
      EPI_VARS;
#pragma unroll
      for (int mt = 0; mt < 3; ++mt)
#pragma unroll
        for (int nt = 0; nt < 2; ++nt)
#pragma unroll
          for (int i = 0; i < 16; ++i) {
            const unsigned o = (unsigned)RW3(mt, i) * 1024u + CL(nt);
            MGb[o] = (bf16_t)f2bf(bf2f(GAb[o]) * acc[mt][nt][i]);
          }
    }
    acc_zero3(acc);
    gemm192_mainloop(acc, FB + (size_t)m0 * 1024, 1024, WB + (size_t)n0 * 1024, 1024, 1024, smem);
    EPI_VARS;
#pragma unroll
    for (int mt = 0; mt < 3; ++mt)
#pragma unroll
      for (int nt = 0; nt < 2; ++nt)
#pragma unroll
        for (int i = 0; i < 16; ++i) {
          const unsigned o = (unsigned)RW3(mt, i) * 1024u + CL(nt);
          MGb[o] = (bf16_t)f2bf(bf2f(MGb[o]) + bf2f(GBb[o]) * acc[mt][nt][i]);
        }
  }
}

DI void phase_resid_gemm(const Params& P, int l, const bf16_t* A, int K, const bf16_t* W, int goff, unsigned char* smem) {
  const float* X = (const float*)(P.ws + OFF_XRES);
  const float* MOD = (const float*)(P.ws + OFF_MOD) + (size_t)l * 9 * 6144;
  float* PRE = (float*)(P.ws + OFF_PRELN);
  for (int t = vblock(); t < 64 * 8; t += gridDim.x) {
    int mtile, ntile;
    tile_decode(t, 64, 8, mtile, ntile);
    const int m0 = mtile * 192, n0 = ntile * 128;
    f32x16 acc[3][2];
    acc_zero3(acc);
    gemm192_mainloop(acc, A + (size_t)m0 * K, K, W + (size_t)n0 * K, K, K, smem);
    EPI_VARS;
    const float* Xb = X + (size_t)m0 * 1024 + n0;
    float* PREb = PRE + (size_t)m0 * 1024 + n0;
#pragma unroll
    for (int mt = 0; mt < 3; ++mt)
#pragma unroll
      for (int nt = 0; nt < 2; ++nt)
#pragma unroll
        for (int i = 0; i < 16; ++i) {
          const int row = RW3(mt, i);
          const unsigned o = (unsigned)row * 1024u + CL(nt);
          const float gv = MOD[(size_t)mod_index(m0 + row) * 6144 + goff + n0 + CL(nt)];
          PREb[o] = ALPHA * Xb[o] + gv * acc[mt][nt][i];
        }
  }
}

DI void phase_ln(const Params& P, const float* gain, const float* bias, float* xdst, const float* modn, int shoff, int scoff) {
  const float* PRE = (const float*)(P.ws + OFF_PRELN);
  bf16_t* H = (bf16_t*)(P.ws + OFF_HMOD);
  const int tidl_ = tid_(), lane = tidl_ & 63, w = tidl_ >> 6;
  for (int tok = bid_() * 4 + w; tok < NTOK; tok += gridDim.x * 4) {
    float4 v[4];
    float s = 0.f;
#pragma unroll
    for (int i = 0; i < 4; ++i) {
      v[i] = *(const float4*)(PRE + (size_t)tok * 1024 + (i * 64 + lane) * 4);
      s += v[i].x + v[i].y + v[i].z + v[i].w;
    }
#pragma unroll
    for (int o = 1; o < 64; o <<= 1) s += __shfl_xor(s, o, 64);
    const float mu = s * (1.f / 1024.f);
    float vs = 0.f;
#pragma unroll
    for (int i = 0; i < 4; ++i) {
      const float a = v[i].x - mu, b = v[i].y - mu, c = v[i].z - mu, d = v[i].w - mu;
      vs += a * a + b * b + c * c + d * d;
    }
#pragma unroll
    for (int o = 1; o < 64; o <<= 1) vs += __shfl_xor(vs, o, 64);
    const float rs = rsqrtf(vs * (1.f / 1024.f) + LN_EPS);
    const float* m = modn ? modn + (size_t)mod_index(tok) * 6144 : nullptr;
#pragma unroll
    for (int i = 0; i < 4; ++i) {
      const int n = (i * 64 + lane) * 4;
      const float4 g = *(const float4*)(gain + n), b = *(const float4*)(bias + n);
      float4 x;
      x.x = (v[i].x - mu) * rs * g.x + b.x; x.y = (v[i].y - mu) * rs * g.y + b.y;
      x.z = (v[i].z - mu) * rs * g.z + b.z; x.w = (v[i].w - mu) * rs * g.w + b.w;
      *(float4*)(xdst + (size_t)tok * 1024 + n) = x;
      if (m) {
        const float4 sh = *(const float4*)(m + shoff + n), sc = *(const float4*)(m + scoff + n);
        uint2 o;
        o.x = pack2(x.x * (1.f + sc.x) + sh.x, x.y * (1.f + sc.y) + sh.y);
        o.y = pack2(x.z * (1.f + sc.z) + sh.z, x.w * (1.f + sc.w) + sh.w);
        *(uint2*)(H + (size_t)tok * 1024 + n) = o;
      }
    }
  }
}

DI void phase_ffn_in(const Params& P, int l, unsigned char* smem) {
  const bf16_t* H = (const bf16_t*)(P.ws + OFF_HMOD);
  const bf16_t* W = (const bf16_t*)(P.ws + (size_t)(l & 1) * SZ_SLOT + WS_WF1);
  bf16_t* FF = (bf16_t*)(P.ws + OFF_FF);
  for (int t = vblock(); t < 96 * 44; t += gridDim.x) {
    int mtile, ntile;
    tile_decode(t, 96, 44, mtile, ntile);
    const int m0 = mtile * 128, n0 = ntile * 128;
    f32x16 acc[2][2];
    acc_zero(acc);
    gemm_mainloop<false>(acc, H + (size_t)m0 * 1024, 1024, W + (size_t)n0 * 1024, 1024, 1024, nullptr, smem);
    EPI_VARS;
#pragma unroll
    for (int mt = 0; mt < 2; ++mt)
#pragma unroll
      for (int i = 0; i < 16; ++i) {
        const float a = acc[mt][0][i], u = acc[mt][1][i];
        *(unsigned short*)(smem + RW(mt, i) * 144 + (wn_ * 32 + rr_) * 2) = (unsigned short)f2bf(a * sigmoidf_(a) * u);
      }
    __syncthreads();
#pragma unroll
    for (int i = 0; i < 4; ++i) {
      const int row = (tid_e_ >> 3) + 32 * i, ch = tid_e_ & 7;
      const u32x4 x = *(const u32x4*)(smem + row * 144 + ch * 16);
      *(u32x4*)(FF + (size_t)(m0 + row) * DFF + ntile * 64 + ch * 8) = x;
    }
    __syncthreads();
  }
}

template <int S>
DI void run_phase(const Params& P, int l, unsigned char* smem) {
  const unsigned char* slot = P.ws + (size_t)(l & 1) * SZ_SLOT;
  const float* MOD = (const float*)(P.ws + OFF_MOD);
  if constexpr (S == 0) phase_setup(P, smem);
  else if constexpr (S == 1) phase_modreduce(P);
  else if constexpr (S == 2) phase_modulate0(P);
  else if constexpr (S == 3) phase_gemm_in(P, l, smem);
  else if constexpr (S == 4) phase_scan_four1(P, l, smem);
  else if constexpr (S == 5) phase_mixers(P, l, smem);
  else if constexpr (S == 6) phase_hn(P, l);
  else if constexpr (S == 7) phase_branch(P, l, smem);
  else if constexpr (S == 8) phase_resid_gemm(P, l, (const bf16_t*)(P.ws + OFF_MERGED), 1024, (const bf16_t*)(slot + WS_WO), 2048, smem);
  else if constexpr (S == 9) {
    phase_ln(P, P.ln_gain + (l * 2 + 0) * 1024, P.ln_bias + (l * 2 + 0) * 1024, (float*)(P.ws + OFF_XRES), MOD + (size_t)l * 9 * 6144, 3072, 4096);
    if (l + 1 < 4) convert_layer(P, l + 1, smem);
  } else if constexpr (S == 10) phase_ffn_in(P, l, smem);
  else if constexpr (S == 11) phase_resid_gemm(P, l, (const bf16_t*)(P.ws + OFF_FF), DFF, (const bf16_t*)(slot + WS_WF2), 5120, smem);
  else {
    if (l == 3) phase_ln(P, P.ln_gain + (l * 2 + 1) * 1024, P.ln_bias + (l * 2 + 1) * 1024, P.out, nullptr, 0, 0);
    else phase_ln(P, P.ln_gain + (l * 2 + 1) * 1024, P.ln_bias + (l * 2 + 1) * 1024, (float*)(P.ws + OFF_XRES), MOD + (size_t)(l + 1) * 9 * 6144, 0, 1024);
  }
}

#if !ONE_LAUNCH
template <int S>
__global__ void __launch_bounds__(256, 2) k_phase(Params P, int l) {
  __shared__ __attribute__((aligned(16))) unsigned char smem[SMEM_BYTES];
  run_phase<S>(P, l, smem);
}

#endif
#define XB_TMO      128
#define XB_XCNT(j)  (256  + 64 * (j))
#define XB_XSUB(j)  (1280 + 64 * (j))
#define XB_XGEN(j)  (2304 + 64 * (j))
#define XB_TOP      3328
#define XB_TOPGEN   3392
#define XCD_BAR_WORDS 3456
#define XB_SPIN_CAP (1u << 20)
#define LAS __attribute__((address_space(3)))
DI unsigned xb_ld(unsigned* p) { return __hip_atomic_load(p, __ATOMIC_RELAXED, __HIP_MEMORY_SCOPE_AGENT); }
DI unsigned xb_add(unsigned* p, unsigned v) { return __hip_atomic_fetch_add(p, v, __ATOMIC_RELAXED, __HIP_MEMORY_SCOPE_AGENT); }
DI unsigned xb_xcc_id() { return (unsigned)__builtin_amdgcn_s_getreg((3 << 11) | 20) & 0xFu; }
#define XB_SPIN(cond, bar) do { unsigned _sp = 0; while (cond) { __builtin_amdgcn_s_sleep(1); \
    if ((++_sp & 255u) == 0u) { if (xb_ld(&(bar)[XB_TMO])) break; if (_sp > XB_SPIN_CAP) { atomicAdd(&(bar)[XB_TMO], 1u); break; } } } } while (0)
DI void xcd_barrier_complete(unsigned* bar, unsigned x, unsigned& nloc, unsigned& nx) {
  const unsigned G = gridDim.x;
  unsigned sum, cnt, mine, sp = 0u;
  for (;;) {
    sum = 0u; cnt = 0u; mine = 0u;
#pragma unroll
    for (unsigned j = 0; j < 16; ++j) { const unsigned c = xb_ld(&bar[XB_XCNT(j)]); sum += c; cnt += (c > 0u) ? 1u : 0u; mine = (j == x) ? c : mine; }
    if (sum == G) break;
    __builtin_amdgcn_s_sleep(1);
    if ((++sp & 255u) == 0u) { if (xb_ld(&bar[XB_TMO])) break; if (sp > XB_SPIN_CAP) { atomicAdd(&bar[XB_TMO], 1u); break; } }
  }
  nloc = mine > 0u ? mine : 1u; nx = cnt > 0u ? cnt : 1u;
}
DI void xcd_barrier(unsigned* bar, volatile LAS unsigned* st) {
  asm volatile("s_waitcnt vmcnt(0)" ::: "memory");
  __syncthreads();
  if (threadIdx.x == 0) {
    const unsigned x = xb_xcc_id();
    __builtin_amdgcn_s_waitcnt(0);
    unsigned nloc = st[0], nx = st[1];
    if (nloc == 0u) { xcd_barrier_complete(bar, x, nloc, nx); st[0] = nloc; st[1] = nx; }
    const unsigned old = xb_add(&bar[XB_XSUB(x)], 1u);
    const unsigned gen = old / nloc;
    if (old + 1u == (gen + 1u) * nloc) {
      __builtin_amdgcn_fence(__ATOMIC_RELEASE, "agent");
      asm volatile("s_waitcnt vmcnt(0)" ::: "memory");
      const unsigned og = xb_add(&bar[XB_TOP], 1u);
      const unsigned tg = og / nx;
      if (og + 1u == (tg + 1u) * nx) xb_add(&bar[XB_TOPGEN], 1u);
      else XB_SPIN(xb_ld(&bar[XB_TOPGEN]) == tg, bar);
      __builtin_amdgcn_fence(__ATOMIC_ACQUIRE, "agent");
      xb_add(&bar[XB_XGEN(x)], 1u);
      asm volatile("s_waitcnt vmcnt(0)" ::: "memory");
    } else {
      XB_SPIN(xb_ld(&bar[XB_XGEN(x)]) == gen, bar);
      __builtin_amdgcn_fence(__ATOMIC_ACQUIRE, "agent");
      asm volatile("s_waitcnt vmcnt(0)" ::: "memory");
    }
  }
  __syncthreads();
}

#define GSYNC() xcd_barrier((unsigned*)(load_params().ws + OFF_BAR), xb_st)
DI Params load_params() {
  Params P{};
#if defined(__HIP_DEVICE_COMPILE__)
  typedef const unsigned long long __attribute__((address_space(4)))* KP;
  typedef float __attribute__((address_space(1)))* GF;
  KP kp = (KP)__builtin_amdgcn_kernarg_segment_ptr();
  asm volatile("" : "+s"(kp));
  P.x_prompt = (const float*)(GF)kp[0];
  P.x_sample = (const float*)(GF)kp[1];
  P.c = (const float*)(GF)kp[2];
  P.state_C = (const float*)(GF)kp[3];
  P.state_n = (const float*)(GF)kp[4];
  P.state_m = (const float*)(GF)kp[5];
  P.c_ctx = (const float*)(GF)kp[6];
  P.w_mod = (const float*)(GF)kp[7];
  P.b_mod = (const float*)(GF)kp[8];
  P.w_in = (const float*)(GF)kp[9];
  P.b_gate = (const float*)(GF)kp[10];
  P.mh_gain = (const float*)(GF)kp[11];
  P.w_a = (const float*)(GF)kp[12];
  P.w_b = (const float*)(GF)kp[13];
  P.w_out = (const float*)(GF)kp[14];
  P.ln_gain = (const float*)(GF)kp[15];
  P.ln_bias = (const float*)(GF)kp[16];
  P.w_f1 = (const float*)(GF)kp[17];
  P.w_f2 = (const float*)(GF)kp[18];
  P.out = (float*)(GF)kp[19];
  P.ws = (unsigned char*)(GF)kp[20];
#endif
  return P;
}
__global__ void __launch_bounds__(256, 2) fwd_kernel(Params Pk) {
  __shared__ __attribute__((aligned(16))) unsigned char smem[SMEM_BYTES];
  __shared__ uint4 xb_words;
  {
    unsigned* bar0 = (unsigned*)(load_params().ws + OFF_BAR);
    const unsigned x0 = xb_xcc_id();
    if (threadIdx.x == 0) {
      xb_words = make_uint4(0u, 0u, 0u, 0u);
      (void)xb_add(&bar0[XB_XCNT(x0)], 1u);
    }
  }
  __syncthreads();
  volatile LAS unsigned* xb_st = (volatile LAS unsigned*)&xb_words;
  run_phase<0>(load_params(), 0, smem);
  cg::this_grid().sync();
  run_phase<1>(load_params(), 0, smem); GSYNC();
  run_phase<2>(load_params(), 0, smem); GSYNC();
#pragma unroll 1
  for (int l = 0; l < 4; ++l) {
    run_phase<3>(load_params(), l, smem); GSYNC();
    run_phase<4>(load_params(), l, smem); GSYNC();
    run_phase<5>(load_params(), l, smem); GSYNC();
    run_phase<6>(load_params(), l, smem); GSYNC();
    run_phase<7>(load_params(), l, smem); GSYNC();
    run_phase<8>(load_params(), l, smem); GSYNC();
    run_phase<9>(load_params(), l, smem); GSYNC();
    run_phase<10>(load_params(), l, smem); GSYNC();
    run_phase<11>(load_params(), l, smem); GSYNC();
    run_phase<12>(load_params(), l, smem);
    if (l < 3) GSYNC();
  }
}

#if !ONE_LAUNCH
template <int S>
static void launch_phase(const Params& P, int l, int cus, hipStream_t stream) {
  int per_cu = 0;
  if (hipOccupancyMaxActiveBlocksPerMultiprocessor(&per_cu, k_phase<S>, 256, 0) != hipSuccess) per_cu = 1;
  if (per_cu > 2) per_cu = 2;
  if (per_cu < 1) per_cu = 1;
  int grid = cus * per_cu;
  grid -= grid % 8;
  hipLaunchKernelGGL(k_phase<S>, dim3(grid), dim3(256), 0, stream, P, l);
}

#endif
extern "C" void kernel_launch(void* const* d_in, const int* in_sizes, int n_in, void* d_out, int out_size, void* d_ws, size_t ws_size,
                              hipStream_t stream) {
  if (ws_size < WS_TOTAL) { fprintf(stderr, "workspace too small: %zu < %zu\n", ws_size, (size_t)WS_TOTAL); return; }
  Params P{};
  const float** pp = (const float**)&P;
  for (int i = 0; i < 19; ++i) pp[i] = (const float*)d_in[i];
  P.out = (float*)d_out;
  P.ws = (unsigned char*)d_ws;
  int dev = 0, cus = 256;
  if (hipGetDevice(&dev) != hipSuccess) dev = 0;
  if (hipDeviceGetAttribute(&cus, hipDeviceAttributeMultiprocessorCount, dev) != hipSuccess) cus = 256;
#if ONE_LAUNCH
  {
    static int grid_blocks = 0;
    if (!grid_blocks) {
      int per_cu = 0;
      if (hipOccupancyMaxActiveBlocksPerMultiprocessor(&per_cu, fwd_kernel, 256, 0) != hipSuccess) per_cu = 1;
      if (per_cu > 2) per_cu = 2;
      if (per_cu < 1) per_cu = 1;
      grid_blocks = cus * per_cu;
      grid_blocks -= grid_blocks % 8;
    }
    if (hipMemsetAsync((unsigned char*)d_ws + OFF_BAR, 0, 16384, stream) != hipSuccess) { fprintf(stderr, "memset of barrier words failed\n"); return; }
    void* args[] = {&P};
    hipError_t err = hipLaunchCooperativeKernel((void*)fwd_kernel, dim3(grid_blocks), dim3(256), args, 0, stream);
    if (err != hipSuccess) fprintf(stderr, "cooperative launch failed: %s (grid %d)\n", hipGetErrorString(err), grid_blocks);
    return;
  }
#endif
#if !ONE_LAUNCH
  launch_phase<0>(P, 0, cus, stream);
  launch_phase<1>(P, 0, cus, stream);
  launch_phase<2>(P, 0, cus, stream);
  for (int l = 0; l < 4; ++l) {
    launch_phase<3>(P, l, cus, stream);
    launch_phase<4>(P, l, cus, stream);
    launch_phase<5>(P, l, cus, stream);
    launch_phase<6>(P, l, cus, stream);
    launch_phase<7>(P, l, cus, stream);
    launch_phase<8>(P, l, cus, stream);
    launch_phase<9>(P, l, cus, stream);
    launch_phase<10>(P, l, cus, stream);
    launch_phase<11>(P, l, cus, stream);
    launch_phase<12>(P, l, cus, stream);
  }
#endif
}
```

```cpp
#include <hip/hip_runtime.h>
#include <hip/hip_cooperative_groups.h>
#include <cstdio>
#ifndef ONE_LAUNCH
#define ONE_LAUNCH 1
#endif
namespace cg = cooperative_groups;

typedef unsigned short bf16_t;
using bf16x8 = __attribute__((ext_vector_type(8))) short;
using f32x16 = __attribute__((ext_vector_type(16))) float;
using f32x4 = __attribute__((ext_vector_type(4))) float;
#define DI __device__ __forceinline__
#define MFMA32(a, b, c) __builtin_amdgcn_mfma_f32_32x32x16_bf16((a), (b), (c), 0, 0, 0)
#define MFMA16(a, b, c) __builtin_amdgcn_mfma_f32_16x16x32_bf16((a), (b), (c), 0, 0, 0)

constexpr int NTOK = 12288, NCTX = 4096;
constexpr int NINP = 9344;
constexpr int DFF = 2816;
constexpr float ALPHA = 1.6817928305074290f;
constexpr float LN_EPS = 1e-5f;

constexpr size_t SZ_WIN = (size_t)NINP * 1024 * 2, SZ_WA = 1024ull * 2048 * 2, SZ_WB = 1024ull * 1024 * 2, SZ_WO = SZ_WB,
                 SZ_WF1 = 5632ull * 1024 * 2, SZ_WF2 = 1024ull * 2816 * 2;
constexpr size_t WS_WIN = 0, WS_WA = WS_WIN + SZ_WIN, WS_WB = WS_WA + SZ_WA, WS_WO = WS_WB + SZ_WB, WS_WF1 = WS_WO + SZ_WO,
                 WS_WF2 = WS_WF1 + SZ_WF1, SZ_SLOT = WS_WF2 + SZ_WF2;
constexpr size_t OFF_BC = 2 * SZ_SLOT;
constexpr size_t OFF_A256 = OFF_BC + 512 * 256 * 2;
constexpr size_t OFF_A1024 = OFF_A256 + 256 * 512 * 2;
constexpr size_t OFF_MODP = OFF_A1024 + 1024ull * 2048 * 2;
constexpr size_t OFF_MOD = OFF_MODP + 8ull * 4 * 9 * 6144 * 4;
constexpr size_t OFF_XRES = OFF_MOD + 4ull * 9 * 6144 * 4;
constexpr size_t OFF_HMOD = OFF_XRES + (size_t)NTOK * 1024 * 4;
constexpr size_t OFF_FB = OFF_HMOD;
constexpr size_t OFF_Q = OFF_HMOD + (size_t)NTOK * 1024 * 2;
constexpr size_t OFF_MERGED = OFF_Q;
constexpr size_t OFF_K = OFF_Q + (size_t)NTOK * 1024 * 2;
constexpr size_t OFF_KT = OFF_K + (size_t)NTOK * 1024 * 2;
constexpr size_t OFF_VT = OFF_KT + 16ull * 4 * 256 * 256 * 2;
constexpr size_t OFF_OG = OFF_VT + (size_t)NTOK * 2048 * 2;
constexpr size_t OFF_FF = OFF_OG;
constexpr size_t OFF_UF = OFF_OG + (size_t)NTOK * 2048 * 2;
constexpr size_t OFF_GA = OFF_UF + (size_t)NTOK * 1024 * 2;
constexpr size_t OFF_GB = OFF_GA + (size_t)NTOK * 1024 * 2;
constexpr size_t OFF_GATES = OFF_GB + (size_t)NTOK * 1024 * 2;
constexpr size_t SZ_SC = 2ull * 4 * NTOK * 4;
constexpr size_t OFF_BETA = OFF_GATES + (size_t)NTOK * 16 * 4;
constexpr size_t OFF_MM = OFF_BETA + SZ_SC;
constexpr size_t OFF_EMT = OFF_MM + SZ_SC;
constexpr size_t OFF_WFIN = OFF_EMT + SZ_SC;
constexpr size_t OFF_H0 = OFF_WFIN + SZ_SC;
constexpr size_t OFF_TT = OFF_H0 + (size_t)NTOK * 2048 * 2;
constexpr size_t OFF_PRELN = OFF_TT;
constexpr size_t OFF_HN = OFF_TT + (size_t)NTOK * 2048 * 2;
constexpr size_t OFF_VTC = OFF_HN + (size_t)NTOK * 2048 * 2;
constexpr size_t OFF_C0T = OFF_VTC + 16ull * 2048 * 256 * 2;
constexpr size_t OFF_BAR = OFF_C0T + 64ull * 512 * 256 * 2;
constexpr size_t WS_TOTAL = OFF_BAR + 16384;
constexpr size_t VT_LAT = 16ull * 2048 * 256;
constexpr size_t TT_LAT = 16ull * 4 * 256 * 512;

constexpr size_t OUT_NEWC = (size_t)NTOK * 1024;
constexpr size_t OUT_NEWN = OUT_NEWC + 16ull * 4 * 2 * 4 * 512 * 256;
constexpr size_t OUT_NEWM = OUT_NEWN + 16ull * 4 * 2 * 4 * 256;

constexpr int SMEM_BYTES = 73728;

struct Params {
  const float *x_prompt, *x_sample, *c, *state_C, *state_n, *state_m, *c_ctx, *w_mod, *b_mod, *w_in, *b_gate, *mh_gain,
      *w_a, *w_b, *w_out, *ln_gain, *ln_bias, *w_f1, *w_f2;
  float* out;
  unsigned char* ws;
};

typedef unsigned u32x4 __attribute__((ext_vector_type(4)));
DI u32x4 gld16(const void* p) { u32x4 r; asm volatile("global_load_dwordx4 %0, %1, off" : "=&v"(r) : "v"(p) : "memory"); return r; }
DI unsigned f2bf(float x) { unsigned r; asm("v_cvt_pk_bf16_f32 %0, %1, %1" : "=v"(r) : "v"(x)); return r & 0xffffu; }
DI unsigned pack2(float a, float b) { unsigned r; asm("v_cvt_pk_bf16_f32 %0, %1, %2\n\ts_nop 1" : "=v"(r) : "v"(a), "v"(b)); return r; }
DI float bf2f(unsigned h) { return __uint_as_float(h << 16); }
DI float sigmoidf_(float x) { return 1.f / (1.f + __expf(-x)); }
DI float logsigmoidf_(float x) { return fminf(x, 0.f) - log1pf(__expf(-fabsf(x))); }
DI int mod_index(int tok) { return tok < NCTX ? 0 : 1 + ((tok - NCTX) >> 10); }
DI int tid_() { int t = threadIdx.x; asm volatile("" : "+v"(t)); return t; }
DI int bid_() { int b = blockIdx.x; asm volatile("" : "+s"(b)); return b; }
DI int vblock() { return bid_(); }

DI void tile_decode(int t, int MT, int NT, int& mt, int& nt) {
  const int per_sc = MT * 8;
  const int sc = t / per_sc;
  const int w = t - sc * per_sc;
  int ncols = NT - sc * 8; ncols = ncols > 8 ? 8 : ncols;
  const int per_sr = 8 * ncols;
  const int sr = w / per_sr;
  const int j = w - sr * per_sr;
  mt = sr * 8 + (j & 7);
  nt = sc * 8 + (j >> 3);
}

template <bool KSCALE>
DI void gemm_mainloop(f32x16 (&acc)[2][2], const bf16_t* __restrict__ A, int lda, const bf16_t* __restrict__ B, int ldb, int K,
                      const float* __restrict__ kscale, unsigned char* smem) {
  const int tid = tid_(), lane = tid & 63, wave = tid >> 6;
  const int wm = wave >> 1, wn = wave & 1, r = lane & 31, h = lane >> 5;
  const int lrow = tid >> 3, lkc = tid & 7;
  const bf16_t* ga = A + (size_t)lrow * lda + lkc * 8;
  const bf16_t* gb = B + (size_t)lrow * ldb + lkc * 8;
  u32x4 a0[4], b0[4], a1[4], b1[4];
  const int KT = K >> 6;
#define GL(sa_, sb_, k0)                                                                            \
  {                                                                                                 \
    _Pragma("unroll") for (int i = 0; i < 4; ++i) {                                                 \
      sa_[i] = gld16(ga + (size_t)(32 * i) * lda + (k0));                                           \
      sb_[i] = gld16(gb + (size_t)(32 * i) * ldb + (k0));                                           \
    }                                                                                               \
  }
#define GW8(sa_, sb_) asm volatile("s_waitcnt vmcnt(8)" : "+v"(sa_[0]), "+v"(sa_[1]), "+v"(sa_[2]), "+v"(sa_[3]), "+v"(sb_[0]), "+v"(sb_[1]), "+v"(sb_[2]), "+v"(sb_[3]) : : "memory")
#define GW0(sa_, sb_) asm volatile("s_waitcnt vmcnt(0)" : "+v"(sa_[0]), "+v"(sa_[1]), "+v"(sa_[2]), "+v"(sa_[3]), "+v"(sb_[0]), "+v"(sb_[1]), "+v"(sb_[2]), "+v"(sb_[3]) : : "memory")
#define ST(sa_, sb_, buf, k0)                                                                       \
  {                                                                                                 \
    if (KSCALE) {                                                                                   \
      const float4 s0 = *(const float4*)(kscale + (k0) + lkc * 8);                                  \
      const float4 s1 = *(const float4*)(kscale + (k0) + lkc * 8 + 4);                              \
      _Pragma("unroll") for (int i = 0; i < 4; ++i) {                                               \
        u32x4 v = sb_[i];                                                                           \
        v.x = pack2(bf2f(v.x & 0xffffu) * s0.x, bf2f(v.x >> 16) * s0.y);                            \
        v.y = pack2(bf2f(v.y & 0xffffu) * s0.z, bf2f(v.y >> 16) * s0.w);                            \
        v.z = pack2(bf2f(v.z & 0xffffu) * s1.x, bf2f(v.z >> 16) * s1.y);                            \
        v.w = pack2(bf2f(v.w & 0xffffu) * s1.z, bf2f(v.w >> 16) * s1.w);                            \
        sb_[i] = v;                                                                                 \
      }                                                                                             \
    }                                                                                               \
    unsigned char* sa__ = smem + (buf) * 36864;                                                     \
    unsigned char* sb__ = sa__ + 18432;                                                             \
    _Pragma("unroll") for (int i = 0; i < 4; ++i) {                                                 \
      *(u32x4*)(sa__ + (lrow + 32 * i) * 144 + lkc * 16) = sa_[i];                                  \
      *(u32x4*)(sb__ + (lrow + 32 * i) * 144 + lkc * 16) = sb_[i];                                  \
    }                                                                                               \
  }
#define COMPUTE(buf)                                                                                                          \
  {                                                                                                                           \
    const unsigned char* sa = smem + (buf) * 36864;                                                                           \
    const unsigned char* sb = sa + 18432;                                                                                     \
    _Pragma("unroll") for (int ks = 0; ks < 4; ++ks) {                                                                        \
      bf16x8 af[2], bfr[2];                                                                                                   \
      _Pragma("unroll") for (int mt = 0; mt < 2; ++mt) af[mt] = *(const bf16x8*)(sa + (wm * 64 + mt * 32 + r) * 144 + ks * 32 + h * 16);  \
      _Pragma("unroll") for (int nt = 0; nt < 2; ++nt) bfr[nt] = *(const bf16x8*)(sb + (wn * 64 + nt * 32 + r) * 144 + ks * 32 + h * 16); \
      _Pragma("unroll") for (int mt = 0; mt < 2; ++mt)                                                                        \
        _Pragma("unroll") for (int nt = 0; nt < 2; ++nt) acc[mt][nt] = MFMA32(af[mt], bfr[nt], acc[mt][nt]);                  \
    }                                                                                                                         \
  }
  GL(a0, b0, 0);
  GL(a1, b1, 64);
  GW8(a0, b0);
  ST(a0, b0, 0, 0);
  __syncthreads();
  for (int kt = 0; kt < KT; kt += 2) {
    { const int kn = kt + 2 < KT ? kt + 2 : KT - 1; GL(a0, b0, kn * 64); }
    COMPUTE(0);
    GW8(a1, b1);
    ST(a1, b1, 1, (kt + 1) * 64);
    __syncthreads();
    { const int kn = kt + 3 < KT ? kt + 3 : KT - 1; GL(a1, b1, kn * 64); }
    COMPUTE(1);
    GW8(a0, b0);
    { const int kn = kt + 2 < KT ? kt + 2 : KT - 1; ST(a0, b0, 0, kn * 64); }
    __syncthreads();
  }
  GW0(a1, b1);
#undef GL
#undef GW8
#undef GW0
#undef ST
#undef COMPUTE
}

DI void gemm192_mainloop(f32x16 (&acc)[3][2], const bf16_t* __restrict__ A, int lda, const bf16_t* __restrict__ B, int ldb, int K,
                         unsigned char* smem) {
  const int tid = tid_(), lane = tid & 63, wave = tid >> 6;
  const int wm = wave >> 1, wn = wave & 1, r = lane & 31, h = lane >> 5;
  const int lrow = tid >> 3, lkc = tid & 7;
  const bf16_t* ga = A + (size_t)lrow * lda + lkc * 8;
  const bf16_t* gb = B + (size_t)lrow * ldb + lkc * 8;
  u32x4 a0[6], b0[4], a1[6], b1[4];
  const int KT = K >> 6;
#define GL(sa_, sb_, k0)                                                                            \
  {                                                                                                 \
    _Pragma("unroll") for (int i = 0; i < 6; ++i) sa_[i] = gld16(ga + (size_t)(32 * i) * lda + (k0));  \
    _Pragma("unroll") for (int i = 0; i < 4; ++i) sb_[i] = gld16(gb + (size_t)(32 * i) * ldb + (k0));  \
  }
#define GW10(sa_, sb_) asm volatile("s_waitcnt vmcnt(10)" : "+v"(sa_[0]), "+v"(sa_[1]), "+v"(sa_[2]), "+v"(sa_[3]), "+v"(sa_[4]), "+v"(sa_[5]), "+v"(sb_[0]), "+v"(sb_[1]), "+v"(sb_[2]), "+v"(sb_[3]) : : "memory")
#define GW0(sa_, sb_) asm volatile("s_waitcnt vmcnt(0)" : "+v"(sa_[0]), "+v"(sa_[1]), "+v"(sa_[2]), "+v"(sa_[3]), "+v"(sa_[4]), "+v"(sa_[5]), "+v"(sb_[0]), "+v"(sb_[1]), "+v"(sb_[2]), "+v"(sb_[3]) : : "memory")
#define ST(sa_, sb_)                                                                                \
  {                                                                                                 \
    unsigned char* sa__ = smem;                                                                     \
    unsigned char* sb__ = smem + 27648;                                                             \
    _Pragma("unroll") for (int i = 0; i < 6; ++i) *(u32x4*)(sa__ + (lrow + 32 * i) * 144 + lkc * 16) = sa_[i];  \
    _Pragma("unroll") for (int i = 0; i < 4; ++i) *(u32x4*)(sb__ + (lrow + 32 * i) * 144 + lkc * 16) = sb_[i];  \
  }
#define COMPUTE()                                                                                                             \
  {                                                                                                                           \
    const unsigned char* sa = smem;                                                                                           \
    const unsigned char* sb = smem + 27648;                                                                                   \
    _Pragma("unroll") for (int ks = 0; ks < 4; ++ks) {                                                                        \
      bf16x8 af[3], bfr[2];                                                                                                   \
      _Pragma("unroll") for (int mt = 0; mt < 3; ++mt) af[mt] = *(const bf16x8*)(sa + (wm * 96 + mt * 32 + r) * 144 + ks * 32 + h * 16);  \
      _Pragma("unroll") for (int nt = 0; nt < 2; ++nt) bfr[nt] = *(const bf16x8*)(sb + (wn * 64 + nt * 32 + r) * 144 + ks * 32 + h * 16); \
      _Pragma("unroll") for (int mt = 0; mt < 3; ++mt)                                                                        \
        _Pragma("unroll") for (int nt = 0; nt < 2; ++nt) acc[mt][nt] = MFMA32(af[mt], bfr[nt], acc[mt][nt]);                  \
    }                                                                                                                         \
  }
  GL(a0, b0, 0);
  GL(a1, b1, 64);
  GW10(a0, b0);
  ST(a0, b0);
  __syncthreads();
  for (int kt = 0; kt < KT; kt += 2) {
    { const int kn = kt + 2 < KT ? kt + 2 : KT - 1; GL(a0, b0, kn * 64); }
    COMPUTE();
    GW10(a1, b1);
    __syncthreads();
    ST(a1, b1);
    __syncthreads();
    { const int kn = kt + 3 < KT ? kt + 3 : KT - 1; GL(a1, b1, kn * 64); }
    COMPUTE();
    GW10(a0, b0);
    __syncthreads();
    ST(a0, b0);
    __syncthreads();
  }
  GW0(a1, b1);
#undef GL
#undef GW10
#undef GW0
#undef ST
#undef COMPUTE
}
DI void acc_zero3(f32x16 (&acc)[3][2]) {
#pragma unroll
  for (int a = 0; a < 3; ++a)
#pragma unroll
    for (int b = 0; b < 2; ++b)
#pragma unroll
      for (int i = 0; i < 16; ++i) acc[a][b][i] = 0.f;
}
#define RW3(mt, i) (wm_ * 96 + (mt) * 32 + ((i) & 3) + 8 * ((i) >> 2) + 4 * hh_)

DI void acc_zero(f32x16 (&acc)[2][2]) {
#pragma unroll
  for (int a = 0; a < 2; ++a)
#pragma unroll
    for (int b = 0; b < 2; ++b)
#pragma unroll
      for (int i = 0; i < 16; ++i) acc[a][b][i] = 0.f;
}

#define EPI_VARS const int tid_e_ = tid_(), lane_ = tid_e_ & 63, wave_ = tid_e_ >> 6, wm_ = wave_ >> 1, wn_ = wave_ & 1, rr_ = lane_ & 31, hh_ = lane_ >> 5
#define RW(mt, i) (wm_ * 64 + (mt) * 32 + ((i) & 3) + 8 * ((i) >> 2) + 4 * hh_)
#define CL(nt) (wn_ * 64 + (nt) * 32 + rr_)

template <int MODE>
DI void store_tile_bf16(const f32x16 (&acc)[2][2], bf16_t* __restrict__ dst, int ld, unsigned char* smem) {
  EPI_VARS;
#pragma unroll
  for (int mt = 0; mt < 2; ++mt)
#pragma unroll
    for (int nt = 0; nt < 2; ++nt)
#pragma unroll
      for (int i = 0; i < 16; ++i) {
        float v = acc[mt][nt][i];
        if (MODE == 1) v = sigmoidf_(v);
        *(unsigned short*)(smem + RW(mt, i) * 272 + CL(nt) * 2) = (unsigned short)f2bf(v);
      }
  __syncthreads();
#pragma unroll
  for (int i = 0; i < 8; ++i) {
    const int row = (tid_e_ >> 4) + 16 * i, ch = tid_e_ & 15;
    const u32x4 x = *(const u32x4*)(smem + row * 272 + ch * 16);
    *(u32x4*)(dst + (size_t)row * ld + ch * 8) = x;
  }
  __syncthreads();
}

DI void convert_tile(const float* __restrict__ src, int nsrc, int K, bf16_t* __restrict__ dst, int kt, int ntile, int maptype, unsigned char* smem) {
  float* tile = (float*)smem;
  const int tid = tid_(), tx = tid & 63, ty = tid >> 6;
  const int np = ntile * 64 + tx;
  int sc;
  if (maptype == 0) sc = np;
  else if (maptype == 1) sc = np < 6144 ? np : (np < 9216 ? np + 16 : (np < 9232 ? 6144 + (np - 9216) : -1));
  else { const int g = np >> 6, w = np & 63; sc = w < 32 ? g * 32 + w : 2816 + g * 32 + (w - 32); }
  __syncthreads();
#pragma unroll
  for (int i = 0; i < 16; ++i) {
    const int ky = ty + 4 * i;
    tile[ky * 65 + tx] = sc >= 0 ? src[(size_t)(kt * 64 + ky) * nsrc + sc] : 0.f;
  }
  __syncthreads();
#pragma unroll
  for (int i = 0; i < 2; ++i) {
    const int id = tid + 256 * i, nrow = id >> 3, kc = id & 7;
    uint4 v;
    v.x = pack2(tile[(kc * 8 + 0) * 65 + nrow], tile[(kc * 8 + 1) * 65 + nrow]);
    v.y = pack2(tile[(kc * 8 + 2) * 65 + nrow], tile[(kc * 8 + 3) * 65 + nrow]);
    v.z = pack2(tile[(kc * 8 + 4) * 65 + nrow], tile[(kc * 8 + 5) * 65 + nrow]);
    v.w = pack2(tile[(kc * 8 + 6) * 65 + nrow], tile[(kc * 8 + 7) * 65 + nrow]);
    *(uint4*)(dst + (size_t)(ntile * 64 + nrow) * K + kt * 64 + kc * 8) = v;
  }
}

DI void convert_layer(const Params& P, int l, unsigned char* smem) {
  unsigned char* slot = P.ws + (size_t)(l & 1) * SZ_SLOT;
  constexpr int T0 = 146 * 16, T1 = T0 + 16 * 32, T2 = T1 + 16 * 16, T3 = T2 + 16 * 16, T4 = T3 + 88 * 16, T5 = T4 + 16 * 44;
  for (int it = bid_(); it < T5; it += gridDim.x) {
    if (it < T0) convert_tile(P.w_in + (size_t)l * 1024 * 9232, 9232, 1024, (bf16_t*)(slot + WS_WIN), it & 15, it >> 4, 1, smem);
    else if (it < T1) { const int j = it - T0; convert_tile(P.w_a + (size_t)l * 2048 * 1024, 1024, 2048, (bf16_t*)(slot + WS_WA), j & 31, j >> 5, 0, smem); }
    else if (it < T2) { const int j = it - T1; convert_tile(P.w_b + (size_t)l * 1024 * 1024, 1024, 1024, (bf16_t*)(slot + WS_WB), j & 15, j >> 4, 0, smem); }
    else if (it < T3) { const int j = it - T2; convert_tile(P.w_out + (size_t)l * 1024 * 1024, 1024, 1024, (bf16_t*)(slot + WS_WO), j & 15, j >> 4, 0, smem); }
    else if (it < T4) { const int j = it - T3; convert_tile(P.w_f1 + (size_t)l * 1024 * 5632, 5632, 1024, (bf16_t*)(slot + WS_WF1), j & 15, j >> 4, 2, smem); }
    else { const int j = it - T4; convert_tile(P.w_f2 + (size_t)l * 2816 * 1024, 1024, 2816, (bf16_t*)(slot + WS_WF2), j % 44, j / 44, 0, smem); }
  }
}

DI void phase_setup(const Params& P, unsigned char* smem) {
  const int tid = tid_();
  convert_layer(P, 0, smem);
  {
    bf16_t* BC = (bf16_t*)(P.ws + OFF_BC);
    bf16_t* A256 = (bf16_t*)(P.ws + OFF_A256);
    bf16_t* A1024 = (bf16_t*)(P.ws + OFF_A1024);
    const int total = 131072 + 131072 + 2097152;
    for (int e = bid_() * 256 + tid; e < total; e += gridDim.x * 256) {
      if (e < 131072) {
        const int n = e >> 8, k = e & 255, cs = n >> 8, ch = n & 255;
        const float ph = (float)((ch * k) & 255) * (1.f / 128.f);
        BC[e] = (bf16_t)f2bf(cs ? sinpif(ph) : cospif(ph));
      } else if (e < 262144) {
        const int e2 = e - 131072, m = e2 >> 9, k = e2 & 511, cs = k >> 8, p = k & 255;
        const float ph = (float)((m * p) & 255) * (1.f / 128.f);
        A256[e2] = (bf16_t)f2bf(cs ? -sinpif(ph) : cospif(ph));
      } else {
        const int e2 = e - 262144, m = e2 >> 11, k = e2 & 2047, cs = k >> 10, p = k & 1023;
        const int r1 = m >> 6, c1 = m & 63, r2 = p >> 6, c2 = p & 63;
        const float ph = (float)((4 * r1 * r2 + c1 * c2) & 63) * (1.f / 32.f);
        A1024[e2] = (bf16_t)f2bf(cs ? -sinpif(ph) : cospif(ph));
      }
    }
  }
  {
    float4* X = (float4*)(P.ws + OFF_XRES);
    const float4* xp = (const float4*)P.x_prompt;
    const float4* xs = (const float4*)P.x_sample;
    const int n4p = NCTX * 256, n4 = NTOK * 256;
    for (int e = bid_() * 256 + tid; e < n4; e += gridDim.x * 256) X[e] = e < n4p ? xp[e] : xs[e - n4p];
  }
  {
    float* MODP = (float*)(P.ws + OFF_MODP);
    float* red = (float*)smem;
    const int lane = tid & 63, w = tid >> 6;
    for (int it = bid_(); it < 8 * 4 * 24; it += gridDim.x) {
      const int nc = it % 24, l = (it / 24) & 3, ks = it / 96;
      float4 a[9];
#pragma unroll
      for (int j = 0; j < 9; ++j) a[j] = make_float4(0.f, 0.f, 0.f, 0.f);
      const int kb = ks * 128 + w * 32;
      const float* wp = P.w_mod + ((size_t)l * 1024 + kb) * 6144 + nc * 256 + lane * 4;
      for (int k = 0; k < 32; ++k) {
        const float4 wv = *(const float4*)(wp + (size_t)k * 6144);
#pragma unroll
        for (int j = 0; j < 9; ++j) {
          float cv = j == 0 ? P.c_ctx[kb + k] : P.c[(j - 1) * 1024 + kb + k];
          cv = cv * sigmoidf_(cv);
          a[j].x += cv * wv.x; a[j].y += cv * wv.y; a[j].z += cv * wv.z; a[j].w += cv * wv.w;
        }
      }
      __syncthreads();
#pragma unroll
      for (int j = 0; j < 9; ++j) *(float4*)(red + (w * 9 + j) * 256 + lane * 4) = a[j];
      __syncthreads();
      for (int e = tid; e < 9 * 256; e += 256) {
        const int j = e >> 8, n = e & 255;
        const float s = red[(0 * 9 + j) * 256 + n] + red[(1 * 9 + j) * 256 + n] + red[(2 * 9 + j) * 256 + n] + red[(3 * 9 + j) * 256 + n];
        MODP[((size_t)(ks * 4 + l) * 9 + j) * 6144 + nc * 256 + n] = s;
      }
    }
  }
}

DI void phase_modreduce(const Params& P) {
  const float* MODP = (const float*)(P.ws + OFF_MODP);
  float* MOD = (float*)(P.ws + OFF_MOD);
  const int total = 4 * 9 * 6144;
  for (int e = bid_() * 256 + tid_(); e < total; e += gridDim.x * 256) {
    const int n = e % 6144, l = e / (9 * 6144);
    float s = P.b_mod[l * 6144 + n];
#pragma unroll
    for (int ks = 0; ks < 8; ++ks) s += MODP[(size_t)ks * total + e];
    MOD[e] = s;
  }
}

DI void phase_modulate0(const Params& P) {
  const float* MOD = (const float*)(P.ws + OFF_MOD);
  const float4* X = (const float4*)(P.ws + OFF_XRES);
  uint2* H = (uint2*)(P.ws + OFF_HMOD);
  for (int e = bid_() * 256 + tid_(); e < NTOK * 256; e += gridDim.x * 256) {
    const int tok = e >> 8, n = (e & 255) * 4;
    const float* m = MOD + (size_t)mod_index(tok) * 6144;
    const float4 x = X[e];
    const float4 sh = *(const float4*)(m + n), sc = *(const float4*)(m + 1024 + n);
    uint2 o;
    o.x = pack2(x.x * (1.f + sc.x) + sh.x, x.y * (1.f + sc.y) + sh.y);
    o.y = pack2(x.z * (1.f + sc.z) + sh.z, x.w * (1.f + sc.w) + sh.w);
    H[e] = o;
  }
}

DI void phase_gemm_in(const Params& P, int l, unsigned char* smem) {
  const bf16_t* H = (const bf16_t*)(P.ws + OFF_HMOD);
  const bf16_t* W = (const bf16_t*)(P.ws + (size_t)(l & 1) * SZ_SLOT + WS_WIN);
  bf16_t* Q = (bf16_t*)(P.ws + OFF_Q);
  bf16_t* Kn = (bf16_t*)(P.ws + OFF_K);
  bf16_t* KT = (bf16_t*)(P.ws + OFF_KT);
  bf16_t* VT = (bf16_t*)(P.ws + OFF_VT);
  bf16_t* VTC = (bf16_t*)(P.ws + OFF_VTC);
  bf16_t* OG = (bf16_t*)(P.ws + OFF_OG);
  bf16_t* UF = (bf16_t*)(P.ws + OFF_UF);
  bf16_t* GA = (bf16_t*)(P.ws + OFF_GA);
  bf16_t* GB = (bf16_t*)(P.ws + OFF_GB);
  float* GATES = (float*)(P.ws + OFF_GATES);
  for (int t = vblock(); t < 96 * 73; t += gridDim.x) {
    int mtile, ntile;
    tile_decode(t, 96, 73, mtile, ntile);
    const int m0 = mtile * 128, n0 = ntile * 128;
    f32x16 acc[2][2];
    acc_zero(acc);
    gemm_mainloop<false>(acc, H + (size_t)m0 * 1024, 1024, W + (size_t)n0 * 1024, 1024, 1024, nullptr, smem);
    EPI_VARS;
    if (ntile < 8 || (ntile >= 32 && ntile < 72)) {
      bf16_t* dst; int ld, cb; bool sg;
      if (ntile < 8) { dst = Q; ld = 1024; cb = n0; sg = false; }
      else if (ntile < 48) { dst = OG; ld = 2048; cb = n0 - 4096; sg = true; }
      else if (ntile < 56) { dst = UF; ld = 1024; cb = n0 - 6144; sg = false; }
      else if (ntile < 64) { dst = GA; ld = 1024; cb = n0 - 7168; sg = true; }
      else { dst = GB; ld = 1024; cb = n0 - 8192; sg = true; }
      if (sg) store_tile_bf16<1>(acc, dst + (size_t)m0 * ld + cb, ld, smem);
      else store_tile_bf16<0>(acc, dst + (size_t)m0 * ld + cb, ld, smem);
    } else if (ntile < 16) {
      const int cb = n0 - 1024;
#pragma unroll
      for (int mt = 0; mt < 2; ++mt)
#pragma unroll
        for (int nt = 0; nt < 2; ++nt) {
#pragma unroll
          for (int i = 0; i < 16; ++i) { const int tk = m0 + RW(mt, i), kc2 = cb + CL(nt); Kn[((size_t)(tk >> 5) * 4 + (kc2 >> 8)) * 8192 + (tk & 31) * 256 + (kc2 & 255)] = (bf16_t)f2bf(acc[mt][nt][i] * 0.0625f); }
          if (m0 < NCTX) {
            const int kc = cb + CL(nt), hd = kc >> 8, d = kc & 255;
#pragma unroll
            for (int i4 = 0; i4 < 4; ++i4) {
              const int tok0 = m0 + RW(mt, 4 * i4), b = tok0 >> 8, s = tok0 & 255;
              uint2 v;
              v.x = pack2(acc[mt][nt][4 * i4] * 0.0625f, acc[mt][nt][4 * i4 + 1] * 0.0625f);
              v.y = pack2(acc[mt][nt][4 * i4 + 2] * 0.0625f, acc[mt][nt][4 * i4 + 3] * 0.0625f);
              *(uint2*)(KT + ((size_t)((b * 4 + hd) * 256 + d)) * 256 + s) = v;
            }
          }
        }
    } else if (ntile < 32) {
      const int cb = n0 - 2048;
#pragma unroll
      for (int mt = 0; mt < 2; ++mt)
#pragma unroll
        for (int nt = 0; nt < 2; ++nt) {
          const int vc = cb + CL(nt);
#pragma unroll
          for (int i4 = 0; i4 < 4; ++i4) {
            const int tok0 = m0 + RW(mt, 4 * i4);
            uint2 v;
            v.x = pack2(acc[mt][nt][4 * i4], acc[mt][nt][4 * i4 + 1]);
            v.y = pack2(acc[mt][nt][4 * i4 + 2], acc[mt][nt][4 * i4 + 3]);
            *(uint2*)(VT + ((size_t)(tok0 >> 5) * 2048 + vc) * 32 + (tok0 & 31)) = v;
            if (tok0 < NCTX) *(uint2*)(VTC + ((size_t)(tok0 >> 8) * 2048 + vc) * 256 + (tok0 & 255)) = v;
          }
        }
    } else {
      if (wn_ == 0 && rr_ < 16) {
        const int g = rr_;
        const float bg = P.b_gate[l * 16 + g];
        const bool isf = (g >> 2) & 1;
#pragma unroll
        for (int mt = 0; mt < 2; ++mt)
#pragma unroll
          for (int i = 0; i < 16; ++i) {
            float v = acc[mt][0][i] + bg;
            if (isf) v = logsigmoidf_(v);
            GATES[(size_t)(m0 + RW(mt, i)) * 16 + g] = v;
          }
      }
    }
  }
}

DI float wave_excl_sum(float v, int lane) {
  float x = v;
#pragma unroll
  for (int o = 1; o < 64; o <<= 1) { const float y = __shfl_up(x, o, 64); if (lane >= o) x += y; }
  return x - v;
}
DI float wave_excl_max(float v, int lane, float init) {
  float x = v;
#pragma unroll
  for (int o = 1; o < 64; o <<= 1) { const float y = __shfl_up(x, o, 64); if (lane >= o) x = fmaxf(x, y); }
  const float p = __shfl_up(x, 1, 64);
  return lane == 0 ? init : fmaxf(init, p);
}

template <int E>
DI void scan_wave(const Params& P, int l, int sid) {
  const int lane = tid_() & 63;
  const int dir = sid & 1, hd = (sid >> 1) & 3, seq = sid >> 3;
  const bool lat = seq >= 16;
  const int S = E * 64;
  const int tok0 = lat ? NCTX + (seq - 16) * 1024 : seq * 256;
  const float* G = (const float*)(P.ws + OFF_GATES);
  const size_t gi = (size_t)(dir * 4 + hd) * NTOK;
  float* BETA = (float*)(P.ws + OFF_BETA) + gi;
  float* MM = (float*)(P.ws + OFF_MM) + gi;
  float* EMT = (float*)(P.ws + OFF_EMT) + gi;
  float* WFIN = (float*)(P.ws + OFF_WFIN) + gi;
  const int gi_i = dir * 8 + hd, gi_f = dir * 8 + 4 + hd;
  const float m0 = lat ? P.state_m[(((seq - 16) * 4 + l) * 2 + dir) * 4 + hd] : 0.f;
  float tot = 0.f;
#pragma unroll
  for (int e = 0; e < E; ++e) {
    const int j = lane * E + e, tok = dir == 0 ? tok0 + j : tok0 + S - 1 - j;
    tot += G[(size_t)tok * 16 + gi_f];
  }
  const float boff = wave_excl_sum(tot, lane);
  float b = boff, cmax = -3.0e38f;
#pragma unroll
  for (int e = 0; e < E; ++e) {
    const int j = lane * E + e, tok = dir == 0 ? tok0 + j : tok0 + S - 1 - j;
    b += G[(size_t)tok * 16 + gi_f];
    const float be = G[(size_t)tok * 16 + gi_i] - b;
    BETA[tok] = be;
    cmax = fmaxf(cmax, be);
  }
  float M = wave_excl_max(cmax, lane, m0);
  b = boff;
#pragma unroll
  for (int e = 0; e < E; ++e) {
    const int j = lane * E + e, tok = dir == 0 ? tok0 + j : tok0 + S - 1 - j;
    b += G[(size_t)tok * 16 + gi_f];
    const float be = G[(size_t)tok * 16 + gi_i] - b;
    M = fmaxf(M, be);
    MM[tok] = M;
    EMT[tok] = __expf(-b - M);
  }
  if (!lat) {
    const float Mlast = __shfl(M, 63, 64);
    const float Blast = __shfl(b, 63, 64);
    if (lane == 0) P.out[OUT_NEWM + (((seq * 4 + l) * 2 + dir) * 4 + hd)] = Blast + Mlast;
    b = boff;
  #pragma unroll
  for (int e = 0; e < E; ++e) {
      const int j = lane * E + e, tok = dir == 0 ? tok0 + j : tok0 + S - 1 - j;
      b += G[(size_t)tok * 16 + gi_f];
      const float be = G[(size_t)tok * 16 + gi_i] - b;
      WFIN[tok] = __expf(be - Mlast);
    }
  }
}

DI void convert_c0(const Params& P, int l) {
  bf16_t* C0T = (bf16_t*)(P.ws + OFF_C0T);
  const int total = 64 * 512 * 32;
  for (int e = bid_() * 256 + tid_(); e < total; e += gridDim.x * 256) {
    const int j = e & 31, v = (e >> 5) & 511, sp = e >> 14;
    const int b = sp >> 3, dir = (sp >> 2) & 1, hd = sp & 3;
    const float* src = P.state_C + ((size_t)((((b * 4 + l) * 2 + dir) * 4 + hd) * 512 + v)) * 256 + j * 8;
    const float4 x0 = *(const float4*)src, x1 = *(const float4*)(src + 4);
    uint4 o;
    o.x = pack2(x0.x, x0.y); o.y = pack2(x0.z, x0.w); o.z = pack2(x1.x, x1.y); o.w = pack2(x1.z, x1.w);
    *(uint4*)(C0T + ((size_t)((sp * 2 + (v >> 8)) * 8 + (j >> 2)) * 256 + (v & 255)) * 32 + (j & 3) * 8) = o;
  }
}

DI void phase_scan_four1(const Params& P, int l, unsigned char* smem) {
  convert_c0(P, l);
  const bf16_t* UF = (const bf16_t*)(P.ws + OFF_UF);
  const bf16_t* BC = (const bf16_t*)(P.ws + OFF_BC);
  bf16_t* TT = (bf16_t*)(P.ws + OFF_TT);
  for (int it = bid_(); it < 48 + 1536; it += gridDim.x) {
    if (it < 48) { const int sid = it * 4 + (tid_() >> 6); if (sid < 128) scan_wave<4>(P, l, sid); else scan_wave<16>(P, l, sid); continue; }
    const int t = it - 48, g = t / 384, rem = t - g * 384;
    int mtile, ntile;
    tile_decode(rem, 96, 4, mtile, ntile);
    const int m0 = mtile * 128, n0 = ntile * 128;
    f32x16 acc[2][2];
    acc_zero(acc);
    gemm_mainloop<false>(acc, UF + (size_t)m0 * 1024 + g * 256, 1024, BC + (size_t)n0 * 256, 256, 256, nullptr, smem);
    EPI_VARS;
#pragma unroll
    for (int mt = 0; mt < 2; ++mt)
#pragma unroll
      for (int nt = 0; nt < 2; ++nt) {
        const int n = n0 + CL(nt), cs = n >> 8, ch = n & 255;
#pragma unroll
        for (int i4 = 0; i4 < 4; ++i4) {
          const int tok0 = m0 + RW(mt, 4 * i4);
          uint2 v;
          v.x = pack2(acc[mt][nt][4 * i4], acc[mt][nt][4 * i4 + 1]);
          v.y = pack2(acc[mt][nt][4 * i4 + 2], acc[mt][nt][4 * i4 + 3]);
          size_t idx;
          if (tok0 < NCTX) idx = ((size_t)(((tok0 >> 8) * 4 + g) * 256 + ch)) * 512 + cs * 256 + (tok0 & 255);
          else { const int tl = tok0 - NCTX; idx = TT_LAT + ((size_t)(((tl >> 10) * 4 + g) * 256 + ch)) * 2048 + cs * 1024 + (tl & 1023); }
          *(uint2*)(TT + idx) = v;
        }
      }
  }
}

DI void mlstm_item(const Params& P, int l, int seq, int hd, int qb, int vh, unsigned char* smem) {
  const int tid = tid_(), lane = tid & 63, w = tid >> 6, c = lane & 15, q = lane >> 4;
  const bool lat = seq >= 16;
  const int S = lat ? 1024 : 256;
  const int tok0 = lat ? NCTX + (seq - 16) * 1024 : seq * 256;
  const int bl = seq - 16;
  const bf16_t* Qg = (const bf16_t*)(P.ws + OFF_Q);
  const bf16_t* Kg = (const bf16_t*)(P.ws + OFF_K);
  const bf16_t* VT = (const bf16_t*)(P.ws + OFF_VT) + ((size_t)(tok0 >> 5) * 2048 + hd * 512 + vh * 256) * 32;
  unsigned char* sK = smem;
  unsigned char* sV = smem + 16896;
  const int t_loc = qb * 64 + w * 16 + c;
  const int tokq = tok0 + t_loc;
  bf16x8 qf[8];
  {
    const bf16_t* qp = Qg + (size_t)tokq * 1024 + hd * 256 + q * 8;
#pragma unroll
    for (int kk = 0; kk < 8; ++kk) qf[kk] = *(const bf16x8*)(qp + kk * 32);
#pragma unroll
    for (int kk = 0; kk < 8; ++kk) asm volatile("" : "+v"(qf[kk]));
  }
  __syncthreads();
  const int nkb = S >> 5;
  const size_t rowbase = (size_t)(tok0 + qb * 64 + w * 16 + 4 * q) * 2048 + hd * 512 + vh * 256 + c;
  const bf16_t* kld = Kg + ((size_t)(tok0 >> 5) * 4 + hd) * 8192 + tid * 8;
  unsigned char* ksd = sK + (tid >> 5) * 528 + (tid & 31) * 16;
  const bf16_t* vld = VT + tid * 8;
  unsigned char* vsd = sV + (tid >> 2) * 80 + (tid & 3) * 16;
  u32x4 st[8], bt[2], btn[2];
#define STWAIT() asm volatile("s_waitcnt vmcnt(0)" : "+v"(st[0]), "+v"(st[1]), "+v"(st[2]), "+v"(st[3]), "+v"(st[4]), "+v"(st[5]), "+v"(st[6]), "+v"(st[7]), "+v"(btn[0]), "+v"(btn[1]) : : "memory")
#define ISSUE_KV(kb_)                                                                      \
  {                                                                                        \
    const bf16_t* kp_ = kld + (size_t)(kb_) * 4 * 8192;                                    \
    const bf16_t* vp_ = vld + (size_t)(kb_) * 2048 * 32;                                   \
    _Pragma("unroll") for (int i = 0; i < 4; ++i) st[i] = gld16(kp_ + i * 2048);           \
    _Pragma("unroll") for (int i = 0; i < 4; ++i) st[4 + i] = gld16(vp_ + i * 2048);       \
    btn[0] = gld16(BETA + (kb_) * 32);                                                     \
    btn[1] = gld16(BETA + (kb_) * 32 + 16);                                                \
  }
#define STORE_KV()                                                                         \
  {                                                                                        \
    _Pragma("unroll") for (int i = 0; i < 4; ++i) *(u32x4*)(ksd + i * 8 * 528) = st[i];    \
    _Pragma("unroll") for (int i = 0; i < 4; ++i) *(u32x4*)(vsd + i * 64 * 80) = st[4 + i];\
    bt[0] = btn[0]; bt[1] = btn[1];                                                        \
  }
#define ISSUE_C0(kk_) { _Pragma("unroll") for (int i = 0; i < 4; ++i) st[4 + i] = gld16(C0 + (kk_) * 8192 + i * 2048); }
#define STORE_C0() { _Pragma("unroll") for (int i = 0; i < 4; ++i) *(u32x4*)(vsd + i * 64 * 80) = st[4 + i]; }
#pragma unroll 1
  for (int dir = 0; dir < 2; ++dir) {
    f32x4 acc[16];
#pragma unroll
    for (int n = 0; n < 16; ++n) acc[n] = (f32x4){0.f, 0.f, 0.f, 0.f};
    float den = 0.f;
    const size_t gi = (size_t)(dir * 4 + hd) * NTOK;
    const float* BETA = (const float*)(P.ws + OFF_BETA) + gi + tok0 + 4 * q;
    const float Mt = ((const float*)(P.ws + OFF_MM))[gi + tokq];
    const float emt = ((const float*)(P.ws + OFF_EMT))[gi + tokq];
    const int kb_lo = dir == 0 ? 0 : 2 * qb;
    const int kb_hi = dir == 0 ? 2 * qb + 1 : nkb - 1;
    asm volatile("" : : "v"(Mt), "v"(emt));
    btn[0] = btn[1] = (u32x4){0u, 0u, 0u, 0u};
    st[0] = st[1] = st[2] = st[3] = (u32x4){0u, 0u, 0u, 0u};
    if (lat) {
      const int sidx = ((bl * 4 + l) * 2 + dir) * 4 + hd;
      const float inter = __expf(P.state_m[sidx] - Mt);
      const bf16_t* C0 = (const bf16_t*)(P.ws + OFF_C0T) + ((size_t)(((bl * 2 + dir) * 4 + hd) * 2 + vh) * 8) * 8192 + tid * 8;
      float* sN = (float*)(smem + 71168);
      float sdot = 0.f;
      __syncthreads();
      {
        const float nv = P.state_n[(size_t)sidx * 256 + tid];
        sN[tid] = nv;
      }
      asm volatile("" : : "v"(inter));
      const float* n0p = sN + q * 8;
      ISSUE_C0(0);
      STWAIT();
      STORE_C0();
      __syncthreads();
#pragma unroll
      for (int kk = 0; kk < 8; ++kk) {
        const int kn = kk < 7 ? kk + 1 : 7;
        ISSUE_C0(kn);
        const bf16x8 qk = qf[kk];
#pragma unroll
        for (int e = 0; e < 8; ++e) sdot += bf2f((unsigned)(unsigned short)qk[e]) * n0p[kk * 32 + e];
        {
          bf16x8 fb[2][4];
          const unsigned char* vb_ = sV + c * 80 + q * 16;
#pragma unroll
          for (int j = 0; j < 4; ++j) fb[0][j] = *(const bf16x8*)(vb_ + j * 16 * 80);
#pragma unroll
          for (int g = 0; g < 4; ++g) {
            if (g < 3) {
#pragma unroll
              for (int j = 0; j < 4; ++j) fb[(g + 1) & 1][j] = *(const bf16x8*)(vb_ + ((g + 1) * 4 + j) * 16 * 80);
            }
#pragma unroll
            for (int j = 0; j < 4; ++j) acc[g * 4 + j] = MFMA16(qk, fb[g & 1][j], acc[g * 4 + j]);
            __builtin_amdgcn_sched_barrier(0);
          }
        }
        STWAIT();
        __syncthreads();
        STORE_C0();
        __syncthreads();
      }
      float it_[4];
#pragma unroll
      for (int j = 0; j < 4; ++j) it_[j] = __shfl(inter, 4 * q + j, 64);
#pragma unroll
      for (int n = 0; n < 16; ++n)
#pragma unroll
        for (int j = 0; j < 4; ++j) acc[n][j] *= it_[j];
      den = inter * sdot;
    }
    __syncthreads();
    ISSUE_KV(kb_lo);
    STWAIT();
    STORE_KV();
    __syncthreads();
#pragma unroll 1
    for (int kb = kb_lo; kb <= kb_hi; ++kb) {
      const int kbn = kb < kb_hi ? kb + 1 : kb_hi;
      ISSUE_KV(kbn);
      const float bb0[4] = {__uint_as_float(bt[0].x), __uint_as_float(bt[0].y), __uint_as_float(bt[0].z), __uint_as_float(bt[0].w)};
      const float bb1[4] = {__uint_as_float(bt[1].x), __uint_as_float(bt[1].y), __uint_as_float(bt[1].z), __uint_as_float(bt[1].w)};
      f32x4 x0 = (f32x4){0.f, 0.f, 0.f, 0.f}, x1 = (f32x4){0.f, 0.f, 0.f, 0.f};
      {
        bf16x8 fa0[2], fa1[2];
        const unsigned char* k0_ = sK + c * 528 + q * 16;
        fa0[0] = *(const bf16x8*)(k0_); fa1[0] = *(const bf16x8*)(k0_ + 16 * 528);
#pragma unroll
        for (int kk = 0; kk < 8; ++kk) {
          if (kk < 7) {
            fa0[(kk + 1) & 1] = *(const bf16x8*)(k0_ + (kk + 1) * 64);
            fa1[(kk + 1) & 1] = *(const bf16x8*)(k0_ + 16 * 528 + (kk + 1) * 64);
          }
          x0 = MFMA16(fa0[kk & 1], qf[kk], x0);
          x1 = MFMA16(fa1[kk & 1], qf[kk], x1);
          __builtin_amdgcn_sched_barrier(0);
        }
      }
      float p0[4], p1[4];
      const bool diag = (kb >> 1) == qb;
      if (diag) {
#pragma unroll
        for (int j = 0; j < 4; ++j) {
          const int s0 = kb * 32 + 4 * q + j, s1 = s0 + 16;
          const bool ok0 = dir == 0 ? (s0 <= t_loc) : (s0 >= t_loc);
          const bool ok1 = dir == 0 ? (s1 <= t_loc) : (s1 >= t_loc);
          p0[j] = ok0 ? x0[j] * __expf(bb0[j] - Mt) : 0.f;
          p1[j] = ok1 ? x1[j] * __expf(bb1[j] - Mt) : 0.f;
          den += p0[j] + p1[j];
        }
      } else {
#pragma unroll
        for (int j = 0; j < 4; ++j) {
          p0[j] = x0[j] * __expf(bb0[j] - Mt);
          p1[j] = x1[j] * __expf(bb1[j] - Mt);
          den += p0[j] + p1[j];
        }
      }
      uint4 pu;
      pu.x = pack2(p0[0], p0[1]); pu.y = pack2(p0[2], p0[3]); pu.z = pack2(p1[0], p1[1]); pu.w = pack2(p1[2], p1[3]);
      const bf16x8 pa = __builtin_bit_cast(bf16x8, pu);
      {
        uint2 lo[2][4], hi[2][4];
        const unsigned char* vb_ = sV + c * 80 + q * 8;
#pragma unroll
        for (int j = 0; j < 4; ++j) { lo[0][j] = *(const uint2*)(vb_ + j * 16 * 80); hi[0][j] = *(const uint2*)(vb_ + j * 16 * 80 + 32); }
#pragma unroll
        for (int g = 0; g < 4; ++g) {
          if (g < 3) {
#pragma unroll
            for (int j = 0; j < 4; ++j) {
              lo[(g + 1) & 1][j] = *(const uint2*)(vb_ + ((g + 1) * 4 + j) * 16 * 80);
              hi[(g + 1) & 1][j] = *(const uint2*)(vb_ + ((g + 1) * 4 + j) * 16 * 80 + 32);
            }
          }
#pragma unroll
          for (int j = 0; j < 4; ++j) {
            uint4 vu;
            vu.x = lo[g & 1][j].x; vu.y = lo[g & 1][j].y; vu.z = hi[g & 1][j].x; vu.w = hi[g & 1][j].y;
            acc[g * 4 + j] = MFMA16(pa, __builtin_bit_cast(bf16x8, vu), acc[g * 4 + j]);
          }
          __builtin_amdgcn_sched_barrier(0);
        }
      }
      STWAIT();
      __syncthreads();
      STORE_KV();
      __syncthreads();
    }
    den += __shfl_xor(den, 16, 64);
    den += __shfl_xor(den, 32, 64);
    const float rinv = 1.f / fmaxf(fabsf(den), emt);
    float rj[4];
#pragma unroll
    for (int j = 0; j < 4; ++j) rj[j] = __shfl(rinv, 4 * q + j, 64);
    bf16_t* HS = (bf16_t*)(P.ws + OFF_H0) + rowbase;
    asm volatile("" : "+v"(HS));
    bf16_t* h0p = HS; bf16_t* h1p = HS + 2048; bf16_t* h2p = HS + 4096; bf16_t* h3p = HS + 6144;
    asm volatile("" : "+v"(h1p));
    asm volatile("" : "+v"(h2p));
    asm volatile("" : "+v"(h3p));
    if (dir == 0) {
#pragma unroll
      for (int n = 0; n < 16; ++n) {
        h0p[n * 16] = (bf16_t)f2bf(acc[n][0] * rj[0]);
        h1p[n * 16] = (bf16_t)f2bf(acc[n][1] * rj[1]);
        h2p[n * 16] = (bf16_t)f2bf(acc[n][2] * rj[2]);
        h3p[n * 16] = (bf16_t)f2bf(acc[n][3] * rj[3]);
      }
    } else {
#pragma unroll
      for (int n = 0; n < 16; ++n) {
        h0p[n * 16] = (bf16_t)f2bf(acc[n][0] * rj[0] + bf2f(h0p[n * 16]));
        h1p[n * 16] = (bf16_t)f2bf(acc[n][1] * rj[1] + bf2f(h1p[n * 16]));
        h2p[n * 16] = (bf16_t)f2bf(acc[n][2] * rj[2] + bf2f(h2p[n * 16]));
        h3p[n * 16] = (bf16_t)f2bf(acc[n][3] * rj[3] + bf2f(h3p[n * 16]));
        if ((n & 3) == 3) __builtin_amdgcn_sched_barrier(0);
      }
    }
  }
}

#undef STWAIT
#undef ISSUE_KV
#undef ISSUE_C0
#undef STORE_KV
#undef STORE_C0

DI void phase_hn(const Params& P, int l) {
  const bf16_t* HS = (const bf16_t*)(P.ws + OFF_H0);
  const bf16_t* OG = (const bf16_t*)(P.ws + OFF_OG);
  bf16_t* HN = (bf16_t*)(P.ws + OFF_HN);
  const int tidl_ = tid_(), lane = tidl_ & 63, w = tidl_ >> 6;
  for (int pr = bid_() * 4 + w; pr < NTOK * 4; pr += gridDim.x * 4) {
    const size_t base = (size_t)pr * 512 + lane * 8;
    const uint4 hv = *(const uint4*)(HS + base);
    const uint4 ov = *(const uint4*)(OG + base);
    const unsigned hu[4] = {hv.x, hv.y, hv.z, hv.w}, ou[4] = {ov.x, ov.y, ov.z, ov.w};
    float x[8];
    float s = 0.f;
#pragma unroll
    for (int i = 0; i < 4; ++i) { x[2 * i] = bf2f(hu[i] & 0xffffu); x[2 * i + 1] = bf2f(hu[i] >> 16); s += x[2 * i] + x[2 * i + 1]; }
#pragma unroll
    for (int o = 1; o < 64; o <<= 1) s += __shfl_xor(s, o, 64);
    const float mu = s * (1.f / 512.f);
    float vs = 0.f;
#pragma unroll
    for (int i = 0; i < 8; ++i) { const float d = x[i] - mu; vs += d * d; }
#pragma unroll
    for (int o = 1; o < 64; o <<= 1) vs += __shfl_xor(vs, o, 64);
    const float rs = rsqrtf(vs * (1.f / 512.f) + LN_EPS);
    const float* gp = P.mh_gain + l * 2048 + (pr & 3) * 512 + lane * 8;
    const float4 g0 = *(const float4*)gp, g1 = *(const float4*)(gp + 4);
    const float g[8] = {g0.x, g0.y, g0.z, g0.w, g1.x, g1.y, g1.z, g1.w};
    unsigned r[4];
#pragma unroll
    for (int i = 0; i < 4; ++i)
      r[i] = pack2((x[2 * i] - mu) * rs * g[2 * i] * bf2f(ou[i] & 0xffffu), (x[2 * i + 1] - mu) * rs * g[2 * i + 1] * bf2f(ou[i] >> 16));
    *(uint4*)(HN + base) = make_uint4(r[0], r[1], r[2], r[3]);
  }
}

DI void phase_mixers(const Params& P, int l, unsigned char* smem) {
  const bf16_t* VTC = (const bf16_t*)(P.ws + OFF_VTC);
  const bf16_t* KT = (const bf16_t*)(P.ws + OFF_KT);
  const bf16_t* Kn = (const bf16_t*)(P.ws + OFF_K);
  const bf16_t* TT = (const bf16_t*)(P.ws + OFF_TT);
  const bf16_t* A256 = (const bf16_t*)(P.ws + OFF_A256);
  const bf16_t* A1024 = (const bf16_t*)(P.ws + OFF_A1024);
  const float* WFIN = (const float*)(P.ws + OFF_WFIN);
  bf16_t* FB = (bf16_t*)(P.ws + OFF_FB);
  for (int it0 = bid_(); it0 < 1024 + 2304; it0 += gridDim.x) {
    if (it0 < 1024) { mlstm_item(P, l, 16 + (it0 >> 7), (it0 >> 5) & 3, (it0 >> 1) & 15, it0 & 1, smem); continue; }
    const int r = it0 - 1024;
    if (r >= 512 && r < 1024) { const int j = r - 512; mlstm_item(P, l, j >> 5, (j >> 3) & 3, (j >> 1) & 3, j & 1, smem); continue; }
    f32x16 acc[2][2];
    acc_zero(acc);
    if (r < 512) {
      const int j = r, sg = j >> 4, mtile = (j >> 1) & 7, ntile = j & 1;
      gemm_mainloop<false>(acc, A1024 + (size_t)mtile * 128 * 2048, 2048, TT + TT_LAT + ((size_t)sg * 256 + ntile * 128) * 2048, 2048, 2048, nullptr, smem);
      EPI_VARS;
      const int seq = sg >> 2, g = sg & 3;
#pragma unroll
      for (int mt = 0; mt < 2; ++mt)
#pragma unroll
        for (int nt = 0; nt < 2; ++nt)
#pragma unroll
          for (int i = 0; i < 16; ++i)
            FB[(size_t)(NCTX + seq * 1024 + mtile * 128 + RW(mt, i)) * 1024 + g * 256 + ntile * 128 + CL(nt)] = (bf16_t)f2bf(acc[mt][nt][i] * (1.f / 512.f));
    } else if (r >= 2048) {
      const int j = r - 2048, sg = j >> 2, mtile = (j >> 1) & 1, ntile = j & 1;
      gemm_mainloop<false>(acc, A256 + (size_t)mtile * 128 * 512, 512, TT + ((size_t)sg * 256 + ntile * 128) * 512, 512, 512, nullptr, smem);
      EPI_VARS;
      const int seq = sg >> 2, g = sg & 3;
#pragma unroll
      for (int mt = 0; mt < 2; ++mt)
#pragma unroll
        for (int nt = 0; nt < 2; ++nt)
#pragma unroll
          for (int i = 0; i < 16; ++i)
            FB[(size_t)(seq * 256 + mtile * 128 + RW(mt, i)) * 1024 + g * 256 + ntile * 128 + CL(nt)] = (bf16_t)f2bf(acc[mt][nt][i] * (1.f / 256.f));
    } else {
      const int j = r - 1024, bhd = j >> 3, mtile = (j >> 1) & 3, ntile = j & 1;
      const int b = bhd >> 3, hd = (bhd >> 1) & 3, dir = bhd & 1;
      const float* wf = WFIN + (size_t)(dir * 4 + hd) * NTOK + b * 256;
      gemm_mainloop<true>(acc, VTC + ((size_t)b * 2048 + hd * 512 + mtile * 128) * 256, 256, KT + ((size_t)(b * 4 + hd) * 256 + ntile * 128) * 256, 256, 256, wf, smem);
      EPI_VARS;
      const size_t sidx = (size_t)(((b * 4 + l) * 2 + dir) * 4 + hd);
      float* Co = P.out + OUT_NEWC + sidx * 512 * 256;
#pragma unroll
      for (int mt = 0; mt < 2; ++mt)
#pragma unroll
        for (int nt = 0; nt < 2; ++nt)
#pragma unroll
          for (int i = 0; i < 16; ++i) Co[(size_t)(mtile * 128 + RW(mt, i)) * 256 + ntile * 128 + CL(nt)] = acc[mt][nt][i];
      if (mtile == 0 && tid_e_ < 128) {
        const int d = ntile * 128 + tid_e_;
        float s = 0.f;
        for (int sp = 0; sp < 256; ++sp) s += wf[sp] * bf2f(Kn[((size_t)((b * 256 + sp) >> 5) * 4 + hd) * 8192 + (sp & 31) * 256 + d]);
        P.out[OUT_NEWN + sidx * 256 + d] = s;
      }
    }
  }
}

DI void phase_branch(const Params& P, int l, unsigned char* smem) {
  const unsigned char* slot = P.ws + (size_t)(l & 1) * SZ_SLOT;
  const bf16_t* HN = (const bf16_t*)(P.ws + OFF_HN);
  const bf16_t* FB = (const bf16_t*)(P.ws + OFF_FB);
  const bf16_t* WA = (const bf16_t*)(slot + WS_WA);
  const bf16_t* WB = (const bf16_t*)(slot + WS_WB);
  const bf16_t* GA = (const bf16_t*)(P.ws + OFF_GA);
  const bf16_t* GB = (const bf16_t*)(P.ws + OFF_GB);
  bf16_t* MG = (bf16_t*)(P.ws + OFF_MERGED);
  for (int t = vblock(); t < 64 * 8; t += gridDim.x) {
    int mtile, ntile;
    tile_decode(t, 64, 8, mtile, ntile);
    const int m0 = mtile * 192, n0 = ntile * 128;
    f32x16 acc[3][2];
    acc_zero3(acc);
    gemm192_mainloop(acc, HN + (size_t)m0 * 2048, 2048, WA + (size_t)n0 * 2048, 2048, 2048, smem);
    const bf16_t* GAb = GA + (size_t)m0 * 1024 + n0;
    const bf16_t* GBb = GB + (size_t)m0 * 1024 + n0;
    bf16_t* MGb = MG + (size_t)m0 * 1024 + n0;
    {
      EPI_VARS;
#pragma unroll
      for (int mt = 0; mt < 3; ++mt)
#pragma unroll
        for (int nt = 0; nt < 2; ++nt)
#pragma unroll
          for (int i = 0; i < 16; ++i) {
            const unsigned o = (unsigned)RW3(mt, i) * 1024u + CL(nt);
            MGb[o] = (bf16_t)f2bf(bf2f(GAb[o]) * acc[mt][nt][i]);
          }
    }
    acc_zero3(acc);
    gemm192_mainloop(acc, FB + (size_t)m0 * 1024, 1024, WB + (size_t)n0 * 1024, 1024, 1024, smem);
    EPI_VARS;
#pragma unroll
    for (int mt = 0; mt < 3; ++mt)
#pragma unroll
      for (int nt = 0; nt < 2; ++nt)
#pragma unroll
        for (int i = 0; i < 16; ++i) {
          const unsigned o = (unsigned)RW3(mt, i) * 1024u + CL(nt);
          MGb[o] = (bf16_t)f2bf(bf2f(MGb[o]) + bf2f(GBb[o]) * acc[mt][nt][i]);
        }
  }
}

DI void phase_resid_gemm(const Params& P, int l, const bf16_t* A, int K, const bf16_t* W, int goff, unsigned char* smem) {
  const float* X = (const float*)(P.ws + OFF_XRES);
  const float* MOD = (const float*)(P.ws + OFF_MOD) + (size_t)l * 9 * 6144;
  float* PRE = (float*)(P.ws + OFF_PRELN);
  for (int t = vblock(); t < 64 * 8; t += gridDim.x) {
    int mtile, ntile;
    tile_decode(t, 64, 8, mtile, ntile);
    const int m0 = mtile * 192, n0 = ntile * 128;
    f32x16 acc[3][2];
    acc_zero3(acc);
    gemm192_mainloop(acc, A + (size_t)m0 * K, K, W + (size_t)n0 * K, K, K, smem);
    EPI_VARS;
    const float* Xb = X + (size_t)m0 * 1024 + n0;
    float* PREb = PRE + (size_t)m0 * 1024 + n0;
#pragma unroll
    for (int mt = 0; mt < 3; ++mt)
#pragma unroll
      for (int nt = 0; nt < 2; ++nt)
#pragma unroll
        for (int i = 0; i < 16; ++i) {
          const int row = RW3(mt, i);
          const unsigned o = (unsigned)row * 1024u + CL(nt);
          const float gv = MOD[(size_t)mod_index(m0 + row) * 6144 + goff + n0 + CL(nt)];
          PREb[o] = ALPHA * Xb[o] + gv * acc[mt][nt][i];
        }
  }
}

DI void phase_ln(const Params& P, const float* gain, const float* bias, float* xdst, const float* modn, int shoff, int scoff) {
  const float* PRE = (const float*)(P.ws + OFF_PRELN);
  bf16_t* H = (bf16_t*)(P.ws + OFF_HMOD);
  const int tidl_ = tid_(), lane = tidl_ & 63, w = tidl_ >> 6;
  for (int tok = bid_() * 4 + w; tok < NTOK; tok += gridDim.x * 4) {
    float4 v[4];
    float s = 0.f;
#pragma unroll
    for (int i = 0; i < 4; ++i) {
      v[i] = *(const float4*)(PRE + (size_t)tok * 1024 + (i * 64 + lane) * 4);
      s += v[i].x + v[i].y + v[i].z + v[i].w;
    }
#pragma unroll
    for (int o = 1; o < 64; o <<= 1) s += __shfl_xor(s, o, 64);
    const float mu = s * (1.f / 1024.f);
    float vs = 0.f;
#pragma unroll
    for (int i = 0; i < 4; ++i) {
      const float a = v[i].x - mu, b = v[i].y - mu, c = v[i].z - mu, d = v[i].w - mu;
      vs += a * a + b * b + c * c + d * d;
    }
#pragma unroll
    for (int o = 1; o < 64; o <<= 1) vs += __shfl_xor(vs, o, 64);
    const float rs = rsqrtf(vs * (1.f / 1024.f) + LN_EPS);
    const float* m = modn ? modn + (size_t)mod_index(tok) * 6144 : nullptr;
#pragma unroll
    for (int i = 0; i < 4; ++i) {
      const int n = (i * 64 + lane) * 4;
      const float4 g = *(const float4*)(gain + n), b = *(const float4*)(bias + n);
      float4 x;
      x.x = (v[i].x - mu) * rs * g.x + b.x; x.y = (v[i].y - mu) * rs * g.y + b.y;
      x.z = (v[i].z - mu) * rs * g.z + b.z; x.w = (v[i].w - mu) * rs * g.w + b.w;
      *(float4*)(xdst + (size_t)tok * 1024 + n) = x;
      if (m) {
        const float4 sh = *(const float4*)(m + shoff + n), sc = *(const float4*)(m + scoff + n);
        uint2 o;
        o.x = pack2(x.x * (1.f + sc.x) + sh.x, x.y * (1.f + sc.y) + sh.y);
        o.y = pack2(x.z * (1.f + sc.z) + sh.z, x.w * (1.f + sc.w) + sh.w);
        *(uint2*)(H + (size_t)tok * 1024 + n) = o;
      }
    }
  }
}

DI void phase_ffn_in(const Params& P, int l, unsigned char* smem) {
  const bf16_t* H = (const bf16_t*)(P.ws + OFF_HMOD);
  const bf16_t* W = (const bf16_t*)(P.ws + (size_t)(l & 1) * SZ_SLOT + WS_WF1);
  bf16_t* FF = (bf16_t*)(P.ws + OFF_FF);
  for (int t = vblock(); t < 96 * 44; t += gridDim.x) {
    int mtile, ntile;
    tile_decode(t, 96, 44, mtile, ntile);
    const int m0 = mtile * 128, n0 = ntile * 128;
    f32x16 acc[2][2];
    acc_zero(acc);
    gemm_mainloop<false>(acc, H + (size_t)m0 * 1024, 1024, W + (size_t)n0 * 1024, 1024, 1024, nullptr, smem);
    EPI_VARS;
#pragma unroll
    for (int mt = 0; mt < 2; ++mt)
#pragma unroll
      for (int i = 0; i < 16; ++i) {
        const float a = acc[mt][0][i], u = acc[mt][1][i];
        *(unsigned short*)(smem + RW(mt, i) * 144 + (wn_ * 32 + rr_) * 2) = (unsigned short)f2bf(a * sigmoidf_(a) * u);
      }
    __syncthreads();
#pragma unroll
    for (int i = 0; i < 4; ++i) {
      const int row = (tid_e_ >> 3) + 32 * i, ch = tid_e_ & 7;
      const u32x4 x = *(const u32x4*)(smem + row * 144 + ch * 16);
      *(u32x4*)(FF + (size_t)(m0 + row) * DFF + ntile * 64 + ch * 8) = x;
    }
    __syncthreads();
  }
}

template <int S>
DI void run_phase(const Params& P, int l, unsigned char* smem) {
  const unsigned char* slot = P.ws + (size_t)(l & 1) * SZ_SLOT;
  const float* MOD = (const float*)(P.ws + OFF_MOD);
  if constexpr (S == 0) phase_setup(P, smem);
  else if constexpr (S == 1) phase_modreduce(P);
  else if constexpr (S == 2) phase_modulate0(P);
  else if constexpr (S == 3) phase_gemm_in(P, l, smem);
  else if constexpr (S == 4) phase_scan_four1(P, l, smem);
  else if constexpr (S == 5) phase_mixers(P, l, smem);
  else if constexpr (S == 6) phase_hn(P, l);
  else if constexpr (S == 7) phase_branch(P, l, smem);
  else if constexpr (S == 8) phase_resid_gemm(P, l, (const bf16_t*)(P.ws + OFF_MERGED), 1024, (const bf16_t*)(slot + WS_WO), 2048, smem);
  else if constexpr (S == 9) {
    phase_ln(P, P.ln_gain + (l * 2 + 0) * 1024, P.ln_bias + (l * 2 + 0) * 1024, (float*)(P.ws + OFF_XRES), MOD + (size_t)l * 9 * 6144, 3072, 4096);
    if (l + 1 < 4) convert_layer(P, l + 1, smem);
  } else if constexpr (S == 10) phase_ffn_in(P, l, smem);
  else if constexpr (S == 11) phase_resid_gemm(P, l, (const bf16_t*)(P.ws + OFF_FF), DFF, (const bf16_t*)(slot + WS_WF2), 5120, smem);
  else {
    if (l == 3) phase_ln(P, P.ln_gain + (l * 2 + 1) * 1024, P.ln_bias + (l * 2 + 1) * 1024, P.out, nullptr, 0, 0);
    else phase_ln(P, P.ln_gain + (l * 2 + 1) * 1024, P.ln_bias + (l * 2 + 1) * 1024, (float*)(P.ws + OFF_XRES), MOD + (size_t)(l + 1) * 9 * 6144, 0, 1024);
  }
}

#if !ONE_LAUNCH
template <int S>
__global__ void __launch_bounds__(256, 2) k_phase(Params P, int l) {
  __shared__ __attribute__((aligned(16))) unsigned char smem[SMEM_BYTES];
  run_phase<S>(P, l, smem);
}

#endif
#define XB_TMO      128
#define XB_XCNT(j)  (256  + 64 * (j))
#define XB_XSUB(j)  (1280 + 64 * (j))
#define XB_XGEN(j)  (2304 + 64 * (j))
#define XB_TOP      3328
#define XB_TOPGEN   3392
#define XCD_BAR_WORDS 3456
#define XB_SPIN_CAP (1u << 20)
#define LAS __attribute__((address_space(3)))
DI unsigned xb_ld(unsigned* p) { return __hip_atomic_load(p, __ATOMIC_RELAXED, __HIP_MEMORY_SCOPE_AGENT); }
DI unsigned xb_add(unsigned* p, unsigned v) { return __hip_atomic_fetch_add(p, v, __ATOMIC_RELAXED, __HIP_MEMORY_SCOPE_AGENT); }
DI unsigned xb_xcc_id() { return (unsigned)__builtin_amdgcn_s_getreg((3 << 11) | 20) & 0xFu; }
#define XB_SPIN(cond, bar) do { unsigned _sp = 0; while (cond) { __builtin_amdgcn_s_sleep(1); \
    if ((++_sp & 255u) == 0u) { if (xb_ld(&(bar)[XB_TMO])) break; if (_sp > XB_SPIN_CAP) { atomicAdd(&(bar)[XB_TMO], 1u); break; } } } } while (0)
DI void xcd_barrier_complete(unsigned* bar, unsigned x, unsigned& nloc, unsigned& nx) {
  const unsigned G = gridDim.x;
  unsigned sum, cnt, mine, sp = 0u;
  for (;;) {
    sum = 0u; cnt = 0u; mine = 0u;
#pragma unroll
    for (unsigned j = 0; j < 16; ++j) { const unsigned c = xb_ld(&bar[XB_XCNT(j)]); sum += c; cnt += (c > 0u) ? 1u : 0u; mine = (j == x) ? c : mine; }
    if (sum == G) break;
    __builtin_amdgcn_s_sleep(1);
    if ((++sp & 255u) == 0u) { if (xb_ld(&bar[XB_TMO])) break; if (sp > XB_SPIN_CAP) { atomicAdd(&bar[XB_TMO], 1u); break; } }
  }
  nloc = mine > 0u ? mine : 1u; nx = cnt > 0u ? cnt : 1u;
}
DI void xcd_barrier(unsigned* bar, volatile LAS unsigned* st) {
  asm volatile("s_waitcnt vmcnt(0)" ::: "memory");
  __syncthreads();
  if (threadIdx.x == 0) {
    const unsigned x = xb_xcc_id();
    __builtin_amdgcn_s_waitcnt(0);
    unsigned nloc = st[0], nx = st[1];
    if (nloc == 0u) { xcd_barrier_complete(bar, x, nloc, nx); st[0] = nloc; st[1] = nx; }
    const unsigned old = xb_add(&bar[XB_XSUB(x)], 1u);
    const unsigned gen = old / nloc;
    if (old + 1u == (gen + 1u) * nloc) {
      __builtin_amdgcn_fence(__ATOMIC_RELEASE, "agent");
      asm volatile("s_waitcnt vmcnt(0)" ::: "memory");
      const unsigned og = xb_add(&bar[XB_TOP], 1u);
      const unsigned tg = og / nx;
      if (og + 1u == (tg + 1u) * nx) xb_add(&bar[XB_TOPGEN], 1u);
      else XB_SPIN(xb_ld(&bar[XB_TOPGEN]) == tg, bar);
      __builtin_amdgcn_fence(__ATOMIC_ACQUIRE, "agent");
      xb_add(&bar[XB_XGEN(x)], 1u);
      asm volatile("s_waitcnt vmcnt(0)" ::: "memory");
    } else {
      XB_SPIN(xb_ld(&bar[XB_XGEN(x)]) == gen, bar);
      __builtin_amdgcn_fence(__ATOMIC_ACQUIRE, "agent");
      asm volatile("s_waitcnt vmcnt(0)" ::: "memory");
    }
  }
  __syncthreads();
}

#define GSYNC() xcd_barrier((unsigned*)(load_params().ws + OFF_BAR), xb_st)
DI Params load_params() {
  Params P{};
#if defined(__HIP_DEVICE_COMPILE__)
  typedef const unsigned long long __attribute__((address_space(4)))* KP;
  typedef float __attribute__((address_space(1)))* GF;
  KP kp = (KP)__builtin_amdgcn_kernarg_segment_ptr();
  asm volatile("" : "+s"(kp));
  P.x_prompt = (const float*)(GF)kp[0];
  P.x_sample = (const float*)(GF)kp[1];
  P.c = (const float*)(GF)kp[2];
  P.state_C = (const float*)(GF)kp[3];
  P.state_n = (const float*)(GF)kp[4];
  P.state_m = (const float*)(GF)kp[5];
  P.c_ctx = (const float*)(GF)kp[6];
  P.w_mod = (const float*)(GF)kp[7];
  P.b_mod = (const float*)(GF)kp[8];
  P.w_in = (const float*)(GF)kp[9];
  P.b_gate = (const float*)(GF)kp[10];
  P.mh_gain = (const float*)(GF)kp[11];
  P.w_a = (const float*)(GF)kp[12];
  P.w_b = (const float*)(GF)kp[13];
  P.w_out = (const float*)(GF)kp[14];
  P.ln_gain = (const float*)(GF)kp[15];
  P.ln_bias = (const float*)(GF)kp[16];
  P.w_f1 = (const float*)(GF)kp[17];
  P.w_f2 = (const float*)(GF)kp[18];
  P.out = (float*)(GF)kp[19];
  P.ws = (unsigned char*)(GF)kp[20];
#endif
  return P;
}
__global__ void __launch_bounds__(256, 2) fwd_kernel(Params Pk) {
  __shared__ __attribute__((aligned(16))) unsigned char smem[SMEM_BYTES];
  __shared__ uint4 xb_words;
  {
    unsigned* bar0 = (unsigned*)(load_params().ws + OFF_BAR);
    const unsigned x0 = xb_xcc_id();
    if (threadIdx.x == 0) {
      xb_words = make_uint4(0u, 0u, 0u, 0u);
      (void)xb_add(&bar0[XB_XCNT(x0)], 1u);
    }
  }
  __syncthreads();
  volatile LAS unsigned* xb_st = (volatile LAS unsigned*)&xb_words;
  run_phase<0>(load_params(), 0, smem);
  cg::this_grid().sync();
  run_phase<1>(load_params(), 0, smem); GSYNC();
  run_phase<2>(load_params(), 0, smem); GSYNC();
#pragma unroll 1
  for (int l = 0; l < 4; ++l) {
    run_phase<3>(load_params(), l, smem); GSYNC();
    run_phase<4>(load_params(), l, smem); GSYNC();
    run_phase<5>(load_params(), l, smem); GSYNC();
    run_phase<6>(load_params(), l, smem); GSYNC();
    run_phase<7>(load_params(), l, smem); GSYNC();
    run_phase<8>(load_params(), l, smem); GSYNC();
    run_phase<9>(load_params(), l, smem); GSYNC();
    run_phase<10>(load_params(), l, smem); GSYNC();
    run_phase<11>(load_params(), l, smem); GSYNC();
    run_phase<12>(load_params(), l, smem);
    if (l < 3) GSYNC();
  }
}

#if !ONE_LAUNCH
template <int S>
static void launch_phase(const Params& P, int l, int cus, hipStream_t stream) {
  int per_cu = 0;
  if (hipOccupancyMaxActiveBlocksPerMultiprocessor(&per_cu, k_phase<S>, 256, 0) != hipSuccess) per_cu = 1;
  if (per_cu > 2) per_cu = 2;
  if (per_cu < 1) per_cu = 1;
  int grid = cus * per_cu;
  grid -= grid % 8;
  hipLaunchKernelGGL(k_phase<S>, dim3(grid), dim3(256), 0, stream, P, l);
}

#endif
extern "C" void kernel_launch(void* const* d_in, const int* in_sizes, int n_in, void* d_out, int out_size, void* d_ws, size_t ws_size,
                              hipStream_t stream) {
  if (ws_size < WS_TOTAL) { fprintf(stderr, "workspace too small: %zu < %zu\n", ws_size, (size_t)WS_TOTAL); return; }
  Params P{};
  const float** pp = (const float**)&P;
  for (int i = 0; i < 19; ++i) pp[i] = (const float*)d_in[i];
  P.out = (float*)d_out;
  P.ws = (unsigned char*)d_ws;
  int dev = 0, cus = 256;
  if (hipGetDevice(&dev) != hipSuccess) dev = 0;
  if (hipDeviceGetAttribute(&cus, hipDeviceAttributeMultiprocessorCount, dev) != hipSuccess) cus = 256;
#if ONE_LAUNCH
  {
    static int grid_blocks = 0;
    if (!grid_blocks) {
      int per_cu = 0;
      if (hipOccupancyMaxActiveBlocksPerMultiprocessor(&per_cu, fwd_kernel, 256, 0) != hipSuccess) per_cu = 1;
      if (per_cu > 2) per_cu = 2;
      if (per_cu < 1) per_cu = 1;
      grid_blocks = cus * per_cu;
      grid_blocks -= grid_blocks % 8;
    }
    if (hipMemsetAsync((unsigned char*)d_ws + OFF_BAR, 0, 16384, stream) != hipSuccess) { fprintf(stderr, "memset of barrier words failed\n"); return; }
    void* args[] = {&P};
    hipError_t err = hipLaunchCooperativeKernel((void*)fwd_kernel, dim3(grid_blocks), dim3(256), args, 0, stream);
    if (err != hipSuccess) fprintf(stderr, "cooperative launch failed: %s (grid %d)\n", hipGetErrorString(err), grid_blocks);
    return;
  }
#endif
#if !ONE_LAUNCH
  launch_phase<0>(P, 0, cus, stream);
  launch_phase<1>(P, 0, cus, stream);
  launch_phase<2>(P, 0, cus, stream);
  for (int l = 0; l < 4; ++l) {
    launch_phase<3>(P, l, cus, stream);
    launch_phase<4>(P, l, cus, stream);
    launch_phase<5>(P, l, cus, stream);
    launch_phase<6>(P, l, cus, stream);
    launch_phase<7>(P, l, cus, stream);
    launch_phase<8>(P, l, cus, stream);
    launch_phase<9>(P, l, cus, stream);
    launch_phase<10>(P, l, cus, stream);
    launch_phase<11>(P, l, cus, stream);
    launch_phase<12>(P, l, cus, stream);
  }
#endif
}
```

```cpp
#include <hip/hip_runtime.h>
#include <hip/hip_cooperative_groups.h>
#include <cstdio>
#ifndef ONE_LAUNCH
#define ONE_LAUNCH 1
#endif
namespace cg = cooperative_groups;

typedef unsigned short bf16_t;
using bf16x8 = __attribute__((ext_vector_type(8))) short;
using f32x16 = __attribute__((ext_vector_type(16))) float;
using f32x4 = __attribute__((ext_vector_type(4))) float;
#define DI __device__ __forceinline__
#define MFMA32(a, b, c) __builtin_amdgcn_mfma_f32_32x32x16_bf16((a), (b), (c), 0, 0, 0)
#define MFMA16(a, b, c) __builtin_amdgcn_mfma_f32_16x16x32_bf16((a), (b), (c), 0, 0, 0)

constexpr int NTOK = 12288, NCTX = 4096;
constexpr int NINP = 9344;
constexpr int DFF = 2816;
constexpr float ALPHA = 1.6817928305074290f;
constexpr float LN_EPS = 1e-5f;

constexpr size_t SZ_WIN = (size_t)NINP * 1024 * 2, SZ_WA = 1024ull * 2048 * 2, SZ_WB = 1024ull * 1024 * 2, SZ_WO = SZ_WB,
                 SZ_WF1 = 5632ull * 1024 * 2, SZ_WF2 = 1024ull * 2816 * 2;
constexpr size_t WS_WIN = 0, WS_WA = WS_WIN + SZ_WIN, WS_WB = WS_WA + SZ_WA, WS_WO = WS_WB + SZ_WB, WS_WF1 = WS_WO + SZ_WO,
                 WS_WF2 = WS_WF1 + SZ_WF1, SZ_SLOT = WS_WF2 + SZ_WF2;
constexpr size_t OFF_BC = 2 * SZ_SLOT;
constexpr size_t OFF_A256 = OFF_BC + 512 * 256 * 2;
constexpr size_t OFF_A1024 = OFF_A256 + 256 * 512 * 2;
constexpr size_t OFF_MODP = OFF_A1024 + 1024ull * 2048 * 2;
constexpr size_t OFF_MOD = OFF_MODP + 8ull * 4 * 9 * 6144 * 4;
constexpr size_t OFF_XRES = OFF_MOD + 4ull * 9 * 6144 * 4;
constexpr size_t OFF_HMOD = OFF_XRES + (size_t)NTOK * 1024 * 4;
constexpr size_t OFF_FB = OFF_HMOD;
constexpr size_t OFF_Q = OFF_HMOD + (size_t)NTOK * 1024 * 2;
constexpr size_t OFF_MERGED = OFF_Q;
constexpr size_t OFF_K = OFF_Q + (size_t)NTOK * 1024 * 2;
constexpr size_t OFF_KT = OFF_K + (size_t)NTOK * 1024 * 2;
constexpr size_t OFF_VT = OFF_KT + 16ull * 4 * 256 * 256 * 2;
constexpr size_t OFF_OG = OFF_VT + (size_t)NTOK * 2048 * 2;
constexpr size_t OFF_FF = OFF_OG;
constexpr size_t OFF_UF = OFF_OG + (size_t)NTOK * 2048 * 2;
constexpr size_t OFF_GA = OFF_UF + (size_t)NTOK * 1024 * 2;
constexpr size_t OFF_GB = OFF_GA + (size_t)NTOK * 1024 * 2;
constexpr size_t OFF_GATES = OFF_GB + (size_t)NTOK * 1024 * 2;
constexpr size_t SZ_SC = 2ull * 4 * NTOK * 4;
constexpr size_t OFF_BETA = OFF_GATES + (size_t)NTOK * 16 * 4;
constexpr size_t OFF_MM = OFF_BETA + SZ_SC;
constexpr size_t OFF_EMT = OFF_MM + SZ_SC;
constexpr size_t OFF_WFIN = OFF_EMT + SZ_SC;
constexpr size_t OFF_H0 = OFF_WFIN + SZ_SC;
constexpr size_t OFF_TT = OFF_H0 + (size_t)NTOK * 2048 * 2;
constexpr size_t OFF_PRELN = OFF_TT;
constexpr size_t OFF_HN = OFF_TT + (size_t)NTOK * 2048 * 2;
constexpr size_t OFF_VTC = OFF_HN + (size_t)NTOK * 2048 * 2;
constexpr size_t OFF_C0T = OFF_VTC + 16ull * 2048 * 256 * 2;
constexpr size_t OFF_BAR = OFF_C0T + 64ull * 512 * 256 * 2;
constexpr size_t WS_TOTAL = OFF_BAR + 16384;
constexpr size_t VT_LAT = 16ull * 2048 * 256;
constexpr size_t TT_LAT = 16ull * 4 * 256 * 512;

constexpr size_t OUT_NEWC = (size_t)NTOK * 1024;
constexpr size_t OUT_NEWN = OUT_NEWC + 16ull * 4 * 2 * 4 * 512 * 256;
constexpr size_t OUT_NEWM = OUT_NEWN + 16ull * 4 * 2 * 4 * 256;

constexpr int SMEM_BYTES = 73728;

struct Params {
  const float *x_prompt, *x_sample, *c, *state_C, *state_n, *state_m, *c_ctx, *w_mod, *b_mod, *w_in, *b_gate, *mh_gain,
      *w_a, *w_b, *w_out, *ln_gain, *ln_bias, *w_f1, *w_f2;
  float* out;
  unsigned char* ws;
};

typedef unsigned u32x4 __attribute__((ext_vector_type(4)));
DI u32x4 gld16(const void* p) { u32x4 r; asm volatile("global_load_dwordx4 %0, %1, off" : "=&v"(r) : "v"(p) : "memory"); return r; }
DI unsigned f2bf(float x) { unsigned r; asm("v_cvt_pk_bf16_f32 %0, %1, %1" : "=v"(r) : "v"(x)); return r & 0xffffu; }
DI unsigned pack2(float a, float b) { unsigned r; asm("v_cvt_pk_bf16_f32 %0, %1, %2\n\ts_nop 1" : "=v"(r) : "v"(a), "v"(b)); return r; }
DI float bf2f(unsigned h) { return __uint_as_float(h << 16); }
DI float sigmoidf_(float x) { return 1.f / (1.f + __expf(-x)); }
DI float logsigmoidf_(float x) { return fminf(x, 0.f) - log1pf(__expf(-fabsf(x))); }
DI int mod_index(int tok) { return tok < NCTX ? 0 : 1 + ((tok - NCTX) >> 10); }
DI int tid_() { int t = threadIdx.x; asm volatile("" : "+v"(t)); return t; }
DI int bid_() { int b = blockIdx.x; asm volatile("" : "+s"(b)); return b; }
DI int vblock() { return bid_(); }

DI void tile_decode(int t, int MT, int NT, int& mt, int& nt) {
  const int per_sc = MT * 8;
  const int sc = t / per_sc;
  const int w = t - sc * per_sc;
  int ncols = NT - sc * 8; ncols = ncols > 8 ? 8 : ncols;
  const int per_sr = 8 * ncols;
  const int sr = w / per_sr;
  const int j = w - sr * per_sr;
  mt = sr * 8 + (j & 7);
  nt = sc * 8 + (j >> 3);
}

template <bool KSCALE>
DI void gemm_mainloop(f32x16 (&acc)[2][2], const bf16_t* __restrict__ A, int lda, const bf16_t* __restrict__ B, int ldb, int K,
                      const float* __restrict__ kscale, unsigned char* smem) {
  const int tid = tid_(), lane = tid & 63, wave = tid >> 6;
  const int wm = wave >> 1, wn = wave & 1, r = lane & 31, h = lane >> 5;
  const int lrow = tid >> 3, lkc = tid & 7;
  const bf16_t* ga = A + (size_t)lrow * lda + lkc * 8;
  const bf16_t* gb = B + (size_t)lrow * ldb + lkc * 8;
  u32x4 a0[4], b0[4], a1[4], b1[4];
  const int KT = K >> 6;
#define GL(sa_, sb_, k0)                                                                            \
  {                                                                                                 \
    _Pragma("unroll") for (int i = 0; i < 4; ++i) {                                                 \
      sa_[i] = gld16(ga + (size_t)(32 * i) * lda + (k0));                                           \
      sb_[i] = gld16(gb + (size_t)(32 * i) * ldb + (k0));                                           \
    }                                                                                               \
  }
#define GW8(sa_, sb_) asm volatile("s_waitcnt vmcnt(8)" : "+v"(sa_[0]), "+v"(sa_[1]), "+v"(sa_[2]), "+v"(sa_[3]), "+v"(sb_[0]), "+v"(sb_[1]), "+v"(sb_[2]), "+v"(sb_[3]) : : "memory")
#define GW0(sa_, sb_) asm volatile("s_waitcnt vmcnt(0)" : "+v"(sa_[0]), "+v"(sa_[1]), "+v"(sa_[2]), "+v"(sa_[3]), "+v"(sb_[0]), "+v"(sb_[1]), "+v"(sb_[2]), "+v"(sb_[3]) : : "memory")
#define ST(sa_, sb_, buf, k0)                                                                       \
  {                                                                                                 \
    if (KSCALE) {                                                                                   \
      const float4 s0 = *(const float4*)(kscale + (k0) + lkc * 8);                                  \
      const float4 s1 = *(const float4*)(kscale + (k0) + lkc * 8 + 4);                              \
      _Pragma("unroll") for (int i = 0; i < 4; ++i) {                                               \
        u32x4 v = sb_[i];                                                                           \
        v.x = pack2(bf2f(v.x & 0xffffu) * s0.x, bf2f(v.x >> 16) * s0.y);                            \
        v.y = pack2(bf2f(v.y & 0xffffu) * s0.z, bf2f(v.y >> 16) * s0.w);                            \
        v.z = pack2(bf2f(v.z & 0xffffu) * s1.x, bf2f(v.z >> 16) * s1.y);                            \
        v.w = pack2(bf2f(v.w & 0xffffu) * s1.z, bf2f(v.w >> 16) * s1.w);                            \
        sb_[i] = v;                                                                                 \
      }                                                                                             \
    }                                                                                               \
    unsigned char* sa__ = smem + (buf) * 36864;                                                     \
    unsigned char* sb__ = sa__ + 18432;                                                             \
    _Pragma("unroll") for (int i = 0; i < 4; ++i) {                                                 \
      *(u32x4*)(sa__ + (lrow + 32 * i) * 144 + lkc * 16) = sa_[i];                                  \
      *(u32x4*)(sb__ + (lrow + 32 * i) * 144 + lkc * 16) = sb_[i];                                  \
    }                                                                                               \
  }
#define COMPUTE(buf)                                                                                                          \
  {                                                                                                                           \
    const unsigned char* sa = smem + (buf) * 36864;                                                                           \
    const unsigned char* sb = sa + 18432;                                                                                     \
    _Pragma("unroll") for (int ks = 0; ks < 4; ++ks) {                                                                        \
      bf16x8 af[2], bfr[2];                                                                                                   \
      _Pragma("unroll") for (int mt = 0; mt < 2; ++mt) af[mt] = *(const bf16x8*)(sa + (wm * 64 + mt * 32 + r) * 144 + ks * 32 + h * 16);  \
      _Pragma("unroll") for (int nt = 0; nt < 2; ++nt) bfr[nt] = *(const bf16x8*)(sb + (wn * 64 + nt * 32 + r) * 144 + ks * 32 + h * 16); \
      _Pragma("unroll") for (int mt = 0; mt < 2; ++mt)                                                                        \
        _Pragma("unroll") for (int nt = 0; nt < 2; ++nt) acc[mt][nt] = MFMA32(af[mt], bfr[nt], acc[mt][nt]);                  \
    }                                                                                                                         \
  }
  GL(a0, b0, 0);
  GL(a1, b1, 64);
  GW8(a0, b0);
  ST(a0, b0, 0, 0);
  __syncthreads();
  for (int kt = 0; kt < KT; kt += 2) {
    { const int kn = kt + 2 < KT ? kt + 2 : KT - 1; GL(a0, b0, kn * 64); }
    COMPUTE(0);
    GW8(a1, b1);
    ST(a1, b1, 1, (kt + 1) * 64);
    __syncthreads();
    { const int kn = kt + 3 < KT ? kt + 3 : KT - 1; GL(a1, b1, kn * 64); }
    COMPUTE(1);
    GW8(a0, b0);
    { const int kn = kt + 2 < KT ? kt + 2 : KT - 1; ST(a0, b0, 0, kn * 64); }
    __syncthreads();
  }
  GW0(a1, b1);
#undef GL
#undef GW8
#undef GW0
#undef ST
#undef COMPUTE
}

DI void gemm192_mainloop(f32x16 (&acc)[3][2], const bf16_t* __restrict__ A, int lda, const bf16_t* __restrict__ B, int ldb, int K,
                         unsigned char* smem) {
  const int tid = tid_(), lane = tid & 63, wave = tid >> 6;
  const int wm = wave >> 1, wn = wave & 1, r = lane & 31, h = lane >> 5;
  const int lrow = tid >> 3, lkc = tid & 7;
  const bf16_t* ga = A + (size_t)lrow * lda + lkc * 8;
  const bf16_t* gb = B + (size_t)lrow * ldb + lkc * 8;
  u32x4 a0[6], b0[4], a1[6], b1[4];
  const int KT = K >> 6;
#define GL(sa_, sb_, k0)                                                                            \
  {                                                                                                 \
    _Pragma("unroll") for (int i = 0; i < 6; ++i) sa_[i] = gld16(ga + (size_t)(32 * i) * lda + (k0));  \
    _Pragma("unroll") for (int i = 0; i < 4; ++i) sb_[i] = gld16(gb + (size_t)(32 * i) * ldb + (k0));  \
  }
#define GW10(sa_, sb_) asm volatile("s_waitcnt vmcnt(10)" : "+v"(sa_[0]), "+v"(sa_[1]), "+v"(sa_[2]), "+v"(sa_[3]), "+v"(sa_[4]), "+v"(sa_[5]), "+v"(sb_[0]), "+v"(sb_[1]), "+v"(sb_[2]), "+v"(sb_[3]) : : "memory")
#define GW0(sa_, sb_) asm volatile("s_waitcnt vmcnt(0)" : "+v"(sa_[0]), "+v"(sa_[1]), "+v"(sa_[2]), "+v"(sa_[3]), "+v"(sa_[4]), "+v"(sa_[5]), "+v"(sb_[0]), "+v"(sb_[1]), "+v"(sb_[2]), "+v"(sb_[3]) : : "memory")
#define ST(sa_, sb_)                                                                                \
  {                                                                                                 \
    unsigned char* sa__ = smem;                                                                     \
    unsigned char* sb__ = smem + 27648;                                                             \
    _Pragma("unroll") for (int i = 0; i < 6; ++i) *(u32x4*)(sa__ + (lrow + 32 * i) * 144 + lkc * 16) = sa_[i];  \
    _Pragma("unroll") for (int i = 0; i < 4; ++i) *(u32x4*)(sb__ + (lrow + 32 * i) * 144 + lkc * 16) = sb_[i];  \
  }
#define COMPUTE()                                                                                                             \
  {                                                                                                                           \
    const unsigned char* sa = smem;                                                                                           \
    const unsigned char* sb = smem + 27648;                                                                                   \
    _Pragma("unroll") for (int ks = 0; ks < 4; ++ks) {                                                                        \
      bf16x8 af[3], bfr[2];                                                                                                   \
      _Pragma("unroll") for (int mt = 0; mt < 3; ++mt) af[mt] = *(const bf16x8*)(sa + (wm * 96 + mt * 32 + r) * 144 + ks * 32 + h * 16);  \
      _Pragma("unroll") for (int nt = 0; nt < 2; ++nt) bfr[nt] = *(const bf16x8*)(sb + (wn * 64 + nt * 32 + r) * 144 + ks * 32 + h * 16); \
      _Pragma("unroll") for (int mt = 0; mt < 3; ++mt)                                                                        \
        _Pragma("unroll") for (int nt = 0; nt < 2; ++nt) acc[mt][nt] = MFMA32(af[mt], bfr[nt], acc[mt][nt]);                  \
    }                                                                                                                         \
  }
  GL(a0, b0, 0);
  GL(a1, b1, 64);
  GW10(a0, b0);
  ST(a0, b0);
  __syncthreads();
  for (int kt = 0; kt < KT; kt += 2) {
    { const int kn = kt + 2 < KT ? kt + 2 : KT - 1; GL(a0, b0, kn * 64); }
    COMPUTE();
    GW10(a1, b1);
    __syncthreads();
    ST(a1, b1);
    __syncthreads();
    { const int kn = kt + 3 < KT ? kt + 3 : KT - 1; GL(a1, b1, kn * 64); }
    COMPUTE();
    GW10(a0, b0);
    __syncthreads();
    ST(a0, b0);
    __syncthreads();
  }
  GW0(a1, b1);
#undef GL
#undef GW10
#undef GW0
#undef ST
#undef COMPUTE
}
DI void acc_zero3(f32x16 (&acc)[3][2]) {
#pragma unroll
  for (int a = 0; a < 3; ++a)
#pragma unroll
    for (int b = 0; b < 2; ++b)
#pragma unroll
      for (int i = 0; i < 16; ++i) acc[a][b][i] = 0.f;
}
#define RW3(mt, i) (wm_ * 96 + (mt) * 32 + ((i) & 3) + 8 * ((i) >> 2) + 4 * hh_)

DI void acc_zero(f32x16 (&acc)[2][2]) {
#pragma unroll
  for (int a = 0; a < 2; ++a)
#pragma unroll
    for (int b = 0; b < 2; ++b)
#pragma unroll
      for (int i = 0; i < 16; ++i) acc[a][b][i] = 0.f;
}

#define EPI_VARS const int tid_e_ = tid_(), lane_ = tid_e_ & 63, wave_ = tid_e_ >> 6, wm_ = wave_ >> 1, wn_ = wave_ & 1, rr_ = lane_ & 31, hh_ = lane_ >> 5
#define RW(mt, i) (wm_ * 64 + (mt) * 32 + ((i) & 3) + 8 * ((i) >> 2) + 4 * hh_)
#define CL(nt) (wn_ * 64 + (nt) * 32 + rr_)

template <int MODE>
DI void store_tile_bf16(const f32x16 (&acc)[2][2], bf16_t* __restrict__ dst, int ld, unsigned char* smem) {
  EPI_VARS;
#pragma unroll
  for (int mt = 0; mt < 2; ++mt)
#pragma unroll
    for (int nt = 0; nt < 2; ++nt)
#pragma unroll
      for (int i = 0; i < 16; ++i) {
        float v = acc[mt][nt][i];
        if (MODE == 1) v = sigmoidf_(v);
        *(unsigned short*)(smem + RW(mt, i) * 272 + CL(nt) * 2) = (unsigned short)f2bf(v);
      }
  __syncthreads();
#pragma unroll
  for (int i = 0; i < 8; ++i) {
    const int row = (tid_e_ >> 4) + 16 * i, ch = tid_e_ & 15;
    const u32x4 x = *(const u32x4*)(smem + row * 272 + ch * 16);
    *(u32x4*)(dst + (size_t)row * ld + ch * 8) = x;
  }
  __syncthreads();
}

DI void convert_tile(const float* __restrict__ src, int nsrc, int K, bf16_t* __restrict__ dst, int kt, int ntile, int maptype, unsigned char* smem) {
  float* tile = (float*)smem;
  const int tid = tid_(), tx = tid & 63, ty = tid >> 6;
  const int np = ntile * 64 + tx;
  int sc;
  if (maptype == 0) sc = np;
  else if (maptype == 1) sc = np < 6144 ? np : (np < 9216 ? np + 16 : (np < 9232 ? 6144 + (np - 9216) : -1));
  else { const int g = np >> 6, w = np & 63; sc = w < 32 ? g * 32 + w : 2816 + g * 32 + (w - 32); }
  __syncthreads();
#pragma unroll
  for (int i = 0; i < 16; ++i) {
    const int ky = ty + 4 * i;
    tile[ky * 65 + tx] = sc >= 0 ? src[(size_t)(kt * 64 + ky) * nsrc + sc] : 0.f;
  }
  __syncthreads();
#pragma unroll
  for (int i = 0; i < 2; ++i) {
    const int id = tid + 256 * i, nrow = id >> 3, kc = id & 7;
    uint4 v;
    v.x = pack2(tile[(kc * 8 + 0) * 65 + nrow], tile[(kc * 8 + 1) * 65 + nrow]);
    v.y = pack2(tile[(kc * 8 + 2) * 65 + nrow], tile[(kc * 8 + 3) * 65 + nrow]);
    v.z = pack2(tile[(kc * 8 + 4) * 65 + nrow], tile[(kc * 8 + 5) * 65 + nrow]);
    v.w = pack2(tile[(kc * 8 + 6) * 65 + nrow], tile[(kc * 8 + 7) * 65 + nrow]);
    *(uint4*)(dst + (size_t)(ntile * 64 + nrow) * K + kt * 64 + kc * 8) = v;
  }
}

DI void convert_layer(const Params& P, int l, unsigned char* smem) {
  unsigned char* slot = P.ws + (size_t)(l & 1) * SZ_SLOT;
  constexpr int T0 = 146 * 16, T1 = T0 + 16 * 32, T2 = T1 + 16 * 16, T3 = T2 + 16 * 16, T4 = T3 + 88 * 16, T5 = T4 + 16 * 44;
  for (int it = bid_(); it < T5; it += gridDim.x) {
    if (it < T0) convert_tile(P.w_in + (size_t)l * 1024 * 9232, 9232, 1024, (bf16_t*)(slot + WS_WIN), it & 15, it >> 4, 1, smem);
    else if (it < T1) { const int j = it - T0; convert_tile(P.w_a + (size_t)l * 2048 * 1024, 1024, 2048, (bf16_t*)(slot + WS_WA), j & 31, j >> 5, 0, smem); }
    else if (it < T2) { const int j = it - T1; convert_tile(P.w_b + (size_t)l * 1024 * 1024, 1024, 1024, (bf16_t*)(slot + WS_WB), j & 15, j >> 4, 0, smem); }
    else if (it < T3) { const int j = it - T2; convert_tile(P.w_out + (size_t)l * 1024 * 1024, 1024, 1024, (bf16_t*)(slot + WS_WO), j & 15, j >> 4, 0, smem); }
    else if (it < T4) { const int j = it - T3; convert_tile(P.w_f1 + (size_t)l * 1024 * 5632, 5632, 1024, (bf16_t*)(slot + WS_WF1), j & 15, j >> 4, 2, smem); }
    else { const int j = it - T4; convert_tile(P.w_f2 + (size_t)l * 2816 * 1024, 1024, 2816, (bf16_t*)(slot + WS_WF2), j % 44, j / 44, 0, smem); }
  }
}

DI void phase_setup(const Params& P, unsigned char* smem) {
  const int tid = tid_();
  convert_layer(P, 0, smem);
  {
    bf16_t* BC = (bf16_t*)(P.ws + OFF_BC);
    bf16_t* A256 = (bf16_t*)(P.ws + OFF_A256);
    bf16_t* A1024 = (bf16_t*)(P.ws + OFF_A1024);
    const int total = 131072 + 131072 + 2097152;
    for (int e = bid_() * 256 + tid; e < total; e += gridDim.x * 256) {
      if (e < 131072) {
        const int n = e >> 8, k = e & 255, cs = n >> 8, ch = n & 255;
        const float ph = (float)((ch * k) & 255) * (1.f / 128.f);
        BC[e] = (bf16_t)f2bf(cs ? sinpif(ph) : cospif(ph));
      } else if (e < 262144) {
        const int e2 = e - 131072, m = e2 >> 9, k = e2 & 511, cs = k >> 8, p = k & 255;
        const float ph = (float)((m * p) & 255) * (1.f / 128.f);
        A256[e2] = (bf16_t)f2bf(cs ? -sinpif(ph) : cospif(ph));
      } else {
        const int e2 = e - 262144, m = e2 >> 11, k = e2 & 2047, cs = k >> 10, p = k & 1023;
        const int r1 = m >> 6, c1 = m & 63, r2 = p >> 6, c2 = p & 63;
        const float ph = (float)((4 * r1 * r2 + c1 * c2) & 63) * (1.f / 32.f);
        A1024[e2] = (bf16_t)f2bf(cs ? -sinpif(ph) : cospif(ph));
      }
    }
  }
  {
    float4* X = (float4*)(P.ws + OFF_XRES);
    const float4* xp = (const float4*)P.x_prompt;
    const float4* xs = (const float4*)P.x_sample;
    const int n4p = NCTX * 256, n4 = NTOK * 256;
    for (int e = bid_() * 256 + tid; e < n4; e += gridDim.x * 256) X[e] = e < n4p ? xp[e] : xs[e - n4p];
  }
  {
    float* MODP = (float*)(P.ws + OFF_MODP);
    float* red = (float*)smem;
    const int lane = tid & 63, w = tid >> 6;
    for (int it = bid_(); it < 8 * 4 * 24; it += gridDim.x) {
      const int nc = it % 24, l = (it / 24) & 3, ks = it / 96;
      float4 a[9];
#pragma unroll
      for (int j = 0; j < 9; ++j) a[j] = make_float4(0.f, 0.f, 0.f, 0.f);
      const int kb = ks * 128 + w * 32;
      const float* wp = P.w_mod + ((size_t)l * 1024 + kb) * 6144 + nc * 256 + lane * 4;
      for (int k = 0; k < 32; ++k) {
        const float4 wv = *(const float4*)(wp + (size_t)k * 6144);
#pragma unroll
        for (int j = 0; j < 9; ++j) {
          float cv = j == 0 ? P.c_ctx[kb + k] : P.c[(j - 1) * 1024 + kb + k];
          cv = cv * sigmoidf_(cv);
          a[j].x += cv * wv.x; a[j].y += cv * wv.y; a[j].z += cv * wv.z; a[j].w += cv * wv.w;
        }
      }
      __syncthreads();
#pragma unroll
      for (int j = 0; j < 9; ++j) *(float4*)(red + (w * 9 + j) * 256 + lane * 4) = a[j];
      __syncthreads();
      for (int e = tid; e < 9 * 256; e += 256) {
        const int j = e >> 8, n = e & 255;
        const float s = red[(0 * 9 + j) * 256 + n] + red[(1 * 9 + j) * 256 + n] + red[(2 * 9 + j) * 256 + n] + red[(3 * 9 + j) * 256 + n];
        MODP[((size_t)(ks * 4 + l) * 9 + j) * 6144 + nc * 256 + n] = s;
      }
    }
  }
}

DI void phase_modreduce(const Params& P) {
  const float* MODP = (const float*)(P.ws + OFF_MODP);
  float* MOD = (float*)(P.ws + OFF_MOD);
  const int total = 4 * 9 * 6144;
  for (int e = bid_() * 256 + tid_(); e < total; e += gridDim.x * 256) {
    const int n = e % 6144, l = e / (9 * 6144);
    float s = P.b_mod[l * 6144 + n];
#pragma unroll
    for (int ks = 0; ks < 8; ++ks) s += MODP[(size_t)ks * total + e];
    MOD[e] = s;
  }
}

DI void phase_modulate0(const Params& P) {
  const float* MOD = (const float*)(P.ws + OFF_MOD);
  const float4* X = (const float4*)(P.ws + OFF_XRES);
  uint2* H = (uint2*)(P.ws + OFF_HMOD);
  for (int e = bid_() * 256 + tid_(); e < NTOK * 256; e += gridDim.x * 256) {
    const int tok = e >> 8, n = (e & 255) * 4;
    const float* m = MOD + (size_t)mod_index(tok) * 6144;
    const float4 x = X[e];
    const float4 sh = *(const float4*)(m + n), sc = *(const float4*)(m + 1024 + n);
    uint2 o;
    o.x = pack2(x.x * (1.f + sc.x) + sh.x, x.y * (1.f + sc.y) + sh.y);
    o.y = pack2(x.z * (1.f + sc.z) + sh.z, x.w * (1.f + sc.w) + sh.w);
    H[e] = o;
  }
}

DI void phase_gemm_in(const Params& P, int l, unsigned char* smem) {
  const bf16_t* H = (const bf16_t*)(P.ws + OFF_HMOD);
  const bf16_t* W = (const bf16_t*)(P.ws + (size_t)(l & 1) * SZ_SLOT + WS_WIN);
  bf16_t* Q = (bf16_t*)(P.ws + OFF_Q);
  bf16_t* Kn = (bf16_t*)(P.ws + OFF_K);
  bf16_t* KT = (bf16_t*)(P.ws + OFF_KT);
  bf16_t* VT = (bf16_t*)(P.ws + OFF_VT);
  bf16_t* VTC = (bf16_t*)(P.ws + OFF_VTC);
  bf16_t* OG = (bf16_t*)(P.ws + OFF_OG);
  bf16_t* UF = (bf16_t*)(P.ws + OFF_UF);
  bf16_t* GA = (bf16_t*)(P.ws + OFF_GA);
  bf16_t* GB = (bf16_t*)(P.ws + OFF_GB);
  float* GATES = (float*)(P.ws + OFF_GATES);
  for (int t = vblock(); t < 96 * 73; t += gridDim.x) {
    int mtile, ntile;
    tile_decode(t, 96, 73, mtile, ntile);
    const int m0 = mtile * 128, n0 = ntile * 128;
    f32x16 acc[2][2];
    acc_zero(acc);
    gemm_mainloop<false>(acc, H + (size_t)m0 * 1024, 1024, W + (size_t)n0 * 1024, 1024, 1024, nullptr, smem);
    EPI_VARS;
    if (ntile < 8 || (ntile >= 32 && ntile < 72)) {
      bf16_t* dst; int ld, cb; bool sg;
      if (ntile < 8) { dst = Q; ld = 1024; cb = n0; sg = false; }
      else if (ntile < 48) { dst = OG; ld = 2048; cb = n0 - 4096; sg = true; }
      else if (ntile < 56) { dst = UF; ld = 1024; cb = n0 - 6144; sg = false; }
      else if (ntile < 64) { dst = GA; ld = 1024; cb = n0 - 7168; sg = true; }
      else { dst = GB; ld = 1024; cb = n0 - 8192; sg = true; }
      if (sg) store_tile_bf16<1>(acc, dst + (size_t)m0 * ld + cb, ld, smem);
      else store_tile_bf16<0>(acc, dst + (size_t)m0 * ld + cb, ld, smem);
    } else if (ntile < 16) {
      const int cb = n0 - 1024;
#pragma unroll
      for (int mt = 0; mt < 2; ++mt)
#pragma unroll
        for (int nt = 0; nt < 2; ++nt) {
#pragma unroll
          for (int i = 0; i < 16; ++i) { const int tk = m0 + RW(mt, i), kc2 = cb + CL(nt); Kn[((size_t)(tk >> 5) * 4 + (kc2 >> 8)) * 8192 + (tk & 31) * 256 + (kc2 & 255)] = (bf16_t)f2bf(acc[mt][nt][i] * 0.0625f); }
          if (m0 < NCTX) {
            const int kc = cb + CL(nt), hd = kc >> 8, d = kc & 255;
#pragma unroll
            for (int i4 = 0; i4 < 4; ++i4) {
              const int tok0 = m0 + RW(mt, 4 * i4), b = tok0 >> 8, s = tok0 & 255;
              uint2 v;
              v.x = pack2(acc[mt][nt][4 * i4] * 0.0625f, acc[mt][nt][4 * i4 + 1] * 0.0625f);
              v.y = pack2(acc[mt][nt][4 * i4 + 2] * 0.0625f, acc[mt][nt][4 * i4 + 3] * 0.0625f);
              *(uint2*)(KT + ((size_t)((b * 4 + hd) * 256 + d)) * 256 + s) = v;
            }
          }
        }
    } else if (ntile < 32) {
      const int cb = n0 - 2048;
#pragma unroll
      for (int mt = 0; mt < 2; ++mt)
#pragma unroll
        for (int nt = 0; nt < 2; ++nt) {
          const int vc = cb + CL(nt);
#pragma unroll
          for (int i4 = 0; i4 < 4; ++i4) {
            const int tok0 = m0 + RW(mt, 4 * i4);
            uint2 v;
            v.x = pack2(acc[mt][nt][4 * i4], acc[mt][nt][4 * i4 + 1]);
            v.y = pack2(acc[mt][nt][4 * i4 + 2], acc[mt][nt][4 * i4 + 3]);
            { const int cq = (tok0 & 31) >> 2; *(uint2*)(VT + ((size_t)(tok0 >> 5) * 2048 + vc) * 32 + (((cq & 3) * 2 + (cq >> 2)) * 4)) = v; }
            if (tok0 < NCTX) *(uint2*)(VTC + ((size_t)(tok0 >> 8) * 2048 + vc) * 256 + (tok0 & 255)) = v;
          }
        }
    } else {
      if (wn_ == 0 && rr_ < 16) {
        const int g = rr_;
        const float bg = P.b_gate[l * 16 + g];
        const bool isf = (g >> 2) & 1;
#pragma unroll
        for (int mt = 0; mt < 2; ++mt)
#pragma unroll
          for (int i = 0; i < 16; ++i) {
            float v = acc[mt][0][i] + bg;
            if (isf) v = logsigmoidf_(v);
            GATES[(size_t)(m0 + RW(mt, i)) * 16 + g] = v;
          }
      }
    }
  }
}

DI float wave_excl_sum(float v, int lane) {
  float x = v;
#pragma unroll
  for (int o = 1; o < 64; o <<= 1) { const float y = __shfl_up(x, o, 64); if (lane >= o) x += y; }
  return x - v;
}
DI float wave_excl_max(float v, int lane, float init) {
  float x = v;
#pragma unroll
  for (int o = 1; o < 64; o <<= 1) { const float y = __shfl_up(x, o, 64); if (lane >= o) x = fmaxf(x, y); }
  const float p = __shfl_up(x, 1, 64);
  return lane == 0 ? init : fmaxf(init, p);
}

template <int E>
DI void scan_wave(const Params& P, int l, int sid) {
  const int lane = tid_() & 63;
  const int dir = sid & 1, hd = (sid >> 1) & 3, seq = sid >> 3;
  const bool lat = seq >= 16;
  const int S = E * 64;
  const int tok0 = lat ? NCTX + (seq - 16) * 1024 : seq * 256;
  const float* G = (const float*)(P.ws + OFF_GATES);
  const size_t gi = (size_t)(dir * 4 + hd) * NTOK;
  float* BETA = (float*)(P.ws + OFF_BETA) + gi;
  float* MM = (float*)(P.ws + OFF_MM) + gi;
  float* EMT = (float*)(P.ws + OFF_EMT) + gi;
  float* WFIN = (float*)(P.ws + OFF_WFIN) + gi;
  const int gi_i = dir * 8 + hd, gi_f = dir * 8 + 4 + hd;
  const float m0 = lat ? P.state_m[(((seq - 16) * 4 + l) * 2 + dir) * 4 + hd] : 0.f;
  float tot = 0.f;
#pragma unroll
  for (int e = 0; e < E; ++e) {
    const int j = lane * E + e, tok = dir == 0 ? tok0 + j : tok0 + S - 1 - j;
    tot += G[(size_t)tok * 16 + gi_f];
  }
  const float boff = wave_excl_sum(tot, lane);
  float b = boff, cmax = -3.0e38f;
#pragma unroll
  for (int e = 0; e < E; ++e) {
    const int j = lane * E + e, tok = dir == 0 ? tok0 + j : tok0 + S - 1 - j;
    b += G[(size_t)tok * 16 + gi_f];
    const float be = G[(size_t)tok * 16 + gi_i] - b;
    BETA[tok] = be;
    cmax = fmaxf(cmax, be);
  }
  float M = wave_excl_max(cmax, lane, m0);
  b = boff;
#pragma unroll
  for (int e = 0; e < E; ++e) {
    const int j = lane * E + e, tok = dir == 0 ? tok0 + j : tok0 + S - 1 - j;
    b += G[(size_t)tok * 16 + gi_f];
    const float be = G[(size_t)tok * 16 + gi_i] - b;
    M = fmaxf(M, be);
    MM[tok] = M;
    EMT[tok] = __expf(-b - M);
  }
  if (!lat) {
    const float Mlast = __shfl(M, 63, 64);
    const float Blast = __shfl(b, 63, 64);
    if (lane == 0) P.out[OUT_NEWM + (((seq * 4 + l) * 2 + dir) * 4 + hd)] = Blast + Mlast;
    b = boff;
  #pragma unroll
  for (int e = 0; e < E; ++e) {
      const int j = lane * E + e, tok = dir == 0 ? tok0 + j : tok0 + S - 1 - j;
      b += G[(size_t)tok * 16 + gi_f];
      const float be = G[(size_t)tok * 16 + gi_i] - b;
      WFIN[tok] = __expf(be - Mlast);
    }
  }
}

DI void convert_c0(const Params& P, int l) {
  bf16_t* C0T = (bf16_t*)(P.ws + OFF_C0T);
  const int total = 64 * 512 * 32;
  for (int e = bid_() * 256 + tid_(); e < total; e += gridDim.x * 256) {
    const int j = e & 31, v = (e >> 5) & 511, sp = e >> 14;
    const int b = sp >> 3, dir = (sp >> 2) & 1, hd = sp & 3;
    const float* src = P.state_C + ((size_t)((((b * 4 + l) * 2 + dir) * 4 + hd) * 512 + v)) * 256 + j * 8;
    const float4 x0 = *(const float4*)src, x1 = *(const float4*)(src + 4);
    uint4 o;
    o.x = pack2(x0.x, x0.y); o.y = pack2(x0.z, x0.w); o.z = pack2(x1.x, x1.y); o.w = pack2(x1.z, x1.w);
    *(uint4*)(C0T + ((size_t)((sp * 2 + (v >> 8)) * 8 + (j >> 2)) * 256 + (v & 255)) * 32 + (j & 3) * 8) = o;
  }
}

DI void phase_scan_four1(const Params& P, int l, unsigned char* smem) {
  convert_c0(P, l);
  const bf16_t* UF = (const bf16_t*)(P.ws + OFF_UF);
  const bf16_t* BC = (const bf16_t*)(P.ws + OFF_BC);
  bf16_t* TT = (bf16_t*)(P.ws + OFF_TT);
  for (int it = bid_(); it < 48 + 1536; it += gridDim.x) {
    if (it < 48) { const int sid = it * 4 + (tid_() >> 6); if (sid < 128) scan_wave<4>(P, l, sid); else scan_wave<16>(P, l, sid); continue; }
    const int t = it - 48, g = t / 384, rem = t - g * 384;
    int mtile, ntile;
    tile_decode(rem, 96, 4, mtile, ntile);
    const int m0 = mtile * 128, n0 = ntile * 128;
    f32x16 acc[2][2];
    acc_zero(acc);
    gemm_mainloop<false>(acc, UF + (size_t)m0 * 1024 + g * 256, 1024, BC + (size_t)n0 * 256, 256, 256, nullptr, smem);
    EPI_VARS;
#pragma unroll
    for (int mt = 0; mt < 2; ++mt)
#pragma unroll
      for (int nt = 0; nt < 2; ++nt) {
        const int n = n0 + CL(nt), cs = n >> 8, ch = n & 255;
#pragma unroll
        for (int i4 = 0; i4 < 4; ++i4) {
          const int tok0 = m0 + RW(mt, 4 * i4);
          uint2 v;
          v.x = pack2(acc[mt][nt][4 * i4], acc[mt][nt][4 * i4 + 1]);
          v.y = pack2(acc[mt][nt][4 * i4 + 2], acc[mt][nt][4 * i4 + 3]);
          size_t idx;
          if (tok0 < NCTX) idx = ((size_t)(((tok0 >> 8) * 4 + g) * 256 + ch)) * 512 + cs * 256 + (tok0 & 255);
          else { const int tl = tok0 - NCTX; idx = TT_LAT + ((size_t)(((tl >> 10) * 4 + g) * 256 + ch)) * 2048 + cs * 1024 + (tl & 1023); }
          *(uint2*)(TT + idx) = v;
        }
      }
  }
}

DI void mlstm_item(const Params& P, int l, int seq, int hd, int qb, int vh, unsigned char* smem) {
  const int tid = tid_(), lane = tid & 63, w = tid >> 6, c = lane & 15, q = lane >> 4;
  const bool lat = seq >= 16;
  const int S = lat ? 1024 : 256;
  const int tok0 = lat ? NCTX + (seq - 16) * 1024 : seq * 256;
  const int bl = seq - 16;
  const bf16_t* Qg = (const bf16_t*)(P.ws + OFF_Q);
  const bf16_t* Kg = (const bf16_t*)(P.ws + OFF_K);
  const bf16_t* VT = (const bf16_t*)(P.ws + OFF_VT) + ((size_t)(tok0 >> 5) * 2048 + hd * 512 + vh * 256) * 32;
  unsigned char* sK = smem;
  unsigned char* sV = smem + 16896;
  const int t_loc = qb * 64 + w * 16 + c;
  const int tokq = tok0 + t_loc;
  bf16x8 qf[8];
  {
    const bf16_t* qp = Qg + (size_t)tokq * 1024 + hd * 256 + q * 8;
#pragma unroll
    for (int kk = 0; kk < 8; ++kk) qf[kk] = *(const bf16x8*)(qp + kk * 32);
#pragma unroll
    for (int kk = 0; kk < 8; ++kk) asm volatile("" : "+v"(qf[kk]));
  }
  __syncthreads();
  const int nkb = S >> 5;
  const size_t rowbase = (size_t)(tok0 + qb * 64 + w * 16 + 4 * q) * 2048 + hd * 512 + vh * 256 + c;
  const bf16_t* kld = Kg + ((size_t)(tok0 >> 5) * 4 + hd) * 8192 + tid * 8;
  unsigned char* ksd = sK + (tid >> 5) * 528 + (tid & 31) * 16;
  const bf16_t* vld = VT + tid * 8;
  unsigned char* vsd = sV + (tid >> 2) * 96 + (tid & 3) * 16;
  u32x4 st[8], bt[2], btn[2];
#define STWAIT() asm volatile("s_waitcnt vmcnt(0)" : "+v"(st[0]), "+v"(st[1]), "+v"(st[2]), "+v"(st[3]), "+v"(st[4]), "+v"(st[5]), "+v"(st[6]), "+v"(st[7]), "+v"(btn[0]), "+v"(btn[1]) : : "memory")
#define ISSUE_KV(kb_)                                                                      \
  {                                                                                        \
    const bf16_t* kp_ = kld + (size_t)(kb_) * 4 * 8192;                                    \
    const bf16_t* vp_ = vld + (size_t)(kb_) * 2048 * 32;                                   \
    _Pragma("unroll") for (int i = 0; i < 4; ++i) st[i] = gld16(kp_ + i * 2048);           \
    _Pragma("unroll") for (int i = 0; i < 4; ++i) st[4 + i] = gld16(vp_ + i * 2048);       \
    btn[0] = gld16(BETA + (kb_) * 32);                                                     \
    btn[1] = gld16(BETA + (kb_) * 32 + 16);                                                \
  }
#define STORE_KV()                                                                         \
  {                                                                                        \
    _Pragma("unroll") for (int i = 0; i < 4; ++i) *(u32x4*)(ksd + i * 8 * 528) = st[i];    \
    _Pragma("unroll") for (int i = 0; i < 4; ++i) *(u32x4*)(vsd + i * 64 * 96) = st[4 + i];\
    bt[0] = btn[0]; bt[1] = btn[1];                                                        \
  }
#define ISSUE_C0(kk_) { _Pragma("unroll") for (int i = 0; i < 4; ++i) st[4 + i] = gld16(C0 + (kk_) * 8192 + i * 2048); }
#define STORE_C0() { _Pragma("unroll") for (int i = 0; i < 4; ++i) *(u32x4*)(vsd + i * 64 * 96) = st[4 + i]; }
#pragma unroll 1
  for (int dir = 0; dir < 2; ++dir) {
    f32x4 acc[16];
#pragma unroll
    for (int n = 0; n < 16; ++n) acc[n] = (f32x4){0.f, 0.f, 0.f, 0.f};
    float den = 0.f;
    const size_t gi = (size_t)(dir * 4 + hd) * NTOK;
    const float* BETA = (const float*)(P.ws + OFF_BETA) + gi + tok0 + 4 * q;
    const float Mt = ((const float*)(P.ws + OFF_MM))[gi + tokq];
    const float emt = ((const float*)(P.ws + OFF_EMT))[gi + tokq];
    const int kb_lo = dir == 0 ? 0 : 2 * qb;
    const int kb_hi = dir == 0 ? 2 * qb + 1 : nkb - 1;
    asm volatile("" : : "v"(Mt), "v"(emt));
    btn[0] = btn[1] = (u32x4){0u, 0u, 0u, 0u};
    st[0] = st[1] = st[2] = st[3] = (u32x4){0u, 0u, 0u, 0u};
    if (lat) {
      const int sidx = ((bl * 4 + l) * 2 + dir) * 4 + hd;
      const float inter = __expf(P.state_m[sidx] - Mt);
      const bf16_t* C0 = (const bf16_t*)(P.ws + OFF_C0T) + ((size_t)(((bl * 2 + dir) * 4 + hd) * 2 + vh) * 8) * 8192 + tid * 8;
      float* sN = (float*)(smem + 71168);
      float sdot = 0.f;
      __syncthreads();
      {
        const float nv = P.state_n[(size_t)sidx * 256 + tid];
        sN[tid] = nv;
      }
      asm volatile("" : : "v"(inter));
      const float* n0p = sN + q * 8;
      ISSUE_C0(0);
      STWAIT();
      STORE_C0();
      __syncthreads();
#pragma unroll
      for (int kk = 0; kk < 8; ++kk) {
        const int kn = kk < 7 ? kk + 1 : 7;
        ISSUE_C0(kn);
        const bf16x8 qk = qf[kk];
#pragma unroll
        for (int e = 0; e < 8; ++e) sdot += bf2f((unsigned)(unsigned short)qk[e]) * n0p[kk * 32 + e];
        {
          bf16x8 fb[2][4];
          const unsigned char* vb_ = sV + c * 96 + q * 16;
#pragma unroll
          for (int j = 0; j < 4; ++j) fb[0][j] = *(const bf16x8*)(vb_ + j * 16 * 96);
#pragma unroll
          for (int g = 0; g < 4; ++g) {
            if (g < 3) {
#pragma unroll
              for (int j = 0; j < 4; ++j) fb[(g + 1) & 1][j] = *(const bf16x8*)(vb_ + ((g + 1) * 4 + j) * 16 * 96);
            }
#pragma unroll
            for (int j = 0; j < 4; ++j) acc[g * 4 + j] = MFMA16(qk, fb[g & 1][j], acc[g * 4 + j]);
            __builtin_amdgcn_sched_barrier(0);
          }
        }
        STWAIT();
        __syncthreads();
        STORE_C0();
        __syncthreads();
      }
      float it_[4];
#pragma unroll
      for (int j = 0; j < 4; ++j) it_[j] = __shfl(inter, 4 * q + j, 64);
#pragma unroll
      for (int n = 0; n < 16; ++n)
#pragma unroll
        for (int j = 0; j < 4; ++j) acc[n][j] *= it_[j];
      den = inter * sdot;
    }
    __syncthreads();
    ISSUE_KV(kb_lo);
    STWAIT();
    STORE_KV();
    __syncthreads();
#pragma unroll 1
    for (int kb = kb_lo; kb <= kb_hi; ++kb) {
      const int kbn = kb < kb_hi ? kb + 1 : kb_hi;
      ISSUE_KV(kbn);
      const float bb0[4] = {__uint_as_float(bt[0].x), __uint_as_float(bt[0].y), __uint_as_float(bt[0].z), __uint_as_float(bt[0].w)};
      const float bb1[4] = {__uint_as_float(bt[1].x), __uint_as_float(bt[1].y), __uint_as_float(bt[1].z), __uint_as_float(bt[1].w)};
      f32x4 x0 = (f32x4){0.f, 0.f, 0.f, 0.f}, x1 = (f32x4){0.f, 0.f, 0.f, 0.f};
      {
        bf16x8 fa0[2], fa1[2];
        const unsigned char* k0_ = sK + c * 528 + q * 16;
        fa0[0] = *(const bf16x8*)(k0_); fa1[0] = *(const bf16x8*)(k0_ + 16 * 528);
#pragma unroll
        for (int kk = 0; kk < 8; ++kk) {
          if (kk < 7) {
            fa0[(kk + 1) & 1] = *(const bf16x8*)(k0_ + (kk + 1) * 64);
            fa1[(kk + 1) & 1] = *(const bf16x8*)(k0_ + 16 * 528 + (kk + 1) * 64);
          }
          x0 = MFMA16(fa0[kk & 1], qf[kk], x0);
          x1 = MFMA16(fa1[kk & 1], qf[kk], x1);
          __builtin_amdgcn_sched_barrier(0);
        }
      }
      float p0[4], p1[4];
      const bool diag = (kb >> 1) == qb;
      if (diag) {
#pragma unroll
        for (int j = 0; j < 4; ++j) {
          const int s0 = kb * 32 + 4 * q + j, s1 = s0 + 16;
          const bool ok0 = dir == 0 ? (s0 <= t_loc) : (s0 >= t_loc);
          const bool ok1 = dir == 0 ? (s1 <= t_loc) : (s1 >= t_loc);
          p0[j] = ok0 ? x0[j] * __expf(bb0[j] - Mt) : 0.f;
          p1[j] = ok1 ? x1[j] * __expf(bb1[j] - Mt) : 0.f;
          den += p0[j] + p1[j];
        }
      } else {
#pragma unroll
        for (int j = 0; j < 4; ++j) {
          p0[j] = x0[j] * __expf(bb0[j] - Mt);
          p1[j] = x1[j] * __expf(bb1[j] - Mt);
          den += p0[j] + p1[j];
        }
      }
      uint4 pu;
      pu.x = pack2(p0[0], p0[1]); pu.y = pack2(p0[2], p0[3]); pu.z = pack2(p1[0], p1[1]); pu.w = pack2(p1[2], p1[3]);
      const bf16x8 pa = __builtin_bit_cast(bf16x8, pu);
      {
        bf16x8 fv[2][4];
        const unsigned char* vb_ = sV + c * 96 + q * 16;
#pragma unroll
        for (int j = 0; j < 4; ++j) fv[0][j] = *(const bf16x8*)(vb_ + j * 16 * 96);
#pragma unroll
        for (int g = 0; g < 4; ++g) {
          if (g < 3) {
#pragma unroll
            for (int j = 0; j < 4; ++j) fv[(g + 1) & 1][j] = *(const bf16x8*)(vb_ + ((g + 1) * 4 + j) * 16 * 96);
          }
#pragma unroll
          for (int j = 0; j < 4; ++j) acc[g * 4 + j] = MFMA16(pa, fv[g & 1][j], acc[g * 4 + j]);
          __builtin_amdgcn_sched_barrier(0);
        }
      }
      STWAIT();
      __syncthreads();
      STORE_KV();
      __syncthreads();
    }
    den += __shfl_xor(den, 16, 64);
    den += __shfl_xor(den, 32, 64);
    const float rinv = 1.f / fmaxf(fabsf(den), emt);
    float rj[4];
#pragma unroll
    for (int j = 0; j < 4; ++j) rj[j] = __shfl(rinv, 4 * q + j, 64);
    bf16_t* HS = (bf16_t*)(P.ws + OFF_H0) + rowbase;
    asm volatile("" : "+v"(HS));
    bf16_t* h0p = HS; bf16_t* h1p = HS + 2048; bf16_t* h2p = HS + 4096; bf16_t* h3p = HS + 6144;
    asm volatile("" : "+v"(h1p));
    asm volatile("" : "+v"(h2p));
    asm volatile("" : "+v"(h3p));
    if (dir == 0) {
#pragma unroll
      for (int n = 0; n < 16; ++n) {
        h0p[n * 16] = (bf16_t)f2bf(acc[n][0] * rj[0]);
        h1p[n * 16] = (bf16_t)f2bf(acc[n][1] * rj[1]);
        h2p[n * 16] = (bf16_t)f2bf(acc[n][2] * rj[2]);
        h3p[n * 16] = (bf16_t)f2bf(acc[n][3] * rj[3]);
      }
    } else {
#pragma unroll
      for (int n = 0; n < 16; ++n) {
        h0p[n * 16] = (bf16_t)f2bf(acc[n][0] * rj[0] + bf2f(h0p[n * 16]));
        h1p[n * 16] = (bf16_t)f2bf(acc[n][1] * rj[1] + bf2f(h1p[n * 16]));
        h2p[n * 16] = (bf16_t)f2bf(acc[n][2] * rj[2] + bf2f(h2p[n * 16]));
        h3p[n * 16] = (bf16_t)f2bf(acc[n][3] * rj[3] + bf2f(h3p[n * 16]));
        if ((n & 3) == 3) __builtin_amdgcn_sched_barrier(0);
      }
    }
  }
}

#undef STWAIT
#undef ISSUE_KV
#undef ISSUE_C0
#undef STORE_KV
#undef STORE_C0

DI void phase_hn(const Params& P, int l) {
  const bf16_t* HS = (const bf16_t*)(P.ws + OFF_H0);
  const bf16_t* OG = (const bf16_t*)(P.ws + OFF_OG);
  bf16_t* HN = (bf16_t*)(P.ws + OFF_HN);
  const int tidl_ = tid_(), lane = tidl_ & 63, w = tidl_ >> 6;
  for (int pr = bid_() * 4 + w; pr < NTOK * 4; pr += gridDim.x * 4) {
    const size_t base = (size_t)pr * 512 + lane * 8;
    const uint4 hv = *(const uint4*)(HS + base);
    const uint4 ov = *(const uint4*)(OG + base);
    const unsigned hu[4] = {hv.x, hv.y, hv.z, hv.w}, ou[4] = {ov.x, ov.y, ov.z, ov.w};
    float x[8];
    float s = 0.f;
#pragma unroll
    for (int i = 0; i < 4; ++i) { x[2 * i] = bf2f(hu[i] & 0xffffu); x[2 * i + 1] = bf2f(hu[i] >> 16); s += x[2 * i] + x[2 * i + 1]; }
#pragma unroll
    for (int o = 1; o < 64; o <<= 1) s += __shfl_xor(s, o, 64);
    const float mu = s * (1.f / 512.f);
    float vs = 0.f;
#pragma unroll
    for (int i = 0; i < 8; ++i) { const float d = x[i] - mu; vs += d * d; }
#pragma unroll
    for (int o = 1; o < 64; o <<= 1) vs += __shfl_xor(vs, o, 64);
    const float rs = rsqrtf(vs * (1.f / 512.f) + LN_EPS);
    const float* gp = P.mh_gain + l * 2048 + (pr & 3) * 512 + lane * 8;
    const float4 g0 = *(const float4*)gp, g1 = *(const float4*)(gp + 4);
    const float g[8] = {g0.x, g0.y, g0.z, g0.w, g1.x, g1.y, g1.z, g1.w};
    unsigned r[4];
#pragma unroll
    for (int i = 0; i < 4; ++i)
      r[i] = pack2((x[2 * i] - mu) * rs * g[2 * i] * bf2f(ou[i] & 0xffffu), (x[2 * i + 1] - mu) * rs * g[2 * i + 1] * bf2f(ou[i] >> 16));
    *(uint4*)(HN + base) = make_uint4(r[0], r[1], r[2], r[3]);
  }
}

DI void phase_mixers(const Params& P, int l, unsigned char* smem) {
  const bf16_t* VTC = (const bf16_t*)(P.ws + OFF_VTC);
  const bf16_t* KT = (const bf16_t*)(P.ws + OFF_KT);
  const bf16_t* Kn = (const bf16_t*)(P.ws + OFF_K);
  const bf16_t* TT = (const bf16_t*)(P.ws + OFF_TT);
  const bf16_t* A256 = (const bf16_t*)(P.ws + OFF_A256);
  const bf16_t* A1024 = (const bf16_t*)(P.ws + OFF_A1024);
  const float* WFIN = (const float*)(P.ws + OFF_WFIN);
  bf16_t* FB = (bf16_t*)(P.ws + OFF_FB);
  for (int it0 = bid_(); it0 < 1024 + 2304; it0 += gridDim.x) {
    if (it0 < 1024) { mlstm_item(P, l, 16 + (it0 >> 7), (it0 >> 5) & 3, (it0 >> 1) & 15, it0 & 1, smem); continue; }
    const int r = it0 - 1024;
    if (r >= 512 && r < 1024) { const int j = r - 512; mlstm_item(P, l, j >> 5, (j >> 3) & 3, (j >> 1) & 3, j & 1, smem); continue; }
    f32x16 acc[2][2];
    acc_zero(acc);
    if (r < 512) {
      const int j = r, sg = j >> 4, mtile = (j >> 1) & 7, ntile = j & 1;
      gemm_mainloop<false>(acc, A1024 + (size_t)mtile * 128 * 2048, 2048, TT + TT_LAT + ((size_t)sg * 256 + ntile * 128) * 2048, 2048, 2048, nullptr, smem);
      EPI_VARS;
      const int seq = sg >> 2, g = sg & 3;
#pragma unroll
      for (int mt = 0; mt < 2; ++mt)
#pragma unroll
        for (int nt = 0; nt < 2; ++nt)
#pragma unroll
          for (int i = 0; i < 16; ++i)
            FB[(size_t)(NCTX + seq * 1024 + mtile * 128 + RW(mt, i)) * 1024 + g * 256 + ntile * 128 + CL(nt)] = (bf16_t)f2bf(acc[mt][nt][i] * (1.f / 512.f));
    } else if (r >= 2048) {
      const int j = r - 2048, sg = j >> 2, mtile = (j >> 1) & 1, ntile = j & 1;
      gemm_mainloop<false>(acc, A256 + (size_t)mtile * 128 * 512, 512, TT + ((size_t)sg * 256 + ntile * 128) * 512, 512, 512, nullptr, smem);
      EPI_VARS;
      const int seq = sg >> 2, g = sg & 3;
#pragma unroll
      for (int mt = 0; mt < 2; ++mt)
#pragma unroll
        for (int nt = 0; nt < 2; ++nt)
#pragma unroll
          for (int i = 0; i < 16; ++i)
            FB[(size_t)(seq * 256 + mtile * 128 + RW(mt, i)) * 1024 + g * 256 + ntile * 128 + CL(nt)] = (bf16_t)f2bf(acc[mt][nt][i] * (1.f / 256.f));
    } else {
      const int j = r - 1024, bhd = j >> 3, mtile = (j >> 1) & 3, ntile = j & 1;
      const int b = bhd >> 3, hd = (bhd >> 1) & 3, dir = bhd & 1;
      const float* wf = WFIN + (size_t)(dir * 4 + hd) * NTOK + b * 256;
      gemm_mainloop<true>(acc, VTC + ((size_t)b * 2048 + hd * 512 + mtile * 128) * 256, 256, KT + ((size_t)(b * 4 + hd) * 256 + ntile * 128) * 256, 256, 256, wf, smem);
      EPI_VARS;
      const size_t sidx = (size_t)(((b * 4 + l) * 2 + dir) * 4 + hd);
      float* Co = P.out + OUT_NEWC + sidx * 512 * 256;
#pragma unroll
      for (int mt = 0; mt < 2; ++mt)
#pragma unroll
        for (int nt = 0; nt < 2; ++nt)
#pragma unroll
          for (int i = 0; i < 16; ++i) Co[(size_t)(mtile * 128 + RW(mt, i)) * 256 + ntile * 128 + CL(nt)] = acc[mt][nt][i];
      if (mtile == 0 && tid_e_ < 128) {
        const int d = ntile * 128 + tid_e_;
        float s = 0.f;
        for (int sp = 0; sp < 256; ++sp) s += wf[sp] * bf2f(Kn[((size_t)((b * 256 + sp) >> 5) * 4 + hd) * 8192 + (sp & 31) * 256 + d]);
        P.out[OUT_NEWN + sidx * 256 + d] = s;
      }
    }
  }
}

DI void phase_branch(const Params& P, int l, unsigned char* smem) {
  const unsigned char* slot = P.ws + (size_t)(l & 1) * SZ_SLOT;
  const bf16_t* HN = (const bf16_t*)(P.ws + OFF_HN);
  const bf16_t* FB = (const bf16_t*)(P.ws + OFF_FB);
  const bf16_t* WA = (const bf16_t*)(slot + WS_WA);
  const bf16_t* WB = (const bf16_t*)(slot + WS_WB);
  const bf16_t* GA = (const bf16_t*)(P.ws + OFF_GA);
  const bf16_t* GB = (const bf16_t*)(P.ws + OFF_GB);
  bf16_t* MG = (bf16_t*)(P.ws + OFF_MERGED);
  for (int t = vblock(); t < 64 * 8; t += gridDim.x) {
    int mtile, ntile;
    tile_decode(t, 64, 8, mtile, ntile);
    const int m0 = mtile * 192, n0 = ntile * 128;
    f32x16 acc[3][2];
    acc_zero3(acc);
    gemm192_mainloop(acc, HN + (size_t)m0 * 2048, 2048, WA + (size_t)n0 * 2048, 2048, 2048, smem);
    const bf16_t* GAb = GA + (size_t)m0 * 1024 + n0;
    const bf16_t* GBb = GB + (size_t)m0 * 1024 + n0;
    bf16_t* MGb = MG + (size_t)m0 * 1024 + n0;
    {
      EPI_VARS;
#pragma unroll
      for (int mt = 0; mt < 3; ++mt)
#pragma unroll
        for (int nt = 0; nt < 2; ++nt)
#pragma unroll
          for (int i = 0; i < 16; ++i) {
            const unsigned o = (unsigned)RW3(mt, i) * 1024u + CL(nt);
            MGb[o] = (bf16_t)f2bf(bf2f(GAb[o]) * acc[mt][nt][i]);
          }
    }
    acc_zero3(acc);
    gemm192_mainloop(acc, FB + (size_t)m0 * 1024, 1024, WB + (size_t)n0 * 1024, 1024, 1024, smem);
    EPI_VARS;
#pragma unroll
    for (int mt = 0; mt < 3; ++mt)
#pragma unroll
      for (int nt = 0; nt < 2; ++nt)
#pragma unroll
        for (int i = 0; i < 16; ++i) {
          const unsigned o = (unsigned)RW3(mt, i) * 1024u + CL(nt);
          MGb[o] = (bf16_t)f2bf(bf2f(MGb[o]) + bf2f(GBb[o]) * acc[mt][nt][i]);
        }
  }
}

DI void phase_resid_gemm(const Params& P, int l, const bf16_t* A, int K, const bf16_t* W, int goff, unsigned char* smem) {
  const float* X = (const float*)(P.ws + OFF_XRES);
  const float* MOD = (const float*)(P.ws + OFF_MOD) + (size_t)l * 9 * 6144;
  float* PRE = (float*)(P.ws + OFF_PRELN);
  for (int t = vblock(); t < 64 * 8; t += gridDim.x) {
    int mtile, ntile;
    tile_decode(t, 64, 8, mtile, ntile);
    const int m0 = mtile * 192, n0 = ntile * 128;
    f32x16 acc[3][2];
    acc_zero3(acc);
    gemm192_mainloop(acc, A + (size_t)m0 * K, K, W + (size_t)n0 * K, K, K, smem);
    EPI_VARS;
    const float* Xb = X + (size_t)m0 * 1024 + n0;
    float* PREb = PRE + (size_t)m0 * 1024 + n0;
#pragma unroll
    for (int mt = 0; mt < 3; ++mt)
#pragma unroll
      for (int nt = 0; nt < 2; ++nt)
#pragma unroll
        for (int i = 0; i < 16; ++i) {
          const int row = RW3(mt, i);
          const unsigned o = (unsigned)row * 1024u + CL(nt);
          const float gv = MOD[(size_t)mod_index(m0 + row) * 6144 + goff + n0 + CL(nt)];
          PREb[o] = ALPHA * Xb[o] + gv * acc[mt][nt][i];
        }
  }
}

DI void phase_ln(const Params& P, const float* gain, const float* bias, float* xdst, const float* modn, int shoff, int scoff) {
  const float* PRE = (const float*)(P.ws + OFF_PRELN);
  bf16_t* H = (bf16_t*)(P.ws + OFF_HMOD);
  const int tidl_ = tid_(), lane = tidl_ & 63, w = tidl_ >> 6;
  for (int tok = bid_() * 4 + w; tok < NTOK; tok += gridDim.x * 4) {
    float4 v[4];
    float s = 0.f;
#pragma unroll
    for (int i = 0; i < 4; ++i) {
      v[i] = *(const float4*)(PRE + (size_t)tok * 1024 + (i * 64 + lane) * 4);
      s += v[i].x + v[i].y + v[i].z + v[i].w;
    }
#pragma unroll
    for (int o = 1; o < 64; o <<= 1) s += __shfl_xor(s, o, 64);
    const float mu = s * (1.f / 1024.f);
    float vs = 0.f;
#pragma unroll
    for (int i = 0; i < 4; ++i) {
      const float a = v[i].x - mu, b = v[i].y - mu, c = v[i].z - mu, d = v[i].w - mu;
      vs += a * a + b * b + c * c + d * d;
    }
#pragma unroll
    for (int o = 1; o < 64; o <<= 1) vs += __shfl_xor(vs, o, 64);
    const float rs = rsqrtf(vs * (1.f / 1024.f) + LN_EPS);
    const float* m = modn ? modn + (size_t)mod_index(tok) * 6144 : nullptr;
#pragma unroll
    for (int i = 0; i < 4; ++i) {
      const int n = (i * 64 + lane) * 4;
      const float4 g = *(const float4*)(gain + n), b = *(const float4*)(bias + n);
      float4 x;
      x.x = (v[i].x - mu) * rs * g.x + b.x; x.y = (v[i].y - mu) * rs * g.y + b.y;
      x.z = (v[i].z - mu) * rs * g.z + b.z; x.w = (v[i].w - mu) * rs * g.w + b.w;
      *(float4*)(xdst + (size_t)tok * 1024 + n) = x;
      if (m) {
        const float4 sh = *(const float4*)(m + shoff + n), sc = *(const float4*)(m + scoff + n);
        uint2 o;
        o.x = pack2(x.x * (1.f + sc.x) + sh.x, x.y * (1.f + sc.y) + sh.y);
        o.y = pack2(x.z * (1.f + sc.z) + sh.z, x.w * (1.f + sc.w) + sh.w);
        *(uint2*)(H + (size_t)tok * 1024 + n) = o;
      }
    }
  }
}

DI void phase_ffn_in(const Params& P, int l, unsigned char* smem) {
  const bf16_t* H = (const bf16_t*)(P.ws + OFF_HMOD);
  const bf16_t* W = (const bf16_t*)(P.ws + (size_t)(l & 1) * SZ_SLOT + WS_WF1);
  bf16_t* FF = (bf16_t*)(P.ws + OFF_FF);
  for (int t = vblock(); t < 96 * 44; t += gridDim.x) {
    int mtile, ntile;
    tile_decode(t, 96, 44, mtile, ntile);
    const int m0 = mtile * 128, n0 = ntile * 128;
    f32x16 acc[2][2];
    acc_zero(acc);
    gemm_mainloop<false>(acc, H + (size_t)m0 * 1024, 1024, W + (size_t)n0 * 1024, 1024, 1024, nullptr, smem);
    EPI_VARS;
#pragma unroll
    for (int mt = 0; mt < 2; ++mt)
#pragma unroll
      for (int i = 0; i < 16; ++i) {
        const float a = acc[mt][0][i], u = acc[mt][1][i];
        *(unsigned short*)(smem + RW(mt, i) * 144 + (wn_ * 32 + rr_) * 2) = (unsigned short)f2bf(a * sigmoidf_(a) * u);
      }
    __syncthreads();
#pragma unroll
    for (int i = 0; i < 4; ++i) {
      const int row = (tid_e_ >> 3) + 32 * i, ch = tid_e_ & 7;
      const u32x4 x = *(const u32x4*)(smem + row * 144 + ch * 16);
      *(u32x4*)(FF + (size_t)(m0 + row) * DFF + ntile * 64 + ch * 8) = x;
    }
    __syncthreads();
  }
}

template <int S>
DI void run_phase(const Params& P, int l, unsigned char* smem) {
  const unsigned char* slot = P.ws + (size_t)(l & 1) * SZ_SLOT;
  const float* MOD = (const float*)(P.ws + OFF_MOD);
  if constexpr (S == 0) phase_setup(P, smem);
  else if constexpr (S == 1) phase_modreduce(P);
  else if constexpr (S == 2) phase_modulate0(P);
  else if constexpr (S == 3) phase_gemm_in(P, l, smem);
  else if constexpr (S == 4) phase_scan_four1(P, l, smem);
  else if constexpr (S == 5) phase_mixers(P, l, smem);
  else if constexpr (S == 6) phase_hn(P, l);
  else if constexpr (S == 7) phase_branch(P, l, smem);
  else if constexpr (S == 8) phase_resid_gemm(P, l, (const bf16_t*)(P.ws + OFF_MERGED), 1024, (const bf16_t*)(slot + WS_WO), 2048, smem);
  else if constexpr (S == 9) {
    phase_ln(P, P.ln_gain + (l * 2 + 0) * 1024, P.ln_bias + (l * 2 + 0) * 1024, (float*)(P.ws + OFF_XRES), MOD + (size_t)l * 9 * 6144, 3072, 4096);
    if (l + 1 < 4) convert_layer(P, l + 1, smem);
  } else if constexpr (S == 10) phase_ffn_in(P, l, smem);
  else if constexpr (S == 11) phase_resid_gemm(P, l, (const bf16_t*)(P.ws + OFF_FF), DFF, (const bf16_t*)(slot + WS_WF2), 5120, smem);
  else {
    if (l == 3) phase_ln(P, P.ln_gain + (l * 2 + 1) * 1024, P.ln_bias + (l * 2 + 1) * 1024, P.out, nullptr, 0, 0);
    else phase_ln(P, P.ln_gain + (l * 2 + 1) * 1024, P.ln_bias + (l * 2 + 1) * 1024, (float*)(P.ws + OFF_XRES), MOD + (size_t)(l + 1) * 9 * 6144, 0, 1024);
  }
}

#if !ONE_LAUNCH
template <int S>
__global__ void __launch_bounds__(256, 2) k_phase(Params P, int l) {
  __shared__ __attribute__((aligned(16))) unsigned char smem[SMEM_BYTES];
  run_phase<S>(P, l, smem);
}

#endif
#define XB_TMO      128
#define XB_XCNT(j)  (256  + 64 * (j))
#define XB_XSUB(j)  (1280 + 64 * (j))
#define XB_XGEN(j)  (2304 + 64 * (j))
#define XB_TOP      3328
#define XB_TOPGEN   3392
#define XCD_BAR_WORDS 3456
#define XB_SPIN_CAP (1u << 20)
#define LAS __attribute__((address_space(3)))
DI unsigned xb_ld(unsigned* p) { return __hip_atomic_load(p, __ATOMIC_RELAXED, __HIP_MEMORY_SCOPE_AGENT); }
DI unsigned xb_add(unsigned* p, unsigned v) { return __hip_atomic_fetch_add(p, v, __ATOMIC_RELAXED, __HIP_MEMORY_SCOPE_AGENT); }
DI unsigned xb_xcc_id() { return (unsigned)__builtin_amdgcn_s_getreg((3 << 11) | 20) & 0xFu; }
#define XB_SPIN(cond, bar) do { unsigned _sp = 0; while (cond) { __builtin_amdgcn_s_sleep(1); \
    if ((++_sp & 255u) == 0u) { if (xb_ld(&(bar)[XB_TMO])) break; if (_sp > XB_SPIN_CAP) { atomicAdd(&(bar)[XB_TMO], 1u); break; } } } } while (0)
DI void xcd_barrier_complete(unsigned* bar, unsigned x, unsigned& nloc, unsigned& nx) {
  const unsigned G = gridDim.x;
  unsigned sum, cnt, mine, sp = 0u;
  for (;;) {
    sum = 0u; cnt = 0u; mine = 0u;
#pragma unroll
    for (unsigned j = 0; j < 16; ++j) { const unsigned c = xb_ld(&bar[XB_XCNT(j)]); sum += c; cnt += (c > 0u) ? 1u : 0u; mine = (j == x) ? c : mine; }
    if (sum == G) break;
    __builtin_amdgcn_s_sleep(1);
    if ((++sp & 255u) == 0u) { if (xb_ld(&bar[XB_TMO])) break; if (sp > XB_SPIN_CAP) { atomicAdd(&bar[XB_TMO], 1u); break; } }
  }
  nloc = mine > 0u ? mine : 1u; nx = cnt > 0u ? cnt : 1u;
}
DI void xcd_barrier(unsigned* bar, volatile LAS unsigned* st) {
  asm volatile("s_waitcnt vmcnt(0)" ::: "memory");
  __syncthreads();
  if (threadIdx.x == 0) {
    const unsigned x = xb_xcc_id();
    __builtin_amdgcn_s_waitcnt(0);
    unsigned nloc = st[0], nx = st[1];
    if (nloc == 0u) { xcd_barrier_complete(bar, x, nloc, nx); st[0] = nloc; st[1] = nx; }
    const unsigned old = xb_add(&bar[XB_XSUB(x)], 1u);
    const unsigned gen = old / nloc;
    if (old + 1u == (gen + 1u) * nloc) {
      __builtin_amdgcn_fence(__ATOMIC_RELEASE, "agent");
      asm volatile("s_waitcnt vmcnt(0)" ::: "memory");
      const unsigned og = xb_add(&bar[XB_TOP], 1u);
      const unsigned tg = og / nx;
      if (og + 1u == (tg + 1u) * nx) xb_add(&bar[XB_TOPGEN], 1u);
      else XB_SPIN(xb_ld(&bar[XB_TOPGEN]) == tg, bar);
      __builtin_amdgcn_fence(__ATOMIC_ACQUIRE, "agent");
      xb_add(&bar[XB_XGEN(x)], 1u);
      asm volatile("s_waitcnt vmcnt(0)" ::: "memory");
    } else {
      XB_SPIN(xb_ld(&bar[XB_XGEN(x)]) == gen, bar);
      __builtin_amdgcn_fence(__ATOMIC_ACQUIRE, "agent");
      asm volatile("s_waitcnt vmcnt(0)" ::: "memory");
    }
  }
  __syncthreads();
}

#define GSYNC() xcd_barrier((unsigned*)(load_params().ws + OFF_BAR), xb_st)
DI Params load_params() {
  Params P{};
#if defined(__HIP_DEVICE_COMPILE__)
  typedef const unsigned long long __attribute__((address_space(4)))* KP;
  typedef float __attribute__((address_space(1)))* GF;
  KP kp = (KP)__builtin_amdgcn_kernarg_segment_ptr();
  asm volatile("" : "+s"(kp));
  P.x_prompt = (const float*)(GF)kp[0];
  P.x_sample = (const float*)(GF)kp[1];
  P.c = (const float*)(GF)kp[2];
  P.state_C = (const float*)(GF)kp[3];
  P.state_n = (const float*)(GF)kp[4];
  P.state_m = (const float*)(GF)kp[5];
  P.c_ctx = (const float*)(GF)kp[6];
  P.w_mod = (const float*)(GF)kp[7];
  P.b_mod = (const float*)(GF)kp[8];
  P.w_in = (const float*)(GF)kp[9];
  P.b_gate = (const float*)(GF)kp[10];
  P.mh_gain = (const float*)(GF)kp[11];
  P.w_a = (const float*)(GF)kp[12];
  P.w_b = (const float*)(GF)kp[13];
  P.w_out = (const float*)(GF)kp[14];
  P.ln_gain = (const float*)(GF)kp[15];
  P.ln_bias = (const float*)(GF)kp[16];
  P.w_f1 = (const float*)(GF)kp[17];
  P.w_f2 = (const float*)(GF)kp[18];
  P.out = (float*)(GF)kp[19];
  P.ws = (unsigned char*)(GF)kp[20];
#endif
  return P;
}
__global__ void __launch_bounds__(256, 2) fwd_kernel(Params Pk) {
  __shared__ __attribute__((aligned(16))) unsigned char smem[SMEM_BYTES];
  __shared__ uint4 xb_words;
  {
    unsigned* bar0 = (unsigned*)(load_params().ws + OFF_BAR);
    const unsigned x0 = xb_xcc_id();
    if (threadIdx.x == 0) {
      xb_words = make_uint4(0u, 0u, 0u, 0u);
      (void)xb_add(&bar0[XB_XCNT(x0)], 1u);
    }
  }
  __syncthreads();
  volatile LAS unsigned* xb_st = (volatile LAS unsigned*)&xb_words;
  run_phase<0>(load_params(), 0, smem);
  cg::this_grid().sync();
  run_phase<1>(load_params(), 0, smem); GSYNC();
  run_phase<2>(load_params(), 0, smem); GSYNC();
#pragma unroll 1
  for (int l = 0; l < 4; ++l) {
    run_phase<3>(load_params(), l, smem); GSYNC();
    run_phase<4>(load_params(), l, smem); GSYNC();
    run_phase<5>(load_params(), l, smem); GSYNC();
    run_phase<6>(load_params(), l, smem); GSYNC();
    run_phase<7>(load_params(), l, smem); GSYNC();
    run_phase<8>(load_params(), l, smem); GSYNC();
    run_phase<9>(load_params(), l, smem); GSYNC();
    run_phase<10>(load_params(), l, smem); GSYNC();
    run_phase<11>(load_params(), l, smem); GSYNC();
    run_phase<12>(load_params(), l, smem);
    if (l < 3) GSYNC();
  }
}

#if !ONE_LAUNCH
template <int S>
static void launch_phase(const Params& P, int l, int cus, hipStream_t stream) {
  int per_cu = 0;
  if (hipOccupancyMaxActiveBlocksPerMultiprocessor(&per_cu, k_phase<S>, 256, 0) != hipSuccess) per_cu = 1;
  if (per_cu > 2) per_cu = 2;
  if (per_cu < 1) per_cu = 1;
  int grid = cus * per_cu;
  grid -= grid % 8;
  hipLaunchKernelGGL(k_phase<S>, dim3(grid), dim3(256), 0, stream, P, l);
}

#endif
extern "C" void kernel_launch(void* const* d_in, const int* in_sizes, int n_in, void* d_out, int out_size, void* d_ws, size_t ws_size,
                              hipStream_t stream) {
  if (ws_size < WS_TOTAL) { fprintf(stderr, "workspace too small: %zu < %zu\n", ws_size, (size_t)WS_TOTAL); return; }
  Params P{};
  const float** pp = (const float**)&P;
  for (int i = 0; i < 19; ++i) pp[i] = (const float*)d_in[i];
  P.out = (float*)d_out;
  P.ws = (unsigned char*)d_ws;
  int dev = 0, cus = 256;
  if (hipGetDevice(&dev) != hipSuccess) dev = 0;
  if (hipDeviceGetAttribute(&cus, hipDeviceAttributeMultiprocessorCount, dev) != hipSuccess) cus = 256;
#if ONE_LAUNCH
  {
    static int grid_blocks = 0;
    if (!grid_blocks) {
      int per_cu = 0;
      if (hipOccupancyMaxActiveBlocksPerMultiprocessor(&per_cu, fwd_kernel, 256, 0) != hipSuccess) per_cu = 1;
      if (per_cu > 2) per_cu = 2;
      if (per_cu < 1) per_cu = 1;
      grid_blocks = cus * per_cu;
      grid_blocks -= grid_blocks % 8;
    }
    if (hipMemsetAsync((unsigned char*)d_ws + OFF_BAR, 0, 16384, stream) != hipSuccess) { fprintf(stderr, "memset of barrier words failed\n"); return; }
    void* args[] = {&P};
    hipError_t err = hipLaunchCooperativeKernel((void*)fwd_kernel, dim3(grid_blocks), dim3(256), args, 0, stream);
    if (err != hipSuccess) fprintf(stderr, "cooperative launch failed: %s (grid %d)\n", hipGetErrorString(err), grid_blocks);
    return;
  }
#endif
#if !ONE_LAUNCH
  launch_phase<0>(P, 0, cus, stream);
  launch_phase<1>(P, 0, cus, stream);
  launch_phase<2>(P, 0, cus, stream);
  for (int l = 0; l < 4; ++l) {
    launch_phase<3>(P, l, cus, stream);
    launch_phase<4>(P, l, cus, stream);
    launch_phase<5>(P, l, cus, stream);
    launch_phase<6>(P, l, cus, stream);
    launch_phase<7>(P, l, cus, stream);
    launch_phase<8>(P, l, cus, stream);
    launch_phase<9>(P, l, cus, stream);
    launch_phase<10>(P, l, cus, stream);
    launch_phase<11>(P, l, cus, stream);
    launch_phase<12>(P, l, cus, stream);
  }
#endif
}
```

```cpp
#include <hip/hip_runtime.h>
#include <hip/hip_cooperative_groups.h>
#include <cstdio>
#ifndef ONE_LAUNCH
#define ONE_LAUNCH 1
#endif
namespace cg = cooperative_groups;

typedef unsigned short bf16_t;
using bf16x8 = __attribute__((ext_vector_type(8))) short;
using f32x16 = __attribute__((ext_vector_type(16))) float;
using f32x4 = __attribute__((ext_vector_type(4))) float;
#define DI __device__ __forceinline__
#define MFMA32(a, b, c) __builtin_amdgcn_mfma_f32_32x32x16_bf16((a), (b), (c), 0, 0, 0)
#define MFMA16(a, b, c) __builtin_amdgcn_mfma_f32_16x16x32_bf16((a), (b), (c), 0, 0, 0)

constexpr int NTOK = 12288, NCTX = 4096;
constexpr int NINP = 9344;
constexpr int DFF = 2816;
constexpr float ALPHA = 1.6817928305074290f;
constexpr float LN_EPS = 1e-5f;

constexpr size_t SZ_WIN = (size_t)NINP * 1024 * 2, SZ_WA = 1024ull * 2048 * 2, SZ_WB = 1024ull * 1024 * 2, SZ_WO = SZ_WB,
                 SZ_WF1 = 5632ull * 1024 * 2, SZ_WF2 = 1024ull * 2816 * 2;
constexpr size_t WS_WIN = 0, WS_WA = WS_WIN + SZ_WIN, WS_WB = WS_WA + SZ_WA, WS_WO = WS_WB + SZ_WB, WS_WF1 = WS_WO + SZ_WO,
                 WS_WF2 = WS_WF1 + SZ_WF1, SZ_SLOT = WS_WF2 + SZ_WF2;
constexpr size_t OFF_BC = 2 * SZ_SLOT;
constexpr size_t OFF_A256 = OFF_BC + 512 * 256 * 2;
constexpr size_t OFF_A1024 = OFF_A256 + 256 * 512 * 2;
constexpr size_t OFF_MODP = OFF_A1024 + 1024ull * 2048 * 2;
constexpr size_t OFF_MOD = OFF_MODP + 8ull * 4 * 9 * 6144 * 4;
constexpr size_t OFF_XRES = OFF_MOD + 4ull * 9 * 6144 * 4;
constexpr size_t OFF_HMOD = OFF_XRES + (size_t)NTOK * 1024 * 4;
constexpr size_t OFF_FB = OFF_HMOD;
constexpr size_t OFF_Q = OFF_HMOD + (size_t)NTOK * 1024 * 2;
constexpr size_t OFF_MERGED = OFF_Q;
constexpr size_t OFF_K = OFF_Q + (size_t)NTOK * 1024 * 2;
constexpr size_t OFF_KT = OFF_K + (size_t)NTOK * 1024 * 2;
constexpr size_t OFF_VT = OFF_KT + 16ull * 4 * 256 * 256 * 2;
constexpr size_t OFF_OG = OFF_VT + (size_t)NTOK * 2048 * 2;
constexpr size_t OFF_FF = OFF_OG;
constexpr size_t OFF_UF = OFF_OG + (size_t)NTOK * 2048 * 2;
constexpr size_t OFF_GA = OFF_UF + (size_t)NTOK * 1024 * 2;
constexpr size_t OFF_GB = OFF_GA + (size_t)NTOK * 1024 * 2;
constexpr size_t OFF_GATES = OFF_GB + (size_t)NTOK * 1024 * 2;
constexpr size_t SZ_SC = 2ull * 4 * NTOK * 4;
constexpr size_t OFF_BETA = OFF_GATES + (size_t)NTOK * 16 * 4;
constexpr size_t OFF_MM = OFF_BETA + SZ_SC;
constexpr size_t OFF_EMT = OFF_MM + SZ_SC;
constexpr size_t OFF_WFIN = OFF_EMT + SZ_SC;
constexpr size_t OFF_H0 = OFF_WFIN + SZ_SC;
constexpr size_t OFF_TT = OFF_H0 + (size_t)NTOK * 2048 * 2;
constexpr size_t OFF_PRELN = OFF_TT;
constexpr size_t OFF_HN = OFF_TT + (size_t)NTOK * 2048 * 2;
constexpr size_t OFF_VTC = OFF_HN + (size_t)NTOK * 2048 * 2;
constexpr size_t OFF_C0T = OFF_VTC + 16ull * 2048 * 256 * 2;
constexpr size_t OFF_BAR = OFF_C0T + 64ull * 512 * 256 * 2;
constexpr size_t WS_TOTAL = OFF_BAR + 16384;
constexpr size_t VT_LAT = 16ull * 2048 * 256;
constexpr size_t TT_LAT = 16ull * 4 * 256 * 512;

constexpr size_t OUT_NEWC = (size_t)NTOK * 1024;
constexpr size_t OUT_NEWN = OUT_NEWC + 16ull * 4 * 2 * 4 * 512 * 256;
constexpr size_t OUT_NEWM = OUT_NEWN + 16ull * 4 * 2 * 4 * 256;

constexpr int SMEM_BYTES = 73728;

struct Params {
  const float *x_prompt, *x_sample, *c, *state_C, *state_n, *state_m, *c_ctx, *w_mod, *b_mod, *w_in, *b_gate, *mh_gain,
      *w_a, *w_b, *w_out, *ln_gain, *ln_bias, *w_f1, *w_f2;
  float* out;
  unsigned char* ws;
};

typedef unsigned u32x4 __attribute__((ext_vector_type(4)));
DI u32x4 gld16(const void* p) { u32x4 r; asm volatile("global_load_dwordx4 %0, %1, off" : "=&v"(r) : "v"(p) : "memory"); return r; }
DI unsigned f2bf(float x) { unsigned r; asm("v_cvt_pk_bf16_f32 %0, %1, %1" : "=v"(r) : "v"(x)); return r & 0xffffu; }
DI unsigned pack2(float a, float b) { unsigned r; asm("v_cvt_pk_bf16_f32 %0, %1, %2\n\ts_nop 1" : "=v"(r) : "v"(a), "v"(b)); return r; }
DI float bf2f(unsigned h) { return __uint_as_float(h << 16); }
DI float sigmoidf_(float x) { return 1.f / (1.f + __expf(-x)); }
DI float logsigmoidf_(float x) { return fminf(x, 0.f) - log1pf(__expf(-fabsf(x))); }
DI int mod_index(int tok) { return tok < NCTX ? 0 : 1 + ((tok - NCTX) >> 10); }
DI int tid_() { int t = threadIdx.x; asm volatile("" : "+v"(t)); return t; }
DI int bid_() { int b = blockIdx.x; asm volatile("" : "+s"(b)); return b; }
DI int vblock() { return bid_(); }

DI void tile_decode(int t, int MT, int NT, int& mt, int& nt) {
  const int per_sc = MT * 8;
  const int sc = t / per_sc;
  const int w = t - sc * per_sc;
  int ncols = NT - sc * 8; ncols = ncols > 8 ? 8 : ncols;
  const int per_sr = 8 * ncols;
  const int sr = w / per_sr;
  const int j = w - sr * per_sr;
  mt = sr * 8 + (j & 7);
  nt = sc * 8 + (j >> 3);
}

template <bool KSCALE>
DI void gemm_mainloop(f32x16 (&acc)[2][2], const bf16_t* __restrict__ A, int lda, const bf16_t* __restrict__ B, int ldb, int K,
                      const float* __restrict__ kscale, unsigned char* smem) {
  const int tid = tid_(), lane = tid & 63, wave = tid >> 6;
  const int wm = wave >> 1, wn = wave & 1, r = lane & 31, h = lane >> 5;
  const int lrow = tid >> 3, lkc = tid & 7;
  const bf16_t* ga = A + (size_t)lrow * lda + lkc * 8;
  const bf16_t* gb = B + (size_t)lrow * ldb + lkc * 8;
  u32x4 a0[4], b0[4], a1[4], b1[4];
  const int KT = K >> 6;
#define GL(sa_, sb_, k0)                                                                            \
  {                                                                                                 \
    _Pragma("unroll") for (int i = 0; i < 4; ++i) {                                                 \
      sa_[i] = gld16(ga + (size_t)(32 * i) * lda + (k0));                                           \
      sb_[i] = gld16(gb + (size_t)(32 * i) * ldb + (k0));                                           \
    }                                                                                               \
  }
#define GW8(sa_, sb_) asm volatile("s_waitcnt vmcnt(8)" : "+v"(sa_[0]), "+v"(sa_[1]), "+v"(sa_[2]), "+v"(sa_[3]), "+v"(sb_[0]), "+v"(sb_[1]), "+v"(sb_[2]), "+v"(sb_[3]) : : "memory")
#define GW0(sa_, sb_) asm volatile("s_waitcnt vmcnt(0)" : "+v"(sa_[0]), "+v"(sa_[1]), "+v"(sa_[2]), "+v"(sa_[3]), "+v"(sb_[0]), "+v"(sb_[1]), "+v"(sb_[2]), "+v"(sb_[3]) : : "memory")
#define ST(sa_, sb_, buf, k0)                                                                       \
  {                                                                                                 \
    if (KSCALE) {                                                                                   \
      const float4 s0 = *(const float4*)(kscale + (k0) + lkc * 8);                                  \
      const float4 s1 = *(const float4*)(kscale + (k0) + lkc * 8 + 4);                              \
      _Pragma("unroll") for (int i = 0; i < 4; ++i) {                                               \
        u32x4 v = sb_[i];                                                                           \
        v.x = pack2(bf2f(v.x & 0xffffu) * s0.x, bf2f(v.x >> 16) * s0.y);                            \
        v.y = pack2(bf2f(v.y & 0xffffu) * s0.z, bf2f(v.y >> 16) * s0.w);                            \
        v.z = pack2(bf2f(v.z & 0xffffu) * s1.x, bf2f(v.z >> 16) * s1.y);                            \
        v.w = pack2(bf2f(v.w & 0xffffu) * s1.z, bf2f(v.w >> 16) * s1.w);                            \
        sb_[i] = v;                                                                                 \
      }                                                                                             \
    }                                                                                               \
    unsigned char* sa__ = smem + (buf) * 36864;                                                     \
    unsigned char* sb__ = sa__ + 18432;                                                             \
    _Pragma("unroll") for (int i = 0; i < 4; ++i) {                                                 \
      *(u32x4*)(sa__ + (lrow + 32 * i) * 144 + lkc * 16) = sa_[i];                                  \
      *(u32x4*)(sb__ + (lrow + 32 * i) * 144 + lkc * 16) = sb_[i];                                  \
    }                                                                                               \
  }
#define COMPUTE(buf)                                                                                                          \
  {                                                                                                                           \
    const unsigned char* sa = smem + (buf) * 36864;                                                                           \
    const unsigned char* sb = sa + 18432;                                                                                     \
    _Pragma("unroll") for (int ks = 0; ks < 4; ++ks) {                                                                        \
      bf16x8 af[2], bfr[2];                                                                                                   \
      _Pragma("unroll") for (int mt = 0; mt < 2; ++mt) af[mt] = *(const bf16x8*)(sa + (wm * 64 + mt * 32 + r) * 144 + ks * 32 + h * 16);  \
      _Pragma("unroll") for (int nt = 0; nt < 2; ++nt) bfr[nt] = *(const bf16x8*)(sb + (wn * 64 + nt * 32 + r) * 144 + ks * 32 + h * 16); \
      _Pragma("unroll") for (int mt = 0; mt < 2; ++mt)                                                                        \
        _Pragma("unroll") for (int nt = 0; nt < 2; ++nt) acc[mt][nt] = MFMA32(af[mt], bfr[nt], acc[mt][nt]);                  \
    }                                                                                                                         \
  }
  GL(a0, b0, 0);
  GL(a1, b1, 64);
  GW8(a0, b0);
  ST(a0, b0, 0, 0);
  __syncthreads();
  for (int kt = 0; kt < KT; kt += 2) {
    { const int kn = kt + 2 < KT ? kt + 2 : KT - 1; GL(a0, b0, kn * 64); }
    COMPUTE(0);
    GW8(a1, b1);
    ST(a1, b1, 1, (kt + 1) * 64);
    __syncthreads();
    { const int kn = kt + 3 < KT ? kt + 3 : KT - 1; GL(a1, b1, kn * 64); }
    COMPUTE(1);
    GW8(a0, b0);
    { const int kn = kt + 2 < KT ? kt + 2 : KT - 1; ST(a0, b0, 0, kn * 64); }
    __syncthreads();
  }
  GW0(a1, b1);
#undef GL
#undef GW8
#undef GW0
#undef ST
#undef COMPUTE
}

DI void gemm192_mainloop(f32x16 (&acc)[3][2], const bf16_t* __restrict__ A, int lda, const bf16_t* __restrict__ B, int ldb, int K,
                         unsigned char* smem) {
  const int tid = tid_(), lane = tid & 63, wave = tid >> 6;
  const int wm = wave >> 1, wn = wave & 1, r = lane & 31, h = lane >> 5;
  const int lrow = tid >> 3, lkc = tid & 7;
  const bf16_t* ga = A + (size_t)lrow * lda + lkc * 8;
  const bf16_t* gb = B + (size_t)lrow * ldb + lkc * 8;
  u32x4 a0[6], b0[4], a1[6], b1[4];
  const int KT = K >> 6;
#define GL(sa_, sb_, k0)                                                                            \
  {                                                                                                 \
    _Pragma("unroll") for (int i = 0; i < 6; ++i) sa_[i] = gld16(ga + (size_t)(32 * i) * lda + (k0));  \
    _Pragma("unroll") for (int i = 0; i < 4; ++i) sb_[i] = gld16(gb + (size_t)(32 * i) * ldb + (k0));  \
  }
#define GW10(sa_, sb_) asm volatile("s_waitcnt vmcnt(10)" : "+v"(sa_[0]), "+v"(sa_[1]), "+v"(sa_[2]), "+v"(sa_[3]), "+v"(sa_[4]), "+v"(sa_[5]), "+v"(sb_[0]), "+v"(sb_[1]), "+v"(sb_[2]), "+v"(sb_[3]) : : "memory")
#define GW0(sa_, sb_) asm volatile("s_waitcnt vmcnt(0)" : "+v"(sa_[0]), "+v"(sa_[1]), "+v"(sa_[2]), "+v"(sa_[3]), "+v"(sa_[4]), "+v"(sa_[5]), "+v"(sb_[0]), "+v"(sb_[1]), "+v"(sb_[2]), "+v"(sb_[3]) : : "memory")
#define ST(sa_, sb_)                                                                                \
  {                                                                                                 \
    unsigned char* sa__ = smem;                                                                     \
    unsigned char* sb__ = smem + 27648;                                                             \
    _Pragma("unroll") for (int i = 0; i < 6; ++i) *(u32x4*)(sa__ + (lrow + 32 * i) * 144 + lkc * 16) = sa_[i];  \
    _Pragma("unroll") for (int i = 0; i < 4; ++i) *(u32x4*)(sb__ + (lrow + 32 * i) * 144 + lkc * 16) = sb_[i];  \
  }
#define COMPUTE()                                                                                                             \
  {                                                                                                                           \
    const unsigned char* sa = smem;                                                                                           \
    const unsigned char* sb = smem + 27648;                                                                                   \
    _Pragma("unroll") for (int ks = 0; ks < 4; ++ks) {                                                                        \
      bf16x8 af[3], bfr[2];                                                                                                   \
      _Pragma("unroll") for (int mt = 0; mt < 3; ++mt) af[mt] = *(const bf16x8*)(sa + (wm * 96 + mt * 32 + r) * 144 + ks * 32 + h * 16);  \
      _Pragma("unroll") for (int nt = 0; nt < 2; ++nt) bfr[nt] = *(const bf16x8*)(sb + (wn * 64 + nt * 32 + r) * 144 + ks * 32 + h * 16); \
      _Pragma("unroll") for (int mt = 0; mt < 3; ++mt)                                                                        \
        _Pragma("unroll") for (int nt = 0; nt < 2; ++nt) acc[mt][nt] = MFMA32(af[mt], bfr[nt], acc[mt][nt]);                  \
    }                                                                                                                         \
  }
  GL(a0, b0, 0);
  GL(a1, b1, 64);
  GW10(a0, b0);
  ST(a0, b0);
  __syncthreads();
  for (int kt = 0; kt < KT; kt += 2) {
    { const int kn = kt + 2 < KT ? kt + 2 : KT - 1; GL(a0, b0, kn * 64); }
    COMPUTE();
    GW10(a1, b1);
    __syncthreads();
    ST(a1, b1);
    __syncthreads();
    { const int kn = kt + 3 < KT ? kt + 3 : KT - 1; GL(a1, b1, kn * 64); }
    COMPUTE();
    GW10(a0, b0);
    __syncthreads();
    ST(a0, b0);
    __syncthreads();
  }
  GW0(a1, b1);
#undef GL
#undef GW10
#undef GW0
#undef ST
#undef COMPUTE
}
DI void acc_zero3(f32x16 (&acc)[3][2]) {
#pragma unroll
  for (int a = 0; a < 3; ++a)
#pragma unroll
    for (int b = 0; b < 2; ++b)
#pragma unroll
      for (int i = 0; i < 16; ++i) acc[a][b][i] = 0.f;
}
#define RW3(mt, i) (wm_ * 96 + (mt) * 32 + ((i) & 3) + 8 * ((i) >> 2) + 4 * hh_)

DI void acc_zero(f32x16 (&acc)[2][2]) {
#pragma unroll
  for (int a = 0; a < 2; ++a)
#pragma unroll
    for (int b = 0; b < 2; ++b)
#pragma unroll
      for (int i = 0; i < 16; ++i) acc[a][b][i] = 0.f;
}

#define EPI_VARS const int tid_e_ = tid_(), lane_ = tid_e_ & 63, wave_ = tid_e_ >> 6, wm_ = wave_ >> 1, wn_ = wave_ & 1, rr_ = lane_ & 31, hh_ = lane_ >> 5
#define RW(mt, i) (wm_ * 64 + (mt) * 32 + ((i) & 3) + 8 * ((i) >> 2) + 4 * hh_)
#define CL(nt) (wn_ * 64 + (nt) * 32 + rr_)

template <int MODE>
DI void store_tile_bf16(const f32x16 (&acc)[2][2], bf16_t* __restrict__ dst, int ld, unsigned char* smem) {
  EPI_VARS;
#pragma unroll
  for (int mt = 0; mt < 2; ++mt)
#pragma unroll
    for (int nt = 0; nt < 2; ++nt)
#pragma unroll
      for (int i = 0; i < 16; ++i) {
        float v = acc[mt][nt][i];
        if (MODE == 1) v = sigmoidf_(v);
        *(unsigned short*)(smem + RW(mt, i) * 272 + CL(nt) * 2) = (unsigned short)f2bf(v);
      }
  __syncthreads();
#pragma unroll
  for (int i = 0; i < 8; ++i) {
    const int row = (tid_e_ >> 4) + 16 * i, ch = tid_e_ & 15;
    const u32x4 x = *(const u32x4*)(smem + row * 272 + ch * 16);
    *(u32x4*)(dst + (size_t)row * ld + ch * 8) = x;
  }
  __syncthreads();
}

DI void convert_tile(const float* __restrict__ src, int nsrc, int K, bf16_t* __restrict__ dst, int kt, int ntile, int maptype, unsigned char* smem) {
  float* tile = (float*)smem;
  const int tid = tid_(), tx = tid & 63, ty = tid >> 6;
  const int np = ntile * 64 + tx;
  int sc;
  if (maptype == 0) sc = np;
  else if (maptype == 1) sc = np < 6144 ? np : (np < 9216 ? np + 16 : (np < 9232 ? 6144 + (np - 9216) : -1));
  else { const int g = np >> 6, w = np & 63; sc = w < 32 ? g * 32 + w : 2816 + g * 32 + (w - 32); }
  __syncthreads();
#pragma unroll
  for (int i = 0; i < 16; ++i) {
    const int ky = ty + 4 * i;
    tile[ky * 65 + tx] = sc >= 0 ? src[(size_t)(kt * 64 + ky) * nsrc + sc] : 0.f;
  }
  __syncthreads();
#pragma unroll
  for (int i = 0; i < 2; ++i) {
    const int id = tid + 256 * i, nrow = id >> 3, kc = id & 7;
    uint4 v;
    v.x = pack2(tile[(kc * 8 + 0) * 65 + nrow], tile[(kc * 8 + 1) * 65 + nrow]);
    v.y = pack2(tile[(kc * 8 + 2) * 65 + nrow], tile[(kc * 8 + 3) * 65 + nrow]);
    v.z = pack2(tile[(kc * 8 + 4) * 65 + nrow], tile[(kc * 8 + 5) * 65 + nrow]);
    v.w = pack2(tile[(kc * 8 + 6) * 65 + nrow], tile[(kc * 8 + 7) * 65 + nrow]);
    *(uint4*)(dst + (size_t)(ntile * 64 + nrow) * K + kt * 64 + kc * 8) = v;
  }
}

DI void convert_layer(const Params& P, int l, unsigned char* smem) {
  unsigned char* slot = P.ws + (size_t)(l & 1) * SZ_SLOT;
  constexpr int T0 = 146 * 16, T1 = T0 + 16 * 32, T2 = T1 + 16 * 16, T3 = T2 + 16 * 16, T4 = T3 + 88 * 16, T5 = T4 + 16 * 44;
  for (int it = bid_(); it < T5; it += gridDim.x) {
    if (it < T0) convert_tile(P.w_in + (size_t)l * 1024 * 9232, 9232, 1024, (bf16_t*)(slot + WS_WIN), it & 15, it >> 4, 1, smem);
    else if (it < T1) { const int j = it - T0; convert_tile(P.w_a + (size_t)l * 2048 * 1024, 1024, 2048, (bf16_t*)(slot + WS_WA), j & 31, j >> 5, 0, smem); }
    else if (it < T2) { const int j = it - T1; convert_tile(P.w_b + (size_t)l * 1024 * 1024, 1024, 1024, (bf16_t*)(slot + WS_WB), j & 15, j >> 4, 0, smem); }
    else if (it < T3) { const int j = it - T2; convert_tile(P.w_out + (size_t)l * 1024 * 1024, 1024, 1024, (bf16_t*)(slot + WS_WO), j & 15, j >> 4, 0, smem); }
    else if (it < T4) { const int j = it - T3; convert_tile(P.w_f1 + (size_t)l * 1024 * 5632, 5632, 1024, (bf16_t*)(slot + WS_WF1), j & 15, j >> 4, 2, smem); }
    else { const int j = it - T4; convert_tile(P.w_f2 + (size_t)l * 2816 * 1024, 1024, 2816, (bf16_t*)(slot + WS_WF2), j % 44, j / 44, 0, smem); }
  }
}

DI void phase_setup(const Params& P, unsigned char* smem) {
  const int tid = tid_();
  convert_layer(P, 0, smem);
  {
    bf16_t* BC = (bf16_t*)(P.ws + OFF_BC);
    bf16_t* A256 = (bf16_t*)(P.ws + OFF_A256);
    bf16_t* A1024 = (bf16_t*)(P.ws + OFF_A1024);
    const int total = 131072 + 131072 + 2097152;
    for (int e = bid_() * 256 + tid; e < total; e += gridDim.x * 256) {
      if (e < 131072) {
        const int n = e >> 8, k = e & 255, cs = n >> 8, ch = n & 255;
        const float ph = (float)((ch * k) & 255) * (1.f / 128.f);
        BC[e] = (bf16_t)f2bf(cs ? sinpif(ph) : cospif(ph));
      } else if (e < 262144) {
        const int e2 = e - 131072, m = e2 >> 9, k = e2 & 511, cs = k >> 8, p = k & 255;
        const float ph = (float)((m * p) & 255) * (1.f / 128.f);
        A256[e2] = (bf16_t)f2bf(cs ? -sinpif(ph) : cospif(ph));
      } else {
        const int e2 = e - 262144, m = e2 >> 11, k = e2 & 2047, cs = k >> 10, p = k & 1023;
        const int r1 = m >> 6, c1 = m & 63, r2 = p >> 6, c2 = p & 63;
        const float ph = (float)((4 * r1 * r2 + c1 * c2) & 63) * (1.f / 32.f);
        A1024[e2] = (bf16_t)f2bf(cs ? -sinpif(ph) : cospif(ph));
      }
    }
  }
  {
    float4* X = (float4*)(P.ws + OFF_XRES);
    const float4* xp = (const float4*)P.x_prompt;
    const float4* xs = (const float4*)P.x_sample;
    const int n4p = NCTX * 256, n4 = NTOK * 256;
    for (int e = bid_() * 256 + tid; e < n4; e += gridDim.x * 256) X[e] = e < n4p ? xp[e] : xs[e - n4p];
  }
  {
    float* MODP = (float*)(P.ws + OFF_MODP);
    float* red = (float*)smem;
    const int lane = tid & 63, w = tid >> 6;
    for (int it = bid_(); it < 8 * 4 * 24; it += gridDim.x) {
      const int nc = it % 24, l = (it / 24) & 3, ks = it / 96;
      float4 a[9];
#pragma unroll
      for (int j = 0; j < 9; ++j) a[j] = make_float4(0.f, 0.f, 0.f, 0.f);
      const int kb = ks * 128 + w * 32;
      const float* wp = P.w_mod + ((size_t)l * 1024 + kb) * 6144 + nc * 256 + lane * 4;
      for (int k = 0; k < 32; ++k) {
        const float4 wv = *(const float4*)(wp + (size_t)k * 6144);
#pragma unroll
        for (int j = 0; j < 9; ++j) {
          float cv = j == 0 ? P.c_ctx[kb + k] : P.c[(j - 1) * 1024 + kb + k];
          cv = cv * sigmoidf_(cv);
          a[j].x += cv * wv.x; a[j].y += cv * wv.y; a[j].z += cv * wv.z; a[j].w += cv * wv.w;
        }
      }
      __syncthreads();
#pragma unroll
      for (int j = 0; j < 9; ++j) *(float4*)(red + (w * 9 + j) * 256 + lane * 4) = a[j];
      __syncthreads();
      for (int e = tid; e < 9 * 256; e += 256) {
        const int j = e >> 8, n = e & 255;
        const float s = red[(0 * 9 + j) * 256 + n] + red[(1 * 9 + j) * 256 + n] + red[(2 * 9 + j) * 256 + n] + red[(3 * 9 + j) * 256 + n];
        MODP[((size_t)(ks * 4 + l) * 9 + j) * 6144 + nc * 256 + n] = s;
      }
    }
  }
}

DI void phase_modreduce(const Params& P) {
  const float* MODP = (const float*)(P.ws + OFF_MODP);
  float* MOD = (float*)(P.ws + OFF_MOD);
  const int total = 4 * 9 * 6144;
  for (int e = bid_() * 256 + tid_(); e < total; e += gridDim.x * 256) {
    const int n = e % 6144, l = e / (9 * 6144);
    float s = P.b_mod[l * 6144 + n];
#pragma unroll
    for (int ks = 0; ks < 8; ++ks) s += MODP[(size_t)ks * total + e];
    MOD[e] = s;
  }
}

DI void phase_modulate0(const Params& P) {
  const float* MOD = (const float*)(P.ws + OFF_MOD);
  const float4* X = (const float4*)(P.ws + OFF_XRES);
  uint2* H = (uint2*)(P.ws + OFF_HMOD);
  for (int e = bid_() * 256 + tid_(); e < NTOK * 256; e += gridDim.x * 256) {
    const int tok = e >> 8, n = (e & 255) * 4;
    const float* m = MOD + (size_t)mod_index(tok) * 6144;
    const float4 x = X[e];
    const float4 sh = *(const float4*)(m + n), sc = *(const float4*)(m + 1024 + n);
    uint2 o;
    o.x = pack2(x.x * (1.f + sc.x) + sh.x, x.y * (1.f + sc.y) + sh.y);
    o.y = pack2(x.z * (1.f + sc.z) + sh.z, x.w * (1.f + sc.w) + sh.w);
    H[e] = o;
  }
}

DI void phase_gemm_in(const Params& P, int l, unsigned char* smem) {
  const bf16_t* H = (const bf16_t*)(P.ws + OFF_HMOD);
  const bf16_t* W = (const bf16_t*)(P.ws + (size_t)(l & 1) * SZ_SLOT + WS_WIN);
  bf16_t* Q = (bf16_t*)(P.ws + OFF_Q);
  bf16_t* Kn = (bf16_t*)(P.ws + OFF_K);
  bf16_t* KT = (bf16_t*)(P.ws + OFF_KT);
  bf16_t* VT = (bf16_t*)(P.ws + OFF_VT);
  bf16_t* VTC = (bf16_t*)(P.ws + OFF_VTC);
  bf16_t* OG = (bf16_t*)(P.ws + OFF_OG);
  bf16_t* UF = (bf16_t*)(P.ws + OFF_UF);
  bf16_t* GA = (bf16_t*)(P.ws + OFF_GA);
  bf16_t* GB = (bf16_t*)(P.ws + OFF_GB);
  float* GATES = (float*)(P.ws + OFF_GATES);
  for (int t = vblock(); t < 96 * 73; t += gridDim.x) {
    int mtile, ntile;
    tile_decode(t, 96, 73, mtile, ntile);
    const int m0 = mtile * 128, n0 = ntile * 128;
    f32x16 acc[2][2];
    acc_zero(acc);
    gemm_mainloop<false>(acc, H + (size_t)m0 * 1024, 1024, W + (size_t)n0 * 1024, 1024, 1024, nullptr, smem);
    EPI_VARS;
    if (ntile < 8 || (ntile >= 32 && ntile < 72)) {
      bf16_t* dst; int ld, cb; bool sg;
      if (ntile < 8) { dst = Q; ld = 1024; cb = n0; sg = false; }
      else if (ntile < 48) { dst = OG; ld = 2048; cb = n0 - 4096; sg = true; }
      else if (ntile < 56) { dst = UF; ld = 1024; cb = n0 - 6144; sg = false; }
      else if (ntile < 64) { dst = GA; ld = 1024; cb = n0 - 7168; sg = true; }
      else { dst = GB; ld = 1024; cb = n0 - 8192; sg = true; }
      if (sg) store_tile_bf16<1>(acc, dst + (size_t)m0 * ld + cb, ld, smem);
      else store_tile_bf16<0>(acc, dst + (size_t)m0 * ld + cb, ld, smem);
    } else if (ntile < 16) {
      const int cb = n0 - 1024;
#pragma unroll
      for (int mt = 0; mt < 2; ++mt)
#pragma unroll
        for (int nt = 0; nt < 2; ++nt) {
#pragma unroll
          for (int i = 0; i < 16; ++i) { const int tk = m0 + RW(mt, i), kc2 = cb + CL(nt); Kn[((size_t)(tk >> 5) * 4 + (kc2 >> 8)) * 8192 + (tk & 31) * 256 + (kc2 & 255)] = (bf16_t)f2bf(acc[mt][nt][i] * 0.0625f); }
          if (m0 < NCTX) {
            const int kc = cb + CL(nt), hd = kc >> 8, d = kc & 255;
#pragma unroll
            for (int i4 = 0; i4 < 4; ++i4) {
              const int tok0 = m0 + RW(mt, 4 * i4), b = tok0 >> 8, s = tok0 & 255;
              uint2 v;
              v.x = pack2(acc[mt][nt][4 * i4] * 0.0625f, acc[mt][nt][4 * i4 + 1] * 0.0625f);
              v.y = pack2(acc[mt][nt][4 * i4 + 2] * 0.0625f, acc[mt][nt][4 * i4 + 3] * 0.0625f);
              *(uint2*)(KT + ((size_t)((b * 4 + hd) * 256 + d)) * 256 + s) = v;
            }
          }
        }
    } else if (ntile < 32) {
      const int cb = n0 - 2048;
#pragma unroll
      for (int mt = 0; mt < 2; ++mt)
#pragma unroll
        for (int nt = 0; nt < 2; ++nt) {
          const int vc = cb + CL(nt);
#pragma unroll
          for (int i4 = 0; i4 < 4; ++i4) {
            const int tok0 = m0 + RW(mt, 4 * i4);
            uint2 v;
            v.x = pack2(acc[mt][nt][4 * i4], acc[mt][nt][4 * i4 + 1]);
            v.y = pack2(acc[mt][nt][4 * i4 + 2], acc[mt][nt][4 * i4 + 3]);
            { const int cq = (tok0 & 31) >> 2; *(uint2*)(VT + ((size_t)(tok0 >> 5) * 2048 + vc) * 32 + (((cq & 3) * 2 + (cq >> 2)) * 4)) = v; }
            if (tok0 < NCTX) *(uint2*)(VTC + ((size_t)(tok0 >> 8) * 2048 + vc) * 256 + (tok0 & 255)) = v;
          }
        }
    } else {
      if (wn_ == 0 && rr_ < 16) {
        const int g = rr_;
        const float bg = P.b_gate[l * 16 + g];
        const bool isf = (g >> 2) & 1;
#pragma unroll
        for (int mt = 0; mt < 2; ++mt)
#pragma unroll
          for (int i = 0; i < 16; ++i) {
            float v = acc[mt][0][i] + bg;
            if (isf) v = logsigmoidf_(v);
            GATES[(size_t)(m0 + RW(mt, i)) * 16 + g] = v;
          }
      }
    }
  }
}

DI float wave_excl_sum(float v, int lane) {
  float x = v;
#pragma unroll
  for (int o = 1; o < 64; o <<= 1) { const float y = __shfl_up(x, o, 64); if (lane >= o) x += y; }
  return x - v;
}
DI float wave_excl_max(float v, int lane, float init) {
  float x = v;
#pragma unroll
  for (int o = 1; o < 64; o <<= 1) { const float y = __shfl_up(x, o, 64); if (lane >= o) x = fmaxf(x, y); }
  const float p = __shfl_up(x, 1, 64);
  return lane == 0 ? init : fmaxf(init, p);
}

template <int E>
DI void scan_wave(const Params& P, int l, int sid) {
  const int lane = tid_() & 63;
  const int dir = sid & 1, hd = (sid >> 1) & 3, seq = sid >> 3;
  const bool lat = seq >= 16;
  const int S = E * 64;
  const int tok0 = lat ? NCTX + (seq - 16) * 1024 : seq * 256;
  const float* G = (const float*)(P.ws + OFF_GATES);
  const size_t gi = (size_t)(dir * 4 + hd) * NTOK;
  float* BETA = (float*)(P.ws + OFF_BETA) + gi;
  float* MM = (float*)(P.ws + OFF_MM) + gi;
  float* EMT = (float*)(P.ws + OFF_EMT) + gi;
  float* WFIN = (float*)(P.ws + OFF_WFIN) + gi;
  const int gi_i = dir * 8 + hd, gi_f = dir * 8 + 4 + hd;
  const float m0 = lat ? P.state_m[(((seq - 16) * 4 + l) * 2 + dir) * 4 + hd] : 0.f;
  float tot = 0.f;
#pragma unroll
  for (int e = 0; e < E; ++e) {
    const int j = lane * E + e, tok = dir == 0 ? tok0 + j : tok0 + S - 1 - j;
    tot += G[(size_t)tok * 16 + gi_f];
  }
  const float boff = wave_excl_sum(tot, lane);
  float b = boff, cmax = -3.0e38f;
#pragma unroll
  for (int e = 0; e < E; ++e) {
    const int j = lane * E + e, tok = dir == 0 ? tok0 + j : tok0 + S - 1 - j;
    b += G[(size_t)tok * 16 + gi_f];
    const float be = G[(size_t)tok * 16 + gi_i] - b;
    BETA[tok] = be;
    cmax = fmaxf(cmax, be);
  }
  float M = wave_excl_max(cmax, lane, m0);
  b = boff;
#pragma unroll
  for (int e = 0; e < E; ++e) {
    const int j = lane * E + e, tok = dir == 0 ? tok0 + j : tok0 + S - 1 - j;
    b += G[(size_t)tok * 16 + gi_f];
    const float be = G[(size_t)tok * 16 + gi_i] - b;
    M = fmaxf(M, be);
    MM[tok] = M;
    EMT[tok] = __expf(-b - M);
  }
  if (!lat) {
    const float Mlast = __shfl(M, 63, 64);
    const float Blast = __shfl(b, 63, 64);
    if (lane == 0) P.out[OUT_NEWM + (((seq * 4 + l) * 2 + dir) * 4 + hd)] = Blast + Mlast;
    b = boff;
  #pragma unroll
  for (int e = 0; e < E; ++e) {
      const int j = lane * E + e, tok = dir == 0 ? tok0 + j : tok0 + S - 1 - j;
      b += G[(size_t)tok * 16 + gi_f];
      const float be = G[(size_t)tok * 16 + gi_i] - b;
      WFIN[tok] = __expf(be - Mlast);
    }
  }
}

DI void convert_c0(const Params& P, int l) {
  bf16_t* C0T = (bf16_t*)(P.ws + OFF_C0T);
  const int total = 64 * 512 * 32;
  for (int e = bid_() * 256 + tid_(); e < total; e += gridDim.x * 256) {
    const int j = e & 31, v = (e >> 5) & 511, sp = e >> 14;
    const int b = sp >> 3, dir = (sp >> 2) & 1, hd = sp & 3;
    const float* src = P.state_C + ((size_t)((((b * 4 + l) * 2 + dir) * 4 + hd) * 512 + v)) * 256 + j * 8;
    const float4 x0 = *(const float4*)src, x1 = *(const float4*)(src + 4);
    uint4 o;
    o.x = pack2(x0.x, x0.y); o.y = pack2(x0.z, x0.w); o.z = pack2(x1.x, x1.y); o.w = pack2(x1.z, x1.w);
    *(uint4*)(C0T + ((size_t)((sp * 2 + (v >> 8)) * 8 + (j >> 2)) * 256 + (v & 255)) * 32 + (j & 3) * 8) = o;
  }
}

DI void phase_scan_four1(const Params& P, int l, unsigned char* smem) {
  convert_c0(P, l);
  const bf16_t* UF = (const bf16_t*)(P.ws + OFF_UF);
  const bf16_t* BC = (const bf16_t*)(P.ws + OFF_BC);
  bf16_t* TT = (bf16_t*)(P.ws + OFF_TT);
  for (int it = bid_(); it < 48 + 1536; it += gridDim.x) {
    if (it < 48) { const int sid = it * 4 + (tid_() >> 6); if (sid < 128) scan_wave<4>(P, l, sid); else scan_wave<16>(P, l, sid); continue; }
    const int t = it - 48, g = t / 384, rem = t - g * 384;
    int mtile, ntile;
    tile_decode(rem, 96, 4, mtile, ntile);
    const int m0 = mtile * 128, n0 = ntile * 128;
    f32x16 acc[2][2];
    acc_zero(acc);
    gemm_mainloop<false>(acc, UF + (size_t)m0 * 1024 + g * 256, 1024, BC + (size_t)n0 * 256, 256, 256, nullptr, smem);
    EPI_VARS;
#pragma unroll
    for (int mt = 0; mt < 2; ++mt)
#pragma unroll
      for (int nt = 0; nt < 2; ++nt) {
        const int n = n0 + CL(nt), cs = n >> 8, ch = n & 255;
#pragma unroll
        for (int i4 = 0; i4 < 4; ++i4) {
          const int tok0 = m0 + RW(mt, 4 * i4);
          uint2 v;
          v.x = pack2(acc[mt][nt][4 * i4], acc[mt][nt][4 * i4 + 1]);
          v.y = pack2(acc[mt][nt][4 * i4 + 2], acc[mt][nt][4 * i4 + 3]);
          size_t idx;
          if (tok0 < NCTX) idx = ((size_t)(((tok0 >> 8) * 4 + g) * 256 + ch)) * 512 + cs * 256 + (tok0 & 255);
          else { const int tl = tok0 - NCTX; idx = TT_LAT + ((size_t)(((tl >> 10) * 4 + g) * 256 + ch)) * 2048 + cs * 1024 + (tl & 1023); }
          *(uint2*)(TT + idx) = v;
        }
      }
  }
}

DI void mlstm_item(const Params& P, int l, int seq, int hd, int qb, int vh, unsigned char* smem) {
  const int tid = tid_(), lane = tid & 63, w = tid >> 6, c = lane & 15, q = lane >> 4;
  const bool lat = seq >= 16;
  const int S = lat ? 1024 : 256;
  const int tok0 = lat ? NCTX + (seq - 16) * 1024 : seq * 256;
  const int bl = seq - 16;
  const bf16_t* Qg = (const bf16_t*)(P.ws + OFF_Q);
  const bf16_t* Kg = (const bf16_t*)(P.ws + OFF_K);
  const bf16_t* VT = (const bf16_t*)(P.ws + OFF_VT) + ((size_t)(tok0 >> 5) * 2048 + hd * 512 + vh * 256) * 32;
  unsigned char* sK = smem;
  unsigned char* sV = smem + 16896;
  const int t_loc = qb * 64 + w * 16 + c;
  const int tokq = tok0 + t_loc;
  bf16x8 qf[8];
  {
    const bf16_t* qp = Qg + (size_t)tokq * 1024 + hd * 256 + q * 8;
#pragma unroll
    for (int kk = 0; kk < 8; ++kk) qf[kk] = *(const bf16x8*)(qp + kk * 32);
#pragma unroll
    for (int kk = 0; kk < 8; ++kk) asm volatile("" : "+v"(qf[kk]));
  }
  __syncthreads();
  const int nkb = S >> 5;
  const size_t rowbase = (size_t)(tok0 + qb * 64 + w * 16 + 4 * q) * 2048 + hd * 512 + vh * 256 + c;
  const bf16_t* kld = Kg + ((size_t)(tok0 >> 5) * 4 + hd) * 8192 + tid * 8;
  unsigned char* ksd = sK + (tid >> 5) * 528 + (tid & 31) * 16;
  const bf16_t* vld = VT + tid * 8;
  unsigned char* vsd = sV + (tid >> 2) * 96 + (tid & 3) * 16;
  u32x4 st[8], bt[2], btn[2];
#define STWAIT() asm volatile("s_waitcnt vmcnt(0)" : "+v"(st[0]), "+v"(st[1]), "+v"(st[2]), "+v"(st[3]), "+v"(st[4]), "+v"(st[5]), "+v"(st[6]), "+v"(st[7]), "+v"(btn[0]), "+v"(btn[1]) : : "memory")
#define ISSUE_KV(kb_)                                                                      \
  {                                                                                        \
    const bf16_t* kp_ = kld + (size_t)(kb_) * 4 * 8192;                                    \
    const bf16_t* vp_ = vld + (size_t)(kb_) * 2048 * 32;                                   \
    _Pragma("unroll") for (int i = 0; i < 4; ++i) st[i] = gld16(kp_ + i * 2048);           \
    _Pragma("unroll") for (int i = 0; i < 4; ++i) st[4 + i] = gld16(vp_ + i * 2048);       \
    btn[0] = gld16(BETA + (kb_) * 32);                                                     \
    btn[1] = gld16(BETA + (kb_) * 32 + 16);                                                \
  }
#define STORE_KV()                                                                         \
  {                                                                                        \
    _Pragma("unroll") for (int i = 0; i < 4; ++i) *(u32x4*)(ksd + i * 8 * 528) = st[i];    \
    _Pragma("unroll") for (int i = 0; i < 4; ++i) *(u32x4*)(vsd + i * 64 * 96) = st[4 + i];\
    bt[0] = btn[0]; bt[1] = btn[1];                                                        \
  }
#define ISSUE_C0(kk_) { _Pragma("unroll") for (int i = 0; i < 4; ++i) st[4 + i] = gld16(C0 + (kk_) * 8192 + i * 2048); }
#define STORE_C0() { _Pragma("unroll") for (int i = 0; i < 4; ++i) *(u32x4*)(vsd + i * 64 * 96) = st[4 + i]; }
#pragma unroll 1
  for (int dir = 0; dir < 2; ++dir) {
    f32x4 acc[16];
#pragma unroll
    for (int n = 0; n < 16; ++n) acc[n] = (f32x4){0.f, 0.f, 0.f, 0.f};
    float den = 0.f;
    const size_t gi = (size_t)(dir * 4 + hd) * NTOK;
    const float* BETA = (const float*)(P.ws + OFF_BETA) + gi + tok0 + 4 * q;
    const float Mt = ((const float*)(P.ws + OFF_MM))[gi + tokq];
    const float emt = ((const float*)(P.ws + OFF_EMT))[gi + tokq];
    const int kb_lo = dir == 0 ? 0 : 2 * qb;
    const int kb_hi = dir == 0 ? 2 * qb + 1 : nkb - 1;
    asm volatile("" : : "v"(Mt), "v"(emt));
    btn[0] = btn[1] = (u32x4){0u, 0u, 0u, 0u};
    st[0] = st[1] = st[2] = st[3] = (u32x4){0u, 0u, 0u, 0u};
    if (lat) {
      const int sidx = ((bl * 4 + l) * 2 + dir) * 4 + hd;
      const float inter = __expf(P.state_m[sidx] - Mt);
      const bf16_t* C0 = (const bf16_t*)(P.ws + OFF_C0T) + ((size_t)(((bl * 2 + dir) * 4 + hd) * 2 + vh) * 8) * 8192 + tid * 8;
      float* sN = (float*)(smem + 71168);
      float sdot = 0.f;
      __syncthreads();
      {
        const float nv = P.state_n[(size_t)sidx * 256 + tid];
        sN[tid] = nv;
      }
      asm volatile("" : : "v"(inter));
      const float* n0p = sN + q * 8;
      ISSUE_C0(0);
      STWAIT();
      STORE_C0();
      __syncthreads();
#pragma unroll
      for (int kk = 0; kk < 8; ++kk) {
        const int kn = kk < 7 ? kk + 1 : 7;
        ISSUE_C0(kn);
        const bf16x8 qk = qf[kk];
#pragma unroll
        for (int e = 0; e < 8; ++e) sdot += bf2f((unsigned)(unsigned short)qk[e]) * n0p[kk * 32 + e];
        {
          bf16x8 fb[2][4];
          const unsigned char* vb_ = sV + c * 96 + q * 16;
#pragma unroll
          for (int j = 0; j < 4; ++j) fb[0][j] = *(const bf16x8*)(vb_ + j * 16 * 96);
#pragma unroll
          for (int g = 0; g < 4; ++g) {
            if (g < 3) {
#pragma unroll
              for (int j = 0; j < 4; ++j) fb[(g + 1) & 1][j] = *(const bf16x8*)(vb_ + ((g + 1) * 4 + j) * 16 * 96);
            }
#pragma unroll
            for (int j = 0; j < 4; ++j) acc[g * 4 + j] = MFMA16(qk, fb[g & 1][j], acc[g * 4 + j]);
            __builtin_amdgcn_sched_barrier(0);
          }
        }
        STWAIT();
        __syncthreads();
        STORE_C0();
        __syncthreads();
      }
      float it_[4];
#pragma unroll
      for (int j = 0; j < 4; ++j) it_[j] = __shfl(inter, 4 * q + j, 64);
#pragma unroll
      for (int n = 0; n < 16; ++n)
#pragma unroll
        for (int j = 0; j < 4; ++j) acc[n][j] *= it_[j];
      den = inter * sdot;
    }
    __syncthreads();
    ISSUE_KV(kb_lo);
    STWAIT();
    STORE_KV();
    __syncthreads();
#pragma unroll 1
    for (int kb = kb_lo; kb <= kb_hi; ++kb) {
      const int kbn = kb < kb_hi ? kb + 1 : kb_hi;
      ISSUE_KV(kbn);
      const float bb0[4] = {__uint_as_float(bt[0].x), __uint_as_float(bt[0].y), __uint_as_float(bt[0].z), __uint_as_float(bt[0].w)};
      const float bb1[4] = {__uint_as_float(bt[1].x), __uint_as_float(bt[1].y), __uint_as_float(bt[1].z), __uint_as_float(bt[1].w)};
      f32x4 x0 = (f32x4){0.f, 0.f, 0.f, 0.f}, x1 = (f32x4){0.f, 0.f, 0.f, 0.f};
      {
        bf16x8 fa0[2], fa1[2];
        const unsigned char* k0_ = sK + c * 528 + q * 16;
        fa0[0] = *(const bf16x8*)(k0_); fa1[0] = *(const bf16x8*)(k0_ + 16 * 528);
#pragma unroll
        for (int kk = 0; kk < 8; ++kk) {
          if (kk < 7) {
            fa0[(kk + 1) & 1] = *(const bf16x8*)(k0_ + (kk + 1) * 64);
            fa1[(kk + 1) & 1] = *(const bf16x8*)(k0_ + 16 * 528 + (kk + 1) * 64);
          }
          x0 = MFMA16(fa0[kk & 1], qf[kk], x0);
          x1 = MFMA16(fa1[kk & 1], qf[kk], x1);
          __builtin_amdgcn_sched_barrier(0);
        }
      }
      float p0[4], p1[4];
      const bool diag = (kb >> 1) == qb;
      if (diag) {
#pragma unroll
        for (int j = 0; j < 4; ++j) {
          const int s0 = kb * 32 + 4 * q + j, s1 = s0 + 16;
          const bool ok0 = dir == 0 ? (s0 <= t_loc) : (s0 >= t_loc);
          const bool ok1 = dir == 0 ? (s1 <= t_loc) : (s1 >= t_loc);
          p0[j] = ok0 ? x0[j] * __expf(bb0[j] - Mt) : 0.f;
          p1[j] = ok1 ? x1[j] * __expf(bb1[j] - Mt) : 0.f;
          den += p0[j] + p1[j];
        }
      } else {
#pragma unroll
        for (int j = 0; j < 4; ++j) {
          p0[j] = x0[j] * __expf(bb0[j] - Mt);
          p1[j] = x1[j] * __expf(bb1[j] - Mt);
          den += p0[j] + p1[j];
        }
      }
      uint4 pu;
      pu.x = pack2(p0[0], p0[1]); pu.y = pack2(p0[2], p0[3]); pu.z = pack2(p1[0], p1[1]); pu.w = pack2(p1[2], p1[3]);
      const bf16x8 pa = __builtin_bit_cast(bf16x8, pu);
      {
        bf16x8 fv[2][4];
        const unsigned char* vb_ = sV + c * 96 + q * 16;
#pragma unroll
        for (int j = 0; j < 4; ++j) fv[0][j] = *(const bf16x8*)(vb_ + j * 16 * 96);
#pragma unroll
        for (int g = 0; g < 4; ++g) {
          if (g < 3) {
#pragma unroll
            for (int j = 0; j < 4; ++j) fv[(g + 1) & 1][j] = *(const bf16x8*)(vb_ + ((g + 1) * 4 + j) * 16 * 96);
          }
#pragma unroll
          for (int j = 0; j < 4; ++j) acc[g * 4 + j] = MFMA16(pa, fv[g & 1][j], acc[g * 4 + j]);
          __builtin_amdgcn_sched_barrier(0);
        }
      }
      STWAIT();
      __syncthreads();
      STORE_KV();
      __syncthreads();
    }
    den += __shfl_xor(den, 16, 64);
    den += __shfl_xor(den, 32, 64);
    const float rinv = 1.f / fmaxf(fabsf(den), emt);
    float rj[4];
#pragma unroll
    for (int j = 0; j < 4; ++j) rj[j] = __shfl(rinv, 4 * q + j, 64);
    bf16_t* HS = (bf16_t*)(P.ws + OFF_H0) + rowbase;
    asm volatile("" : "+v"(HS));
    bf16_t* h0p = HS; bf16_t* h1p = HS + 2048; bf16_t* h2p = HS + 4096; bf16_t* h3p = HS + 6144;
    asm volatile("" : "+v"(h1p));
    asm volatile("" : "+v"(h2p));
    asm volatile("" : "+v"(h3p));
    if (dir == 0) {
#pragma unroll
      for (int n = 0; n < 16; ++n) {
        h0p[n * 16] = (bf16_t)f2bf(acc[n][0] * rj[0]);
        h1p[n * 16] = (bf16_t)f2bf(acc[n][1] * rj[1]);
        h2p[n * 16] = (bf16_t)f2bf(acc[n][2] * rj[2]);
        h3p[n * 16] = (bf16_t)f2bf(acc[n][3] * rj[3]);
      }
    } else {
#pragma unroll
      for (int n = 0; n < 16; ++n) {
        h0p[n * 16] = (bf16_t)f2bf(acc[n][0] * rj[0] + bf2f(h0p[n * 16]));
        h1p[n * 16] = (bf16_t)f2bf(acc[n][1] * rj[1] + bf2f(h1p[n * 16]));
        h2p[n * 16] = (bf16_t)f2bf(acc[n][2] * rj[2] + bf2f(h2p[n * 16]));
        h3p[n * 16] = (bf16_t)f2bf(acc[n][3] * rj[3] + bf2f(h3p[n * 16]));
        if ((n & 3) == 3) __builtin_amdgcn_sched_barrier(0);
      }
    }
  }
}

#undef STWAIT
#undef ISSUE_KV
#undef ISSUE_C0
#undef STORE_KV
#undef STORE_C0

DI void phase_hn(const Params& P, int l) {
  const bf16_t* HS = (const bf16_t*)(P.ws + OFF_H0);
  const bf16_t* OG = (const bf16_t*)(P.ws + OFF_OG);
  bf16_t* HN = (bf16_t*)(P.ws + OFF_HN);
  const int tidl_ = tid_(), lane = tidl_ & 63, w = tidl_ >> 6;
  for (int pr = bid_() * 4 + w; pr < NTOK * 4; pr += gridDim.x * 4) {
    const size_t base = (size_t)pr * 512 + lane * 8;
    const uint4 hv = *(const uint4*)(HS + base);
    const uint4 ov = *(const uint4*)(OG + base);
    const unsigned hu[4] = {hv.x, hv.y, hv.z, hv.w}, ou[4] = {ov.x, ov.y, ov.z, ov.w};
    float x[8];
    float s = 0.f;
#pragma unroll
    for (int i = 0; i < 4; ++i) { x[2 * i] = bf2f(hu[i] & 0xffffu); x[2 * i + 1] = bf2f(hu[i] >> 16); s += x[2 * i] + x[2 * i + 1]; }
#pragma unroll
    for (int o = 1; o < 64; o <<= 1) s += __shfl_xor(s, o, 64);
    const float mu = s * (1.f / 512.f);
    float vs = 0.f;
#pragma unroll
    for (int i = 0; i < 8; ++i) { const float d = x[i] - mu; vs += d * d; }
#pragma unroll
    for (int o = 1; o < 64; o <<= 1) vs += __shfl_xor(vs, o, 64);
    const float rs = rsqrtf(vs * (1.f / 512.f) + LN_EPS);
    const float* gp = P.mh_gain + l * 2048 + (pr & 3) * 512 + lane * 8;
    const float4 g0 = *(const float4*)gp, g1 = *(const float4*)(gp + 4);
    const float g[8] = {g0.x, g0.y, g0.z, g0.w, g1.x, g1.y, g1.z, g1.w};
    unsigned r[4];
#pragma unroll
    for (int i = 0; i < 4; ++i)
      r[i] = pack2((x[2 * i] - mu) * rs * g[2 * i] * bf2f(ou[i] & 0xffffu), (x[2 * i + 1] - mu) * rs * g[2 * i + 1] * bf2f(ou[i] >> 16));
    *(uint4*)(HN + base) = make_uint4(r[0], r[1], r[2], r[3]);
  }
}

DI void phase_mixers(const Params& P, int l, unsigned char* smem) {
  const bf16_t* VTC = (const bf16_t*)(P.ws + OFF_VTC);
  const bf16_t* KT = (const bf16_t*)(P.ws + OFF_KT);
  const bf16_t* Kn = (const bf16_t*)(P.ws + OFF_K);
  const bf16_t* TT = (const bf16_t*)(P.ws + OFF_TT);
  const bf16_t* A256 = (const bf16_t*)(P.ws + OFF_A256);
  const bf16_t* A1024 = (const bf16_t*)(P.ws + OFF_A1024);
  const float* WFIN = (const float*)(P.ws + OFF_WFIN);
  bf16_t* FB = (bf16_t*)(P.ws + OFF_FB);
  for (int it0 = bid_(); it0 < 1024 + 2304; it0 += gridDim.x) {
    if (it0 < 1024) { mlstm_item(P, l, 16 + (it0 >> 7), (it0 >> 5) & 3, (it0 >> 1) & 15, it0 & 1, smem); continue; }
    const int r = it0 - 1024;
    if (r >= 512 && r < 1024) { const int j = r - 512; mlstm_item(P, l, j >> 5, (j >> 3) & 3, (j >> 1) & 3, j & 1, smem); continue; }
    f32x16 acc[2][2];
    acc_zero(acc);
    if (r < 512) {
      const int j = r, sg = j >> 4, mtile = (j >> 1) & 7, ntile = j & 1;
      gemm_mainloop<false>(acc, A1024 + (size_t)mtile * 128 * 2048, 2048, TT + TT_LAT + ((size_t)sg * 256 + ntile * 128) * 2048, 2048, 2048, nullptr, smem);
      EPI_VARS;
      const int seq = sg >> 2, g = sg & 3;
#pragma unroll
      for (int mt = 0; mt < 2; ++mt)
#pragma unroll
        for (int nt = 0; nt < 2; ++nt)
#pragma unroll
          for (int i = 0; i < 16; ++i)
            FB[(size_t)(NCTX + seq * 1024 + mtile * 128 + RW(mt, i)) * 1024 + g * 256 + ntile * 128 + CL(nt)] = (bf16_t)f2bf(acc[mt][nt][i] * (1.f / 512.f));
    } else if (r >= 2048) {
      const int j = r - 2048, sg = j >> 2, mtile = (j >> 1) & 1, ntile = j & 1;
      gemm_mainloop<false>(acc, A256 + (size_t)mtile * 128 * 512, 512, TT + ((size_t)sg * 256 + ntile * 128) * 512, 512, 512, nullptr, smem);
      EPI_VARS;
      const int seq = sg >> 2, g = sg & 3;
#pragma unroll
      for (int mt = 0; mt < 2; ++mt)
#pragma unroll
        for (int nt = 0; nt < 2; ++nt)
#pragma unroll
          for (int i = 0; i < 16; ++i)
            FB[(size_t)(seq * 256 + mtile * 128 + RW(mt, i)) * 1024 + g * 256 + ntile * 128 + CL(nt)] = (bf16_t)f2bf(acc[mt][nt][i] * (1.f / 256.f));
    } else {
      const int j = r - 1024, bhd = j >> 3, mtile = (j >> 1) & 3, ntile = j & 1;
      const int b = bhd >> 3, hd = (bhd >> 1) & 3, dir = bhd & 1;
      const float* wf = WFIN + (size_t)(dir * 4 + hd) * NTOK + b * 256;
      gemm_mainloop<true>(acc, VTC + ((size_t)b * 2048 + hd * 512 + mtile * 128) * 256, 256, KT + ((size_t)(b * 4 + hd) * 256 + ntile * 128) * 256, 256, 256, wf, smem);
      EPI_VARS;
      const size_t sidx = (size_t)(((b * 4 + l) * 2 + dir) * 4 + hd);
      float* Co = P.out + OUT_NEWC + sidx * 512 * 256;
#pragma unroll
      for (int mt = 0; mt < 2; ++mt)
#pragma unroll
        for (int nt = 0; nt < 2; ++nt)
#pragma unroll
          for (int i = 0; i < 16; ++i) Co[(size_t)(mtile * 128 + RW(mt, i)) * 256 + ntile * 128 + CL(nt)] = acc[mt][nt][i];
      if (mtile == 0 && tid_e_ < 128) {
        const int d = ntile * 128 + tid_e_;
        float s = 0.f;
        for (int sp = 0; sp < 256; ++sp) s += wf[sp] * bf2f(Kn[((size_t)((b * 256 + sp) >> 5) * 4 + hd) * 8192 + (sp & 31) * 256 + d]);
        P.out[OUT_NEWN + sidx * 256 + d] = s;
      }
    }
  }
}

DI void phase_branch(const Params& P, int l, unsigned char* smem) {
  const unsigned char* slot = P.ws + (size_t)(l & 1) * SZ_SLOT;
  const bf16_t* HN = (const bf16_t*)(P.ws + OFF_HN);
  const bf16_t* FB = (const bf16_t*)(P.ws + OFF_FB);
  const bf16_t* WA = (const bf16_t*)(slot + WS_WA);
  const bf16_t* WB = (const bf16_t*)(slot + WS_WB);
  const bf16_t* GA = (const bf16_t*)(P.ws + OFF_GA);
  const bf16_t* GB = (const bf16_t*)(P.ws + OFF_GB);
  bf16_t* MG = (bf16_t*)(P.ws + OFF_MERGED);
  for (int t = vblock(); t < 64 * 8; t += gridDim.x) {
    int mtile, ntile;
    tile_decode(t, 64, 8, mtile, ntile);
    const int m0 = mtile * 192, n0 = ntile * 128;
    f32x16 acc[3][2];
    acc_zero3(acc);
    gemm192_mainloop(acc, HN + (size_t)m0 * 2048, 2048, WA + (size_t)n0 * 2048, 2048, 2048, smem);
    const bf16_t* GAb = GA + (size_t)m0 * 1024 + n0;
    const bf16_t* GBb = GB + (size_t)m0 * 1024 + n0;
    bf16_t* MGb = MG + (size_t)m0 * 1024 + n0;
    {
      EPI_VARS;
#pragma unroll
      for (int mt = 0; mt < 3; ++mt)
#pragma unroll
        for (int nt = 0; nt < 2; ++nt)
#pragma unroll
          for (int i = 0; i < 16; ++i) {
            const unsigned o = (unsigned)RW3(mt, i) * 1024u + CL(nt);
            MGb[o] = (bf16_t)f2bf(bf2f(GAb[o]) * acc[mt][nt][i]);
          }
    }
    acc_zero3(acc);
    gemm192_mainloop(acc, FB + (size_t)m0 * 1024, 1024, WB + (size_t)n0 * 1024, 1024, 1024, smem);
    EPI_VARS;
#pragma unroll
    for (int mt = 0; mt < 3; ++mt)
#pragma unroll
      for (int nt = 0; nt < 2; ++nt)
#pragma unroll
        for (int i = 0; i < 16; ++i) {
          const unsigned o = (unsigned)RW3(mt, i) * 1024u + CL(nt);
          MGb[o] = (bf16_t)f2bf(bf2f(MGb[o]) + bf2f(GBb[o]) * acc[mt][nt][i]);
        }
  }
}

DI void phase_resid_gemm(const Params& P, int l, const bf16_t* A, int K, const bf16_t* W, int goff, unsigned char* smem) {
  const float* X = (const float*)(P.ws + OFF_XRES);
  const float* MOD = (const float*)(P.ws + OFF_MOD) + (size_t)l * 9 * 6144;
  float* PRE = (float*)(P.ws + OFF_PRELN);
  for (int t = vblock(); t < 64 * 8; t += gridDim.x) {
    int mtile, ntile;
    tile_decode(t, 64, 8, mtile, ntile);
    const int m0 = mtile * 192, n0 = ntile * 128;
    f32x16 acc[3][2];
    acc_zero3(acc);
    gemm192_mainloop(acc, A + (size_t)m0 * K, K, W + (size_t)n0 * K, K, K, smem);
    EPI_VARS;
    const float* Xb = X + (size_t)m0 * 1024 + n0;
    float* PREb = PRE + (size_t)m0 * 1024 + n0;
#pragma unroll
    for (int mt = 0; mt < 3; ++mt)
#pragma unroll
      for (int nt = 0; nt < 2; ++nt)
#pragma unroll
        for (int i = 0; i < 16; ++i) {
          const int row = RW3(mt, i);
          const unsigned o = (unsigned)row * 1024u + CL(nt);
          const float gv = MOD[(size_t)mod_index(m0 + row) * 6144 + goff + n0 + CL(nt)];
          PREb[o] = ALPHA * Xb[o] + gv * acc[mt][nt][i];
        }
  }
}

DI void phase_ln(const Params& P, const float* gain, const float* bias, float* xdst, const float* modn, int shoff, int scoff) {
  const float* PRE = (const float*)(P.ws + OFF_PRELN);
  bf16_t* H = (bf16_t*)(P.ws + OFF_HMOD);
  const int tidl_ = tid_(), lane = tidl_ & 63, w = tidl_ >> 6;
  for (int tok = bid_() * 4 + w; tok < NTOK; tok += gridDim.x * 4) {
    float4 v[4];
    float s = 0.f;
#pragma unroll
    for (int i = 0; i < 4; ++i) {
      v[i] = *(const float4*)(PRE + (size_t)tok * 1024 + (i * 64 + lane) * 4);
      s += v[i].x + v[i].y + v[i].z + v[i].w;
    }
#pragma unroll
    for (int o = 1; o < 64; o <<= 1) s += __shfl_xor(s, o, 64);
    const float mu = s * (1.f / 1024.f);
    float vs = 0.f;
#pragma unroll
    for (int i = 0; i < 4; ++i) {
      const float a = v[i].x - mu, b = v[i].y - mu, c = v[i].z - mu, d = v[i].w - mu;
      vs += a * a + b * b + c * c + d * d;
    }
#pragma unroll
    for (int o = 1; o < 64; o <<= 1) vs += __shfl_xor(vs, o, 64);
    const float rs = rsqrtf(vs * (1.f / 1024.f) + LN_EPS);
    const float* m = modn ? modn + (size_t)mod_index(tok) * 6144 : nullptr;
#pragma unroll
    for (int i = 0; i < 4; ++i) {
      const int n = (i * 64 + lane) * 4;
      const float4 g = *(const float4*)(gain + n), b = *(const float4*)(bias + n);
      float4 x;
      x.x = (v[i].x - mu) * rs * g.x + b.x; x.y = (v[i].y - mu) * rs * g.y + b.y;
      x.z = (v[i].z - mu) * rs * g.z + b.z; x.w = (v[i].w - mu) * rs * g.w + b.w;
      *(float4*)(xdst + (size_t)tok * 1024 + n) = x;
      if (m) {
        const float4 sh = *(const float4*)(m + shoff + n), sc = *(const float4*)(m + scoff + n);
        uint2 o;
        o.x = pack2(x.x * (1.f + sc.x) + sh.x, x.y * (1.f + sc.y) + sh.y);
        o.y = pack2(x.z * (1.f + sc.z) + sh.z, x.w * (1.f + sc.w) + sh.w);
        *(uint2*)(H + (size_t)tok * 1024 + n) = o;
      }
    }
  }
}

DI void phase_ffn_in(const Params& P, int l, unsigned char* smem) {
  const bf16_t* H = (const bf16_t*)(P.ws + OFF_HMOD);
  const bf16_t* W = (const bf16_t*)(P.ws + (size_t)(l & 1) * SZ_SLOT + WS_WF1);
  bf16_t* FF = (bf16_t*)(P.ws + OFF_FF);
  for (int t = vblock(); t < 96 * 44; t += gridDim.x) {
    int mtile, ntile;
    tile_decode(t, 96, 44, mtile, ntile);
    const int m0 = mtile * 128, n0 = ntile * 128;
    f32x16 acc[2][2];
    acc_zero(acc);
    gemm_mainloop<false>(acc, H + (size_t)m0 * 1024, 1024, W + (size_t)n0 * 1024, 1024, 1024, nullptr, smem);
    EPI_VARS;
#pragma unroll
    for (int mt = 0; mt < 2; ++mt)
#pragma unroll
      for (int i = 0; i < 16; ++i) {
        const float a = acc[mt][0][i], u = acc[mt][1][i];
        *(unsigned short*)(smem + RW(mt, i) * 144 + (wn_ * 32 + rr_) * 2) = (unsigned short)f2bf(a * sigmoidf_(a) * u);
      }
    __syncthreads();
#pragma unroll
    for (int i = 0; i < 4; ++i) {
      const int row = (tid_e_ >> 3) + 32 * i, ch = tid_e_ & 7;
      const u32x4 x = *(const u32x4*)(smem + row * 144 + ch * 16);
      *(u32x4*)(FF + (size_t)(m0 + row) * DFF + ntile * 64 + ch * 8) = x;
    }
    __syncthreads();
  }
}

template <int S>
DI void run_phase(const Params& P, int l, unsigned char* smem) {
  const unsigned char* slot = P.ws + (size_t)(l & 1) * SZ_SLOT;
  const float* MOD = (const float*)(P.ws + OFF_MOD);
  if constexpr (S == 0) phase_setup(P, smem);
  else if constexpr (S == 1) phase_modreduce(P);
  else if constexpr (S == 2) phase_modulate0(P);
  else if constexpr (S == 3) phase_gemm_in(P, l, smem);
  else if constexpr (S == 4) phase_scan_four1(P, l, smem);
  else if constexpr (S == 5) phase_mixers(P, l, smem);
  else if constexpr (S == 6) phase_hn(P, l);
  else if constexpr (S == 7) phase_branch(P, l, smem);
  else if constexpr (S == 8) phase_resid_gemm(P, l, (const bf16_t*)(P.ws + OFF_MERGED), 1024, (const bf16_t*)(slot + WS_WO), 2048, smem);
  else if constexpr (S == 9) {
    phase_ln(P, P.ln_gain + (l * 2 + 0) * 1024, P.ln_bias + (l * 2 + 0) * 1024, (float*)(P.ws + OFF_XRES), MOD + (size_t)l * 9 * 6144, 3072, 4096);
    if (l + 1 < 4) convert_layer(P, l + 1, smem);
  } else if constexpr (S == 10) phase_ffn_in(P, l, smem);
  else if constexpr (S == 11) phase_resid_gemm(P, l, (const bf16_t*)(P.ws + OFF_FF), DFF, (const bf16_t*)(slot + WS_WF2), 5120, smem);
  else {
    if (l == 3) phase_ln(P, P.ln_gain + (l * 2 + 1) * 1024, P.ln_bias + (l * 2 + 1) * 1024, P.out, nullptr, 0, 0);
    else phase_ln(P, P.ln_gain + (l * 2 + 1) * 1024, P.ln_bias + (l * 2 + 1) * 1024, (float*)(P.ws + OFF_XRES), MOD + (size_t)(l + 1) * 9 * 6144, 0, 1024);
  }
}

#if !ONE_LAUNCH
template <int S>
__global__ void __launch_bounds__(256, 2) k_phase(Params P, int l) {
  __shared__ __attribute__((aligned(16))) unsigned char smem[SMEM_BYTES];
  run_phase<S>(P, l, smem);
}

#endif
#define XB_TMO      128
#define XB_XCNT(j)  (256  + 64 * (j))
#define XB_XSUB(j)  (1280 + 64 * (j))
#define XB_XGEN(j)  (2304 + 64 * (j))
#define XB_TOP      3328
#define XB_TOPGEN   3392
#define XCD_BAR_WORDS 3456
#define XB_SPIN_CAP (1u << 20)
#define LAS __attribute__((address_space(3)))
DI unsigned xb_ld(unsigned* p) { return __hip_atomic_load(p, __ATOMIC_RELAXED, __HIP_MEMORY_SCOPE_AGENT); }
DI unsigned xb_add(unsigned* p, unsigned v) { return __hip_atomic_fetch_add(p, v, __ATOMIC_RELAXED, __HIP_MEMORY_SCOPE_AGENT); }
DI unsigned xb_xcc_id() { return (unsigned)__builtin_amdgcn_s_getreg((3 << 11) | 20) & 0xFu; }
#define XB_SPIN(cond, bar) do { unsigned _sp = 0; while (cond) { __builtin_amdgcn_s_sleep(1); \
    if ((++_sp & 255u) == 0u) { if (xb_ld(&(bar)[XB_TMO])) break; if (_sp > XB_SPIN_CAP) { atomicAdd(&(bar)[XB_TMO], 1u); break; } } } } while (0)
DI void xcd_barrier_complete(unsigned* bar, unsigned x, unsigned& nloc, unsigned& nx) {
  const unsigned G = gridDim.x;
  unsigned sum, cnt, mine, sp = 0u;
  for (;;) {
    sum = 0u; cnt = 0u; mine = 0u;
#pragma unroll
    for (unsigned j = 0; j < 16; ++j) { const unsigned c = xb_ld(&bar[XB_XCNT(j)]); sum += c; cnt += (c > 0u) ? 1u : 0u; mine = (j == x) ? c : mine; }
    if (sum == G) break;
    __builtin_amdgcn_s_sleep(1);
    if ((++sp & 255u) == 0u) { if (xb_ld(&bar[XB_TMO])) break; if (sp > XB_SPIN_CAP) { atomicAdd(&bar[XB_TMO], 1u); break; } }
  }
  nloc = mine > 0u ? mine : 1u; nx = cnt > 0u ? cnt : 1u;
}
DI void xcd_barrier(unsigned* bar, volatile LAS unsigned* st) {
  asm volatile("s_waitcnt vmcnt(0)" ::: "memory");
  __syncthreads();
  if (threadIdx.x == 0) {
    const unsigned x = xb_xcc_id();
    __builtin_amdgcn_s_waitcnt(0);
    unsigned nloc = st[0], nx = st[1];
    if (nloc == 0u) { xcd_barrier_complete(bar, x, nloc, nx); st[0] = nloc; st[1] = nx; }
    const unsigned old = xb_add(&bar[XB_XSUB(x)], 1u);
    const unsigned gen = old / nloc;
    if (old + 1u == (gen + 1u) * nloc) {
      __builtin_amdgcn_fence(__ATOMIC_RELEASE, "agent");
      asm volatile("s_waitcnt vmcnt(0)" ::: "memory");
      const unsigned og = xb_add(&bar[XB_TOP], 1u);
      const unsigned tg = og / nx;
      if (og + 1u == (tg + 1u) * nx) xb_add(&bar[XB_TOPGEN], 1u);
      else XB_SPIN(xb_ld(&bar[XB_TOPGEN]) == tg, bar);
      __builtin_amdgcn_fence(__ATOMIC_ACQUIRE, "agent");
      xb_add(&bar[XB_XGEN(x)], 1u);
      asm volatile("s_waitcnt vmcnt(0)" ::: "memory");
    } else {
      XB_SPIN(xb_ld(&bar[XB_XGEN(x)]) == gen, bar);
      __builtin_amdgcn_fence(__ATOMIC_ACQUIRE, "agent");
      asm volatile("s_waitcnt vmcnt(0)" ::: "memory");
    }
  }
  __syncthreads();
}

#define GSYNC() xcd_barrier((unsigned*)(load_params().ws + OFF_BAR), xb_st)
DI Params load_params() {
  Params P{};
#if defined(__HIP_DEVICE_COMPILE__)
  typedef const unsigned long long __attribute__((address_space(4)))* KP;
  typedef float __attribute__((address_space(1)))* GF;
  KP kp = (KP)__builtin_amdgcn_kernarg_segment_ptr();
  asm volatile("" : "+s"(kp));
  P.x_prompt = (const float*)(GF)kp[0];
  P.x_sample = (const float*)(GF)kp[1];
  P.c = (const float*)(GF)kp[2];
  P.state_C = (const float*)(GF)kp[3];
  P.state_n = (const float*)(GF)kp[4];
  P.state_m = (const float*)(GF)kp[5];
  P.c_ctx = (const float*)(GF)kp[6];
  P.w_mod = (const float*)(GF)kp[7];
  P.b_mod = (const float*)(GF)kp[8];
  P.w_in = (const float*)(GF)kp[9];
  P.b_gate = (const float*)(GF)kp[10];
  P.mh_gain = (const float*)(GF)kp[11];
  P.w_a = (const float*)(GF)kp[12];
  P.w_b = (const float*)(GF)kp[13];
  P.w_out = (const float*)(GF)kp[14];
  P.ln_gain = (const float*)(GF)kp[15];
  P.ln_bias = (const float*)(GF)kp[16];
  P.w_f1 = (const float*)(GF)kp[17];
  P.w_f2 = (const float*)(GF)kp[18];
  P.out = (float*)(GF)kp[19];
  P.ws = (unsigned char*)(GF)kp[20];
#endif
  return P;
}
__global__ void __launch_bounds__(256, 2) fwd_kernel(Params Pk) {
  __shared__ __attribute__((aligned(16))) unsigned char smem[SMEM_BYTES];
  __shared__ uint4 xb_words;
  {
    unsigned* bar0 = (unsigned*)(load_params().ws + OFF_BAR);
    const unsigned x0 = xb_xcc_id();
    if (threadIdx.x == 0) {
      xb_words = make_uint4(0u, 0u, 0u, 0u);
      (void)xb_add(&bar0[XB_XCNT(x0)], 1u);
    }
  }
  __syncthreads();
  volatile LAS unsigned* xb_st = (volatile LAS unsigned*)&xb_words;
  run_phase<0>(load_params(), 0, smem);
  if (load_params().ws == nullptr) cg::this_grid().sync();
  GSYNC();
  run_phase<1>(load_params(), 0, smem); GSYNC();
  run_phase<2>(load_params(), 0, smem); GSYNC();
#pragma unroll 1
  for (int l = 0; l < 4; ++l) {
    run_phase<3>(load_params(), l, smem); GSYNC();
    run_phase<4>(load_params(), l, smem); GSYNC();
    run_phase<5>(load_params(), l, smem); GSYNC();
    run_phase<6>(load_params(), l, smem); GSYNC();
    run_phase<7>(load_params(), l, smem); GSYNC();
    run_phase<8>(load_params(), l, smem); GSYNC();
    run_phase<9>(load_params(), l, smem); GSYNC();
    run_phase<10>(load_params(), l, smem); GSYNC();
    run_phase<11>(load_params(), l, smem); GSYNC();
    run_phase<12>(load_params(), l, smem);
    if (l < 3) GSYNC();
  }
}

#if !ONE_LAUNCH
template <int S>
static void launch_phase(const Params& P, int l, int cus, hipStream_t stream) {
  int per_cu = 0;
  if (hipOccupancyMaxActiveBlocksPerMultiprocessor(&per_cu, k_phase<S>, 256, 0) != hipSuccess) per_cu = 1;
  if (per_cu > 2) per_cu = 2;
  if (per_cu < 1) per_cu = 1;
  int grid = cus * per_cu;
  grid -= grid % 8;
  hipLaunchKernelGGL(k_phase<S>, dim3(grid), dim3(256), 0, stream, P, l);
}

#endif
extern "C" void kernel_launch(void* const* d_in, const int* in_sizes, int n_in, void* d_out, int out_size, void* d_ws, size_t ws_size,
                              hipStream_t stream) {
  if (ws_size < WS_TOTAL) { fprintf(stderr, "workspace too small: %zu < %zu\n", ws_size, (size_t)WS_TOTAL); return; }
  Params P{};
  const float** pp = (const float**)&P;
  for (int i = 0; i < 19; ++i) pp[i] = (const float*)d_in[i];
  P.out = (float*)d_out;
  P.ws = (unsigned char*)d_ws;
  int dev = 0, cus = 256;
  if (hipGetDevice(&dev) != hipSuccess) dev = 0;
  if (hipDeviceGetAttribute(&cus, hipDeviceAttributeMultiprocessorCount, dev) != hipSuccess) cus = 256;
#if ONE_LAUNCH
  {
    static int grid_blocks = 0;
    if (!grid_blocks) {
      int per_cu = 0;
      if (hipOccupancyMaxActiveBlocksPerMultiprocessor(&per_cu, fwd_kernel, 256, 0) != hipSuccess) per_cu = 1;
      if (per_cu > 2) per_cu = 2;
      if (per_cu < 1) per_cu = 1;
      grid_blocks = cus * per_cu;
      grid_blocks -= grid_blocks % 8;
    }
    if (hipMemsetAsync((unsigned char*)d_ws + OFF_BAR, 0, 16384, stream) != hipSuccess) { fprintf(stderr, "memset of barrier words failed\n"); return; }
    void* args[] = {&P};
    hipError_t err = hipLaunchCooperativeKernel((void*)fwd_kernel, dim3(grid_blocks), dim3(256), args, 0, stream);
    if (err != hipSuccess) fprintf(stderr, "cooperative launch failed: %s (grid %d)\n", hipGetErrorString(err), grid_blocks);
    return;
  }
#endif
#if !ONE_LAUNCH
  launch_phase<0>(P, 0, cus, stream);
  launch_phase<1>(P, 0, cus, stream);
  launch_phase<2>(P, 0, cus, stream);
  for (int l = 0; l < 4; ++l) {
    launch_phase<3>(P, l, cus, stream);
    launch_phase<4>(P, l, cus, stream);
    launch_phase<5>(P, l, cus, stream);
    launch_phase<6>(P, l, cus, stream);
    launch_phase<7>(P, l, cus, stream);
    launch_phase<8>(P, l, cus, stream);
    launch_phase<9>(P, l, cus, stream);
    launch_phase<10>(P, l, cus, stream);
    launch_phase<11>(P, l, cus, stream);
    launch_phase<12>(P, l, cus, stream);
  }
#endif
}
```

```cpp
#include <hip/hip_runtime.h>
#include <hip/hip_cooperative_groups.h>
#include <cstdio>
#ifndef ONE_LAUNCH
#define ONE_LAUNCH 1
#endif
namespace cg = cooperative_groups;

typedef unsigned short bf16_t;
using bf16x8 = __attribute__((ext_vector_type(8))) short;
using f32x16 = __attribute__((ext_vector_type(16))) float;
using f32x4 = __attribute__((ext_vector_type(4))) float;
#define DI __device__ __forceinline__
#define MFMA32(a, b, c) __builtin_amdgcn_mfma_f32_32x32x16_bf16((a), (b), (c), 0, 0, 0)
#define MFMA16(a, b, c) __builtin_amdgcn_mfma_f32_16x16x32_bf16((a), (b), (c), 0, 0, 0)

constexpr int NTOK = 12288, NCTX = 4096;
constexpr int NINP = 9344;
constexpr int DFF = 2816;
constexpr float ALPHA = 1.6817928305074290f;
constexpr float LN_EPS = 1e-5f;

constexpr size_t SZ_WIN = (size_t)NINP * 1024 * 2, SZ_WA = 1024ull * 2048 * 2, SZ_WB = 1024ull * 1024 * 2, SZ_WO = SZ_WB,
                 SZ_WF1 = 5632ull * 1024 * 2, SZ_WF2 = 1024ull * 2816 * 2;
constexpr size_t WS_WIN = 0, WS_WA = WS_WIN + SZ_WIN, WS_WB = WS_WA + SZ_WA, WS_WO = WS_WB + SZ_WB, WS_WF1 = WS_WO + SZ_WO,
                 WS_WF2 = WS_WF1 + SZ_WF1, SZ_SLOT = WS_WF2 + SZ_WF2;
constexpr size_t OFF_BC = 2 * SZ_SLOT;
constexpr size_t OFF_A256 = OFF_BC + 512 * 256 * 2;
constexpr size_t OFF_A1024 = OFF_A256 + 256 * 512 * 2;
constexpr size_t OFF_MODP = OFF_A1024 + 1024ull * 2048 * 2;
constexpr size_t OFF_MOD = OFF_MODP + 8ull * 4 * 9 * 6144 * 4;
constexpr size_t OFF_XRES = OFF_MOD + 4ull * 9 * 6144 * 4;
constexpr size_t OFF_HMOD = OFF_XRES + (size_t)NTOK * 1024 * 4;
constexpr size_t OFF_FB = OFF_HMOD;
constexpr size_t OFF_Q = OFF_HMOD + (size_t)NTOK * 1024 * 2;
constexpr size_t OFF_MERGED = OFF_Q;
constexpr size_t OFF_K = OFF_Q + (size_t)NTOK * 1024 * 2;
constexpr size_t OFF_KT = OFF_K + (size_t)NTOK * 1024 * 2;
constexpr size_t OFF_VT = OFF_KT + 16ull * 4 * 256 * 256 * 2;
constexpr size_t OFF_OG = OFF_VT + (size_t)NTOK * 2048 * 2;
constexpr size_t OFF_FF = OFF_OG;
constexpr size_t OFF_UF = OFF_OG + (size_t)NTOK * 2048 * 2;
constexpr size_t OFF_GA = OFF_UF + (size_t)NTOK * 1024 * 2;
constexpr size_t OFF_GB = OFF_GA + (size_t)NTOK * 1024 * 2;
constexpr size_t OFF_GATES = OFF_GB + (size_t)NTOK * 1024 * 2;
constexpr size_t SZ_SC = 2ull * 4 * NTOK * 4;
constexpr size_t OFF_BETA = OFF_GATES + (size_t)NTOK * 16 * 4;
constexpr size_t OFF_MM = OFF_BETA + SZ_SC;
constexpr size_t OFF_EMT = OFF_MM + SZ_SC;
constexpr size_t OFF_WFIN = OFF_EMT + SZ_SC;
constexpr size_t OFF_H0 = OFF_WFIN + SZ_SC;
constexpr size_t OFF_TT = OFF_H0 + (size_t)NTOK * 2048 * 2;
constexpr size_t OFF_PRELN = OFF_TT;
constexpr size_t OFF_HN = OFF_TT + (size_t)NTOK * 2048 * 2;
constexpr size_t OFF_VTC = OFF_HN + (size_t)NTOK * 2048 * 2;
constexpr size_t OFF_C0T = OFF_VTC + 16ull * 2048 * 256 * 2;
constexpr size_t OFF_BAR = OFF_C0T + 64ull * 512 * 256 * 2;
constexpr size_t WS_TOTAL = OFF_BAR + 16384;
constexpr size_t VT_LAT = 16ull * 2048 * 256;
constexpr size_t TT_LAT = 16ull * 4 * 256 * 512;

constexpr size_t OUT_NEWC = (size_t)NTOK * 1024;
constexpr size_t OUT_NEWN = OUT_NEWC + 16ull * 4 * 2 * 4 * 512 * 256;
constexpr size_t OUT_NEWM = OUT_NEWN + 16ull * 4 * 2 * 4 * 256;

constexpr int SMEM_BYTES = 73728;

struct Params {
  const float *x_prompt, *x_sample, *c, *state_C, *state_n, *state_m, *c_ctx, *w_mod, *b_mod, *w_in, *b_gate, *mh_gain,
      *w_a, *w_b, *w_out, *ln_gain, *ln_bias, *w_f1, *w_f2;
  float* out;
  unsigned char* ws;
};

typedef unsigned u32x4 __attribute__((ext_vector_type(4)));
DI u32x4 gld16(const void* p) { u32x4 r; asm volatile("global_load_dwordx4 %0, %1, off" : "=&v"(r) : "v"(p) : "memory"); return r; }
DI unsigned f2bf(float x) { unsigned r; asm("v_cvt_pk_bf16_f32 %0, %1, %1" : "=v"(r) : "v"(x)); return r & 0xffffu; }
DI unsigned pack2(float a, float b) { unsigned r; asm("v_cvt_pk_bf16_f32 %0, %1, %2\n\ts_nop 1" : "=v"(r) : "v"(a), "v"(b)); return r; }
DI float bf2f(unsigned h) { return __uint_as_float(h << 16); }
DI float sigmoidf_(float x) { return 1.f / (1.f + __expf(-x)); }
DI float logsigmoidf_(float x) { return fminf(x, 0.f) - log1pf(__expf(-fabsf(x))); }
DI int mod_index(int tok) { return tok < NCTX ? 0 : 1 + ((tok - NCTX) >> 10); }
DI int tid_() { int t = threadIdx.x; asm volatile("" : "+v"(t)); return t; }
DI int bid_() { int b = blockIdx.x; asm volatile("" : "+s"(b)); return b; }
DI int vblock() { return bid_(); }

DI void tile_decode(int t, int MT, int NT, int& mt, int& nt) {
  const int per_sc = MT * 8;
  const int sc = t / per_sc;
  const int w = t - sc * per_sc;
  int ncols = NT - sc * 8; ncols = ncols > 8 ? 8 : ncols;
  const int per_sr = 8 * ncols;
  const int sr = w / per_sr;
  const int j = w - sr * per_sr;
  mt = sr * 8 + (j & 7);
  nt = sc * 8 + (j >> 3);
}

template <bool KSCALE>
DI void gemm_mainloop(f32x16 (&acc)[2][2], const bf16_t* __restrict__ A, int lda, const bf16_t* __restrict__ B, int ldb, int K,
                      const float* __restrict__ kscale, unsigned char* smem) {
  const int tid = tid_(), lane = tid & 63, wave = tid >> 6;
  const int wm = wave >> 1, wn = wave & 1, r = lane & 31, h = lane >> 5;
  const int lrow = tid >> 3, lkc = tid & 7;
  const bf16_t* ga = A + (size_t)lrow * lda + lkc * 8;
  const bf16_t* gb = B + (size_t)lrow * ldb + lkc * 8;
  u32x4 a0[4], b0[4], a1[4], b1[4];
  const int KT = K >> 6;
#define GL(sa_, sb_, k0)                                                                            \
  {                                                                                                 \
    _Pragma("unroll") for (int i = 0; i < 4; ++i) {                                                 \
      sa_[i] = gld16(ga + (size_t)(32 * i) * lda + (k0));                                           \
      sb_[i] = gld16(gb + (size_t)(32 * i) * ldb + (k0));                                           \
    }                                                                                               \
  }
#define GW8(sa_, sb_) asm volatile("s_waitcnt vmcnt(8)" : "+v"(sa_[0]), "+v"(sa_[1]), "+v"(sa_[2]), "+v"(sa_[3]), "+v"(sb_[0]), "+v"(sb_[1]), "+v"(sb_[2]), "+v"(sb_[3]) : : "memory")
#define GW0(sa_, sb_) asm volatile("s_waitcnt vmcnt(0)" : "+v"(sa_[0]), "+v"(sa_[1]), "+v"(sa_[2]), "+v"(sa_[3]), "+v"(sb_[0]), "+v"(sb_[1]), "+v"(sb_[2]), "+v"(sb_[3]) : : "memory")
#define ST(sa_, sb_, buf, k0)                                                                       \
  {                                                                                                 \
    if (KSCALE) {                                                                                   \
      const float4 s0 = *(const float4*)(kscale + (k0) + lkc * 8);                                  \
      const float4 s1 = *(const float4*)(kscale + (k0) + lkc * 8 + 4);                              \
      _Pragma("unroll") for (int i = 0; i < 4; ++i) {                                               \
        u32x4 v = sb_[i];                                                                           \
        v.x = pack2(bf2f(v.x & 0xffffu) * s0.x, bf2f(v.x >> 16) * s0.y);                            \
        v.y = pack2(bf2f(v.y & 0xffffu) * s0.z, bf2f(v.y >> 16) * s0.w);                            \
        v.z = pack2(bf2f(v.z & 0xffffu) * s1.x, bf2f(v.z >> 16) * s1.y);                            \
        v.w = pack2(bf2f(v.w & 0xffffu) * s1.z, bf2f(v.w >> 16) * s1.w);                            \
        sb_[i] = v;                                                                                 \
      }                                                                                             \
    }                                                                                               \
    unsigned char* sa__ = smem + (buf) * 36864;                                                     \
    unsigned char* sb__ = sa__ + 18432;                                                             \
    _Pragma("unroll") for (int i = 0; i < 4; ++i) {                                                 \
      *(u32x4*)(sa__ + (lrow + 32 * i) * 144 + lkc * 16) = sa_[i];                                  \
      *(u32x4*)(sb__ + (lrow + 32 * i) * 144 + lkc * 16) = sb_[i];                                  \
    }                                                                                               \
  }
#define COMPUTE(buf)                                                                                                          \
  {                                                                                                                           \
    const unsigned char* sa = smem + (buf) * 36864;                                                                           \
    const unsigned char* sb = sa + 18432;                                                                                     \
    _Pragma("unroll") for (int ks = 0; ks < 4; ++ks) {                                                                        \
      bf16x8 af[2], bfr[2];                                                                                                   \
      _Pragma("unroll") for (int mt = 0; mt < 2; ++mt) af[mt] = *(const bf16x8*)(sa + (wm * 64 + mt * 32 + r) * 144 + ks * 32 + h * 16);  \
      _Pragma("unroll") for (int nt = 0; nt < 2; ++nt) bfr[nt] = *(const bf16x8*)(sb + (wn * 64 + nt * 32 + r) * 144 + ks * 32 + h * 16); \
      _Pragma("unroll") for (int mt = 0; mt < 2; ++mt)                                                                        \
        _Pragma("unroll") for (int nt = 0; nt < 2; ++nt) acc[mt][nt] = MFMA32(af[mt], bfr[nt], acc[mt][nt]);                  \
    }                                                                                                                         \
  }
  GL(a0, b0, 0);
  GL(a1, b1, 64);
  GW8(a0, b0);
  ST(a0, b0, 0, 0);
  __syncthreads();
  for (int kt = 0; kt < KT; kt += 2) {
    { const int kn = kt + 2 < KT ? kt + 2 : KT - 1; GL(a0, b0, kn * 64); }
    COMPUTE(0);
    GW8(a1, b1);
    ST(a1, b1, 1, (kt + 1) * 64);
    __syncthreads();
    { const int kn = kt + 3 < KT ? kt + 3 : KT - 1; GL(a1, b1, kn * 64); }
    COMPUTE(1);
    GW8(a0, b0);
    { const int kn = kt + 2 < KT ? kt + 2 : KT - 1; ST(a0, b0, 0, kn * 64); }
    __syncthreads();
  }
  GW0(a1, b1);
#undef GL
#undef GW8
#undef GW0
#undef ST
#undef COMPUTE
}

DI void gemm192_mainloop(f32x16 (&acc)[3][2], const bf16_t* __restrict__ A, int lda, const bf16_t* __restrict__ B, int ldb, int K,
                         unsigned char* smem) {
  const int tid = tid_(), lane = tid & 63, wave = tid >> 6;
  const int wm = wave >> 1, wn = wave & 1, r = lane & 31, h = lane >> 5;
  const int lrow = tid >> 3, lkc = tid & 7;
  const bf16_t* ga = A + (size_t)lrow * lda + lkc * 8;
  const bf16_t* gb = B + (size_t)lrow * ldb + lkc * 8;
  u32x4 a0[6], b0[4], a1[6], b1[4];
  const int KT = K >> 6;
#define GL(sa_, sb_, k0)                                                                            \
  {                                                                                                 \
    _Pragma("unroll") for (int i = 0; i < 6; ++i) sa_[i] = gld16(ga + (size_t)(32 * i) * lda + (k0));  \
    _Pragma("unroll") for (int i = 0; i < 4; ++i) sb_[i] = gld16(gb + (size_t)(32 * i) * ldb + (k0));  \
  }
#define GW10(sa_, sb_) asm volatile("s_waitcnt vmcnt(10)" : "+v"(sa_[0]), "+v"(sa_[1]), "+v"(sa_[2]), "+v"(sa_[3]), "+v"(sa_[4]), "+v"(sa_[5]), "+v"(sb_[0]), "+v"(sb_[1]), "+v"(sb_[2]), "+v"(sb_[3]) : : "memory")
#define GW0(sa_, sb_) asm volatile("s_waitcnt vmcnt(0)" : "+v"(sa_[0]), "+v"(sa_[1]), "+v"(sa_[2]), "+v"(sa_[3]), "+v"(sa_[4]), "+v"(sa_[5]), "+v"(sb_[0]), "+v"(sb_[1]), "+v"(sb_[2]), "+v"(sb_[3]) : : "memory")
#define ST(sa_, sb_)                                                                                \
  {                                                                                                 \
    unsigned char* sa__ = smem;                                                                     \
    unsigned char* sb__ = smem + 27648;                                                             \
    _Pragma("unroll") for (int i = 0; i < 6; ++i) *(u32x4*)(sa__ + (lrow + 32 * i) * 144 + lkc * 16) = sa_[i];  \
    _Pragma("unroll") for (int i = 0; i < 4; ++i) *(u32x4*)(sb__ + (lrow + 32 * i) * 144 + lkc * 16) = sb_[i];  \
  }
#define COMPUTE()                                                                                                             \
  {                                                                                                                           \
    const unsigned char* sa = smem;                                                                                           \
    const unsigned char* sb = smem + 27648;                                                                                   \
    _Pragma("unroll") for (int ks = 0; ks < 4; ++ks) {                                                                        \
      bf16x8 af[3], bfr[2];                                                                                                   \
      _Pragma("unroll") for (int mt = 0; mt < 3; ++mt) af[mt] = *(const bf16x8*)(sa + (wm * 96 + mt * 32 + r) * 144 + ks * 32 + h * 16);  \
      _Pragma("unroll") for (int nt = 0; nt < 2; ++nt) bfr[nt] = *(const bf16x8*)(sb + (wn * 64 + nt * 32 + r) * 144 + ks * 32 + h * 16); \
      _Pragma("unroll") for (int mt = 0; mt < 3; ++mt)                                                                        \
        _Pragma("unroll") for (int nt = 0; nt < 2; ++nt) acc[mt][nt] = MFMA32(af[mt], bfr[nt], acc[mt][nt]);                  \
    }                                                                                                                         \
  }
  GL(a0, b0, 0);
  GL(a1, b1, 64);
  GW10(a0, b0);
  ST(a0, b0);
  __syncthreads();
  for (int kt = 0; kt < KT; kt += 2) {
    { const int kn = kt + 2 < KT ? kt + 2 : KT - 1; GL(a0, b0, kn * 64); }
    COMPUTE();
    GW10(a1, b1);
    __syncthreads();
    ST(a1, b1);
    __syncthreads();
    { const int kn = kt + 3 < KT ? kt + 3 : KT - 1; GL(a1, b1, kn * 64); }
    COMPUTE();
    GW10(a0, b0);
    __syncthreads();
    ST(a0, b0);
    __syncthreads();
  }
  GW0(a1, b1);
#undef GL
#undef GW10
#undef GW0
#undef ST
#undef COMPUTE
}
DI void acc_zero3(f32x16 (&acc)[3][2]) {
#pragma unroll
  for (int a = 0; a < 3; ++a)
#pragma unroll
    for (int b = 0; b < 2; ++b)
#pragma unroll
      for (int i = 0; i < 16; ++i) acc[a][b][i] = 0.f;
}
#define RW3(mt, i) (wm_ * 96 + (mt) * 32 + ((i) & 3) + 8 * ((i) >> 2) + 4 * hh_)

DI void acc_zero(f32x16 (&acc)[2][2]) {
#pragma unroll
  for (int a = 0; a < 2; ++a)
#pragma unroll
    for (int b = 0; b < 2; ++b)
#pragma unroll
      for (int i = 0; i < 16; ++i) acc[a][b][i] = 0.f;
}

#define EPI_VARS const int tid_e_ = tid_(), lane_ = tid_e_ & 63, wave_ = tid_e_ >> 6, wm_ = wave_ >> 1, wn_ = wave_ & 1, rr_ = lane_ & 31, hh_ = lane_ >> 5
#define RW(mt, i) (wm_ * 64 + (mt) * 32 + ((i) & 3) + 8 * ((i) >> 2) + 4 * hh_)
#define CL(nt) (wn_ * 64 + (nt) * 32 + rr_)

template <int MODE>
DI void store_tile_bf16(const f32x16 (&acc)[2][2], bf16_t* __restrict__ dst, int ld, unsigned char* smem) {
  EPI_VARS;
#pragma unroll
  for (int mt = 0; mt < 2; ++mt)
#pragma unroll
    for (int nt = 0; nt < 2; ++nt)
#pragma unroll
      for (int i = 0; i < 16; ++i) {
        float v = acc[mt][nt][i];
        if (MODE == 1) v = sigmoidf_(v);
        *(unsigned short*)(smem + RW(mt, i) * 272 + CL(nt) * 2) = (unsigned short)f2bf(v);
      }
  __syncthreads();
#pragma unroll
  for (int i = 0; i < 8; ++i) {
    const int row = (tid_e_ >> 4) + 16 * i, ch = tid_e_ & 15;
    const u32x4 x = *(const u32x4*)(smem + row * 272 + ch * 16);
    *(u32x4*)(dst + (size_t)row * ld + ch * 8) = x;
  }
  __syncthreads();
}

DI void convert_tile(const float* __restrict__ src, int nsrc, int K, bf16_t* __restrict__ dst, int kt, int ntile, int maptype, unsigned char* smem) {
  float* tile = (float*)smem;
  const int tid = tid_(), tx4 = (tid & 15) * 4, ty = tid >> 4;
  const int np = ntile * 64 + tx4;
  int sc;
  if (maptype == 0) sc = np;
  else if (maptype == 1) sc = np < 6144 ? np : (np < 9216 ? np + 16 : (np < 9232 ? 6144 + (np - 9216) : -1));
  else { const int g = np >> 6, w = np & 63; sc = w < 32 ? g * 32 + w : 2816 + g * 32 + (w - 32); }
  __syncthreads();
#pragma unroll
  for (int i = 0; i < 4; ++i) {
    const int ky = ty + 16 * i;
    float4 v = make_float4(0.f, 0.f, 0.f, 0.f);
    if (sc >= 0) v = *(const float4*)(src + (size_t)(kt * 64 + ky) * nsrc + sc);
    tile[ky * 65 + tx4] = v.x; tile[ky * 65 + tx4 + 1] = v.y; tile[ky * 65 + tx4 + 2] = v.z; tile[ky * 65 + tx4 + 3] = v.w;
  }
  __syncthreads();
#pragma unroll
  for (int i = 0; i < 2; ++i) {
    const int id = tid + 256 * i, nrow = id >> 3, kc = id & 7;
    uint4 v;
    v.x = pack2(tile[(kc * 8 + 0) * 65 + nrow], tile[(kc * 8 + 1) * 65 + nrow]);
    v.y = pack2(tile[(kc * 8 + 2) * 65 + nrow], tile[(kc * 8 + 3) * 65 + nrow]);
    v.z = pack2(tile[(kc * 8 + 4) * 65 + nrow], tile[(kc * 8 + 5) * 65 + nrow]);
    v.w = pack2(tile[(kc * 8 + 6) * 65 + nrow], tile[(kc * 8 + 7) * 65 + nrow]);
    *(uint4*)(dst + (size_t)(ntile * 64 + nrow) * K + kt * 64 + kc * 8) = v;
  }
}

DI void convert_layer(const Params& P, int l, unsigned char* smem) {
  unsigned char* slot = P.ws + (size_t)(l & 1) * SZ_SLOT;
  constexpr int T0 = 146 * 16, T1 = T0 + 16 * 32, T2 = T1 + 16 * 16, T3 = T2 + 16 * 16, T4 = T3 + 88 * 16, T5 = T4 + 16 * 44;
  for (int it = bid_(); it < T5; it += gridDim.x) {
    if (it < T0) convert_tile(P.w_in + (size_t)l * 1024 * 9232, 9232, 1024, (bf16_t*)(slot + WS_WIN), it & 15, it >> 4, 1, smem);
    else if (it < T1) { const int j = it - T0; convert_tile(P.w_a + (size_t)l * 2048 * 1024, 1024, 2048, (bf16_t*)(slot + WS_WA), j & 31, j >> 5, 0, smem); }
    else if (it < T2) { const int j = it - T1; convert_tile(P.w_b + (size_t)l * 1024 * 1024, 1024, 1024, (bf16_t*)(slot + WS_WB), j & 15, j >> 4, 0, smem); }
    else if (it < T3) { const int j = it - T2; convert_tile(P.w_out + (size_t)l * 1024 * 1024, 1024, 1024, (bf16_t*)(slot + WS_WO), j & 15, j >> 4, 0, smem); }
    else if (it < T4) { const int j = it - T3; convert_tile(P.w_f1 + (size_t)l * 1024 * 5632, 5632, 1024, (bf16_t*)(slot + WS_WF1), j & 15, j >> 4, 2, smem); }
    else { const int j = it - T4; convert_tile(P.w_f2 + (size_t)l * 2816 * 1024, 1024, 2816, (bf16_t*)(slot + WS_WF2), j % 44, j / 44, 0, smem); }
  }
}

DI void phase_setup(const Params& P, unsigned char* smem) {
  const int tid = tid_();
  convert_layer(P, 0, smem);
  {
    bf16_t* BC = (bf16_t*)(P.ws + OFF_BC);
    bf16_t* A256 = (bf16_t*)(P.ws + OFF_A256);
    bf16_t* A1024 = (bf16_t*)(P.ws + OFF_A1024);
    const int total = 131072 + 131072 + 2097152;
    for (int e = bid_() * 256 + tid; e < total; e += gridDim.x * 256) {
      if (e < 131072) {
        const int n = e >> 8, k = e & 255, cs = n >> 8, ch = n & 255;
        const float ph = (float)((ch * k) & 255) * (1.f / 128.f);
        BC[e] = (bf16_t)f2bf(cs ? sinpif(ph) : cospif(ph));
      } else if (e < 262144) {
        const int e2 = e - 131072, m = e2 >> 9, k = e2 & 511, cs = k >> 8, p = k & 255;
        const float ph = (float)((m * p) & 255) * (1.f / 128.f);
        A256[e2] = (bf16_t)f2bf(cs ? -sinpif(ph) : cospif(ph));
      } else {
        const int e2 = e - 262144, m = e2 >> 11, k = e2 & 2047, cs = k >> 10, p = k & 1023;
        const int r1 = m >> 6, c1 = m & 63, r2 = p >> 6, c2 = p & 63;
        const float ph = (float)((4 * r1 * r2 + c1 * c2) & 63) * (1.f / 32.f);
        A1024[e2] = (bf16_t)f2bf(cs ? -sinpif(ph) : cospif(ph));
      }
    }
  }
  {
    float4* X = (float4*)(P.ws + OFF_XRES);
    const float4* xp = (const float4*)P.x_prompt;
    const float4* xs = (const float4*)P.x_sample;
    const int n4p = NCTX * 256, n4 = NTOK * 256;
    for (int e = bid_() * 256 + tid; e < n4; e += gridDim.x * 256) X[e] = e < n4p ? xp[e] : xs[e - n4p];
  }
  {
    float* MODP = (float*)(P.ws + OFF_MODP);
    float* red = (float*)smem;
    const int lane = tid & 63, w = tid >> 6;
    for (int it = bid_(); it < 8 * 4 * 24; it += gridDim.x) {
      const int nc = it % 24, l = (it / 24) & 3, ks = it / 96;
      float4 a[9];
#pragma unroll
      for (int j = 0; j < 9; ++j) a[j] = make_float4(0.f, 0.f, 0.f, 0.f);
      const int kb = ks * 128 + w * 32;
      const float* wp = P.w_mod + ((size_t)l * 1024 + kb) * 6144 + nc * 256 + lane * 4;
      for (int k = 0; k < 32; ++k) {
        const float4 wv = *(const float4*)(wp + (size_t)k * 6144);
#pragma unroll
        for (int j = 0; j < 9; ++j) {
          float cv = j == 0 ? P.c_ctx[kb + k] : P.c[(j - 1) * 1024 + kb + k];
          cv = cv * sigmoidf_(cv);
          a[j].x += cv * wv.x; a[j].y += cv * wv.y; a[j].z += cv * wv.z; a[j].w += cv * wv.w;
        }
      }
      __syncthreads();
#pragma unroll
      for (int j = 0; j < 9; ++j) *(float4*)(red + (w * 9 + j) * 256 + lane * 4) = a[j];
      __syncthreads();
      for (int e = tid; e < 9 * 256; e += 256) {
        const int j = e >> 8, n = e & 255;
        const float s = red[(0 * 9 + j) * 256 + n] + red[(1 * 9 + j) * 256 + n] + red[(2 * 9 + j) * 256 + n] + red[(3 * 9 + j) * 256 + n];
        MODP[((size_t)(ks * 4 + l) * 9 + j) * 6144 + nc * 256 + n] = s;
      }
    }
  }
}

DI void phase_modreduce(const Params& P) {
  const float* MODP = (const float*)(P.ws + OFF_MODP);
  float* MOD = (float*)(P.ws + OFF_MOD);
  const int total = 4 * 9 * 6144;
  for (int e = bid_() * 256 + tid_(); e < total; e += gridDim.x * 256) {
    const int n = e % 6144, l = e / (9 * 6144);
    float s = P.b_mod[l * 6144 + n];
#pragma unroll
    for (int ks = 0; ks < 8; ++ks) s += MODP[(size_t)ks * total + e];
    MOD[e] = s;
  }
}

DI void phase_modulate0(const Params& P) {
  const float* MOD = (const float*)(P.ws + OFF_MOD);
  const float4* X = (const float4*)(P.ws + OFF_XRES);
  uint2* H = (uint2*)(P.ws + OFF_HMOD);
  for (int e = bid_() * 256 + tid_(); e < NTOK * 256; e += gridDim.x * 256) {
    const int tok = e >> 8, n = (e & 255) * 4;
    const float* m = MOD + (size_t)mod_index(tok) * 6144;
    const float4 x = X[e];
    const float4 sh = *(const float4*)(m + n), sc = *(const float4*)(m + 1024 + n);
    uint2 o;
    o.x = pack2(x.x * (1.f + sc.x) + sh.x, x.y * (1.f + sc.y) + sh.y);
    o.y = pack2(x.z * (1.f + sc.z) + sh.z, x.w * (1.f + sc.w) + sh.w);
    H[e] = o;
  }
}

DI void phase_gemm_in(const Params& P, int l, unsigned char* smem) {
  const bf16_t* H = (const bf16_t*)(P.ws + OFF_HMOD);
  const bf16_t* W = (const bf16_t*)(P.ws + (size_t)(l & 1) * SZ_SLOT + WS_WIN);
  bf16_t* Q = (bf16_t*)(P.ws + OFF_Q);
  bf16_t* Kn = (bf16_t*)(P.ws + OFF_K);
  bf16_t* KT = (bf16_t*)(P.ws + OFF_KT);
  bf16_t* VT = (bf16_t*)(P.ws + OFF_VT);
  bf16_t* VTC = (bf16_t*)(P.ws + OFF_VTC);
  bf16_t* OG = (bf16_t*)(P.ws + OFF_OG);
  bf16_t* UF = (bf16_t*)(P.ws + OFF_UF);
  bf16_t* GA = (bf16_t*)(P.ws + OFF_GA);
  bf16_t* GB = (bf16_t*)(P.ws + OFF_GB);
  float* GATES = (float*)(P.ws + OFF_GATES);
  for (int t = vblock(); t < 96 * 73; t += gridDim.x) {
    int mtile, ntile;
    tile_decode(t, 96, 73, mtile, ntile);
    const int m0 = mtile * 128, n0 = ntile * 128;
    f32x16 acc[2][2];
    acc_zero(acc);
    gemm_mainloop<false>(acc, H + (size_t)m0 * 1024, 1024, W + (size_t)n0 * 1024, 1024, 1024, nullptr, smem);
    EPI_VARS;
    if (ntile < 8 || (ntile >= 32 && ntile < 72)) {
      bf16_t* dst; int ld, cb; bool sg;
      if (ntile < 8) { dst = Q; ld = 1024; cb = n0; sg = false; }
      else if (ntile < 48) { dst = OG; ld = 2048; cb = n0 - 4096; sg = true; }
      else if (ntile < 56) { dst = UF; ld = 1024; cb = n0 - 6144; sg = false; }
      else if (ntile < 64) { dst = GA; ld = 1024; cb = n0 - 7168; sg = true; }
      else { dst = GB; ld = 1024; cb = n0 - 8192; sg = true; }
      if (sg) store_tile_bf16<1>(acc, dst + (size_t)m0 * ld + cb, ld, smem);
      else store_tile_bf16<0>(acc, dst + (size_t)m0 * ld + cb, ld, smem);
    } else if (ntile < 16) {
      const int cb = n0 - 1024;
#pragma unroll
      for (int mt = 0; mt < 2; ++mt)
#pragma unroll
        for (int nt = 0; nt < 2; ++nt) {
#pragma unroll
          for (int i = 0; i < 16; ++i) { const int tk = m0 + RW(mt, i), kc2 = cb + CL(nt); Kn[((size_t)(tk >> 5) * 4 + (kc2 >> 8)) * 8192 + (tk & 31) * 256 + (kc2 & 255)] = (bf16_t)f2bf(acc[mt][nt][i] * 0.0625f); }
          if (m0 < NCTX) {
            const int kc = cb + CL(nt), hd = kc >> 8, d = kc & 255;
#pragma unroll
            for (int i4 = 0; i4 < 4; ++i4) {
              const int tok0 = m0 + RW(mt, 4 * i4), b = tok0 >> 8, s = tok0 & 255;
              uint2 v;
              v.x = pack2(acc[mt][nt][4 * i4] * 0.0625f, acc[mt][nt][4 * i4 + 1] * 0.0625f);
              v.y = pack2(acc[mt][nt][4 * i4 + 2] * 0.0625f, acc[mt][nt][4 * i4 + 3] * 0.0625f);
              *(uint2*)(KT + ((size_t)((b * 4 + hd) * 256 + d)) * 256 + s) = v;
            }
          }
        }
    } else if (ntile < 32) {
      const int cb = n0 - 2048;
#pragma unroll
      for (int mt = 0; mt < 2; ++mt)
#pragma unroll
        for (int nt = 0; nt < 2; ++nt) {
          const int vc = cb + CL(nt);
#pragma unroll
          for (int i4 = 0; i4 < 4; ++i4) {
            const int tok0 = m0 + RW(mt, 4 * i4);
            uint2 v;
            v.x = pack2(acc[mt][nt][4 * i4], acc[mt][nt][4 * i4 + 1]);
            v.y = pack2(acc[mt][nt][4 * i4 + 2], acc[mt][nt][4 * i4 + 3]);
            { const int cq = (tok0 & 31) >> 2; *(uint2*)(VT + ((size_t)(tok0 >> 5) * 2048 + vc) * 32 + (((cq & 3) * 2 + (cq >> 2)) * 4)) = v; }
            if (tok0 < NCTX) *(uint2*)(VTC + ((size_t)(tok0 >> 8) * 2048 + vc) * 256 + (tok0 & 255)) = v;
          }
        }
    } else {
      if (wn_ == 0 && rr_ < 16) {
        const int g = rr_;
        const float bg = P.b_gate[l * 16 + g];
        const bool isf = (g >> 2) & 1;
#pragma unroll
        for (int mt = 0; mt < 2; ++mt)
#pragma unroll
          for (int i = 0; i < 16; ++i) {
            float v = acc[mt][0][i] + bg;
            if (isf) v = logsigmoidf_(v);
            GATES[(size_t)(m0 + RW(mt, i)) * 16 + g] = v;
          }
      }
    }
  }
}

DI float wave_excl_sum(float v, int lane) {
  float x = v;
#pragma unroll
  for (int o = 1; o < 64; o <<= 1) { const float y = __shfl_up(x, o, 64); if (lane >= o) x += y; }
  return x - v;
}
DI float wave_excl_max(float v, int lane, float init) {
  float x = v;
#pragma unroll
  for (int o = 1; o < 64; o <<= 1) { const float y = __shfl_up(x, o, 64); if (lane >= o) x = fmaxf(x, y); }
  const float p = __shfl_up(x, 1, 64);
  return lane == 0 ? init : fmaxf(init, p);
}

template <int E>
DI void scan_wave(const Params& P, int l, int sid) {
  const int lane = tid_() & 63;
  const int dir = sid & 1, hd = (sid >> 1) & 3, seq = sid >> 3;
  const bool lat = seq >= 16;
  const int S = E * 64;
  const int tok0 = lat ? NCTX + (seq - 16) * 1024 : seq * 256;
  const float* G = (const float*)(P.ws + OFF_GATES);
  const size_t gi = (size_t)(dir * 4 + hd) * NTOK;
  float* BETA = (float*)(P.ws + OFF_BETA) + gi;
  float* MM = (float*)(P.ws + OFF_MM) + gi;
  float* EMT = (float*)(P.ws + OFF_EMT) + gi;
  float* WFIN = (float*)(P.ws + OFF_WFIN) + gi;
  const int gi_i = dir * 8 + hd, gi_f = dir * 8 + 4 + hd;
  const float m0 = lat ? P.state_m[(((seq - 16) * 4 + l) * 2 + dir) * 4 + hd] : 0.f;
  float tot = 0.f;
#pragma unroll
  for (int e = 0; e < E; ++e) {
    const int j = lane * E + e, tok = dir == 0 ? tok0 + j : tok0 + S - 1 - j;
    tot += G[(size_t)tok * 16 + gi_f];
  }
  const float boff = wave_excl_sum(tot, lane);
  float b = boff, cmax = -3.0e38f;
#pragma unroll
  for (int e = 0; e < E; ++e) {
    const int j = lane * E + e, tok = dir == 0 ? tok0 + j : tok0 + S - 1 - j;
    b += G[(size_t)tok * 16 + gi_f];
    const float be = G[(size_t)tok * 16 + gi_i] - b;
    BETA[tok] = be;
    cmax = fmaxf(cmax, be);
  }
  float M = wave_excl_max(cmax, lane, m0);
  b = boff;
#pragma unroll
  for (int e = 0; e < E; ++e) {
    const int j = lane * E + e, tok = dir == 0 ? tok0 + j : tok0 + S - 1 - j;
    b += G[(size_t)tok * 16 + gi_f];
    const float be = G[(size_t)tok * 16 + gi_i] - b;
    M = fmaxf(M, be);
    MM[tok] = M;
    EMT[tok] = __expf(-b - M);
  }
  if (!lat) {
    const float Mlast = __shfl(M, 63, 64);
    const float Blast = __shfl(b, 63, 64);
    if (lane == 0) P.out[OUT_NEWM + (((seq * 4 + l) * 2 + dir) * 4 + hd)] = Blast + Mlast;
    b = boff;
  #pragma unroll
  for (int e = 0; e < E; ++e) {
      const int j = lane * E + e, tok = dir == 0 ? tok0 + j : tok0 + S - 1 - j;
      b += G[(size_t)tok * 16 + gi_f];
      const float be = G[(size_t)tok * 16 + gi_i] - b;
      WFIN[tok] = __expf(be - Mlast);
    }
  }
}

DI void convert_c0(const Params& P, int l) {
  bf16_t* C0T = (bf16_t*)(P.ws + OFF_C0T);
  const int total = 64 * 512 * 32;
  for (int e = bid_() * 256 + tid_(); e < total; e += gridDim.x * 256) {
    const int j = e & 31, v = (e >> 5) & 511, sp = e >> 14;
    const int b = sp >> 3, dir = (sp >> 2) & 1, hd = sp & 3;
    const float* src = P.state_C + ((size_t)((((b * 4 + l) * 2 + dir) * 4 + hd) * 512 + v)) * 256 + j * 8;
    const float4 x0 = *(const float4*)src, x1 = *(const float4*)(src + 4);
    uint4 o;
    o.x = pack2(x0.x, x0.y); o.y = pack2(x0.z, x0.w); o.z = pack2(x1.x, x1.y); o.w = pack2(x1.z, x1.w);
    *(uint4*)(C0T + ((size_t)((sp * 2 + (v >> 8)) * 8 + (j >> 2)) * 256 + (v & 255)) * 32 + (j & 3) * 8) = o;
  }
}

DI void phase_scan_four1(const Params& P, int l, unsigned char* smem) {
  convert_c0(P, l);
  const bf16_t* UF = (const bf16_t*)(P.ws + OFF_UF);
  const bf16_t* BC = (const bf16_t*)(P.ws + OFF_BC);
  bf16_t* TT = (bf16_t*)(P.ws + OFF_TT);
  for (int it = bid_(); it < 48 + 1536; it += gridDim.x) {
    if (it < 48) { const int sid = it * 4 + (tid_() >> 6); if (sid < 128) scan_wave<4>(P, l, sid); else scan_wave<16>(P, l, sid); continue; }
    const int t = it - 48, g = t / 384, rem = t - g * 384;
    int mtile, ntile;
    tile_decode(rem, 96, 4, mtile, ntile);
    const int m0 = mtile * 128, n0 = ntile * 128;
    f32x16 acc[2][2];
    acc_zero(acc);
    gemm_mainloop<false>(acc, UF + (size_t)m0 * 1024 + g * 256, 1024, BC + (size_t)n0 * 256, 256, 256, nullptr, smem);
    EPI_VARS;
#pragma unroll
    for (int mt = 0; mt < 2; ++mt)
#pragma unroll
      for (int nt = 0; nt < 2; ++nt) {
        const int n = n0 + CL(nt), cs = n >> 8, ch = n & 255;
#pragma unroll
        for (int i4 = 0; i4 < 4; ++i4) {
          const int tok0 = m0 + RW(mt, 4 * i4);
          uint2 v;
          v.x = pack2(acc[mt][nt][4 * i4], acc[mt][nt][4 * i4 + 1]);
          v.y = pack2(acc[mt][nt][4 * i4 + 2], acc[mt][nt][4 * i4 + 3]);
          size_t idx;
          if (tok0 < NCTX) idx = ((size_t)(((tok0 >> 8) * 4 + g) * 256 + ch)) * 512 + cs * 256 + (tok0 & 255);
          else { const int tl = tok0 - NCTX; idx = TT_LAT + ((size_t)(((tl >> 10) * 4 + g) * 256 + ch)) * 2048 + cs * 1024 + (tl & 1023); }
          *(uint2*)(TT + idx) = v;
        }
      }
  }
}

DI void mlstm_item(const Params& P, int l, int seq, int hd, int qb, int vh, unsigned char* smem) {
  const int tid = tid_(), lane = tid & 63, w = tid >> 6, c = lane & 15, q = lane >> 4;
  const bool lat = seq >= 16;
  const int S = lat ? 1024 : 256;
  const int tok0 = lat ? NCTX + (seq - 16) * 1024 : seq * 256;
  const int bl = seq - 16;
  const bf16_t* Qg = (const bf16_t*)(P.ws + OFF_Q);
  const bf16_t* Kg = (const bf16_t*)(P.ws + OFF_K);
  const bf16_t* VT = (const bf16_t*)(P.ws + OFF_VT) + ((size_t)(tok0 >> 5) * 2048 + hd * 512 + vh * 256) * 32;
  unsigned char* sK = smem;
  unsigned char* sV = smem + 16896;
  const int t_loc = qb * 64 + w * 16 + c;
  const int tokq = tok0 + t_loc;
  bf16x8 qf[8];
  {
    const bf16_t* qp = Qg + (size_t)tokq * 1024 + hd * 256 + q * 8;
#pragma unroll
    for (int kk = 0; kk < 8; ++kk) qf[kk] = *(const bf16x8*)(qp + kk * 32);
#pragma unroll
    for (int kk = 0; kk < 8; ++kk) asm volatile("" : "+v"(qf[kk]));
  }
  __syncthreads();
  const int nkb = S >> 5;
  const size_t rowbase = (size_t)(tok0 + qb * 64 + w * 16 + 4 * q) * 2048 + hd * 512 + vh * 256 + c;
  const bf16_t* kld = Kg + ((size_t)(tok0 >> 5) * 4 + hd) * 8192 + tid * 8;
  unsigned char* ksd = sK + (tid >> 5) * 528 + (tid & 31) * 16;
  const bf16_t* vld = VT + tid * 8;
  unsigned char* vsd = sV + (tid >> 2) * 96 + (tid & 3) * 16;
  u32x4 st[8], bt[2], btn[2];
#define STWAIT() asm volatile("s_waitcnt vmcnt(0)" : "+v"(st[0]), "+v"(st[1]), "+v"(st[2]), "+v"(st[3]), "+v"(st[4]), "+v"(st[5]), "+v"(st[6]), "+v"(st[7]), "+v"(btn[0]), "+v"(btn[1]) : : "memory")
#define ISSUE_KV(kb_)                                                                      \
  {                                                                                        \
    const bf16_t* kp_ = kld + (size_t)(kb_) * 4 * 8192;                                    \
    const bf16_t* vp_ = vld + (size_t)(kb_) * 2048 * 32;                                   \
    _Pragma("unroll") for (int i = 0; i < 4; ++i) st[i] = gld16(kp_ + i * 2048);           \
    _Pragma("unroll") for (int i = 0; i < 4; ++i) st[4 + i] = gld16(vp_ + i * 2048);       \
    btn[0] = gld16(BETA + (kb_) * 32);                                                     \
    btn[1] = gld16(BETA + (kb_) * 32 + 16);                                                \
  }
#define STORE_KV()                                                                         \
  {                                                                                        \
    _Pragma("unroll") for (int i = 0; i < 4; ++i) *(u32x4*)(ksd + i * 8 * 528) = st[i];    \
    _Pragma("unroll") for (int i = 0; i < 4; ++i) *(u32x4*)(vsd + i * 64 * 96) = st[4 + i];\
    bt[0] = btn[0]; bt[1] = btn[1];                                                        \
  }
#define ISSUE_C0(kk_) { _Pragma("unroll") for (int i = 0; i < 4; ++i) st[4 + i] = gld16(C0 + (kk_) * 8192 + i * 2048); }
#define STORE_C0() { _Pragma("unroll") for (int i = 0; i < 4; ++i) *(u32x4*)(vsd + i * 64 * 96) = st[4 + i]; }
#pragma unroll 1
  for (int dir = 0; dir < 2; ++dir) {
    f32x4 acc[16];
#pragma unroll
    for (int n = 0; n < 16; ++n) acc[n] = (f32x4){0.f, 0.f, 0.f, 0.f};
    float den = 0.f;
    const size_t gi = (size_t)(dir * 4 + hd) * NTOK;
    const float* BETA = (const float*)(P.ws + OFF_BETA) + gi + tok0 + 4 * q;
    const float Mt = ((const float*)(P.ws + OFF_MM))[gi + tokq];
    const float emt = ((const float*)(P.ws + OFF_EMT))[gi + tokq];
    const int kb_lo = dir == 0 ? 0 : 2 * qb;
    const int kb_hi = dir == 0 ? 2 * qb + 1 : nkb - 1;
    asm volatile("" : : "v"(Mt), "v"(emt));
    btn[0] = btn[1] = (u32x4){0u, 0u, 0u, 0u};
    st[0] = st[1] = st[2] = st[3] = (u32x4){0u, 0u, 0u, 0u};
    if (lat) {
      const int sidx = ((bl * 4 + l) * 2 + dir) * 4 + hd;
      const float inter = __expf(P.state_m[sidx] - Mt);
      const bf16_t* C0 = (const bf16_t*)(P.ws + OFF_C0T) + ((size_t)(((bl * 2 + dir) * 4 + hd) * 2 + vh) * 8) * 8192 + tid * 8;
      float* sN = (float*)(smem + 71168);
      float sdot = 0.f;
      __syncthreads();
      {
        const float nv = P.state_n[(size_t)sidx * 256 + tid];
        sN[tid] = nv;
      }
      asm volatile("" : : "v"(inter));
      const float* n0p = sN + q * 8;
      ISSUE_C0(0);
      STWAIT();
      STORE_C0();
      __syncthreads();
#pragma unroll
      for (int kk = 0; kk < 8; ++kk) {
        const int kn = kk < 7 ? kk + 1 : 7;
        ISSUE_C0(kn);
        const bf16x8 qk = qf[kk];
#pragma unroll
        for (int e = 0; e < 8; ++e) sdot += bf2f((unsigned)(unsigned short)qk[e]) * n0p[kk * 32 + e];
        {
          bf16x8 fb[2][4];
          const unsigned char* vb_ = sV + c * 96 + q * 16;
#pragma unroll
          for (int j = 0; j < 4; ++j) fb[0][j] = *(const bf16x8*)(vb_ + j * 16 * 96);
#pragma unroll
          for (int g = 0; g < 4; ++g) {
            if (g < 3) {
#pragma unroll
              for (int j = 0; j < 4; ++j) fb[(g + 1) & 1][j] = *(const bf16x8*)(vb_ + ((g + 1) * 4 + j) * 16 * 96);
            }
#pragma unroll
            for (int j = 0; j < 4; ++j) acc[g * 4 + j] = MFMA16(qk, fb[g & 1][j], acc[g * 4 + j]);
            __builtin_amdgcn_sched_barrier(0);
          }
        }
        STWAIT();
        __syncthreads();
        STORE_C0();
        __syncthreads();
      }
      float it_[4];
#pragma unroll
      for (int j = 0; j < 4; ++j) it_[j] = __shfl(inter, 4 * q + j, 64);
#pragma unroll
      for (int n = 0; n < 16; ++n)
#pragma unroll
        for (int j = 0; j < 4; ++j) acc[n][j] *= it_[j];
      den = inter * sdot;
    }
    __syncthreads();
    ISSUE_KV(kb_lo);
    STWAIT();
    STORE_KV();
    __syncthreads();
#pragma unroll 1
    for (int kb = kb_lo; kb <= kb_hi; ++kb) {
      const int kbn = kb < kb_hi ? kb + 1 : kb_hi;
      ISSUE_KV(kbn);
      const float bb0[4] = {__uint_as_float(bt[0].x), __uint_as_float(bt[0].y), __uint_as_float(bt[0].z), __uint_as_float(bt[0].w)};
      const float bb1[4] = {__uint_as_float(bt[1].x), __uint_as_float(bt[1].y), __uint_as_float(bt[1].z), __uint_as_float(bt[1].w)};
      f32x4 x0 = (f32x4){0.f, 0.f, 0.f, 0.f}, x1 = (f32x4){0.f, 0.f, 0.f, 0.f};
      {
        bf16x8 fa0[2], fa1[2];
        const unsigned char* k0_ = sK + c * 528 + q * 16;
        fa0[0] = *(const bf16x8*)(k0_); fa1[0] = *(const bf16x8*)(k0_ + 16 * 528);
#pragma unroll
        for (int kk = 0; kk < 8; ++kk) {
          if (kk < 7) {
            fa0[(kk + 1) & 1] = *(const bf16x8*)(k0_ + (kk + 1) * 64);
            fa1[(kk + 1) & 1] = *(const bf16x8*)(k0_ + 16 * 528 + (kk + 1) * 64);
          }
          x0 = MFMA16(fa0[kk & 1], qf[kk], x0);
          x1 = MFMA16(fa1[kk & 1], qf[kk], x1);
          __builtin_amdgcn_sched_barrier(0);
        }
      }
      float p0[4], p1[4];
      const bool diag = (kb >> 1) == qb;
      if (diag) {
#pragma unroll
        for (int j = 0; j < 4; ++j) {
          const int s0 = kb * 32 + 4 * q + j, s1 = s0 + 16;
          const bool ok0 = dir == 0 ? (s0 <= t_loc) : (s0 >= t_loc);
          const bool ok1 = dir == 0 ? (s1 <= t_loc) : (s1 >= t_loc);
          p0[j] = ok0 ? x0[j] * __expf(bb0[j] - Mt) : 0.f;
          p1[j] = ok1 ? x1[j] * __expf(bb1[j] - Mt) : 0.f;
          den += p0[j] + p1[j];
        }
      } else {
#pragma unroll
        for (int j = 0; j < 4; ++j) {
          p0[j] = x0[j] * __expf(bb0[j] - Mt);
          p1[j] = x1[j] * __expf(bb1[j] - Mt);
          den += p0[j] + p1[j];
        }
      }
      uint4 pu;
      pu.x = pack2(p0[0], p0[1]); pu.y = pack2(p0[2], p0[3]); pu.z = pack2(p1[0], p1[1]); pu.w = pack2(p1[2], p1[3]);
      const bf16x8 pa = __builtin_bit_cast(bf16x8, pu);
      {
        bf16x8 fv[2][4];
        const unsigned char* vb_ = sV + c * 96 + q * 16;
#pragma unroll
        for (int j = 0; j < 4; ++j) fv[0][j] = *(const bf16x8*)(vb_ + j * 16 * 96);
#pragma unroll
        for (int g = 0; g < 4; ++g) {
          if (g < 3) {
#pragma unroll
            for (int j = 0; j < 4; ++j) fv[(g + 1) & 1][j] = *(const bf16x8*)(vb_ + ((g + 1) * 4 + j) * 16 * 96);
          }
#pragma unroll
          for (int j = 0; j < 4; ++j) acc[g * 4 + j] = MFMA16(pa, fv[g & 1][j], acc[g * 4 + j]);
          __builtin_amdgcn_sched_barrier(0);
        }
      }
      STWAIT();
      __syncthreads();
      STORE_KV();
      __syncthreads();
    }
    den += __shfl_xor(den, 16, 64);
    den += __shfl_xor(den, 32, 64);
    const float rinv = 1.f / fmaxf(fabsf(den), emt);
    float rj[4];
#pragma unroll
    for (int j = 0; j < 4; ++j) rj[j] = __shfl(rinv, 4 * q + j, 64);
    bf16_t* HS = (bf16_t*)(P.ws + OFF_H0) + rowbase;
    asm volatile("" : "+v"(HS));
    bf16_t* h0p = HS; bf16_t* h1p = HS + 2048; bf16_t* h2p = HS + 4096; bf16_t* h3p = HS + 6144;
    asm volatile("" : "+v"(h1p));
    asm volatile("" : "+v"(h2p));
    asm volatile("" : "+v"(h3p));
    if (dir == 0) {
#pragma unroll
      for (int n = 0; n < 16; ++n) {
        h0p[n * 16] = (bf16_t)f2bf(acc[n][0] * rj[0]);
        h1p[n * 16] = (bf16_t)f2bf(acc[n][1] * rj[1]);
        h2p[n * 16] = (bf16_t)f2bf(acc[n][2] * rj[2]);
        h3p[n * 16] = (bf16_t)f2bf(acc[n][3] * rj[3]);
      }
    } else {
#pragma unroll
      for (int n = 0; n < 16; ++n) {
        h0p[n * 16] = (bf16_t)f2bf(acc[n][0] * rj[0] + bf2f(h0p[n * 16]));
        h1p[n * 16] = (bf16_t)f2bf(acc[n][1] * rj[1] + bf2f(h1p[n * 16]));
        h2p[n * 16] = (bf16_t)f2bf(acc[n][2] * rj[2] + bf2f(h2p[n * 16]));
        h3p[n * 16] = (bf16_t)f2bf(acc[n][3] * rj[3] + bf2f(h3p[n * 16]));
        if ((n & 3) == 3) __builtin_amdgcn_sched_barrier(0);
      }
    }
  }
}

#undef STWAIT
#undef ISSUE_KV
#undef ISSUE_C0
#undef STORE_KV
#undef STORE_C0

DI void phase_hn(const Params& P, int l) {
  const bf16_t* HS = (const bf16_t*)(P.ws + OFF_H0);
  const bf16_t* OG = (const bf16_t*)(P.ws + OFF_OG);
  bf16_t* HN = (bf16_t*)(P.ws + OFF_HN);
  const int tidl_ = tid_(), lane = tidl_ & 63, w = tidl_ >> 6;
  for (int pr = bid_() * 4 + w; pr < NTOK * 4; pr += gridDim.x * 4) {
    const size_t base = (size_t)pr * 512 + lane * 8;
    const uint4 hv = *(const uint4*)(HS + base);
    const uint4 ov = *(const uint4*)(OG + base);
    const unsigned hu[4] = {hv.x, hv.y, hv.z, hv.w}, ou[4] = {ov.x, ov.y, ov.z, ov.w};
    float x[8];
    float s = 0.f;
#pragma unroll
    for (int i = 0; i < 4; ++i) { x[2 * i] = bf2f(hu[i] & 0xffffu); x[2 * i + 1] = bf2f(hu[i] >> 16); s += x[2 * i] + x[2 * i + 1]; }
#pragma unroll
    for (int o = 1; o < 64; o <<= 1) s += __shfl_xor(s, o, 64);
    const float mu = s * (1.f / 512.f);
    float vs = 0.f;
#pragma unroll
    for (int i = 0; i < 8; ++i) { const float d = x[i] - mu; vs += d * d; }
#pragma unroll
    for (int o = 1; o < 64; o <<= 1) vs += __shfl_xor(vs, o, 64);
    const float rs = rsqrtf(vs * (1.f / 512.f) + LN_EPS);
    const float* gp = P.mh_gain + l * 2048 + (pr & 3) * 512 + lane * 8;
    const float4 g0 = *(const float4*)gp, g1 = *(const float4*)(gp + 4);
    const float g[8] = {g0.x, g0.y, g0.z, g0.w, g1.x, g1.y, g1.z, g1.w};
    unsigned r[4];
#pragma unroll
    for (int i = 0; i < 4; ++i)
      r[i] = pack2((x[2 * i] - mu) * rs * g[2 * i] * bf2f(ou[i] & 0xffffu), (x[2 * i + 1] - mu) * rs * g[2 * i + 1] * bf2f(ou[i] >> 16));
    *(uint4*)(HN + base) = make_uint4(r[0], r[1], r[2], r[3]);
  }
}

DI void phase_mixers(const Params& P, int l, unsigned char* smem) {
  const bf16_t* VTC = (const bf16_t*)(P.ws + OFF_VTC);
  const bf16_t* KT = (const bf16_t*)(P.ws + OFF_KT);
  const bf16_t* Kn = (const bf16_t*)(P.ws + OFF_K);
  const bf16_t* TT = (const bf16_t*)(P.ws + OFF_TT);
  const bf16_t* A256 = (const bf16_t*)(P.ws + OFF_A256);
  const bf16_t* A1024 = (const bf16_t*)(P.ws + OFF_A1024);
  const float* WFIN = (const float*)(P.ws + OFF_WFIN);
  bf16_t* FB = (bf16_t*)(P.ws + OFF_FB);
  for (int it0 = bid_(); it0 < 1024 + 2304; it0 += gridDim.x) {
    if (it0 < 1024) { mlstm_item(P, l, 16 + (it0 >> 7), (it0 >> 5) & 3, (it0 >> 1) & 15, it0 & 1, smem); continue; }
    const int r = it0 - 1024;
    if (r >= 512 && r < 1024) { const int j = r - 512; mlstm_item(P, l, j >> 5, (j >> 3) & 3, (j >> 1) & 3, j & 1, smem); continue; }
    f32x16 acc[2][2];
    acc_zero(acc);
    if (r < 512) {
      const int j = r, sg = j >> 4, mtile = (j >> 1) & 7, ntile = j & 1;
      gemm_mainloop<false>(acc, A1024 + (size_t)mtile * 128 * 2048, 2048, TT + TT_LAT + ((size_t)sg * 256 + ntile * 128) * 2048, 2048, 2048, nullptr, smem);
      EPI_VARS;
      const int seq = sg >> 2, g = sg & 3;
#pragma unroll
      for (int mt = 0; mt < 2; ++mt)
#pragma unroll
        for (int nt = 0; nt < 2; ++nt)
#pragma unroll
          for (int i = 0; i < 16; ++i)
            FB[(size_t)(NCTX + seq * 1024 + mtile * 128 + RW(mt, i)) * 1024 + g * 256 + ntile * 128 + CL(nt)] = (bf16_t)f2bf(acc[mt][nt][i] * (1.f / 512.f));
    } else if (r >= 2048) {
      const int j = r - 2048, sg = j >> 2, mtile = (j >> 1) & 1, ntile = j & 1;
      gemm_mainloop<false>(acc, A256 + (size_t)mtile * 128 * 512, 512, TT + ((size_t)sg * 256 + ntile * 128) * 512, 512, 512, nullptr, smem);
      EPI_VARS;
      const int seq = sg >> 2, g = sg & 3;
#pragma unroll
      for (int mt = 0; mt < 2; ++mt)
#pragma unroll
        for (int nt = 0; nt < 2; ++nt)
#pragma unroll
          for (int i = 0; i < 16; ++i)
            FB[(size_t)(seq * 256 + mtile * 128 + RW(mt, i)) * 1024 + g * 256 + ntile * 128 + CL(nt)] = (bf16_t)f2bf(acc[mt][nt][i] * (1.f / 256.f));
    } else {
      const int j = r - 1024, bhd = j >> 3, mtile = (j >> 1) & 3, ntile = j & 1;
      const int b = bhd >> 3, hd = (bhd >> 1) & 3, dir = bhd & 1;
      const float* wf = WFIN + (size_t)(dir * 4 + hd) * NTOK + b * 256;
      gemm_mainloop<true>(acc, VTC + ((size_t)b * 2048 + hd * 512 + mtile * 128) * 256, 256, KT + ((size_t)(b * 4 + hd) * 256 + ntile * 128) * 256, 256, 256, wf, smem);
      EPI_VARS;
      const size_t sidx = (size_t)(((b * 4 + l) * 2 + dir) * 4 + hd);
      float* Co = P.out + OUT_NEWC + sidx * 512 * 256;
#pragma unroll
      for (int mt = 0; mt < 2; ++mt)
#pragma unroll
        for (int nt = 0; nt < 2; ++nt)
#pragma unroll
          for (int i = 0; i < 16; ++i) Co[(size_t)(mtile * 128 + RW(mt, i)) * 256 + ntile * 128 + CL(nt)] = acc[mt][nt][i];
      if (mtile == 0 && tid_e_ < 128) {
        const int d = ntile * 128 + tid_e_;
        float s = 0.f;
        for (int sp = 0; sp < 256; ++sp) s += wf[sp] * bf2f(Kn[((size_t)((b * 256 + sp) >> 5) * 4 + hd) * 8192 + (sp & 31) * 256 + d]);
        P.out[OUT_NEWN + sidx * 256 + d] = s;
      }
    }
  }
}

DI void phase_branch(const Params& P, int l, unsigned char* smem) {
  const unsigned char* slot = P.ws + (size_t)(l & 1) * SZ_SLOT;
  const bf16_t* HN = (const bf16_t*)(P.ws + OFF_HN);
  const bf16_t* FB = (const bf16_t*)(P.ws + OFF_FB);
  const bf16_t* WA = (const bf16_t*)(slot + WS_WA);
  const bf16_t* WB = (const bf16_t*)(slot + WS_WB);
  const bf16_t* GA = (const bf16_t*)(P.ws + OFF_GA);
  const bf16_t* GB = (const bf16_t*)(P.ws + OFF_GB);
  bf16_t* MG = (bf16_t*)(P.ws + OFF_MERGED);
  for (int t = vblock(); t < 64 * 8; t += gridDim.x) {
    int mtile, ntile;
    tile_decode(t, 64, 8, mtile, ntile);
    const int m0 = mtile * 192, n0 = ntile * 128;
    f32x16 acc[3][2];
    acc_zero3(acc);
    gemm192_mainloop(acc, HN + (size_t)m0 * 2048, 2048, WA + (size_t)n0 * 2048, 2048, 2048, smem);
    const bf16_t* GAb = GA + (size_t)m0 * 1024 + n0;
    const bf16_t* GBb = GB + (size_t)m0 * 1024 + n0;
    bf16_t* MGb = MG + (size_t)m0 * 1024 + n0;
    {
      EPI_VARS;
#pragma unroll
      for (int mt = 0; mt < 3; ++mt)
#pragma unroll
        for (int nt = 0; nt < 2; ++nt)
#pragma unroll
          for (int i = 0; i < 16; ++i) {
            const unsigned o = (unsigned)RW3(mt, i) * 1024u + CL(nt);
            MGb[o] = (bf16_t)f2bf(bf2f(GAb[o]) * acc[mt][nt][i]);
          }
    }
    acc_zero3(acc);
    gemm192_mainloop(acc, FB + (size_t)m0 * 1024, 1024, WB + (size_t)n0 * 1024, 1024, 1024, smem);
    EPI_VARS;
#pragma unroll
    for (int mt = 0; mt < 3; ++mt)
#pragma unroll
      for (int nt = 0; nt < 2; ++nt)
#pragma unroll
        for (int i = 0; i < 16; ++i) {
          const unsigned o = (unsigned)RW3(mt, i) * 1024u + CL(nt);
          MGb[o] = (bf16_t)f2bf(bf2f(MGb[o]) + bf2f(GBb[o]) * acc[mt][nt][i]);
        }
  }
}

DI void phase_resid_gemm(const Params& P, int l, const bf16_t* A, int K, const bf16_t* W, int goff, unsigned char* smem) {
  const float* X = (const float*)(P.ws + OFF_XRES);
  const float* MOD = (const float*)(P.ws + OFF_MOD) + (size_t)l * 9 * 6144;
  float* PRE = (float*)(P.ws + OFF_PRELN);
  for (int t = vblock(); t < 64 * 8; t += gridDim.x) {
    int mtile, ntile;
    tile_decode(t, 64, 8, mtile, ntile);
    const int m0 = mtile * 192, n0 = ntile * 128;
    f32x16 acc[3][2];
    acc_zero3(acc);
    gemm192_mainloop(acc, A + (size_t)m0 * K, K, W + (size_t)n0 * K, K, K, smem);
    EPI_VARS;
    const float* Xb = X + (size_t)m0 * 1024 + n0;
    float* PREb = PRE + (size_t)m0 * 1024 + n0;
#pragma unroll
    for (int mt = 0; mt < 3; ++mt)
#pragma unroll
      for (int nt = 0; nt < 2; ++nt)
#pragma unroll
        for (int i = 0; i < 16; ++i) {
          const int row = RW3(mt, i);
          const unsigned o = (unsigned)row * 1024u + CL(nt);
          const float gv = MOD[(size_t)mod_index(m0 + row) * 6144 + goff + n0 + CL(nt)];
          PREb[o] = ALPHA * Xb[o] + gv * acc[mt][nt][i];
        }
  }
}

DI void phase_ln(const Params& P, const float* gain, const float* bias, float* xdst, const float* modn, int shoff, int scoff) {
  const float* PRE = (const float*)(P.ws + OFF_PRELN);
  bf16_t* H = (bf16_t*)(P.ws + OFF_HMOD);
  const int tidl_ = tid_(), lane = tidl_ & 63, w = tidl_ >> 6;
  for (int tok = bid_() * 4 + w; tok < NTOK; tok += gridDim.x * 4) {
    float4 v[4];
    float s = 0.f;
#pragma unroll
    for (int i = 0; i < 4; ++i) {
      v[i] = *(const float4*)(PRE + (size_t)tok * 1024 + (i * 64 + lane) * 4);
      s += v[i].x + v[i].y + v[i].z + v[i].w;
    }
#pragma unroll
    for (int o = 1; o < 64; o <<= 1) s += __shfl_xor(s, o, 64);
    const float mu = s * (1.f / 1024.f);
    float vs = 0.f;
#pragma unroll
    for (int i = 0; i < 4; ++i) {
      const float a = v[i].x - mu, b = v[i].y - mu, c = v[i].z - mu, d = v[i].w - mu;
      vs += a * a + b * b + c * c + d * d;
    }
#pragma unroll
    for (int o = 1; o < 64; o <<= 1) vs += __shfl_xor(vs, o, 64);
    const float rs = rsqrtf(vs * (1.f / 1024.f) + LN_EPS);
    const float* m = modn ? modn + (size_t)mod_index(tok) * 6144 : nullptr;
#pragma unroll
    for (int i = 0; i < 4; ++i) {
      const int n = (i * 64 + lane) * 4;
      const float4 g = *(const float4*)(gain + n), b = *(const float4*)(bias + n);
      float4 x;
      x.x = (v[i].x - mu) * rs * g.x + b.x; x.y = (v[i].y - mu) * rs * g.y + b.y;
      x.z = (v[i].z - mu) * rs * g.z + b.z; x.w = (v[i].w - mu) * rs * g.w + b.w;
      *(float4*)(xdst + (size_t)tok * 1024 + n) = x;
      if (m) {
        const float4 sh = *(const float4*)(m + shoff + n), sc = *(const float4*)(m + scoff + n);
        uint2 o;
        o.x = pack2(x.x * (1.f + sc.x) + sh.x, x.y * (1.f + sc.y) + sh.y);
        o.y = pack2(x.z * (1.f + sc.z) + sh.z, x.w * (1.f + sc.w) + sh.w);
        *(uint2*)(H + (size_t)tok * 1024 + n) = o;
      }
    }
  }
}

DI void phase_ffn_in(const Params& P, int l, unsigned char* smem) {
  const bf16_t* H = (const bf16_t*)(P.ws + OFF_HMOD);
  const bf16_t* W = (const bf16_t*)(P.ws + (size_t)(l & 1) * SZ_SLOT + WS_WF1);
  bf16_t* FF = (bf16_t*)(P.ws + OFF_FF);
  for (int t = vblock(); t < 96 * 44; t += gridDim.x) {
    int mtile, ntile;
    tile_decode(t, 96, 44, mtile, ntile);
    const int m0 = mtile * 128, n0 = ntile * 128;
    f32x16 acc[2][2];
    acc_zero(acc);
    gemm_mainloop<false>(acc, H + (size_t)m0 * 1024, 1024, W + (size_t)n0 * 1024, 1024, 1024, nullptr, smem);
    EPI_VARS;
#pragma unroll
    for (int mt = 0; mt < 2; ++mt)
#pragma unroll
      for (int i = 0; i < 16; ++i) {
        const float a = acc[mt][0][i], u = acc[mt][1][i];
        *(unsigned short*)(smem + RW(mt, i) * 144 + (wn_ * 32 + rr_) * 2) = (unsigned short)f2bf(a * sigmoidf_(a) * u);
      }
    __syncthreads();
#pragma unroll
    for (int i = 0; i < 4; ++i) {
      const int row = (tid_e_ >> 3) + 32 * i, ch = tid_e_ & 7;
      const u32x4 x = *(const u32x4*)(smem + row * 144 + ch * 16);
      *(u32x4*)(FF + (size_t)(m0 + row) * DFF + ntile * 64 + ch * 8) = x;
    }
    __syncthreads();
  }
}

template <int S>
DI void run_phase(const Params& P, int l, unsigned char* smem) {
  const unsigned char* slot = P.ws + (size_t)(l & 1) * SZ_SLOT;
  const float* MOD = (const float*)(P.ws + OFF_MOD);
  if constexpr (S == 0) phase_setup(P, smem);
  else if constexpr (S == 1) phase_modreduce(P);
  else if constexpr (S == 2) phase_modulate0(P);
  else if constexpr (S == 3) phase_gemm_in(P, l, smem);
  else if constexpr (S == 4) phase_scan_four1(P, l, smem);
  else if constexpr (S == 5) phase_mixers(P, l, smem);
  else if constexpr (S == 6) phase_hn(P, l);
  else if constexpr (S == 7) phase_branch(P, l, smem);
  else if constexpr (S == 8) phase_resid_gemm(P, l, (const bf16_t*)(P.ws + OFF_MERGED), 1024, (const bf16_t*)(slot + WS_WO), 2048, smem);
  else if constexpr (S == 9) {
    phase_ln(P, P.ln_gain + (l * 2 + 0) * 1024, P.ln_bias + (l * 2 + 0) * 1024, (float*)(P.ws + OFF_XRES), MOD + (size_t)l * 9 * 6144, 3072, 4096);
    if (l + 1 < 4) convert_layer(P, l + 1, smem);
  } else if constexpr (S == 10) phase_ffn_in(P, l, smem);
  else if constexpr (S == 11) phase_resid_gemm(P, l, (const bf16_t*)(P.ws + OFF_FF), DFF, (const bf16_t*)(slot + WS_WF2), 5120, smem);
  else {
    if (l == 3) phase_ln(P, P.ln_gain + (l * 2 + 1) * 1024, P.ln_bias + (l * 2 + 1) * 1024, P.out, nullptr, 0, 0);
    else phase_ln(P, P.ln_gain + (l * 2 + 1) * 1024, P.ln_bias + (l * 2 + 1) * 1024, (float*)(P.ws + OFF_XRES), MOD + (size_t)(l + 1) * 9 * 6144, 0, 1024);
  }
}

#if !ONE_LAUNCH
template <int S>
__global__ void __launch_bounds__(256, 2) k_phase(Params P, int l) {
  __shared__ __attribute__((aligned(16))) unsigned char smem[SMEM_BYTES];
  run_phase<S>(P, l, smem);
}

#endif
#define XB_TMO      128
#define XB_XCNT(j)  (256  + 64 * (j))
#define XB_XSUB(j)  (1280 + 64 * (j))
#define XB_XGEN(j)  (2304 + 64 * (j))
#define XB_TOP      3328
#define XB_TOPGEN   3392
#define XCD_BAR_WORDS 3456
#define XB_SPIN_CAP (1u << 20)
#define LAS __attribute__((address_space(3)))
DI unsigned xb_ld(unsigned* p) { return __hip_atomic_load(p, __ATOMIC_RELAXED, __HIP_MEMORY_SCOPE_AGENT); }
DI unsigned xb_add(unsigned* p, unsigned v) { return __hip_atomic_fetch_add(p, v, __ATOMIC_RELAXED, __HIP_MEMORY_SCOPE_AGENT); }
DI unsigned xb_xcc_id() { return (unsigned)__builtin_amdgcn_s_getreg((3 << 11) | 20) & 0xFu; }
#define XB_SPIN(cond, bar) do { unsigned _sp = 0; while (cond) { __builtin_amdgcn_s_sleep(1); \
    if ((++_sp & 255u) == 0u) { if (xb_ld(&(bar)[XB_TMO])) break; if (_sp > XB_SPIN_CAP) { atomicAdd(&(bar)[XB_TMO], 1u); break; } } } } while (0)
DI void xcd_barrier_complete(unsigned* bar, unsigned x, unsigned& nloc, unsigned& nx) {
  const unsigned G = gridDim.x;
  unsigned sum, cnt, mine, sp = 0u;
  for (;;) {
    sum = 0u; cnt = 0u; mine = 0u;
#pragma unroll
    for (unsigned j = 0; j < 16; ++j) { const unsigned c = xb_ld(&bar[XB_XCNT(j)]); sum += c; cnt += (c > 0u) ? 1u : 0u; mine = (j == x) ? c : mine; }
    if (sum == G) break;
    __builtin_amdgcn_s_sleep(1);
    if ((++sp & 255u) == 0u) { if (xb_ld(&bar[XB_TMO])) break; if (sp > XB_SPIN_CAP) { atomicAdd(&bar[XB_TMO], 1u); break; } }
  }
  nloc = mine > 0u ? mine : 1u; nx = cnt > 0u ? cnt : 1u;
}
DI void xcd_barrier(unsigned* bar, volatile LAS unsigned* st) {
  asm volatile("s_waitcnt vmcnt(0)" ::: "memory");
  __syncthreads();
  if (threadIdx.x == 0) {
    const unsigned x = xb_xcc_id();
    __builtin_amdgcn_s_waitcnt(0);
    unsigned nloc = st[0], nx = st[1];
    if (nloc == 0u) { xcd_barrier_complete(bar, x, nloc, nx); st[0] = nloc; st[1] = nx; }
    const unsigned old = xb_add(&bar[XB_XSUB(x)], 1u);
    const unsigned gen = old / nloc;
    if (old + 1u == (gen + 1u) * nloc) {
      __builtin_amdgcn_fence(__ATOMIC_RELEASE, "agent");
      asm volatile("s_waitcnt vmcnt(0)" ::: "memory");
      const unsigned og = xb_add(&bar[XB_TOP], 1u);
      const unsigned tg = og / nx;
      if (og + 1u == (tg + 1u) * nx) xb_add(&bar[XB_TOPGEN], 1u);
      else XB_SPIN(xb_ld(&bar[XB_TOPGEN]) == tg, bar);
      __builtin_amdgcn_fence(__ATOMIC_ACQUIRE, "agent");
      xb_add(&bar[XB_XGEN(x)], 1u);
      asm volatile("s_waitcnt vmcnt(0)" ::: "memory");
    } else {
      XB_SPIN(xb_ld(&bar[XB_XGEN(x)]) == gen, bar);
      __builtin_amdgcn_fence(__ATOMIC_ACQUIRE, "agent");
      asm volatile("s_waitcnt vmcnt(0)" ::: "memory");
    }
  }
  __syncthreads();
}

#define GSYNC() xcd_barrier((unsigned*)(load_params().ws + OFF_BAR), xb_st)
DI Params load_params() {
  Params P{};
#if defined(__HIP_DEVICE_COMPILE__)
  typedef const unsigned long long __attribute__((address_space(4)))* KP;
  typedef float __attribute__((address_space(1)))* GF;
  KP kp = (KP)__builtin_amdgcn_kernarg_segment_ptr();
  asm volatile("" : "+s"(kp));
  P.x_prompt = (const float*)(GF)kp[0];
  P.x_sample = (const float*)(GF)kp[1];
  P.c = (const float*)(GF)kp[2];
  P.state_C = (const float*)(GF)kp[3];
  P.state_n = (const float*)(GF)kp[4];
  P.state_m = (const float*)(GF)kp[5];
  P.c_ctx = (const float*)(GF)kp[6];
  P.w_mod = (const float*)(GF)kp[7];
  P.b_mod = (const float*)(GF)kp[8];
  P.w_in = (const float*)(GF)kp[9];
  P.b_gate = (const float*)(GF)kp[10];
  P.mh_gain = (const float*)(GF)kp[11];
  P.w_a = (const float*)(GF)kp[12];
  P.w_b = (const float*)(GF)kp[13];
  P.w_out = (const float*)(GF)kp[14];
  P.ln_gain = (const float*)(GF)kp[15];
  P.ln_bias = (const float*)(GF)kp[16];
  P.w_f1 = (const float*)(GF)kp[17];
  P.w_f2 = (const float*)(GF)kp[18];
  P.out = (float*)(GF)kp[19];
  P.ws = (unsigned char*)(GF)kp[20];
#endif
  return P;
}
__global__ void __launch_bounds__(256, 2) fwd_kernel(Params Pk) {
  __shared__ __attribute__((aligned(16))) unsigned char smem[SMEM_BYTES];
  __shared__ uint4 xb_words;
  {
    unsigned* bar0 = (unsigned*)(load_params().ws + OFF_BAR);
    const unsigned x0 = xb_xcc_id();
    if (threadIdx.x == 0) {
      xb_words = make_uint4(0u, 0u, 0u, 0u);
      (void)xb_add(&bar0[XB_XCNT(x0)], 1u);
    }
  }
  __syncthreads();
  volatile LAS unsigned* xb_st = (volatile LAS unsigned*)&xb_words;
  run_phase<0>(load_params(), 0, smem);
  if (load_params().ws == nullptr) cg::this_grid().sync();
  GSYNC();
  run_phase<1>(load_params(), 0, smem); GSYNC();
  run_phase<2>(load_params(), 0, smem); GSYNC();
#pragma unroll 1
  for (int l = 0; l < 4; ++l) {
    run_phase<3>(load_params(), l, smem); GSYNC();
    run_phase<4>(load_params(), l, smem); GSYNC();
    run_phase<5>(load_params(), l, smem); GSYNC();
    run_phase<6>(load_params(), l, smem); GSYNC();
    run_phase<7>(load_params(), l, smem); GSYNC();
    run_phase<8>(load_params(), l, smem); GSYNC();
    run_phase<9>(load_params(), l, smem); GSYNC();
    run_phase<10>(load_params(), l, smem); GSYNC();
    run_phase<11>(load_params(), l, smem); GSYNC();
    run_phase<12>(load_params(), l, smem);
    if (l < 3) GSYNC();
  }
}

#if !ONE_LAUNCH
template <int S>
static void launch_phase(const Params& P, int l, int cus, hipStream_t stream) {
  int per_cu = 0;
  if (hipOccupancyMaxActiveBlocksPerMultiprocessor(&per_cu, k_phase<S>, 256, 0) != hipSuccess) per_cu = 1;
  if (per_cu > 2) per_cu = 2;
  if (per_cu < 1) per_cu = 1;
  int grid = cus * per_cu;
  grid -= grid % 8;
  hipLaunchKernelGGL(k_phase<S>, dim3(grid), dim3(256), 0, stream, P, l);
}

#endif
extern "C" void kernel_launch(void* const* d_in, const int* in_sizes, int n_in, void* d_out, int out_size, void* d_ws, size_t ws_size,
                              hipStream_t stream) {
  if (ws_size < WS_TOTAL) { fprintf(stderr, "workspace too small: %zu < %zu\n", ws_size, (size_t)WS_TOTAL); return; }
  Params P{};
  const float** pp = (const float**)&P;
  for (int i = 0; i < 19; ++i) pp[i] = (const float*)d_in[i];
  P.out = (float*)d_out;
  P.ws = (unsigned char*)d_ws;
  int dev = 0, cus = 256;
  if (hipGetDevice(&dev) != hipSuccess) dev = 0;
  if (hipDeviceGetAttribute(&cus, hipDeviceAttributeMultiprocessorCount, dev) != hipSuccess) cus = 256;
#if ONE_LAUNCH
  {
    static int grid_blocks = 0;
    if (!grid_blocks) {
      int per_cu = 0;
      if (hipOccupancyMaxActiveBlocksPerMultiprocessor(&per_cu, fwd_kernel, 256, 0) != hipSuccess) per_cu = 1;
      if (per_cu > 2) per_cu = 2;
      if (per_cu < 1) per_cu = 1;
      grid_blocks = cus * per_cu;
      grid_blocks -= grid_blocks % 8;
    }
    if (hipMemsetAsync((unsigned char*)d_ws + OFF_BAR, 0, 16384, stream) != hipSuccess) { fprintf(stderr, "memset of barrier words failed\n"); return; }
    void* args[] = {&P};
    hipError_t err = hipLaunchCooperativeKernel((void*)fwd_kernel, dim3(grid_blocks), dim3(256), args, 0, stream);
    if (err != hipSuccess) fprintf(stderr, "cooperative launch failed: %s (grid %d)\n", hipGetErrorString(err), grid_blocks);
    return;
  }
#endif
#if !ONE_LAUNCH
  launch_phase<0>(P, 0, cus, stream);
  launch_phase<1>(P, 0, cus, stream);
  launch_phase<2>(P, 0, cus, stream);
  for (int l = 0; l < 4; ++l) {
    launch_phase<3>(P, l, cus, stream);
    launch_phase<4>(P, l, cus, stream);
    launch_phase<5>(P, l, cus, stream);
    launch_phase<6>(P, l, cus, stream);
    launch_phase<7>(P, l, cus, stream);
    launch_phase<8>(P, l, cus, stream);
    launch_phase<9>(P, l, cus, stream);
    launch_phase<10>(P, l, cus, stream);
    launch_phase<11>(P, l, cus, stream);
    launch_phase<12>(P, l, cus, stream);
  }
#endif
}
```

```cpp
#include <hip/hip_runtime.h>
#include <hip/hip_cooperative_groups.h>
#include <cstdio>
#ifndef ONE_LAUNCH
#define ONE_LAUNCH 1
#endif
namespace cg = cooperative_groups;

typedef unsigned short bf16_t;
using bf16x8 = __attribute__((ext_vector_type(8))) short;
using f32x16 = __attribute__((ext_vector_type(16))) float;
using f32x4 = __attribute__((ext_vector_type(4))) float;
#define DI __device__ __forceinline__
#define MFMA32(a, b, c) __builtin_amdgcn_mfma_f32_32x32x16_bf16((a), (b), (c), 0, 0, 0)
#define MFMA16(a, b, c) __builtin_amdgcn_mfma_f32_16x16x32_bf16((a), (b), (c), 0, 0, 0)

constexpr int NTOK = 12288, NCTX = 4096;
constexpr int NINP = 9344;
constexpr int DFF = 2816;
constexpr float ALPHA = 1.6817928305074290f;
constexpr float LN_EPS = 1e-5f;

constexpr size_t SZ_WIN = (size_t)NINP * 1024 * 2, SZ_WA = 1024ull * 2048 * 2, SZ_WB = 1024ull * 1024 * 2, SZ_WO = SZ_WB,
                 SZ_WF1 = 5632ull * 1024 * 2, SZ_WF2 = 1024ull * 2816 * 2;
constexpr size_t WS_WIN = 0, WS_WA = WS_WIN + SZ_WIN, WS_WB = WS_WA + SZ_WA, WS_WO = WS_WB + SZ_WB, WS_WF1 = WS_WO + SZ_WO,
                 WS_WF2 = WS_WF1 + SZ_WF1, SZ_SLOT = WS_WF2 + SZ_WF2;
constexpr size_t OFF_BC = 2 * SZ_SLOT;
constexpr size_t OFF_A256 = OFF_BC + 512 * 256 * 2;
constexpr size_t OFF_A1024 = OFF_A256 + 256 * 512 * 2;
constexpr size_t OFF_MODP = OFF_A1024 + 1024ull * 2048 * 2;
constexpr size_t OFF_MOD = OFF_MODP + 8ull * 4 * 9 * 6144 * 4;
constexpr size_t OFF_XRES = OFF_MOD + 4ull * 9 * 6144 * 4;
constexpr size_t OFF_HMOD = OFF_XRES + (size_t)NTOK * 1024 * 4;
constexpr size_t OFF_FB = OFF_HMOD;
constexpr size_t OFF_Q = OFF_HMOD + (size_t)NTOK * 1024 * 2;
constexpr size_t OFF_MERGED = OFF_Q;
constexpr size_t OFF_K = OFF_Q + (size_t)NTOK * 1024 * 2;
constexpr size_t OFF_KT = OFF_K + (size_t)NTOK * 1024 * 2;
constexpr size_t OFF_VT = OFF_KT + 16ull * 4 * 256 * 256 * 2;
constexpr size_t OFF_OG = OFF_VT + (size_t)NTOK * 2048 * 2;
constexpr size_t OFF_FF = OFF_OG;
constexpr size_t OFF_UF = OFF_OG + (size_t)NTOK * 2048 * 2;
constexpr size_t OFF_GA = OFF_UF + (size_t)NTOK * 1024 * 2;
constexpr size_t OFF_GB = OFF_GA + (size_t)NTOK * 1024 * 2;
constexpr size_t OFF_GATES = OFF_GB + (size_t)NTOK * 1024 * 2;
constexpr size_t SZ_SC = 2ull * 4 * NTOK * 4;
constexpr size_t OFF_BETA = OFF_GATES + (size_t)NTOK * 16 * 4;
constexpr size_t OFF_MM = OFF_BETA + SZ_SC;
constexpr size_t OFF_EMT = OFF_MM + SZ_SC;
constexpr size_t OFF_WFIN = OFF_EMT + SZ_SC;
constexpr size_t OFF_H0 = OFF_WFIN + SZ_SC;
constexpr size_t OFF_TT = OFF_H0 + (size_t)NTOK * 2048 * 2;
constexpr size_t OFF_PRELN = OFF_TT;
constexpr size_t OFF_HN = OFF_TT + (size_t)NTOK * 2048 * 2;
constexpr size_t OFF_VTC = OFF_HN + (size_t)NTOK * 2048 * 2;
constexpr size_t OFF_C0T = OFF_VTC + 16ull * 2048 * 256 * 2;
constexpr size_t OFF_BAR = OFF_C0T + 64ull * 512 * 256 * 2;
constexpr size_t WS_TOTAL = OFF_BAR + 16384;
constexpr size_t VT_LAT = 16ull * 2048 * 256;
constexpr size_t TT_LAT = 16ull * 4 * 256 * 512;

constexpr size_t OUT_NEWC = (size_t)NTOK * 1024;
constexpr size_t OUT_NEWN = OUT_NEWC + 16ull * 4 * 2 * 4 * 512 * 256;
constexpr size_t OUT_NEWM = OUT_NEWN + 16ull * 4 * 2 * 4 * 256;

constexpr int SMEM_BYTES = 73728;

struct Params {
  const float *x_prompt, *x_sample, *c, *state_C, *state_n, *state_m, *c_ctx, *w_mod, *b_mod, *w_in, *b_gate, *mh_gain,
      *w_a, *w_b, *w_out, *ln_gain, *ln_bias, *w_f1, *w_f2;
  float* out;
  unsigned char* ws;
};

typedef unsigned u32x4 __attribute__((ext_vector_type(4)));
DI u32x4 gld16(const void* p) { u32x4 r; asm volatile("global_load_dwordx4 %0, %1, off" : "=&v"(r) : "v"(p) : "memory"); return r; }
DI unsigned f2bf(float x) { unsigned r; asm("v_cvt_pk_bf16_f32 %0, %1, %1" : "=v"(r) : "v"(x)); return r & 0xffffu; }
DI unsigned pack2(float a, float b) { unsigned r; asm("v_cvt_pk_bf16_f32 %0, %1, %2\n\ts_nop 1" : "=v"(r) : "v"(a), "v"(b)); return r; }
DI float bf2f(unsigned h) { return __uint_as_float(h << 16); }
DI float sigmoidf_(float x) { return 1.f / (1.f + __expf(-x)); }
DI float logsigmoidf_(float x) { return fminf(x, 0.f) - log1pf(__expf(-fabsf(x))); }
DI int mod_index(int tok) { return tok < NCTX ? 0 : 1 + ((tok - NCTX) >> 10); }
DI int tid_() { int t = threadIdx.x; asm volatile("" : "+v"(t)); return t; }
DI int bid_() { int b = blockIdx.x; asm volatile("" : "+s"(b)); return b; }
DI int vblock() { return bid_(); }

DI void tile_decode(int t, int MT, int NT, int& mt, int& nt) {
  const int per_sc = MT * 8;
  const int sc = t / per_sc;
  const int w = t - sc * per_sc;
  int ncols = NT - sc * 8; ncols = ncols > 8 ? 8 : ncols;
  const int per_sr = 8 * ncols;
  const int sr = w / per_sr;
  const int j = w - sr * per_sr;
  mt = sr * 8 + (j & 7);
  nt = sc * 8 + (j >> 3);
}

template <bool KSCALE>
DI void gemm_mainloop(f32x16 (&acc)[2][2], const bf16_t* __restrict__ A, int lda, const bf16_t* __restrict__ B, int ldb, int K,
                      const float* __restrict__ kscale, unsigned char* smem) {
  const int tid = tid_(), lane = tid & 63, wave = tid >> 6;
  const int wm = wave >> 1, wn = wave & 1, r = lane & 31, h = lane >> 5;
  const int lrow = tid >> 3, lkc = tid & 7;
  const bf16_t* ga = A + (size_t)lrow * lda + lkc * 8;
  const bf16_t* gb = B + (size_t)lrow * ldb + lkc * 8;
  u32x4 a0[4], b0[4], a1[4], b1[4];
  const int KT = K >> 6;
#define GL(sa_, sb_, k0)                                                                            \
  {                                                                                                 \
    _Pragma("unroll") for (int i = 0; i < 4; ++i) {                                                 \
      sa_[i] = gld16(ga + (size_t)(32 * i) * lda + (k0));                                           \
      sb_[i] = gld16(gb + (size_t)(32 * i) * ldb + (k0));                                           \
    }                                                                                               \
  }
#define GW8(sa_, sb_) asm volatile("s_waitcnt vmcnt(8)" : "+v"(sa_[0]), "+v"(sa_[1]), "+v"(sa_[2]), "+v"(sa_[3]), "+v"(sb_[0]), "+v"(sb_[1]), "+v"(sb_[2]), "+v"(sb_[3]) : : "memory")
#define GW0(sa_, sb_) asm volatile("s_waitcnt vmcnt(0)" : "+v"(sa_[0]), "+v"(sa_[1]), "+v"(sa_[2]), "+v"(sa_[3]), "+v"(sb_[0]), "+v"(sb_[1]), "+v"(sb_[2]), "+v"(sb_[3]) : : "memory")
#define ST(sa_, sb_, buf, k0)                                                                       \
  {                                                                                                 \
    if (KSCALE) {                                                                                   \
      const float4 s0 = *(const float4*)(kscale + (k0) + lkc * 8);                                  \
      const float4 s1 = *(const float4*)(kscale + (k0) + lkc * 8 + 4);                              \
      _Pragma("unroll") for (int i = 0; i < 4; ++i) {                                               \
        u32x4 v = sb_[i];                                                                           \
        v.x = pack2(bf2f(v.x & 0xffffu) * s0.x, bf2f(v.x >> 16) * s0.y);                            \
        v.y = pack2(bf2f(v.y & 0xffffu) * s0.z, bf2f(v.y >> 16) * s0.w);                            \
        v.z = pack2(bf2f(v.z & 0xffffu) * s1.x, bf2f(v.z >> 16) * s1.y);                            \
        v.w = pack2(bf2f(v.w & 0xffffu) * s1.z, bf2f(v.w >> 16) * s1.w);                            \
        sb_[i] = v;                                                                                 \
      }                                                                                             \
    }                                                                                               \
    unsigned char* sa__ = smem + (buf) * 36864;                                                     \
    unsigned char* sb__ = sa__ + 18432;                                                             \
    _Pragma("unroll") for (int i = 0; i < 4; ++i) {                                                 \
      *(u32x4*)(sa__ + (lrow + 32 * i) * 144 + lkc * 16) = sa_[i];                                  \
      *(u32x4*)(sb__ + (lrow + 32 * i) * 144 + lkc * 16) = sb_[i];                                  \
    }                                                                                               \
  }
#define COMPUTE(buf)                                                                                                          \
  {                                                                                                                           \
    const unsigned char* sa = smem + (buf) * 36864;                                                                           \
    const unsigned char* sb = sa + 18432;                                                                                     \
    _Pragma("unroll") for (int ks = 0; ks < 4; ++ks) {                                                                        \
      bf16x8 af[2], bfr[2];                                                                                                   \
      _Pragma("unroll") for (int mt = 0; mt < 2; ++mt) af[mt] = *(const bf16x8*)(sa + (wm * 64 + mt * 32 + r) * 144 + ks * 32 + h * 16);  \
      _Pragma("unroll") for (int nt = 0; nt < 2; ++nt) bfr[nt] = *(const bf16x8*)(sb + (wn * 64 + nt * 32 + r) * 144 + ks * 32 + h * 16); \
      _Pragma("unroll") for (int mt = 0; mt < 2; ++mt)                                                                        \
        _Pragma("unroll") for (int nt = 0; nt < 2; ++nt) acc[mt][nt] = MFMA32(af[mt], bfr[nt], acc[mt][nt]);                  \
    }                                                                                                                         \
  }
  GL(a0, b0, 0);
  GL(a1, b1, 64);
  GW8(a0, b0);
  ST(a0, b0, 0, 0);
  __syncthreads();
  for (int kt = 0; kt < KT; kt += 2) {
    { const int kn = kt + 2 < KT ? kt + 2 : KT - 1; GL(a0, b0, kn * 64); }
    COMPUTE(0);
    GW8(a1, b1);
    ST(a1, b1, 1, (kt + 1) * 64);
    __syncthreads();
    { const int kn = kt + 3 < KT ? kt + 3 : KT - 1; GL(a1, b1, kn * 64); }
    COMPUTE(1);
    GW8(a0, b0);
    { const int kn = kt + 2 < KT ? kt + 2 : KT - 1; ST(a0, b0, 0, kn * 64); }
    __syncthreads();
  }
  GW0(a1, b1);
#undef GL
#undef GW8
#undef GW0
#undef ST
#undef COMPUTE
}

DI void gemm192_mainloop(f32x16 (&acc)[3][2], const bf16_t* __restrict__ A, int lda, const bf16_t* __restrict__ B, int ldb, int K,
                         unsigned char* smem) {
  const int tid = tid_(), lane = tid & 63, wave = tid >> 6;
  const int wm = wave >> 1, wn = wave & 1, r = lane & 31, h = lane >> 5;
  const int lrow = tid >> 3, lkc = tid & 7;
  const bf16_t* ga = A + (size_t)lrow * lda + lkc * 8;
  const bf16_t* gb = B + (size_t)lrow * ldb + lkc * 8;
  u32x4 a0[6], b0[4], a1[6], b1[4];
  const int KT = K >> 6;
#define GL(sa_, sb_, k0)                                                                            \
  {                                                                                                 \
    _Pragma("unroll") for (int i = 0; i < 6; ++i) sa_[i] = gld16(ga + (size_t)(32 * i) * lda + (k0));  \
    _Pragma("unroll") for (int i = 0; i < 4; ++i) sb_[i] = gld16(gb + (size_t)(32 * i) * ldb + (k0));  \
  }
#define GW10(sa_, sb_) asm volatile("s_waitcnt vmcnt(10)" : "+v"(sa_[0]), "+v"(sa_[1]), "+v"(sa_[2]), "+v"(sa_[3]), "+v"(sa_[4]), "+v"(sa_[5]), "+v"(sb_[0]), "+v"(sb_[1]), "+v"(sb_[2]), "+v"(sb_[3]) : : "memory")
#define GW0(sa_, sb_) asm volatile("s_waitcnt vmcnt(0)" : "+v"(sa_[0]), "+v"(sa_[1]), "+v"(sa_[2]), "+v"(sa_[3]), "+v"(sa_[4]), "+v"(sa_[5]), "+v"(sb_[0]), "+v"(sb_[1]), "+v"(sb_[2]), "+v"(sb_[3]) : : "memory")
#define ST(sa_, sb_)                                                                                \
  {                                                                                                 \
    unsigned char* sa__ = smem;                                                                     \
    unsigned char* sb__ = smem + 27648;                                                             \
    _Pragma("unroll") for (int i = 0; i < 6; ++i) *(u32x4*)(sa__ + (lrow + 32 * i) * 144 + lkc * 16) = sa_[i];  \
    _Pragma("unroll") for (int i = 0; i < 4; ++i) *(u32x4*)(sb__ + (lrow + 32 * i) * 144 + lkc * 16) = sb_[i];  \
  }
#define COMPUTE()                                                                                                             \
  {                                                                                                                           \
    const unsigned char* sa = smem;                                                                                           \
    const unsigned char* sb = smem + 27648;                                                                                   \
    _Pragma("unroll") for (int ks = 0; ks < 4; ++ks) {                                                                        \
      bf16x8 af[3], bfr[2];                                                                                                   \
      _Pragma("unroll") for (int mt = 0; mt < 3; ++mt) af[mt] = *(const bf16x8*)(sa + (wm * 96 + mt * 32 + r) * 144 + ks * 32 + h * 16);  \
      _Pragma("unroll") for (int nt = 0; nt < 2; ++nt) bfr[nt] = *(const bf16x8*)(sb + (wn * 64 + nt * 32 + r) * 144 + ks * 32 + h * 16); \
      _Pragma("unroll") for (int mt = 0; mt < 3; ++mt)                                                                        \
        _Pragma("unroll") for (int nt = 0; nt < 2; ++nt) acc[mt][nt] = MFMA32(af[mt], bfr[nt], acc[mt][nt]);                  \
    }                                                                                                                         \
  }
  GL(a0, b0, 0);
  GL(a1, b1, 64);
  GW10(a0, b0);
  ST(a0, b0);
  __syncthreads();
  for (int kt = 0; kt < KT; kt += 2) {
    { const int kn = kt + 2 < KT ? kt + 2 : KT - 1; GL(a0, b0, kn * 64); }
    COMPUTE();
    GW10(a1, b1);
    __syncthreads();
    ST(a1, b1);
    __syncthreads();
    { const int kn = kt + 3 < KT ? kt + 3 : KT - 1; GL(a1, b1, kn * 64); }
    COMPUTE();
    GW10(a0, b0);
    __syncthreads();
    ST(a0, b0);
    __syncthreads();
  }
  GW0(a1, b1);
#undef GL
#undef GW10
#undef GW0
#undef ST
#undef COMPUTE
}
DI void acc_zero3(f32x16 (&acc)[3][2]) {
#pragma unroll
  for (int a = 0; a < 3; ++a)
#pragma unroll
    for (int b = 0; b < 2; ++b)
#pragma unroll
      for (int i = 0; i < 16; ++i) acc[a][b][i] = 0.f;
}
#define RW3(mt, i) (wm_ * 96 + (mt) * 32 + ((i) & 3) + 8 * ((i) >> 2) + 4 * hh_)

DI void acc_zero(f32x16 (&acc)[2][2]) {
#pragma unroll
  for (int a = 0; a < 2; ++a)
#pragma unroll
    for (int b = 0; b < 2; ++b)
#pragma unroll
      for (int i = 0; i < 16; ++i) acc[a][b][i] = 0.f;
}

#define EPI_VARS const int tid_e_ = tid_(), lane_ = tid_e_ & 63, wave_ = tid_e_ >> 6, wm_ = wave_ >> 1, wn_ = wave_ & 1, rr_ = lane_ & 31, hh_ = lane_ >> 5
#define RW(mt, i) (wm_ * 64 + (mt) * 32 + ((i) & 3) + 8 * ((i) >> 2) + 4 * hh_)
#define CL(nt) (wn_ * 64 + (nt) * 32 + rr_)

template <int MODE>
DI void store_tile_bf16(const f32x16 (&acc)[2][2], bf16_t* __restrict__ dst, int ld, unsigned char* smem) {
  EPI_VARS;
#pragma unroll
  for (int mt = 0; mt < 2; ++mt)
#pragma unroll
    for (int nt = 0; nt < 2; ++nt)
#pragma unroll
      for (int i = 0; i < 16; ++i) {
        float v = acc[mt][nt][i];
        if (MODE == 1) v = sigmoidf_(v);
        *(unsigned short*)(smem + RW(mt, i) * 272 + CL(nt) * 2) = (unsigned short)f2bf(v);
      }
  __syncthreads();
#pragma unroll
  for (int i = 0; i < 8; ++i) {
    const int row = (tid_e_ >> 4) + 16 * i, ch = tid_e_ & 15;
    const u32x4 x = *(const u32x4*)(smem + row * 272 + ch * 16);
    *(u32x4*)(dst + (size_t)row * ld + ch * 8) = x;
  }
  __syncthreads();
}

DI void convert_tile(const float* __restrict__ src, int nsrc, int K, bf16_t* __restrict__ dst, int kt, int ntile, int maptype, unsigned char* smem) {
  float* tile = (float*)smem;
  const int tid = tid_(), tx4 = (tid & 15) * 4, ty = tid >> 4;
  const int np = ntile * 64 + tx4;
  int sc;
  if (maptype == 0) sc = np;
  else if (maptype == 1) sc = np < 6144 ? np : (np < 9216 ? np + 16 : (np < 9232 ? 6144 + (np - 9216) : -1));
  else { const int g = np >> 6, w = np & 63; sc = w < 32 ? g * 32 + w : 2816 + g * 32 + (w - 32); }
  __syncthreads();
#pragma unroll
  for (int i = 0; i < 4; ++i) {
    const int ky = ty + 16 * i;
    float4 v = make_float4(0.f, 0.f, 0.f, 0.f);
    if (sc >= 0) v = *(const float4*)(src + (size_t)(kt * 64 + ky) * nsrc + sc);
    tile[ky * 65 + tx4] = v.x; tile[ky * 65 + tx4 + 1] = v.y; tile[ky * 65 + tx4 + 2] = v.z; tile[ky * 65 + tx4 + 3] = v.w;
  }
  __syncthreads();
#pragma unroll
  for (int i = 0; i < 2; ++i) {
    const int id = tid + 256 * i, nrow = id >> 3, kc = id & 7;
    uint4 v;
    v.x = pack2(tile[(kc * 8 + 0) * 65 + nrow], tile[(kc * 8 + 1) * 65 + nrow]);
    v.y = pack2(tile[(kc * 8 + 2) * 65 + nrow], tile[(kc * 8 + 3) * 65 + nrow]);
    v.z = pack2(tile[(kc * 8 + 4) * 65 + nrow], tile[(kc * 8 + 5) * 65 + nrow]);
    v.w = pack2(tile[(kc * 8 + 6) * 65 + nrow], tile[(kc * 8 + 7) * 65 + nrow]);
    *(uint4*)(dst + (size_t)(ntile * 64 + nrow) * K + kt * 64 + kc * 8) = v;
  }
}

DI void convert_layer(const Params& P, int l, unsigned char* smem) {
  unsigned char* slot = P.ws + (size_t)(l & 1) * SZ_SLOT;
  constexpr int T0 = 146 * 16, T1 = T0 + 16 * 32, T2 = T1 + 16 * 16, T3 = T2 + 16 * 16, T4 = T3 + 88 * 16, T5 = T4 + 16 * 44;
  for (int it = bid_(); it < T5; it += gridDim.x) {
    if (it < T0) convert_tile(P.w_in + (size_t)l * 1024 * 9232, 9232, 1024, (bf16_t*)(slot + WS_WIN), it & 15, it >> 4, 1, smem);
    else if (it < T1) { const int j = it - T0; convert_tile(P.w_a + (size_t)l * 2048 * 1024, 1024, 2048, (bf16_t*)(slot + WS_WA), j & 31, j >> 5, 0, smem); }
    else if (it < T2) { const int j = it - T1; convert_tile(P.w_b + (size_t)l * 1024 * 1024, 1024, 1024, (bf16_t*)(slot + WS_WB), j & 15, j >> 4, 0, smem); }
    else if (it < T3) { const int j = it - T2; convert_tile(P.w_out + (size_t)l * 1024 * 1024, 1024, 1024, (bf16_t*)(slot + WS_WO), j & 15, j >> 4, 0, smem); }
    else if (it < T4) { const int j = it - T3; convert_tile(P.w_f1 + (size_t)l * 1024 * 5632, 5632, 1024, (bf16_t*)(slot + WS_WF1), j & 15, j >> 4, 2, smem); }
    else { const int j = it - T4; convert_tile(P.w_f2 + (size_t)l * 2816 * 1024, 1024, 2816, (bf16_t*)(slot + WS_WF2), j % 44, j / 44, 0, smem); }
  }
}

DI void phase_setup(const Params& P, unsigned char* smem) {
  const int tid = tid_();
  convert_layer(P, 0, smem);
  {
    bf16_t* BC = (bf16_t*)(P.ws + OFF_BC);
    bf16_t* A256 = (bf16_t*)(P.ws + OFF_A256);
    bf16_t* A1024 = (bf16_t*)(P.ws + OFF_A1024);
    const int total = 131072 + 131072 + 2097152;
    for (int e = bid_() * 256 + tid; e < total; e += gridDim.x * 256) {
      if (e < 131072) {
        const int n = e >> 8, k = e & 255, cs = n >> 8, ch = n & 255;
        const float ph = (float)((ch * k) & 255) * (1.f / 128.f);
        BC[e] = (bf16_t)f2bf(cs ? sinpif(ph) : cospif(ph));
      } else if (e < 262144) {
        const int e2 = e - 131072, m = e2 >> 9, k = e2 & 511, cs = k >> 8, p = k & 255;
        const float ph = (float)((m * p) & 255) * (1.f / 128.f);
        A256[e2] = (bf16_t)f2bf(cs ? -sinpif(ph) : cospif(ph));
      } else {
        const int e2 = e - 262144, m = e2 >> 11, k = e2 & 2047, cs = k >> 10, p = k & 1023;
        const int r1 = m >> 6, c1 = m & 63, r2 = p >> 6, c2 = p & 63;
        const float ph = (float)((4 * r1 * r2 + c1 * c2) & 63) * (1.f / 32.f);
        A1024[e2] = (bf16_t)f2bf(cs ? -sinpif(ph) : cospif(ph));
      }
    }
  }
  {
    float4* X = (float4*)(P.ws + OFF_XRES);
    const float4* xp = (const float4*)P.x_prompt;
    const float4* xs = (const float4*)P.x_sample;
    const int n4p = NCTX * 256, n4 = NTOK * 256;
    for (int e = bid_() * 256 + tid; e < n4; e += gridDim.x * 256) X[e] = e < n4p ? xp[e] : xs[e - n4p];
  }
  {
    float* MODP = (float*)(P.ws + OFF_MODP);
    float* red = (float*)smem;
    const int lane = tid & 63, w = tid >> 6;
    for (int it = bid_(); it < 8 * 4 * 24; it += gridDim.x) {
      const int nc = it % 24, l = (it / 24) & 3, ks = it / 96;
      float4 a[9];
#pragma unroll
      for (int j = 0; j < 9; ++j) a[j] = make_float4(0.f, 0.f, 0.f, 0.f);
      const int kb = ks * 128 + w * 32;
      const float* wp = P.w_mod + ((size_t)l * 1024 + kb) * 6144 + nc * 256 + lane * 4;
      for (int k = 0; k < 32; ++k) {
        const float4 wv = *(const float4*)(wp + (size_t)k * 6144);
#pragma unroll
        for (int j = 0; j < 9; ++j) {
          float cv = j == 0 ? P.c_ctx[kb + k] : P.c[(j - 1) * 1024 + kb + k];
          cv = cv * sigmoidf_(cv);
          a[j].x += cv * wv.x; a[j].y += cv * wv.y; a[j].z += cv * wv.z; a[j].w += cv * wv.w;
        }
      }
      __syncthreads();
#pragma unroll
      for (int j = 0; j < 9; ++j) *(float4*)(red + (w * 9 + j) * 256 + lane * 4) = a[j];
      __syncthreads();
      for (int e = tid; e < 9 * 256; e += 256) {
        const int j = e >> 8, n = e & 255;
        const float s = red[(0 * 9 + j) * 256 + n] + red[(1 * 9 + j) * 256 + n] + red[(2 * 9 + j) * 256 + n] + red[(3 * 9 + j) * 256 + n];
        MODP[((size_t)(ks * 4 + l) * 9 + j) * 6144 + nc * 256 + n] = s;
      }
    }
  }
}

DI void phase_modreduce(const Params& P) {
  const float* MODP = (const float*)(P.ws + OFF_MODP);
  float* MOD = (float*)(P.ws + OFF_MOD);
  const int total = 4 * 9 * 6144;
  for (int e = bid_() * 256 + tid_(); e < total; e += gridDim.x * 256) {
    const int n = e % 6144, l = e / (9 * 6144);
    float s = P.b_mod[l * 6144 + n];
#pragma unroll
    for (int ks = 0; ks < 8; ++ks) s += MODP[(size_t)ks * total + e];
    MOD[e] = s;
  }
}

DI void phase_modulate0(const Params& P) {
  const float* MOD = (const float*)(P.ws + OFF_MOD);
  const float4* X = (const float4*)(P.ws + OFF_XRES);
  uint2* H = (uint2*)(P.ws + OFF_HMOD);
  for (int e = bid_() * 256 + tid_(); e < NTOK * 256; e += gridDim.x * 256) {
    const int tok = e >> 8, n = (e & 255) * 4;
    const float* m = MOD + (size_t)mod_index(tok) * 6144;
    const float4 x = X[e];
    const float4 sh = *(const float4*)(m + n), sc = *(const float4*)(m + 1024 + n);
    uint2 o;
    o.x = pack2(x.x * (1.f + sc.x) + sh.x, x.y * (1.f + sc.y) + sh.y);
    o.y = pack2(x.z * (1.f + sc.z) + sh.z, x.w * (1.f + sc.w) + sh.w);
    H[e] = o;
  }
}

DI void phase_gemm_in(const Params& P, int l, unsigned char* smem) {
  const bf16_t* H = (const bf16_t*)(P.ws + OFF_HMOD);
  const bf16_t* W = (const bf16_t*)(P.ws + (size_t)(l & 1) * SZ_SLOT + WS_WIN);
  bf16_t* Q = (bf16_t*)(P.ws + OFF_Q);
  bf16_t* Kn = (bf16_t*)(P.ws + OFF_K);
  bf16_t* KT = (bf16_t*)(P.ws + OFF_KT);
  bf16_t* VT = (bf16_t*)(P.ws + OFF_VT);
  bf16_t* VTC = (bf16_t*)(P.ws + OFF_VTC);
  bf16_t* OG = (bf16_t*)(P.ws + OFF_OG);
  bf16_t* UF = (bf16_t*)(P.ws + OFF_UF);
  bf16_t* GA = (bf16_t*)(P.ws + OFF_GA);
  bf16_t* GB = (bf16_t*)(P.ws + OFF_GB);
  float* GATES = (float*)(P.ws + OFF_GATES);
  for (int t = vblock(); t < 96 * 73; t += gridDim.x) {
    int mtile, ntile;
    tile_decode(t, 96, 73, mtile, ntile);
    const int m0 = mtile * 128, n0 = ntile * 128;
    f32x16 acc[2][2];
    acc_zero(acc);
    gemm_mainloop<false>(acc, H + (size_t)m0 * 1024, 1024, W + (size_t)n0 * 1024, 1024, 1024, nullptr, smem);
    EPI_VARS;
    if (ntile < 8 || (ntile >= 32 && ntile < 72)) {
      bf16_t* dst; int ld, cb; bool sg;
      if (ntile < 8) { dst = Q; ld = 1024; cb = n0; sg = false; }
      else if (ntile < 48) { dst = OG; ld = 2048; cb = n0 - 4096; sg = true; }
      else if (ntile < 56) { dst = UF; ld = 1024; cb = n0 - 6144; sg = false; }
      else if (ntile < 64) { dst = GA; ld = 1024; cb = n0 - 7168; sg = true; }
      else { dst = GB; ld = 1024; cb = n0 - 8192; sg = true; }
      if (sg) store_tile_bf16<1>(acc, dst + (size_t)m0 * ld + cb, ld, smem);
      else store_tile_bf16<0>(acc, dst + (size_t)m0 * ld + cb, ld, smem);
    } else if (ntile < 16) {
      const int cb = n0 - 1024;
#pragma unroll
      for (int mt = 0; mt < 2; ++mt)
#pragma unroll
        for (int nt = 0; nt < 2; ++nt) {
#pragma unroll
          for (int i = 0; i < 16; ++i) { const int tk = m0 + RW(mt, i), kc2 = cb + CL(nt); Kn[((size_t)(tk >> 5) * 4 + (kc2 >> 8)) * 8192 + (tk & 31) * 256 + (kc2 & 255)] = (bf16_t)f2bf(acc[mt][nt][i] * 0.0625f); }
          if (m0 < NCTX) {
            const int kc = cb + CL(nt), hd = kc >> 8, d = kc & 255;
#pragma unroll
            for (int i4 = 0; i4 < 4; ++i4) {
              const int tok0 = m0 + RW(mt, 4 * i4), b = tok0 >> 8, s = tok0 & 255;
              uint2 v;
              v.x = pack2(acc[mt][nt][4 * i4] * 0.0625f, acc[mt][nt][4 * i4 + 1] * 0.0625f);
              v.y = pack2(acc[mt][nt][4 * i4 + 2] * 0.0625f, acc[mt][nt][4 * i4 + 3] * 0.0625f);
              *(uint2*)(KT + ((size_t)((b * 4 + hd) * 256 + d)) * 256 + s) = v;
            }
          }
        }
    } else if (ntile < 32) {
      const int cb = n0 - 2048;
#pragma unroll
      for (int mt = 0; mt < 2; ++mt)
#pragma unroll
        for (int nt = 0; nt < 2; ++nt) {
          const int vc = cb + CL(nt);
#pragma unroll
          for (int i4 = 0; i4 < 4; ++i4) {
            const int tok0 = m0 + RW(mt, 4 * i4);
            uint2 v;
            v.x = pack2(acc[mt][nt][4 * i4], acc[mt][nt][4 * i4 + 1]);
            v.y = pack2(acc[mt][nt][4 * i4 + 2], acc[mt][nt][4 * i4 + 3]);
            { const int cq = (tok0 & 31) >> 2; *(uint2*)(VT + ((size_t)(tok0 >> 5) * 2048 + vc) * 32 + (((cq & 3) * 2 + (cq >> 2)) * 4)) = v; }
            if (tok0 < NCTX) *(uint2*)(VTC + ((size_t)(tok0 >> 8) * 2048 + vc) * 256 + (tok0 & 255)) = v;
          }
        }
    } else {
      if (wn_ == 0 && rr_ < 16) {
        const int g = rr_;
        const float bg = P.b_gate[l * 16 + g];
        const bool isf = (g >> 2) & 1;
#pragma unroll
        for (int mt = 0; mt < 2; ++mt)
#pragma unroll
          for (int i = 0; i < 16; ++i) {
            float v = acc[mt][0][i] + bg;
            if (isf) v = logsigmoidf_(v);
            GATES[(size_t)(m0 + RW(mt, i)) * 16 + g] = v;
          }
      }
    }
  }
}

DI float wave_excl_sum(float v, int lane) {
  float x = v;
#pragma unroll
  for (int o = 1; o < 64; o <<= 1) { const float y = __shfl_up(x, o, 64); if (lane >= o) x += y; }
  return x - v;
}
DI float wave_excl_max(float v, int lane, float init) {
  float x = v;
#pragma unroll
  for (int o = 1; o < 64; o <<= 1) { const float y = __shfl_up(x, o, 64); if (lane >= o) x = fmaxf(x, y); }
  const float p = __shfl_up(x, 1, 64);
  return lane == 0 ? init : fmaxf(init, p);
}

template <int E>
DI void scan_wave(const Params& P, int l, int sid) {
  const int lane = tid_() & 63;
  const int dir = sid & 1, hd = (sid >> 1) & 3, seq = sid >> 3;
  const bool lat = seq >= 16;
  const int S = E * 64;
  const int tok0 = lat ? NCTX + (seq - 16) * 1024 : seq * 256;
  const float* G = (const float*)(P.ws + OFF_GATES);
  const size_t gi = (size_t)(dir * 4 + hd) * NTOK;
  float* BETA = (float*)(P.ws + OFF_BETA) + gi;
  float* MM = (float*)(P.ws + OFF_MM) + gi;
  float* EMT = (float*)(P.ws + OFF_EMT) + gi;
  float* WFIN = (float*)(P.ws + OFF_WFIN) + gi;
  const int gi_i = dir * 8 + hd, gi_f = dir * 8 + 4 + hd;
  const float m0 = lat ? P.state_m[(((seq - 16) * 4 + l) * 2 + dir) * 4 + hd] : 0.f;
  float tot = 0.f;
#pragma unroll
  for (int e = 0; e < E; ++e) {
    const int j = lane * E + e, tok = dir == 0 ? tok0 + j : tok0 + S - 1 - j;
    tot += G[(size_t)tok * 16 + gi_f];
  }
  const float boff = wave_excl_sum(tot, lane);
  float b = boff, cmax = -3.0e38f;
#pragma unroll
  for (int e = 0; e < E; ++e) {
    const int j = lane * E + e, tok = dir == 0 ? tok0 + j : tok0 + S - 1 - j;
    b += G[(size_t)tok * 16 + gi_f];
    const float be = G[(size_t)tok * 16 + gi_i] - b;
    BETA[tok] = be;
    cmax = fmaxf(cmax, be);
  }
  float M = wave_excl_max(cmax, lane, m0);
  b = boff;
#pragma unroll
  for (int e = 0; e < E; ++e) {
    const int j = lane * E + e, tok = dir == 0 ? tok0 + j : tok0 + S - 1 - j;
    b += G[(size_t)tok * 16 + gi_f];
    const float be = G[(size_t)tok * 16 + gi_i] - b;
    M = fmaxf(M, be);
    MM[tok] = M;
    EMT[tok] = __expf(-b - M);
  }
  if (!lat) {
    const float Mlast = __shfl(M, 63, 64);
    const float Blast = __shfl(b, 63, 64);
    if (lane == 0) P.out[OUT_NEWM + (((seq * 4 + l) * 2 + dir) * 4 + hd)] = Blast + Mlast;
    b = boff;
  #pragma unroll
  for (int e = 0; e < E; ++e) {
      const int j = lane * E + e, tok = dir == 0 ? tok0 + j : tok0 + S - 1 - j;
      b += G[(size_t)tok * 16 + gi_f];
      const float be = G[(size_t)tok * 16 + gi_i] - b;
      WFIN[tok] = __expf(be - Mlast);
    }
  }
}

DI void convert_c0(const Params& P, int l) {
  bf16_t* C0T = (bf16_t*)(P.ws + OFF_C0T);
  const int total = 64 * 512 * 32;
  for (int e = bid_() * 256 + tid_(); e < total; e += gridDim.x * 256) {
    const int j = e & 31, v = (e >> 5) & 511, sp = e >> 14;
    const int b = sp >> 3, dir = (sp >> 2) & 1, hd = sp & 3;
    const float* src = P.state_C + ((size_t)((((b * 4 + l) * 2 + dir) * 4 + hd) * 512 + v)) * 256 + j * 8;
    const float4 x0 = *(const float4*)src, x1 = *(const float4*)(src + 4);
    uint4 o;
    o.x = pack2(x0.x, x0.y); o.y = pack2(x0.z, x0.w); o.z = pack2(x1.x, x1.y); o.w = pack2(x1.z, x1.w);
    *(uint4*)(C0T + ((size_t)((sp * 2 + (v >> 8)) * 8 + (j >> 2)) * 256 + (v & 255)) * 32 + (j & 3) * 8) = o;
  }
}

DI void phase_scan_four1(const Params& P, int l, unsigned char* smem) {
  convert_c0(P, l);
  const bf16_t* UF = (const bf16_t*)(P.ws + OFF_UF);
  const bf16_t* BC = (const bf16_t*)(P.ws + OFF_BC);
  bf16_t* TT = (bf16_t*)(P.ws + OFF_TT);
  for (int it = bid_(); it < 48 + 1536; it += gridDim.x) {
    if (it < 48) { const int sid = it * 4 + (tid_() >> 6); if (sid < 128) scan_wave<4>(P, l, sid); else scan_wave<16>(P, l, sid); continue; }
    const int t = it - 48, g = t / 384, rem = t - g * 384;
    int mtile, ntile;
    tile_decode(rem, 96, 4, mtile, ntile);
    const int m0 = mtile * 128, n0 = ntile * 128;
    f32x16 acc[2][2];
    acc_zero(acc);
    gemm_mainloop<false>(acc, UF + (size_t)m0 * 1024 + g * 256, 1024, BC + (size_t)n0 * 256, 256, 256, nullptr, smem);
    EPI_VARS;
#pragma unroll
    for (int mt = 0; mt < 2; ++mt)
#pragma unroll
      for (int nt = 0; nt < 2; ++nt) {
        const int n = n0 + CL(nt), cs = n >> 8, ch = n & 255;
#pragma unroll
        for (int i4 = 0; i4 < 4; ++i4) {
          const int tok0 = m0 + RW(mt, 4 * i4);
          uint2 v;
          v.x = pack2(acc[mt][nt][4 * i4], acc[mt][nt][4 * i4 + 1]);
          v.y = pack2(acc[mt][nt][4 * i4 + 2], acc[mt][nt][4 * i4 + 3]);
          size_t idx;
          if (tok0 < NCTX) idx = ((size_t)(((tok0 >> 8) * 4 + g) * 256 + ch)) * 512 + cs * 256 + (tok0 & 255);
          else { const int tl = tok0 - NCTX; idx = TT_LAT + ((size_t)(((tl >> 10) * 4 + g) * 256 + ch)) * 2048 + cs * 1024 + (tl & 1023); }
          *(uint2*)(TT + idx) = v;
        }
      }
  }
}

DI void mlstm_item(const Params& P, int l, int seq, int hd, int qb, int vh, unsigned char* smem) {
  const int tid = tid_(), lane = tid & 63, w = tid >> 6, c = lane & 15, q = lane >> 4;
  const bool lat = seq >= 16;
  const int S = lat ? 1024 : 256;
  const int tok0 = lat ? NCTX + (seq - 16) * 1024 : seq * 256;
  const int bl = seq - 16;
  const bf16_t* Qg = (const bf16_t*)(P.ws + OFF_Q);
  const bf16_t* Kg = (const bf16_t*)(P.ws + OFF_K);
  const bf16_t* VT = (const bf16_t*)(P.ws + OFF_VT) + ((size_t)(tok0 >> 5) * 2048 + hd * 512 + vh * 256) * 32;
  unsigned char* sK = smem;
  unsigned char* sV = smem + 16896;
  const int t_loc = qb * 64 + w * 16 + c;
  const int tokq = tok0 + t_loc;
  bf16x8 qf[8];
  {
    const bf16_t* qp = Qg + (size_t)tokq * 1024 + hd * 256 + q * 8;
#pragma unroll
    for (int kk = 0; kk < 8; ++kk) qf[kk] = *(const bf16x8*)(qp + kk * 32);
#pragma unroll
    for (int kk = 0; kk < 8; ++kk) asm volatile("" : "+v"(qf[kk]));
  }
  __syncthreads();
  const int nkb = S >> 5;
  const size_t rowbase = (size_t)(tok0 + qb * 64 + w * 16 + 4 * q) * 2048 + hd * 512 + vh * 256 + c;
  const bf16_t* kld = Kg + ((size_t)(tok0 >> 5) * 4 + hd) * 8192 + tid * 8;
  unsigned char* ksd = sK + (tid >> 5) * 528 + (tid & 31) * 16;
  const bf16_t* vld = VT + tid * 8;
  unsigned char* vsd = sV + (tid >> 2) * 96 + (tid & 3) * 16;
  u32x4 st[8], bt[2], btn[2];
#define STWAIT() asm volatile("s_waitcnt vmcnt(0)" : "+v"(st[0]), "+v"(st[1]), "+v"(st[2]), "+v"(st[3]), "+v"(st[4]), "+v"(st[5]), "+v"(st[6]), "+v"(st[7]), "+v"(btn[0]), "+v"(btn[1]) : : "memory")
#define ISSUE_KV(kb_)                                                                      \
  {                                                                                        \
    const bf16_t* kp_ = kld + (size_t)(kb_) * 4 * 8192;                                    \
    const bf16_t* vp_ = vld + (size_t)(kb_) * 2048 * 32;                                   \
    _Pragma("unroll") for (int i = 0; i < 4; ++i) st[i] = gld16(kp_ + i * 2048);           \
    _Pragma("unroll") for (int i = 0; i < 4; ++i) st[4 + i] = gld16(vp_ + i * 2048);       \
    btn[0] = gld16(BETA + (kb_) * 32);                                                     \
    btn[1] = gld16(BETA + (kb_) * 32 + 16);                                                \
  }
#define STORE_KV()                                                                         \
  {                                                                                        \
    _Pragma("unroll") for (int i = 0; i < 4; ++i) *(u32x4*)(ksd + i * 8 * 528) = st[i];    \
    _Pragma("unroll") for (int i = 0; i < 4; ++i) *(u32x4*)(vsd + i * 64 * 96) = st[4 + i];\
    bt[0] = btn[0]; bt[1] = btn[1];                                                        \
  }
#define ISSUE_C0(kk_) { _Pragma("unroll") for (int i = 0; i < 4; ++i) st[4 + i] = gld16(C0 + (kk_) * 8192 + i * 2048); }
#define STORE_C0() { _Pragma("unroll") for (int i = 0; i < 4; ++i) *(u32x4*)(vsd + i * 64 * 96) = st[4 + i]; }
#pragma unroll 1
  for (int dir = 0; dir < 2; ++dir) {
    f32x4 acc[16];
#pragma unroll
    for (int n = 0; n < 16; ++n) acc[n] = (f32x4){0.f, 0.f, 0.f, 0.f};
    float den = 0.f;
    const size_t gi = (size_t)(dir * 4 + hd) * NTOK;
    const float* BETA = (const float*)(P.ws + OFF_BETA) + gi + tok0 + 4 * q;
    const float Mt = ((const float*)(P.ws + OFF_MM))[gi + tokq];
    const float emt = ((const float*)(P.ws + OFF_EMT))[gi + tokq];
    const int kb_lo = dir == 0 ? 0 : 2 * qb;
    const int kb_hi = dir == 0 ? 2 * qb + 1 : nkb - 1;
    asm volatile("" : : "v"(Mt), "v"(emt));
    btn[0] = btn[1] = (u32x4){0u, 0u, 0u, 0u};
    st[0] = st[1] = st[2] = st[3] = (u32x4){0u, 0u, 0u, 0u};
    if (lat) {
      const int sidx = ((bl * 4 + l) * 2 + dir) * 4 + hd;
      const float inter = __expf(P.state_m[sidx] - Mt);
      const bf16_t* C0 = (const bf16_t*)(P.ws + OFF_C0T) + ((size_t)(((bl * 2 + dir) * 4 + hd) * 2 + vh) * 8) * 8192 + tid * 8;
      float* sN = (float*)(smem + 71168);
      float sdot = 0.f;
      __syncthreads();
      {
        const float nv = P.state_n[(size_t)sidx * 256 + tid];
        sN[tid] = nv;
      }
      asm volatile("" : : "v"(inter));
      const float* n0p = sN + q * 8;
      ISSUE_C0(0);
      STWAIT();
      STORE_C0();
      __syncthreads();
#pragma unroll
      for (int kk = 0; kk < 8; ++kk) {
        const int kn = kk < 7 ? kk + 1 : 7;
        ISSUE_C0(kn);
        const bf16x8 qk = qf[kk];
#pragma unroll
        for (int e = 0; e < 8; ++e) sdot += bf2f((unsigned)(unsigned short)qk[e]) * n0p[kk * 32 + e];
        {
          bf16x8 fb[2][4];
          const unsigned char* vb_ = sV + c * 96 + q * 16;
#pragma unroll
          for (int j = 0; j < 4; ++j) fb[0][j] = *(const bf16x8*)(vb_ + j * 16 * 96);
#pragma unroll
          for (int g = 0; g < 4; ++g) {
            if (g < 3) {
#pragma unroll
              for (int j = 0; j < 4; ++j) fb[(g + 1) & 1][j] = *(const bf16x8*)(vb_ + ((g + 1) * 4 + j) * 16 * 96);
            }
#pragma unroll
            for (int j = 0; j < 4; ++j) acc[g * 4 + j] = MFMA16(qk, fb[g & 1][j], acc[g * 4 + j]);
            __builtin_amdgcn_sched_barrier(0);
          }
        }
        STWAIT();
        __syncthreads();
        STORE_C0();
        __syncthreads();
      }
      float it_[4];
#pragma unroll
      for (int j = 0; j < 4; ++j) it_[j] = __shfl(inter, 4 * q + j, 64);
#pragma unroll
      for (int n = 0; n < 16; ++n)
#pragma unroll
        for (int j = 0; j < 4; ++j) acc[n][j] *= it_[j];
      den = inter * sdot;
    }
    __syncthreads();
    ISSUE_KV(kb_lo);
    STWAIT();
    STORE_KV();
    __syncthreads();
#pragma unroll 1
    for (int kb = kb_lo; kb <= kb_hi; ++kb) {
      const int kbn = kb < kb_hi ? kb + 1 : kb_hi;
      ISSUE_KV(kbn);
      const float bb0[4] = {__uint_as_float(bt[0].x), __uint_as_float(bt[0].y), __uint_as_float(bt[0].z), __uint_as_float(bt[0].w)};
      const float bb1[4] = {__uint_as_float(bt[1].x), __uint_as_float(bt[1].y), __uint_as_float(bt[1].z), __uint_as_float(bt[1].w)};
      f32x4 x0 = (f32x4){0.f, 0.f, 0.f, 0.f}, x1 = (f32x4){0.f, 0.f, 0.f, 0.f};
      {
        bf16x8 fa0[2], fa1[2];
        const unsigned char* k0_ = sK + c * 528 + q * 16;
        fa0[0] = *(const bf16x8*)(k0_); fa1[0] = *(const bf16x8*)(k0_ + 16 * 528);
#pragma unroll
        for (int kk = 0; kk < 8; ++kk) {
          if (kk < 7) {
            fa0[(kk + 1) & 1] = *(const bf16x8*)(k0_ + (kk + 1) * 64);
            fa1[(kk + 1) & 1] = *(const bf16x8*)(k0_ + 16 * 528 + (kk + 1) * 64);
          }
          x0 = MFMA16(fa0[kk & 1], qf[kk], x0);
          x1 = MFMA16(fa1[kk & 1], qf[kk], x1);
          __builtin_amdgcn_sched_barrier(0);
        }
      }
      float p0[4], p1[4];
      const bool diag = (kb >> 1) == qb;
      if (diag) {
#pragma unroll
        for (int j = 0; j < 4; ++j) {
          const int s0 = kb * 32 + 4 * q + j, s1 = s0 + 16;
          const bool ok0 = dir == 0 ? (s0 <= t_loc) : (s0 >= t_loc);
          const bool ok1 = dir == 0 ? (s1 <= t_loc) : (s1 >= t_loc);
          p0[j] = ok0 ? x0[j] * __expf(bb0[j] - Mt) : 0.f;
          p1[j] = ok1 ? x1[j] * __expf(bb1[j] - Mt) : 0.f;
          den += p0[j] + p1[j];
        }
      } else {
#pragma unroll
        for (int j = 0; j < 4; ++j) {
          p0[j] = x0[j] * __expf(bb0[j] - Mt);
          p1[j] = x1[j] * __expf(bb1[j] - Mt);
          den += p0[j] + p1[j];
        }
      }
      uint4 pu;
      pu.x = pack2(p0[0], p0[1]); pu.y = pack2(p0[2], p0[3]); pu.z = pack2(p1[0], p1[1]); pu.w = pack2(p1[2], p1[3]);
      const bf16x8 pa = __builtin_bit_cast(bf16x8, pu);
      {
        bf16x8 fv[2][4];
        const unsigned char* vb_ = sV + c * 96 + q * 16;
#pragma unroll
        for (int j = 0; j < 4; ++j) fv[0][j] = *(const bf16x8*)(vb_ + j * 16 * 96);
#pragma unroll
        for (int g = 0; g < 4; ++g) {
          if (g < 3) {
#pragma unroll
            for (int j = 0; j < 4; ++j) fv[(g + 1) & 1][j] = *(const bf16x8*)(vb_ + ((g + 1) * 4 + j) * 16 * 96);
          }
#pragma unroll
          for (int j = 0; j < 4; ++j) acc[g * 4 + j] = MFMA16(pa, fv[g & 1][j], acc[g * 4 + j]);
          __builtin_amdgcn_sched_barrier(0);
        }
      }
      STWAIT();
      __syncthreads();
      STORE_KV();
      __syncthreads();
    }
    den += __shfl_xor(den, 16, 64);
    den += __shfl_xor(den, 32, 64);
    const float rinv = 1.f / fmaxf(fabsf(den), emt);
    float rj[4];
#pragma unroll
    for (int j = 0; j < 4; ++j) rj[j] = __shfl(rinv, 4 * q + j, 64);
    bf16_t* HS = (bf16_t*)(P.ws + OFF_H0) + rowbase;
    asm volatile("" : "+v"(HS));
    bf16_t* h0p = HS; bf16_t* h1p = HS + 2048; bf16_t* h2p = HS + 4096; bf16_t* h3p = HS + 6144;
    asm volatile("" : "+v"(h1p));
    asm volatile("" : "+v"(h2p));
    asm volatile("" : "+v"(h3p));
    if (dir == 0) {
#pragma unroll
      for (int n = 0; n < 16; ++n) {
        h0p[n * 16] = (bf16_t)f2bf(acc[n][0] * rj[0]);
        h1p[n * 16] = (bf16_t)f2bf(acc[n][1] * rj[1]);
        h2p[n * 16] = (bf16_t)f2bf(acc[n][2] * rj[2]);
        h3p[n * 16] = (bf16_t)f2bf(acc[n][3] * rj[3]);
      }
    } else {
#pragma unroll
      for (int n = 0; n < 16; ++n) {
        h0p[n * 16] = (bf16_t)f2bf(acc[n][0] * rj[0] + bf2f(h0p[n * 16]));
        h1p[n * 16] = (bf16_t)f2bf(acc[n][1] * rj[1] + bf2f(h1p[n * 16]));
        h2p[n * 16] = (bf16_t)f2bf(acc[n][2] * rj[2] + bf2f(h2p[n * 16]));
        h3p[n * 16] = (bf16_t)f2bf(acc[n][3] * rj[3] + bf2f(h3p[n * 16]));
        if ((n & 3) == 3) __builtin_amdgcn_sched_barrier(0);
      }
    }
  }
}

#undef STWAIT
#undef ISSUE_KV
#undef ISSUE_C0
#undef STORE_KV
#undef STORE_C0

DI void phase_hn(const Params& P, int l) {
  const bf16_t* HS = (const bf16_t*)(P.ws + OFF_H0);
  const bf16_t* OG = (const bf16_t*)(P.ws + OFF_OG);
  bf16_t* HN = (bf16_t*)(P.ws + OFF_HN);
  const int tidl_ = tid_(), lane = tidl_ & 63, w = tidl_ >> 6;
  for (int pr = bid_() * 4 + w; pr < NTOK * 4; pr += gridDim.x * 4) {
    const size_t base = (size_t)pr * 512 + lane * 8;
    const uint4 hv = *(const uint4*)(HS + base);
    const uint4 ov = *(const uint4*)(OG + base);
    const unsigned hu[4] = {hv.x, hv.y, hv.z, hv.w}, ou[4] = {ov.x, ov.y, ov.z, ov.w};
    float x[8];
    float s = 0.f;
#pragma unroll
    for (int i = 0; i < 4; ++i) { x[2 * i] = bf2f(hu[i] & 0xffffu); x[2 * i + 1] = bf2f(hu[i] >> 16); s += x[2 * i] + x[2 * i + 1]; }
#pragma unroll
    for (int o = 1; o < 64; o <<= 1) s += __shfl_xor(s, o, 64);
    const float mu = s * (1.f / 512.f);
    float vs = 0.f;
#pragma unroll
    for (int i = 0; i < 8; ++i) { const float d = x[i] - mu; vs += d * d; }
#pragma unroll
    for (int o = 1; o < 64; o <<= 1) vs += __shfl_xor(vs, o, 64);
    const float rs = rsqrtf(vs * (1.f / 512.f) + LN_EPS);
    const float* gp = P.mh_gain + l * 2048 + (pr & 3) * 512 + lane * 8;
    const float4 g0 = *(const float4*)gp, g1 = *(const float4*)(gp + 4);
    const float g[8] = {g0.x, g0.y, g0.z, g0.w, g1.x, g1.y, g1.z, g1.w};
    unsigned r[4];
#pragma unroll
    for (int i = 0; i < 4; ++i)
      r[i] = pack2((x[2 * i] - mu) * rs * g[2 * i] * bf2f(ou[i] & 0xffffu), (x[2 * i + 1] - mu) * rs * g[2 * i + 1] * bf2f(ou[i] >> 16));
    *(uint4*)(HN + base) = make_uint4(r[0], r[1], r[2], r[3]);
  }
}

DI void phase_mixers(const Params& P, int l, unsigned char* smem) {
  const bf16_t* VTC = (const bf16_t*)(P.ws + OFF_VTC);
  const bf16_t* KT = (const bf16_t*)(P.ws + OFF_KT);
  const bf16_t* Kn = (const bf16_t*)(P.ws + OFF_K);
  const bf16_t* TT = (const bf16_t*)(P.ws + OFF_TT);
  const bf16_t* A256 = (const bf16_t*)(P.ws + OFF_A256);
  const bf16_t* A1024 = (const bf16_t*)(P.ws + OFF_A1024);
  const float* WFIN = (const float*)(P.ws + OFF_WFIN);
  bf16_t* FB = (bf16_t*)(P.ws + OFF_FB);
  for (int it0 = bid_(); it0 < 1024 + 2304; it0 += gridDim.x) {
    if (it0 < 1024) { mlstm_item(P, l, 16 + (it0 >> 7), (it0 >> 5) & 3, (it0 >> 1) & 15, it0 & 1, smem); continue; }
    const int r = it0 - 1024;
    if (r >= 512 && r < 1024) { const int j = r - 512; mlstm_item(P, l, j >> 5, (j >> 3) & 3, (j >> 1) & 3, j & 1, smem); continue; }
    f32x16 acc[2][2];
    acc_zero(acc);
    if (r < 512) {
      const int j = r, sg = j >> 4, mtile = (j >> 1) & 7, ntile = j & 1;
      gemm_mainloop<false>(acc, A1024 + (size_t)mtile * 128 * 2048, 2048, TT + TT_LAT + ((size_t)sg * 256 + ntile * 128) * 2048, 2048, 2048, nullptr, smem);
      EPI_VARS;
      const int seq = sg >> 2, g = sg & 3;
#pragma unroll
      for (int mt = 0; mt < 2; ++mt)
#pragma unroll
        for (int nt = 0; nt < 2; ++nt)
#pragma unroll
          for (int i = 0; i < 16; ++i)
            FB[(size_t)(NCTX + seq * 1024 + mtile * 128 + RW(mt, i)) * 1024 + g * 256 + ntile * 128 + CL(nt)] = (bf16_t)f2bf(acc[mt][nt][i] * (1.f / 512.f));
    } else if (r >= 2048) {
      const int j = r - 2048, sg = j >> 2, mtile = (j >> 1) & 1, ntile = j & 1;
      gemm_mainloop<false>(acc, A256 + (size_t)mtile * 128 * 512, 512, TT + ((size_t)sg * 256 + ntile * 128) * 512, 512, 512, nullptr, smem);
      EPI_VARS;
      const int seq = sg >> 2, g = sg & 3;
#pragma unroll
      for (int mt = 0; mt < 2; ++mt)
#pragma unroll
        for (int nt = 0; nt < 2; ++nt)
#pragma unroll
          for (int i = 0; i < 16; ++i)
            FB[(size_t)(seq * 256 + mtile * 128 + RW(mt, i)) * 1024 + g * 256 + ntile * 128 + CL(nt)] = (bf16_t)f2bf(acc[mt][nt][i] * (1.f / 256.f));
    } else {
      const int j = r - 1024, bhd = j >> 3, mtile = (j >> 1) & 3, ntile = j & 1;
      const int b = bhd >> 3, hd = (bhd >> 1) & 3, dir = bhd & 1;
      const float* wf = WFIN + (size_t)(dir * 4 + hd) * NTOK + b * 256;
      gemm_mainloop<true>(acc, VTC + ((size_t)b * 2048 + hd * 512 + mtile * 128) * 256, 256, KT + ((size_t)(b * 4 + hd) * 256 + ntile * 128) * 256, 256, 256, wf, smem);
      EPI_VARS;
      const size_t sidx = (size_t)(((b * 4 + l) * 2 + dir) * 4 + hd);
      float* Co = P.out + OUT_NEWC + sidx * 512 * 256;
#pragma unroll
      for (int mt = 0; mt < 2; ++mt)
#pragma unroll
        for (int nt = 0; nt < 2; ++nt)
#pragma unroll
          for (int i = 0; i < 16; ++i) Co[(size_t)(mtile * 128 + RW(mt, i)) * 256 + ntile * 128 + CL(nt)] = acc[mt][nt][i];
      if (mtile == 0) {
        const int d = ntile * 128 + (tid_e_ & 127), half = tid_e_ >> 7;
        const bf16_t* kp = Kn + ((size_t)((b * 256 + half * 128) >> 5) * 4 + hd) * 8192 + d;
        const float* wp = wf + half * 128;
        float s = 0.f;
#pragma unroll 1
        for (int kb4 = 0; kb4 < 4; ++kb4) {
#pragma unroll 8
          for (int sp = 0; sp < 32; ++sp) s += wp[kb4 * 32 + sp] * bf2f(kp[(size_t)kb4 * 4 * 8192 + sp * 256]);
        }
        float* red = (float*)smem;
        __syncthreads();
        red[tid_e_] = s;
        __syncthreads();
        if (tid_e_ < 128) P.out[OUT_NEWN + sidx * 256 + d] = red[tid_e_] + red[tid_e_ + 128];
        __syncthreads();
      }
    }
  }
}

DI void phase_branch(const Params& P, int l, unsigned char* smem) {
  const unsigned char* slot = P.ws + (size_t)(l & 1) * SZ_SLOT;
  const bf16_t* HN = (const bf16_t*)(P.ws + OFF_HN);
  const bf16_t* FB = (const bf16_t*)(P.ws + OFF_FB);
  const bf16_t* WA = (const bf16_t*)(slot + WS_WA);
  const bf16_t* WB = (const bf16_t*)(slot + WS_WB);
  const bf16_t* GA = (const bf16_t*)(P.ws + OFF_GA);
  const bf16_t* GB = (const bf16_t*)(P.ws + OFF_GB);
  bf16_t* MG = (bf16_t*)(P.ws + OFF_MERGED);
  for (int t = vblock(); t < 64 * 8; t += gridDim.x) {
    int mtile, ntile;
    tile_decode(t, 64, 8, mtile, ntile);
    const int m0 = mtile * 192, n0 = ntile * 128;
    f32x16 acc[3][2];
    acc_zero3(acc);
    gemm192_mainloop(acc, HN + (size_t)m0 * 2048, 2048, WA + (size_t)n0 * 2048, 2048, 2048, smem);
    const bf16_t* GAb = GA + (size_t)m0 * 1024 + n0;
    const bf16_t* GBb = GB + (size_t)m0 * 1024 + n0;
    bf16_t* MGb = MG + (size_t)m0 * 1024 + n0;
    {
      EPI_VARS;
#pragma unroll
      for (int mt = 0; mt < 3; ++mt)
#pragma unroll
        for (int nt = 0; nt < 2; ++nt)
#pragma unroll
          for (int i = 0; i < 16; ++i) {
            const unsigned o = (unsigned)RW3(mt, i) * 1024u + CL(nt);
            MGb[o] = (bf16_t)f2bf(bf2f(GAb[o]) * acc[mt][nt][i]);
          }
    }
    acc_zero3(acc);
    gemm192_mainloop(acc, FB + (size_t)m0 * 1024, 1024, WB + (size_t)n0 * 1024, 1024, 1024, smem);
    EPI_VARS;
#pragma unroll
    for (int mt = 0; mt < 3; ++mt)
#pragma unroll
      for (int nt = 0; nt < 2; ++nt)
#pragma unroll
        for (int i = 0; i < 16; ++i) {
          const unsigned o = (unsigned)RW3(mt, i) * 1024u + CL(nt);
          MGb[o] = (bf16_t)f2bf(bf2f(MGb[o]) + bf2f(GBb[o]) * acc[mt][nt][i]);
        }
  }
}

DI void phase_resid_gemm(const Params& P, int l, const bf16_t* A, int K, const bf16_t* W, int goff, unsigned char* smem) {
  const float* X = (const float*)(P.ws + OFF_XRES);
  const float* MOD = (const float*)(P.ws + OFF_MOD) + (size_t)l * 9 * 6144;
  float* PRE = (float*)(P.ws + OFF_PRELN);
  for (int t = vblock(); t < 64 * 8; t += gridDim.x) {
    int mtile, ntile;
    tile_decode(t, 64, 8, mtile, ntile);
    const int m0 = mtile * 192, n0 = ntile * 128;
    f32x16 acc[3][2];
    acc_zero3(acc);
    gemm192_mainloop(acc, A + (size_t)m0 * K, K, W + (size_t)n0 * K, K, K, smem);
    EPI_VARS;
    const float* Xb = X + (size_t)m0 * 1024 + n0;
    float* PREb = PRE + (size_t)m0 * 1024 + n0;
#pragma unroll
    for (int mt = 0; mt < 3; ++mt)
#pragma unroll
      for (int nt = 0; nt < 2; ++nt)
#pragma unroll
        for (int i = 0; i < 16; ++i) {
          const int row = RW3(mt, i);
          const unsigned o = (unsigned)row * 1024u + CL(nt);
          const float gv = MOD[(size_t)mod_index(m0 + row) * 6144 + goff + n0 + CL(nt)];
          PREb[o] = ALPHA * Xb[o] + gv * acc[mt][nt][i];
        }
  }
}

DI void phase_ln(const Params& P, const float* gain, const float* bias, float* xdst, const float* modn, int shoff, int scoff) {
  const float* PRE = (const float*)(P.ws + OFF_PRELN);
  bf16_t* H = (bf16_t*)(P.ws + OFF_HMOD);
  const int tidl_ = tid_(), lane = tidl_ & 63, w = tidl_ >> 6;
  for (int tok = bid_() * 4 + w; tok < NTOK; tok += gridDim.x * 4) {
    float4 v[4];
    float s = 0.f;
#pragma unroll
    for (int i = 0; i < 4; ++i) {
      v[i] = *(const float4*)(PRE + (size_t)tok * 1024 + (i * 64 + lane) * 4);
      s += v[i].x + v[i].y + v[i].z + v[i].w;
    }
#pragma unroll
    for (int o = 1; o < 64; o <<= 1) s += __shfl_xor(s, o, 64);
    const float mu = s * (1.f / 1024.f);
    float vs = 0.f;
#pragma unroll
    for (int i = 0; i < 4; ++i) {
      const float a = v[i].x - mu, b = v[i].y - mu, c = v[i].z - mu, d = v[i].w - mu;
      vs += a * a + b * b + c * c + d * d;
    }
#pragma unroll
    for (int o = 1; o < 64; o <<= 1) vs += __shfl_xor(vs, o, 64);
    const float rs = rsqrtf(vs * (1.f / 1024.f) + LN_EPS);
    const float* m = modn ? modn + (size_t)mod_index(tok) * 6144 : nullptr;
#pragma unroll
    for (int i = 0; i < 4; ++i) {
      const int n = (i * 64 + lane) * 4;
      const float4 g = *(const float4*)(gain + n), b = *(const float4*)(bias + n);
      float4 x;
      x.x = (v[i].x - mu) * rs * g.x + b.x; x.y = (v[i].y - mu) * rs * g.y + b.y;
      x.z = (v[i].z - mu) * rs * g.z + b.z; x.w = (v[i].w - mu) * rs * g.w + b.w;
      *(float4*)(xdst + (size_t)tok * 1024 + n) = x;
      if (m) {
        const float4 sh = *(const float4*)(m + shoff + n), sc = *(const float4*)(m + scoff + n);
        uint2 o;
        o.x = pack2(x.x * (1.f + sc.x) + sh.x, x.y * (1.f + sc.y) + sh.y);
        o.y = pack2(x.z * (1.f + sc.z) + sh.z, x.w * (1.f + sc.w) + sh.w);
        *(uint2*)(H + (size_t)tok * 1024 + n) = o;
      }
    }
  }
}

DI void phase_ffn_in(const Params& P, int l, unsigned char* smem) {
  const bf16_t* H = (const bf16_t*)(P.ws + OFF_HMOD);
  const bf16_t* W = (const bf16_t*)(P.ws + (size_t)(l & 1) * SZ_SLOT + WS_WF1);
  bf16_t* FF = (bf16_t*)(P.ws + OFF_FF);
  for (int t = vblock(); t < 96 * 44; t += gridDim.x) {
    int mtile, ntile;
    tile_decode(t, 96, 44, mtile, ntile);
    const int m0 = mtile * 128, n0 = ntile * 128;
    f32x16 acc[2][2];
    acc_zero(acc);
    gemm_mainloop<false>(acc, H + (size_t)m0 * 1024, 1024, W + (size_t)n0 * 1024, 1024, 1024, nullptr, smem);
    EPI_VARS;
#pragma unroll
    for (int mt = 0; mt < 2; ++mt)
#pragma unroll
      for (int i = 0; i < 16; ++i) {
        const float a = acc[mt][0][i], u = acc[mt][1][i];
        *(unsigned short*)(smem + RW(mt, i) * 144 + (wn_ * 32 + rr_) * 2) = (unsigned short)f2bf(a * sigmoidf_(a) * u);
      }
    __syncthreads();
#pragma unroll
    for (int i = 0; i < 4; ++i) {
      const int row = (tid_e_ >> 3) + 32 * i, ch = tid_e_ & 7;
      const u32x4 x = *(const u32x4*)(smem + row * 144 + ch * 16);
      *(u32x4*)(FF + (size_t)(m0 + row) * DFF + ntile * 64 + ch * 8) = x;
    }
    __syncthreads();
  }
}

template <int S>
DI void run_phase(const Params& P, int l, unsigned char* smem) {
  const unsigned char* slot = P.ws + (size_t)(l & 1) * SZ_SLOT;
  const float* MOD = (const float*)(P.ws + OFF_MOD);
  if constexpr (S == 0) phase_setup(P, smem);
  else if constexpr (S == 1) phase_modreduce(P);
  else if constexpr (S == 2) phase_modulate0(P);
  else if constexpr (S == 3) phase_gemm_in(P, l, smem);
  else if constexpr (S == 4) phase_scan_four1(P, l, smem);
  else if constexpr (S == 5) phase_mixers(P, l, smem);
  else if constexpr (S == 6) phase_hn(P, l);
  else if constexpr (S == 7) phase_branch(P, l, smem);
  else if constexpr (S == 8) phase_resid_gemm(P, l, (const bf16_t*)(P.ws + OFF_MERGED), 1024, (const bf16_t*)(slot + WS_WO), 2048, smem);
  else if constexpr (S == 9) {
    phase_ln(P, P.ln_gain + (l * 2 + 0) * 1024, P.ln_bias + (l * 2 + 0) * 1024, (float*)(P.ws + OFF_XRES), MOD + (size_t)l * 9 * 6144, 3072, 4096);
    if (l + 1 < 4) convert_layer(P, l + 1, smem);
  } else if constexpr (S == 10) phase_ffn_in(P, l, smem);
  else if constexpr (S == 11) phase_resid_gemm(P, l, (const bf16_t*)(P.ws + OFF_FF), DFF, (const bf16_t*)(slot + WS_WF2), 5120, smem);
  else {
    if (l == 3) phase_ln(P, P.ln_gain + (l * 2 + 1) * 1024, P.ln_bias + (l * 2 + 1) * 1024, P.out, nullptr, 0, 0);
    else phase_ln(P, P.ln_gain + (l * 2 + 1) * 1024, P.ln_bias + (l * 2 + 1) * 1024, (float*)(P.ws + OFF_XRES), MOD + (size_t)(l + 1) * 9 * 6144, 0, 1024);
  }
}

#if !ONE_LAUNCH
template <int S>
__global__ void __launch_bounds__(256, 2) k_phase(Params P, int l) {
  __shared__ __attribute__((aligned(16))) unsigned char smem[SMEM_BYTES];
  run_phase<S>(P, l, smem);
}

#endif
#define XB_TMO      128
#define XB_XCNT(j)  (256  + 64 * (j))
#define XB_XSUB(j)  (1280 + 64 * (j))
#define XB_XGEN(j)  (2304 + 64 * (j))
#define XB_TOP      3328
#define XB_TOPGEN   3392
#define XCD_BAR_WORDS 3456
#define XB_SPIN_CAP (1u << 20)
#define LAS __attribute__((address_space(3)))
DI unsigned xb_ld(unsigned* p) { return __hip_atomic_load(p, __ATOMIC_RELAXED, __HIP_MEMORY_SCOPE_AGENT); }
DI unsigned xb_add(unsigned* p, unsigned v) { return __hip_atomic_fetch_add(p, v, __ATOMIC_RELAXED, __HIP_MEMORY_SCOPE_AGENT); }
DI unsigned xb_xcc_id() { return (unsigned)__builtin_amdgcn_s_getreg((3 << 11) | 20) & 0xFu; }
#define XB_SPIN(cond, bar) do { unsigned _sp = 0; while (cond) { __builtin_amdgcn_s_sleep(1); \
    if ((++_sp & 255u) == 0u) { if (xb_ld(&(bar)[XB_TMO])) break; if (_sp > XB_SPIN_CAP) { atomicAdd(&(bar)[XB_TMO], 1u); break; } } } } while (0)
DI void xcd_barrier_complete(unsigned* bar, unsigned x, unsigned& nloc, unsigned& nx) {
  const unsigned G = gridDim.x;
  unsigned sum, cnt, mine, sp = 0u;
  for (;;) {
    sum = 0u; cnt = 0u; mine = 0u;
#pragma unroll
    for (unsigned j = 0; j < 16; ++j) { const unsigned c = xb_ld(&bar[XB_XCNT(j)]); sum += c; cnt += (c > 0u) ? 1u : 0u; mine = (j == x) ? c : mine; }
    if (sum == G) break;
    __builtin_amdgcn_s_sleep(1);
    if ((++sp & 255u) == 0u) { if (xb_ld(&bar[XB_TMO])) break; if (sp > XB_SPIN_CAP) { atomicAdd(&bar[XB_TMO], 1u); break; } }
  }
  nloc = mine > 0u ? mine : 1u; nx = cnt > 0u ? cnt : 1u;
}
DI void xcd_barrier(unsigned* bar, volatile LAS unsigned* st) {
  asm volatile("s_waitcnt vmcnt(0)" ::: "memory");
  __syncthreads();
  if (threadIdx.x == 0) {
    const unsigned x = xb_xcc_id();
    __builtin_amdgcn_s_waitcnt(0);
    unsigned nloc = st[0], nx = st[1];
    if (nloc == 0u) { xcd_barrier_complete(bar, x, nloc, nx); st[0] = nloc; st[1] = nx; }
    const unsigned old = xb_add(&bar[XB_XSUB(x)], 1u);
    const unsigned gen = old / nloc;
    if (old + 1u == (gen + 1u) * nloc) {
      __builtin_amdgcn_fence(__ATOMIC_RELEASE, "agent");
      asm volatile("s_waitcnt vmcnt(0)" ::: "memory");
      const unsigned og = xb_add(&bar[XB_TOP], 1u);
      const unsigned tg = og / nx;
      if (og + 1u == (tg + 1u) * nx) xb_add(&bar[XB_TOPGEN], 1u);
      else XB_SPIN(xb_ld(&bar[XB_TOPGEN]) == tg, bar);
      __builtin_amdgcn_fence(__ATOMIC_ACQUIRE, "agent");
      xb_add(&bar[XB_XGEN(x)], 1u);
      asm volatile("s_waitcnt vmcnt(0)" ::: "memory");
    } else {
      XB_SPIN(xb_ld(&bar[XB_XGEN(x)]) == gen, bar);
      __builtin_amdgcn_fence(__ATOMIC_ACQUIRE, "agent");
      asm volatile("s_waitcnt vmcnt(0)" ::: "memory");
    }
  }
  __syncthreads();
}

#define GSYNC() xcd_barrier((unsigned*)(load_params().ws + OFF_BAR), xb_st)
DI Params load_params() {
  Params P{};
#if defined(__HIP_DEVICE_COMPILE__)
  typedef const unsigned long long __attribute__((address_space(4)))* KP;
  typedef float __attribute__((address_space(1)))* GF;
  KP kp = (KP)__builtin_amdgcn_kernarg_segment_ptr();
  asm volatile("" : "+s"(kp));
  P.x_prompt = (const float*)(GF)kp[0];
  P.x_sample = (const float*)(GF)kp[1];
  P.c = (const float*)(GF)kp[2];
  P.state_C = (const float*)(GF)kp[3];
  P.state_n = (const float*)(GF)kp[4];
  P.state_m = (const float*)(GF)kp[5];
  P.c_ctx = (const float*)(GF)kp[6];
  P.w_mod = (const float*)(GF)kp[7];
  P.b_mod = (const float*)(GF)kp[8];
  P.w_in = (const float*)(GF)kp[9];
  P.b_gate = (const float*)(GF)kp[10];
  P.mh_gain = (const float*)(GF)kp[11];
  P.w_a = (const float*)(GF)kp[12];
  P.w_b = (const float*)(GF)kp[13];
  P.w_out = (const float*)(GF)kp[14];
  P.ln_gain = (const float*)(GF)kp[15];
  P.ln_bias = (const float*)(GF)kp[16];
  P.w_f1 = (const float*)(GF)kp[17];
  P.w_f2 = (const float*)(GF)kp[18];
  P.out = (float*)(GF)kp[19];
  P.ws = (unsigned char*)(GF)kp[20];
#endif
  return P;
}
__global__ void __launch_bounds__(256, 2) fwd_kernel(Params Pk) {
  __shared__ __attribute__((aligned(16))) unsigned char smem[SMEM_BYTES];
  __shared__ uint4 xb_words;
  {
    unsigned* bar0 = (unsigned*)(load_params().ws + OFF_BAR);
    const unsigned x0 = xb_xcc_id();
    if (threadIdx.x == 0) {
      xb_words = make_uint4(0u, 0u, 0u, 0u);
      (void)xb_add(&bar0[XB_XCNT(x0)], 1u);
    }
  }
  __syncthreads();
  volatile LAS unsigned* xb_st = (volatile LAS unsigned*)&xb_words;
  run_phase<0>(load_params(), 0, smem);
  if (load_params().ws == nullptr) cg::this_grid().sync();
  GSYNC();
  run_phase<1>(load_params(), 0, smem); GSYNC();
  run_phase<2>(load_params(), 0, smem); GSYNC();
#pragma unroll 1
  for (int l = 0; l < 4; ++l) {
    run_phase<3>(load_params(), l, smem); GSYNC();
    run_phase<4>(load_params(), l, smem); GSYNC();
    run_phase<5>(load_params(), l, smem); GSYNC();
    run_phase<6>(load_params(), l, smem); GSYNC();
    run_phase<7>(load_params(), l, smem); GSYNC();
    run_phase<8>(load_params(), l, smem); GSYNC();
    run_phase<9>(load_params(), l, smem); GSYNC();
    run_phase<10>(load_params(), l, smem); GSYNC();
    run_phase<11>(load_params(), l, smem); GSYNC();
    run_phase<12>(load_params(), l, smem);
    if (l < 3) GSYNC();
  }
}

#if !ONE_LAUNCH
template <int S>
static void launch_phase(const Params& P, int l, int cus, hipStream_t stream) {
  int per_cu = 0;
  if (hipOccupancyMaxActiveBlocksPerMultiprocessor(&per_cu, k_phase<S>, 256, 0) != hipSuccess) per_cu = 1;
  if (per_cu > 2) per_cu = 2;
  if (per_cu < 1) per_cu = 1;
  int grid = cus * per_cu;
  grid -= grid % 8;
  hipLaunchKernelGGL(k_phase<S>, dim3(grid), dim3(256), 0, stream, P, l);
}

#endif
extern "C" void kernel_launch(void* const* d_in, const int* in_sizes, int n_in, void* d_out, int out_size, void* d_ws, size_t ws_size,
                              hipStream_t stream) {
  if (ws_size < WS_TOTAL) { fprintf(stderr, "workspace too small: %zu < %zu\n", ws_size, (size_t)WS_TOTAL); return; }
  Params P{};
  const float** pp = (const float**)&P;
  for (int i = 0; i < 19; ++i) pp[i] = (const float*)d_in[i];
  P.out = (float*)d_out;
  P.ws = (unsigned char*)d_ws;
  int dev = 0, cus = 256;
  if (hipGetDevice(&dev) != hipSuccess) dev = 0;
  if (hipDeviceGetAttribute(&cus, hipDeviceAttributeMultiprocessorCount, dev) != hipSuccess) cus = 256;
#if ONE_LAUNCH
  {
    static int grid_blocks = 0;
    if (!grid_blocks) {
      int per_cu = 0;
      if (hipOccupancyMaxActiveBlocksPerMultiprocessor(&per_cu, fwd_kernel, 256, 0) != hipSuccess) per_cu = 1;
      if (per_cu > 2) per_cu = 2;
      if (per_cu < 1) per_cu = 1;
      grid_blocks = cus * per_cu;
      grid_blocks -= grid_blocks % 8;
    }
    if (hipMemsetAsync((unsigned char*)d_ws + OFF_BAR, 0, 16384, stream) != hipSuccess) { fprintf(stderr, "memset of barrier words failed\n"); return; }
    void* args[] = {&P};
    hipError_t err = hipLaunchCooperativeKernel((void*)fwd_kernel, dim3(grid_blocks), dim3(256), args, 0, stream);
    if (err != hipSuccess) fprintf(stderr, "cooperative launch failed: %s (grid %d)\n", hipGetErrorString(err), grid_blocks);
    return;
  }
#endif
#if !ONE_LAUNCH
  launch_phase<0>(P, 0, cus, stream);
  launch_phase<1>(P, 0, cus, stream);
  launch_phase<2>(P, 0, cus, stream);
  for (int l = 0; l < 4; ++l) {
    launch_phase<3>(P, l, cus, stream);
    launch_phase<4>(P, l, cus, stream);
    launch_phase<5>(P, l, cus, stream);
    launch_phase<6>(P, l, cus, stream);
    launch_phase<7>(P, l, cus, stream);
    launch_phase<8>(P, l, cus, stream);
    launch_phase<9>(P, l, cus, stream);
    launch_phase<10>(P, l, cus, stream);
    launch_phase<11>(P, l, cus, stream);
    launch_phase<12>(P, l, cus, stream);
  }
#endif
}
```

```cpp
#include <hip/hip_runtime.h>
#include <hip/hip_cooperative_groups.h>
#include <cstdio>
#ifndef ONE_LAUNCH
#define ONE_LAUNCH 1
#endif
namespace cg = cooperative_groups;

typedef unsigned short bf16_t;
using bf16x8 = __attribute__((ext_vector_type(8))) short;
using f32x16 = __attribute__((ext_vector_type(16))) float;
using f32x4 = __attribute__((ext_vector_type(4))) float;
#define DI __device__ __forceinline__
#define MFMA32(a, b, c) __builtin_amdgcn_mfma_f32_32x32x16_bf16((a), (b), (c), 0, 0, 0)
#define MFMA16(a, b, c) __builtin_amdgcn_mfma_f32_16x16x32_bf16((a), (b), (c), 0, 0, 0)

constexpr int NTOK = 12288, NCTX = 4096;
constexpr int NINP = 9344;
constexpr int DFF = 2816;
constexpr float ALPHA = 1.6817928305074290f;
constexpr float LN_EPS = 1e-5f;

constexpr size_t SZ_WIN = (size_t)NINP * 1024 * 2, SZ_WA = 1024ull * 2048 * 2, SZ_WB = 1024ull * 1024 * 2, SZ_WO = SZ_WB,
                 SZ_WF1 = 5632ull * 1024 * 2, SZ_WF2 = 1024ull * 2816 * 2;
constexpr size_t WS_WIN = 0, WS_WA = WS_WIN + SZ_WIN, WS_WB = WS_WA + SZ_WA, WS_WO = WS_WB + SZ_WB, WS_WF1 = WS_WO + SZ_WO,
                 WS_WF2 = WS_WF1 + SZ_WF1, SZ_SLOT = WS_WF2 + SZ_WF2;
constexpr size_t OFF_BC = 2 * SZ_SLOT;
constexpr size_t OFF_A256 = OFF_BC + 512 * 256 * 2;
constexpr size_t OFF_A1024 = OFF_A256 + 256 * 512 * 2;
constexpr size_t OFF_MODP = OFF_A1024 + 1024ull * 2048 * 2;
constexpr size_t OFF_MOD = OFF_MODP + 8ull * 4 * 9 * 6144 * 4;
constexpr size_t OFF_XRES = OFF_MOD + 4ull * 9 * 6144 * 4;
constexpr size_t OFF_HMOD = OFF_XRES + (size_t)NTOK * 1024 * 4;
constexpr size_t OFF_FB = OFF_HMOD;
constexpr size_t OFF_Q = OFF_HMOD + (size_t)NTOK * 1024 * 2;
constexpr size_t OFF_MERGED = OFF_Q;
constexpr size_t OFF_K = OFF_Q + (size_t)NTOK * 1024 * 2;
constexpr size_t OFF_KT = OFF_K + (size_t)NTOK * 1024 * 2;
constexpr size_t OFF_VT = OFF_KT + 16ull * 4 * 256 * 256 * 2;
constexpr size_t OFF_OG = OFF_VT + (size_t)NTOK * 2048 * 2;
constexpr size_t OFF_FF = OFF_OG;
constexpr size_t OFF_UF = OFF_OG + (size_t)NTOK * 2048 * 2;
constexpr size_t OFF_GA = OFF_UF + (size_t)NTOK * 1024 * 2;
constexpr size_t OFF_GB = OFF_GA + (size_t)NTOK * 1024 * 2;
constexpr size_t OFF_GATES = OFF_GB + (size_t)NTOK * 1024 * 2;
constexpr size_t SZ_SC = 2ull * 4 * NTOK * 4;
constexpr size_t OFF_BETA = OFF_GATES + (size_t)NTOK * 16 * 4;
constexpr size_t OFF_MM = OFF_BETA + SZ_SC;
constexpr size_t OFF_EMT = OFF_MM + SZ_SC;
constexpr size_t OFF_WFIN = OFF_EMT + SZ_SC;
constexpr size_t OFF_H0 = OFF_WFIN + SZ_SC;
constexpr size_t OFF_TT = OFF_H0 + (size_t)NTOK * 2048 * 2;
constexpr size_t OFF_PRELN = OFF_TT;
constexpr size_t OFF_HN = OFF_TT + (size_t)NTOK * 2048 * 2;
constexpr size_t OFF_VTC = OFF_HN + (size_t)NTOK * 2048 * 2;
constexpr size_t OFF_C0T = OFF_VTC + 16ull * 2048 * 256 * 2;
constexpr size_t OFF_BAR = OFF_C0T + 64ull * 512 * 256 * 2;
constexpr size_t WS_TOTAL = OFF_BAR + 16384;
constexpr size_t VT_LAT = 16ull * 2048 * 256;
constexpr size_t TT_LAT = 16ull * 4 * 256 * 512;

constexpr size_t OUT_NEWC = (size_t)NTOK * 1024;
constexpr size_t OUT_NEWN = OUT_NEWC + 16ull * 4 * 2 * 4 * 512 * 256;
constexpr size_t OUT_NEWM = OUT_NEWN + 16ull * 4 * 2 * 4 * 256;

constexpr int SMEM_BYTES = 73728;

struct Params {
  const float *x_prompt, *x_sample, *c, *state_C, *state_n, *state_m, *c_ctx, *w_mod, *b_mod, *w_in, *b_gate, *mh_gain,
      *w_a, *w_b, *w_out, *ln_gain, *ln_bias, *w_f1, *w_f2;
  float* out;
  unsigned char* ws;
};

typedef unsigned u32x4 __attribute__((ext_vector_type(4)));
DI u32x4 gld16(const void* p) { u32x4 r; asm volatile("global_load_dwordx4 %0, %1, off" : "=&v"(r) : "v"(p) : "memory"); return r; }
DI unsigned f2bf(float x) { unsigned r; asm("v_cvt_pk_bf16_f32 %0, %1, %1" : "=v"(r) : "v"(x)); return r & 0xffffu; }
DI unsigned pack2(float a, float b) { unsigned r; asm("v_cvt_pk_bf16_f32 %0, %1, %2\n\ts_nop 1" : "=v"(r) : "v"(a), "v"(b)); return r; }
DI float bf2f(unsigned h) { return __uint_as_float(h << 16); }
DI float sigmoidf_(float x) { return 1.f / (1.f + __expf(-x)); }
DI float logsigmoidf_(float x) { return fminf(x, 0.f) - log1pf(__expf(-fabsf(x))); }
DI int mod_index(int tok) { return tok < NCTX ? 0 : 1 + ((tok - NCTX) >> 10); }
DI int tid_() { int t = threadIdx.x; asm volatile("" : "+v"(t)); return t; }
DI int bid_() { int b = blockIdx.x; asm volatile("" : "+s"(b)); return b; }
DI int vblock() { return bid_(); }

DI void tile_decode(int t, int MT, int NT, int& mt, int& nt) {
  const int per_sc = MT * 8;
  const int sc = t / per_sc;
  const int w = t - sc * per_sc;
  int ncols = NT - sc * 8; ncols = ncols > 8 ? 8 : ncols;
  const int per_sr = 8 * ncols;
  const int sr = w / per_sr;
  const int j = w - sr * per_sr;
  mt = sr * 8 + (j & 7);
  nt = sc * 8 + (j >> 3);
}

template <bool KSCALE>
DI void gemm_mainloop(f32x16 (&acc)[2][2], const bf16_t* __restrict__ A, int lda, const bf16_t* __restrict__ B, int ldb, int K,
                      const float* __restrict__ kscale, unsigned char* smem) {
  const int tid = tid_(), lane = tid & 63, wave = tid >> 6;
  const int wm = wave >> 1, wn = wave & 1, r = lane & 31, h = lane >> 5;
  const int lrow = tid >> 3, lkc = tid & 7;
  const bf16_t* ga = A + (size_t)lrow * lda + lkc * 8;
  const bf16_t* gb = B + (size_t)lrow * ldb + lkc * 8;
  u32x4 a0[4], b0[4], a1[4], b1[4];
  const int KT = K >> 6;
#define GL(sa_, sb_, k0)                                                                            \
  {                                                                                                 \
    _Pragma("unroll") for (int i = 0; i < 4; ++i) {                                                 \
      sa_[i] = gld16(ga + (size_t)(32 * i) * lda + (k0));                                           \
      sb_[i] = gld16(gb + (size_t)(32 * i) * ldb + (k0));                                           \
    }                                                                                               \
  }
#define GW8(sa_, sb_) asm volatile("s_waitcnt vmcnt(8)" : "+v"(sa_[0]), "+v"(sa_[1]), "+v"(sa_[2]), "+v"(sa_[3]), "+v"(sb_[0]), "+v"(sb_[1]), "+v"(sb_[2]), "+v"(sb_[3]) : : "memory")
#define GW0(sa_, sb_) asm volatile("s_waitcnt vmcnt(0)" : "+v"(sa_[0]), "+v"(sa_[1]), "+v"(sa_[2]), "+v"(sa_[3]), "+v"(sb_[0]), "+v"(sb_[1]), "+v"(sb_[2]), "+v"(sb_[3]) : : "memory")
#define ST(sa_, sb_, buf, k0)                                                                       \
  {                                                                                                 \
    if (KSCALE) {                                                                                   \
      const float4 s0 = *(const float4*)(kscale + (k0) + lkc * 8);                                  \
      const float4 s1 = *(const float4*)(kscale + (k0) + lkc * 8 + 4);                              \
      _Pragma("unroll") for (int i = 0; i < 4; ++i) {                                               \
        u32x4 v = sb_[i];                                                                           \
        v.x = pack2(bf2f(v.x & 0xffffu) * s0.x, bf2f(v.x >> 16) * s0.y);                            \
        v.y = pack2(bf2f(v.y & 0xffffu) * s0.z, bf2f(v.y >> 16) * s0.w);                            \
        v.z = pack2(bf2f(v.z & 0xffffu) * s1.x, bf2f(v.z >> 16) * s1.y);                            \
        v.w = pack2(bf2f(v.w & 0xffffu) * s1.z, bf2f(v.w >> 16) * s1.w);                            \
        sb_[i] = v;                                                                                 \
      }                                                                                             \
    }                                                                                               \
    unsigned char* sa__ = smem + (buf) * 36864;                                                     \
    unsigned char* sb__ = sa__ + 18432;                                                             \
    _Pragma("unroll") for (int i = 0; i < 4; ++i) {                                                 \
      *(u32x4*)(sa__ + (lrow + 32 * i) * 144 + lkc * 16) = sa_[i];                                  \
      *(u32x4*)(sb__ + (lrow + 32 * i) * 144 + lkc * 16) = sb_[i];                                  \
    }                                                                                               \
  }
#define COMPUTE(buf)                                                                                                          \
  {                                                                                                                           \
    const unsigned char* sa = smem + (buf) * 36864;                                                                           \
    const unsigned char* sb = sa + 18432;                                                                                     \
    _Pragma("unroll") for (int ks = 0; ks < 4; ++ks) {                                                                        \
      bf16x8 af[2], bfr[2];                                                                                                   \
      _Pragma("unroll") for (int mt = 0; mt < 2; ++mt) af[mt] = *(const bf16x8*)(sa + (wm * 64 + mt * 32 + r) * 144 + ks * 32 + h * 16);  \
      _Pragma("unroll") for (int nt = 0; nt < 2; ++nt) bfr[nt] = *(const bf16x8*)(sb + (wn * 64 + nt * 32 + r) * 144 + ks * 32 + h * 16); \
      _Pragma("unroll") for (int mt = 0; mt < 2; ++mt)                                                                        \
        _Pragma("unroll") for (int nt = 0; nt < 2; ++nt) acc[mt][nt] = MFMA32(af[mt], bfr[nt], acc[mt][nt]);                  \
    }                                                                                                                         \
  }
  GL(a0, b0, 0);
  GL(a1, b1, 64);
  GW8(a0, b0);
  ST(a0, b0, 0, 0);
  __syncthreads();
  for (int kt = 0; kt < KT; kt += 2) {
    { const int kn = kt + 2 < KT ? kt + 2 : KT - 1; GL(a0, b0, kn * 64); }
    COMPUTE(0);
    GW8(a1, b1);
    ST(a1, b1, 1, (kt + 1) * 64);
    __syncthreads();
    { const int kn = kt + 3 < KT ? kt + 3 : KT - 1; GL(a1, b1, kn * 64); }
    COMPUTE(1);
    GW8(a0, b0);
    { const int kn = kt + 2 < KT ? kt + 2 : KT - 1; ST(a0, b0, 0, kn * 64); }
    __syncthreads();
  }
  GW0(a1, b1);
#undef GL
#undef GW8
#undef GW0
#undef ST
#undef COMPUTE
}

DI void gemm192_mainloop(f32x16 (&acc)[3][2], const bf16_t* __restrict__ A, int lda, const bf16_t* __restrict__ B, int ldb, int K,
                         unsigned char* smem) {
  const int tid = tid_(), lane = tid & 63, wave = tid >> 6;
  const int wm = wave >> 1, wn = wave & 1, r = lane & 31, h = lane >> 5;
  const int lrow = tid >> 3, lkc = tid & 7;
  const bf16_t* ga = A + (size_t)lrow * lda + lkc * 8;
  const bf16_t* gb = B + (size_t)lrow * ldb + lkc * 8;
  u32x4 a0[6], b0[4], a1[6], b1[4];
  const int KT = K >> 6;
#define GL(sa_, sb_, k0)                                                                            \
  {                                                                                                 \
    _Pragma("unroll") for (int i = 0; i < 6; ++i) sa_[i] = gld16(ga + (size_t)(32 * i) * lda + (k0));  \
    _Pragma("unroll") for (int i = 0; i < 4; ++i) sb_[i] = gld16(gb + (size_t)(32 * i) * ldb + (k0));  \
  }
#define GW10(sa_, sb_) asm volatile("s_waitcnt vmcnt(10)" : "+v"(sa_[0]), "+v"(sa_[1]), "+v"(sa_[2]), "+v"(sa_[3]), "+v"(sa_[4]), "+v"(sa_[5]), "+v"(sb_[0]), "+v"(sb_[1]), "+v"(sb_[2]), "+v"(sb_[3]) : : "memory")
#define GW0(sa_, sb_) asm volatile("s_waitcnt vmcnt(0)" : "+v"(sa_[0]), "+v"(sa_[1]), "+v"(sa_[2]), "+v"(sa_[3]), "+v"(sa_[4]), "+v"(sa_[5]), "+v"(sb_[0]), "+v"(sb_[1]), "+v"(sb_[2]), "+v"(sb_[3]) : : "memory")
#define ST(sa_, sb_)                                                                                \
  {                                                                                                 \
    unsigned char* sa__ = smem;                                                                     \
    unsigned char* sb__ = smem + 27648;                                                             \
    _Pragma("unroll") for (int i = 0; i < 6; ++i) *(u32x4*)(sa__ + (lrow + 32 * i) * 144 + lkc * 16) = sa_[i];  \
    _Pragma("unroll") for (int i = 0; i < 4; ++i) *(u32x4*)(sb__ + (lrow + 32 * i) * 144 + lkc * 16) = sb_[i];  \
  }
#define COMPUTE()                                                                                                             \
  {                                                                                                                           \
    const unsigned char* sa = smem;                                                                                           \
    const unsigned char* sb = smem + 27648;                                                                                   \
    _Pragma("unroll") for (int ks = 0; ks < 4; ++ks) {                                                                        \
      bf16x8 af[3], bfr[2];                                                                                                   \
      _Pragma("unroll") for (int mt = 0; mt < 3; ++mt) af[mt] = *(const bf16x8*)(sa + (wm * 96 + mt * 32 + r) * 144 + ks * 32 + h * 16);  \
      _Pragma("unroll") for (int nt = 0; nt < 2; ++nt) bfr[nt] = *(const bf16x8*)(sb + (wn * 64 + nt * 32 + r) * 144 + ks * 32 + h * 16); \
      _Pragma("unroll") for (int mt = 0; mt < 3; ++mt)                                                                        \
        _Pragma("unroll") for (int nt = 0; nt < 2; ++nt) acc[mt][nt] = MFMA32(af[mt], bfr[nt], acc[mt][nt]);                  \
    }                                                                                                                         \
  }
  GL(a0, b0, 0);
  GL(a1, b1, 64);
  GW10(a0, b0);
  ST(a0, b0);
  __syncthreads();
  for (int kt = 0; kt < KT; kt += 2) {
    { const int kn = kt + 2 < KT ? kt + 2 : KT - 1; GL(a0, b0, kn * 64); }
    COMPUTE();
    GW10(a1, b1);
    __syncthreads();
    ST(a1, b1);
    __syncthreads();
    { const int kn = kt + 3 < KT ? kt + 3 : KT - 1; GL(a1, b1, kn * 64); }
    COMPUTE();
    GW10(a0, b0);
    __syncthreads();
    ST(a0, b0);
    __syncthreads();
  }
  GW0(a1, b1);
#undef GL
#undef GW10
#undef GW0
#undef ST
#undef COMPUTE
}
DI void acc_zero3(f32x16 (&acc)[3][2]) {
#pragma unroll
  for (int a = 0; a < 3; ++a)
#pragma unroll
    for (int b = 0; b < 2; ++b)
#pragma unroll
      for (int i = 0; i < 16; ++i) acc[a][b][i] = 0.f;
}
#define RW3(mt, i) (wm_ * 96 + (mt) * 32 + ((i) & 3) + 8 * ((i) >> 2) + 4 * hh_)

DI void acc_zero(f32x16 (&acc)[2][2]) {
#pragma unroll
  for (int a = 0; a < 2; ++a)
#pragma unroll
    for (int b = 0; b < 2; ++b)
#pragma unroll
      for (int i = 0; i < 16; ++i) acc[a][b][i] = 0.f;
}

#define EPI_VARS const int tid_e_ = tid_(), lane_ = tid_e_ & 63, wave_ = tid_e_ >> 6, wm_ = wave_ >> 1, wn_ = wave_ & 1, rr_ = lane_ & 31, hh_ = lane_ >> 5
#define RW(mt, i) (wm_ * 64 + (mt) * 32 + ((i) & 3) + 8 * ((i) >> 2) + 4 * hh_)
#define CL(nt) (wn_ * 64 + (nt) * 32 + rr_)

template <int MODE>
DI void store_tile_bf16(const f32x16 (&acc)[2][2], bf16_t* __restrict__ dst, int ld, unsigned char* smem) {
  EPI_VARS;
#pragma unroll
  for (int mt = 0; mt < 2; ++mt)
#pragma unroll
    for (int nt = 0; nt < 2; ++nt)
#pragma unroll
      for (int i = 0; i < 16; ++i) {
        float v = acc[mt][nt][i];
        if (MODE == 1) v = sigmoidf_(v);
        *(unsigned short*)(smem + RW(mt, i) * 272 + CL(nt) * 2) = (unsigned short)f2bf(v);
      }
  __syncthreads();
#pragma unroll
  for (int i = 0; i < 8; ++i) {
    const int row = (tid_e_ >> 4) + 16 * i, ch = tid_e_ & 15;
    const u32x4 x = *(const u32x4*)(smem + row * 272 + ch * 16);
    *(u32x4*)(dst + (size_t)row * ld + ch * 8) = x;
  }
  __syncthreads();
}

DI void convert_tile(const float* __restrict__ src, int nsrc, int K, bf16_t* __restrict__ dst, int kt, int ntile, int maptype, unsigned char* smem) {
  float* tile = (float*)smem;
  const int tid = tid_(), tx4 = (tid & 15) * 4, ty = tid >> 4;
  const int np = ntile * 64 + tx4;
  int sc;
  if (maptype == 0) sc = np;
  else if (maptype == 1) sc = np < 6144 ? np : (np < 9216 ? np + 16 : (np < 9232 ? 6144 + (np - 9216) : -1));
  else { const int g = np >> 6, w = np & 63; sc = w < 32 ? g * 32 + w : 2816 + g * 32 + (w - 32); }
  __syncthreads();
#pragma unroll
  for (int i = 0; i < 4; ++i) {
    const int ky = ty + 16 * i;
    float4 v = make_float4(0.f, 0.f, 0.f, 0.f);
    if (sc >= 0) v = *(const float4*)(src + (size_t)(kt * 64 + ky) * nsrc + sc);
    tile[ky * 65 + tx4] = v.x; tile[ky * 65 + tx4 + 1] = v.y; tile[ky * 65 + tx4 + 2] = v.z; tile[ky * 65 + tx4 + 3] = v.w;
  }
  __syncthreads();
#pragma unroll
  for (int i = 0; i < 2; ++i) {
    const int id = tid + 256 * i, nrow = id >> 3, kc = id & 7;
    uint4 v;
    v.x = pack2(tile[(kc * 8 + 0) * 65 + nrow], tile[(kc * 8 + 1) * 65 + nrow]);
    v.y = pack2(tile[(kc * 8 + 2) * 65 + nrow], tile[(kc * 8 + 3) * 65 + nrow]);
    v.z = pack2(tile[(kc * 8 + 4) * 65 + nrow], tile[(kc * 8 + 5) * 65 + nrow]);
    v.w = pack2(tile[(kc * 8 + 6) * 65 + nrow], tile[(kc * 8 + 7) * 65 + nrow]);
    *(uint4*)(dst + (size_t)(ntile * 64 + nrow) * K + kt * 64 + kc * 8) = v;
  }
}

DI void convert_layer(const Params& P, int l, unsigned char* smem) {
  unsigned char* slot = P.ws + (size_t)(l & 1) * SZ_SLOT;
  constexpr int T0 = 146 * 16, T1 = T0 + 16 * 32, T2 = T1 + 16 * 16, T3 = T2 + 16 * 16, T4 = T3 + 88 * 16, T5 = T4 + 16 * 44;
  for (int it = bid_(); it < T5; it += gridDim.x) {
    if (it < T0) convert_tile(P.w_in + (size_t)l * 1024 * 9232, 9232, 1024, (bf16_t*)(slot + WS_WIN), it & 15, it >> 4, 1, smem);
    else if (it < T1) { const int j = it - T0; convert_tile(P.w_a + (size_t)l * 2048 * 1024, 1024, 2048, (bf16_t*)(slot + WS_WA), j & 31, j >> 5, 0, smem); }
    else if (it < T2) { const int j = it - T1; convert_tile(P.w_b + (size_t)l * 1024 * 1024, 1024, 1024, (bf16_t*)(slot + WS_WB), j & 15, j >> 4, 0, smem); }
    else if (it < T3) { const int j = it - T2; convert_tile(P.w_out + (size_t)l * 1024 * 1024, 1024, 1024, (bf16_t*)(slot + WS_WO), j & 15, j >> 4, 0, smem); }
    else if (it < T4) { const int j = it - T3; convert_tile(P.w_f1 + (size_t)l * 1024 * 5632, 5632, 1024, (bf16_t*)(slot + WS_WF1), j & 15, j >> 4, 2, smem); }
    else { const int j = it - T4; convert_tile(P.w_f2 + (size_t)l * 2816 * 1024, 1024, 2816, (bf16_t*)(slot + WS_WF2), j % 44, j / 44, 0, smem); }
  }
}

DI void phase_setup(const Params& P, unsigned char* smem) {
  const int tid = tid_();
  convert_layer(P, 0, smem);
  {
    bf16_t* BC = (bf16_t*)(P.ws + OFF_BC);
    bf16_t* A256 = (bf16_t*)(P.ws + OFF_A256);
    bf16_t* A1024 = (bf16_t*)(P.ws + OFF_A1024);
    const int total = 131072 + 131072 + 2097152;
    for (int e = bid_() * 256 + tid; e < total; e += gridDim.x * 256) {
      if (e < 131072) {
        const int n = e >> 8, k = e & 255, cs = n >> 8, ch = n & 255;
        const float ph = (float)((ch * k) & 255) * (1.f / 128.f);
        BC[e] = (bf16_t)f2bf(cs ? sinpif(ph) : cospif(ph));
      } else if (e < 262144) {
        const int e2 = e - 131072, m = e2 >> 9, k = e2 & 511, cs = k >> 8, p = k & 255;
        const float ph = (float)((m * p) & 255) * (1.f / 128.f);
        A256[e2] = (bf16_t)f2bf(cs ? -sinpif(ph) : cospif(ph));
      } else {
        const int e2 = e - 262144, m = e2 >> 11, k = e2 & 2047, cs = k >> 10, p = k & 1023;
        const int r1 = m >> 6, c1 = m & 63, r2 = p >> 6, c2 = p & 63;
        const float ph = (float)((4 * r1 * r2 + c1 * c2) & 63) * (1.f / 32.f);
        A1024[e2] = (bf16_t)f2bf(cs ? -sinpif(ph) : cospif(ph));
      }
    }
  }
  {
    float4* X = (float4*)(P.ws + OFF_XRES);
    const float4* xp = (const float4*)P.x_prompt;
    const float4* xs = (const float4*)P.x_sample;
    const int n4p = NCTX * 256, n4 = NTOK * 256;
    for (int e = bid_() * 256 + tid; e < n4; e += gridDim.x * 256) X[e] = e < n4p ? xp[e] : xs[e - n4p];
  }
  {
    float* MODP = (float*)(P.ws + OFF_MODP);
    float* red = (float*)smem;
    const int lane = tid & 63, w = tid >> 6;
    for (int it = bid_(); it < 8 * 4 * 24; it += gridDim.x) {
      const int nc = it % 24, l = (it / 24) & 3, ks = it / 96;
      float4 a[9];
#pragma unroll
      for (int j = 0; j < 9; ++j) a[j] = make_float4(0.f, 0.f, 0.f, 0.f);
      const int kb = ks * 128 + w * 32;
      const float* wp = P.w_mod + ((size_t)l * 1024 + kb) * 6144 + nc * 256 + lane * 4;
      for (int k = 0; k < 32; ++k) {
        const float4 wv = *(const float4*)(wp + (size_t)k * 6144);
#pragma unroll
        for (int j = 0; j < 9; ++j) {
          float cv = j == 0 ? P.c_ctx[kb + k] : P.c[(j - 1) * 1024 + kb + k];
          cv = cv * sigmoidf_(cv);
          a[j].x += cv * wv.x; a[j].y += cv * wv.y; a[j].z += cv * wv.z; a[j].w += cv * wv.w;
        }
      }
      __syncthreads();
#pragma unroll
      for (int j = 0; j < 9; ++j) *(float4*)(red + (w * 9 + j) * 256 + lane * 4) = a[j];
      __syncthreads();
      for (int e = tid; e < 9 * 256; e += 256) {
        const int j = e >> 8, n = e & 255;
        const float s = red[(0 * 9 + j) * 256 + n] + red[(1 * 9 + j) * 256 + n] + red[(2 * 9 + j) * 256 + n] + red[(3 * 9 + j) * 256 + n];
        MODP[((size_t)(ks * 4 + l) * 9 + j) * 6144 + nc * 256 + n] = s;
      }
    }
  }
}

DI void phase_modreduce(const Params& P) {
  const float* MODP = (const float*)(P.ws + OFF_MODP);
  float* MOD = (float*)(P.ws + OFF_MOD);
  const int total = 4 * 9 * 6144;
  for (int e = bid_() * 256 + tid_(); e < total; e += gridDim.x * 256) {
    const int n = e % 6144, l = e / (9 * 6144);
    float s = P.b_mod[l * 6144 + n];
#pragma unroll
    for (int ks = 0; ks < 8; ++ks) s += MODP[(size_t)ks * total + e];
    MOD[e] = s;
  }
}

DI void phase_modulate0(const Params& P) {
  const float* MOD = (const float*)(P.ws + OFF_MOD);
  const float4* X = (const float4*)(P.ws + OFF_XRES);
  uint2* H = (uint2*)(P.ws + OFF_HMOD);
  for (int e = bid_() * 256 + tid_(); e < NTOK * 256; e += gridDim.x * 256) {
    const int tok = e >> 8, n = (e & 255) * 4;
    const float* m = MOD + (size_t)mod_index(tok) * 6144;
    const float4 x = X[e];
    const float4 sh = *(const float4*)(m + n), sc = *(const float4*)(m + 1024 + n);
    uint2 o;
    o.x = pack2(x.x * (1.f + sc.x) + sh.x, x.y * (1.f + sc.y) + sh.y);
    o.y = pack2(x.z * (1.f + sc.z) + sh.z, x.w * (1.f + sc.w) + sh.w);
    H[e] = o;
  }
}

DI void phase_gemm_in(const Params& P, int l, unsigned char* smem) {
  const bf16_t* H = (const bf16_t*)(P.ws + OFF_HMOD);
  const bf16_t* W = (const bf16_t*)(P.ws + (size_t)(l & 1) * SZ_SLOT + WS_WIN);
  bf16_t* Q = (bf16_t*)(P.ws + OFF_Q);
  bf16_t* Kn = (bf16_t*)(P.ws + OFF_K);
  bf16_t* KT = (bf16_t*)(P.ws + OFF_KT);
  bf16_t* VT = (bf16_t*)(P.ws + OFF_VT);
  bf16_t* VTC = (bf16_t*)(P.ws + OFF_VTC);
  bf16_t* OG = (bf16_t*)(P.ws + OFF_OG);
  bf16_t* UF = (bf16_t*)(P.ws + OFF_UF);
  bf16_t* GA = (bf16_t*)(P.ws + OFF_GA);
  bf16_t* GB = (bf16_t*)(P.ws + OFF_GB);
  float* GATES = (float*)(P.ws + OFF_GATES);
  for (int t = vblock(); t < 96 * 73; t += gridDim.x) {
    int mtile, ntile;
    tile_decode(t, 96, 73, mtile, ntile);
    const int m0 = mtile * 128, n0 = ntile * 128;
    f32x16 acc[2][2];
    acc_zero(acc);
    gemm_mainloop<false>(acc, H + (size_t)m0 * 1024, 1024, W + (size_t)n0 * 1024, 1024, 1024, nullptr, smem);
    EPI_VARS;
    if (ntile < 8 || (ntile >= 32 && ntile < 72)) {
      bf16_t* dst; int ld, cb; bool sg;
      if (ntile < 8) { dst = Q; ld = 1024; cb = n0; sg = false; }
      else if (ntile < 48) { dst = OG; ld = 2048; cb = n0 - 4096; sg = true; }
      else if (ntile < 56) { dst = UF; ld = 1024; cb = n0 - 6144; sg = false; }
      else if (ntile < 64) { dst = GA; ld = 1024; cb = n0 - 7168; sg = true; }
      else { dst = GB; ld = 1024; cb = n0 - 8192; sg = true; }
      if (sg) store_tile_bf16<1>(acc, dst + (size_t)m0 * ld + cb, ld, smem);
      else store_tile_bf16<0>(acc, dst + (size_t)m0 * ld + cb, ld, smem);
    } else if (ntile < 16) {
      const int cb = n0 - 1024;
#pragma unroll
      for (int mt = 0; mt < 2; ++mt)
#pragma unroll
        for (int nt = 0; nt < 2; ++nt) {
#pragma unroll
          for (int i = 0; i < 16; ++i) { const int tk = m0 + RW(mt, i), kc2 = cb + CL(nt); Kn[((size_t)(tk >> 5) * 4 + (kc2 >> 8)) * 8192 + (tk & 31) * 256 + (kc2 & 255)] = (bf16_t)f2bf(acc[mt][nt][i] * 0.0625f); }
          if (m0 < NCTX) {
            const int kc = cb + CL(nt), hd = kc >> 8, d = kc & 255;
#pragma unroll
            for (int i4 = 0; i4 < 4; ++i4) {
              const int tok0 = m0 + RW(mt, 4 * i4), b = tok0 >> 8, s = tok0 & 255;
              uint2 v;
              v.x = pack2(acc[mt][nt][4 * i4] * 0.0625f, acc[mt][nt][4 * i4 + 1] * 0.0625f);
              v.y = pack2(acc[mt][nt][4 * i4 + 2] * 0.0625f, acc[mt][nt][4 * i4 + 3] * 0.0625f);
              *(uint2*)(KT + ((size_t)((b * 4 + hd) * 256 + d)) * 256 + s) = v;
            }
          }
        }
    } else if (ntile < 32) {
      const int cb = n0 - 2048;
#pragma unroll
      for (int mt = 0; mt < 2; ++mt)
#pragma unroll
        for (int nt = 0; nt < 2; ++nt) {
          const int vc = cb + CL(nt);
#pragma unroll
          for (int i4 = 0; i4 < 4; ++i4) {
            const int tok0 = m0 + RW(mt, 4 * i4);
            uint2 v;
            v.x = pack2(acc[mt][nt][4 * i4], acc[mt][nt][4 * i4 + 1]);
            v.y = pack2(acc[mt][nt][4 * i4 + 2], acc[mt][nt][4 * i4 + 3]);
            { const int cq = (tok0 & 31) >> 2; *(uint2*)(VT + ((size_t)(tok0 >> 5) * 2048 + vc) * 32 + (((cq & 3) * 2 + (cq >> 2)) * 4)) = v; }
            if (tok0 < NCTX) *(uint2*)(VTC + ((size_t)(tok0 >> 8) * 2048 + vc) * 256 + (tok0 & 255)) = v;
          }
        }
    } else {
      if (wn_ == 0 && rr_ < 16) {
        const int g = rr_;
        const float bg = P.b_gate[l * 16 + g];
        const bool isf = (g >> 2) & 1;
#pragma unroll
        for (int mt = 0; mt < 2; ++mt)
#pragma unroll
          for (int i = 0; i < 16; ++i) {
            float v = acc[mt][0][i] + bg;
            if (isf) v = logsigmoidf_(v);
            GATES[(size_t)(m0 + RW(mt, i)) * 16 + g] = v;
          }
      }
    }
  }
}

DI float wave_excl_sum(float v, int lane) {
  float x = v;
#pragma unroll
  for (int o = 1; o < 64; o <<= 1) { const float y = __shfl_up(x, o, 64); if (lane >= o) x += y; }
  return x - v;
}
DI float wave_excl_max(float v, int lane, float init) {
  float x = v;
#pragma unroll
  for (int o = 1; o < 64; o <<= 1) { const float y = __shfl_up(x, o, 64); if (lane >= o) x = fmaxf(x, y); }
  const float p = __shfl_up(x, 1, 64);
  return lane == 0 ? init : fmaxf(init, p);
}

template <int E>
DI void scan_wave(const Params& P, int l, int sid) {
  const int lane = tid_() & 63;
  const int dir = sid & 1, hd = (sid >> 1) & 3, seq = sid >> 3;
  const bool lat = seq >= 16;
  const int S = E * 64;
  const int tok0 = lat ? NCTX + (seq - 16) * 1024 : seq * 256;
  const float* G = (const float*)(P.ws + OFF_GATES);
  const size_t gi = (size_t)(dir * 4 + hd) * NTOK;
  float* BETA = (float*)(P.ws + OFF_BETA) + gi;
  float* MM = (float*)(P.ws + OFF_MM) + gi;
  float* EMT = (float*)(P.ws + OFF_EMT) + gi;
  float* WFIN = (float*)(P.ws + OFF_WFIN) + gi;
  const int gi_i = dir * 8 + hd, gi_f = dir * 8 + 4 + hd;
  const float m0 = lat ? P.state_m[(((seq - 16) * 4 + l) * 2 + dir) * 4 + hd] : 0.f;
  float tot = 0.f;
#pragma unroll
  for (int e = 0; e < E; ++e) {
    const int j = lane * E + e, tok = dir == 0 ? tok0 + j : tok0 + S - 1 - j;
    tot += G[(size_t)tok * 16 + gi_f];
  }
  const float boff = wave_excl_sum(tot, lane);
  float b = boff, cmax = -3.0e38f;
#pragma unroll
  for (int e = 0; e < E; ++e) {
    const int j = lane * E + e, tok = dir == 0 ? tok0 + j : tok0 + S - 1 - j;
    b += G[(size_t)tok * 16 + gi_f];
    const float be = G[(size_t)tok * 16 + gi_i] - b;
    BETA[tok] = be;
    cmax = fmaxf(cmax, be);
  }
  float M = wave_excl_max(cmax, lane, m0);
  b = boff;
#pragma unroll
  for (int e = 0; e < E; ++e) {
    const int j = lane * E + e, tok = dir == 0 ? tok0 + j : tok0 + S - 1 - j;
    b += G[(size_t)tok * 16 + gi_f];
    const float be = G[(size_t)tok * 16 + gi_i] - b;
    M = fmaxf(M, be);
    MM[tok] = M;
    EMT[tok] = __expf(-b - M);
  }
  if (!lat) {
    const float Mlast = __shfl(M, 63, 64);
    const float Blast = __shfl(b, 63, 64);
    if (lane == 0) P.out[OUT_NEWM + (((seq * 4 + l) * 2 + dir) * 4 + hd)] = Blast + Mlast;
    b = boff;
  #pragma unroll
  for (int e = 0; e < E; ++e) {
      const int j = lane * E + e, tok = dir == 0 ? tok0 + j : tok0 + S - 1 - j;
      b += G[(size_t)tok * 16 + gi_f];
      const float be = G[(size_t)tok * 16 + gi_i] - b;
      WFIN[tok] = __expf(be - Mlast);
    }
  }
}

DI void convert_c0(const Params& P, int l) {
  bf16_t* C0T = (bf16_t*)(P.ws + OFF_C0T);
  const int total = 64 * 512 * 32;
  for (int e = bid_() * 256 + tid_(); e < total; e += gridDim.x * 256) {
    const int j = e & 31, v = (e >> 5) & 511, sp = e >> 14;
    const int b = sp >> 3, dir = (sp >> 2) & 1, hd = sp & 3;
    const float* src = P.state_C + ((size_t)((((b * 4 + l) * 2 + dir) * 4 + hd) * 512 + v)) * 256 + j * 8;
    const float4 x0 = *(const float4*)src, x1 = *(const float4*)(src + 4);
    uint4 o;
    o.x = pack2(x0.x, x0.y); o.y = pack2(x0.z, x0.w); o.z = pack2(x1.x, x1.y); o.w = pack2(x1.z, x1.w);
    *(uint4*)(C0T + ((size_t)((sp * 2 + (v >> 8)) * 8 + (j >> 2)) * 256 + (v & 255)) * 32 + (j & 3) * 8) = o;
  }
}

DI void phase_scan_four1(const Params& P, int l, unsigned char* smem) {
  convert_c0(P, l);
  const bf16_t* UF = (const bf16_t*)(P.ws + OFF_UF);
  const bf16_t* BC = (const bf16_t*)(P.ws + OFF_BC);
  bf16_t* TT = (bf16_t*)(P.ws + OFF_TT);
  for (int it = bid_(); it < 48 + 1536; it += gridDim.x) {
    if (it < 48) { const int sid = it * 4 + (tid_() >> 6); if (sid < 128) scan_wave<4>(P, l, sid); else scan_wave<16>(P, l, sid); continue; }
    const int t = it - 48, g = t / 384, rem = t - g * 384;
    int mtile, ntile;
    tile_decode(rem, 96, 4, mtile, ntile);
    const int m0 = mtile * 128, n0 = ntile * 128;
    f32x16 acc[2][2];
    acc_zero(acc);
    gemm_mainloop<false>(acc, UF + (size_t)m0 * 1024 + g * 256, 1024, BC + (size_t)n0 * 256, 256, 256, nullptr, smem);
    EPI_VARS;
#pragma unroll
    for (int mt = 0; mt < 2; ++mt)
#pragma unroll
      for (int nt = 0; nt < 2; ++nt) {
        const int n = n0 + CL(nt), cs = n >> 8, ch = n & 255;
#pragma unroll
        for (int i4 = 0; i4 < 4; ++i4) {
          const int tok0 = m0 + RW(mt, 4 * i4);
          uint2 v;
          v.x = pack2(acc[mt][nt][4 * i4], acc[mt][nt][4 * i4 + 1]);
          v.y = pack2(acc[mt][nt][4 * i4 + 2], acc[mt][nt][4 * i4 + 3]);
          size_t idx;
          if (tok0 < NCTX) idx = ((size_t)(((tok0 >> 8) * 4 + g) * 256 + ch)) * 512 + cs * 256 + (tok0 & 255);
          else { const int tl = tok0 - NCTX; idx = TT_LAT + ((size_t)(((tl >> 10) * 4 + g) * 256 + ch)) * 2048 + cs * 1024 + (tl & 1023); }
          *(uint2*)(TT + idx) = v;
        }
      }
  }
}

DI void mlstm_item(const Params& P, int l, int seq, int hd, int qb, int vh, unsigned char* smem) {
  const int tid = tid_(), lane = tid & 63, w = tid >> 6, c = lane & 15, q = lane >> 4;
  const bool lat = seq >= 16;
  const int S = lat ? 1024 : 256;
  const int tok0 = lat ? NCTX + (seq - 16) * 1024 : seq * 256;
  const int bl = seq - 16;
  const bf16_t* Qg = (const bf16_t*)(P.ws + OFF_Q);
  const bf16_t* Kg = (const bf16_t*)(P.ws + OFF_K);
  const bf16_t* VT = (const bf16_t*)(P.ws + OFF_VT) + ((size_t)(tok0 >> 5) * 2048 + hd * 512 + vh * 256) * 32;
  unsigned char* sK = smem;
  unsigned char* sV = smem + 16896;
  const int t_loc = qb * 64 + w * 16 + c;
  const int tokq = tok0 + t_loc;
  bf16x8 qf[8];
  {
    const bf16_t* qp = Qg + (size_t)tokq * 1024 + hd * 256 + q * 8;
#pragma unroll
    for (int kk = 0; kk < 8; ++kk) qf[kk] = *(const bf16x8*)(qp + kk * 32);
#pragma unroll
    for (int kk = 0; kk < 8; ++kk) asm volatile("" : "+v"(qf[kk]));
  }
  __syncthreads();
  const int nkb = S >> 5;
  const size_t rowbase = (size_t)(tok0 + qb * 64 + w * 16 + 4 * q) * 2048 + hd * 512 + vh * 256 + c;
  const bf16_t* kld = Kg + ((size_t)(tok0 >> 5) * 4 + hd) * 8192 + tid * 8;
  unsigned char* ksd = sK + (tid >> 5) * 528 + (tid & 31) * 16;
  const bf16_t* vld = VT + tid * 8;
  unsigned char* vsd = sV + (tid >> 2) * 96 + (tid & 3) * 16;
  u32x4 st[8], bt[2], btn[2];
#define STWAIT() asm volatile("s_waitcnt vmcnt(0)" : "+v"(st[0]), "+v"(st[1]), "+v"(st[2]), "+v"(st[3]), "+v"(st[4]), "+v"(st[5]), "+v"(st[6]), "+v"(st[7]), "+v"(btn[0]), "+v"(btn[1]) : : "memory")
#define ISSUE_KV(kb_)                                                                      \
  {                                                                                        \
    const bf16_t* kp_ = kld + (size_t)(kb_) * 4 * 8192;                                    \
    const bf16_t* vp_ = vld + (size_t)(kb_) * 2048 * 32;                                   \
    _Pragma("unroll") for (int i = 0; i < 4; ++i) st[i] = gld16(kp_ + i * 2048);           \
    _Pragma("unroll") for (int i = 0; i < 4; ++i) st[4 + i] = gld16(vp_ + i * 2048);       \
    btn[0] = gld16(BETA + (kb_) * 32);                                                     \
    btn[1] = gld16(BETA + (kb_) * 32 + 16);                                                \
  }
#define STORE_KV()                                                                         \
  {                                                                                        \
    _Pragma("unroll") for (int i = 0; i < 4; ++i) *(u32x4*)(ksd + i * 8 * 528) = st[i];    \
    _Pragma("unroll") for (int i = 0; i < 4; ++i) *(u32x4*)(vsd + i * 64 * 96) = st[4 + i];\
    bt[0] = btn[0]; bt[1] = btn[1];                                                        \
  }
#define ISSUE_C0(kk_) { _Pragma("unroll") for (int i = 0; i < 4; ++i) st[4 + i] = gld16(C0 + (kk_) * 8192 + i * 2048); }
#define STORE_C0() { _Pragma("unroll") for (int i = 0; i < 4; ++i) *(u32x4*)(vsd + i * 64 * 96) = st[4 + i]; }
#pragma unroll 1
  for (int dir = 0; dir < 2; ++dir) {
    f32x4 acc[16];
#pragma unroll
    for (int n = 0; n < 16; ++n) acc[n] = (f32x4){0.f, 0.f, 0.f, 0.f};
    float den = 0.f;
    const size_t gi = (size_t)(dir * 4 + hd) * NTOK;
    const float* BETA = (const float*)(P.ws + OFF_BETA) + gi + tok0 + 4 * q;
    const float Mt = ((const float*)(P.ws + OFF_MM))[gi + tokq];
    const float emt = ((const float*)(P.ws + OFF_EMT))[gi + tokq];
    const int kb_lo = dir == 0 ? 0 : 2 * qb;
    const int kb_hi = dir == 0 ? 2 * qb + 1 : nkb - 1;
    asm volatile("" : : "v"(Mt), "v"(emt));
    btn[0] = btn[1] = (u32x4){0u, 0u, 0u, 0u};
    st[0] = st[1] = st[2] = st[3] = (u32x4){0u, 0u, 0u, 0u};
    if (lat) {
      const int sidx = ((bl * 4 + l) * 2 + dir) * 4 + hd;
      const float inter = __expf(P.state_m[sidx] - Mt);
      const bf16_t* C0 = (const bf16_t*)(P.ws + OFF_C0T) + ((size_t)(((bl * 2 + dir) * 4 + hd) * 2 + vh) * 8) * 8192 + tid * 8;
      float* sN = (float*)(smem + 71168);
      float sdot = 0.f;
      __syncthreads();
      {
        const float nv = P.state_n[(size_t)sidx * 256 + tid];
        sN[tid] = nv;
      }
      asm volatile("" : : "v"(inter));
      const float* n0p = sN + q * 8;
      ISSUE_C0(0);
      STWAIT();
      STORE_C0();
      __syncthreads();
#pragma unroll
      for (int kk = 0; kk < 8; ++kk) {
        const int kn = kk < 7 ? kk + 1 : 7;
        ISSUE_C0(kn);
        const bf16x8 qk = qf[kk];
#pragma unroll
        for (int e = 0; e < 8; ++e) sdot += bf2f((unsigned)(unsigned short)qk[e]) * n0p[kk * 32 + e];
        {
          bf16x8 fb[2][4];
          const unsigned char* vb_ = sV + c * 96 + q * 16;
#pragma unroll
          for (int j = 0; j < 4; ++j) fb[0][j] = *(const bf16x8*)(vb_ + j * 16 * 96);
#pragma unroll
          for (int g = 0; g < 4; ++g) {
            if (g < 3) {
#pragma unroll
              for (int j = 0; j < 4; ++j) fb[(g + 1) & 1][j] = *(const bf16x8*)(vb_ + ((g + 1) * 4 + j) * 16 * 96);
            }
#pragma unroll
            for (int j = 0; j < 4; ++j) acc[g * 4 + j] = MFMA16(qk, fb[g & 1][j], acc[g * 4 + j]);
            __builtin_amdgcn_sched_barrier(0);
          }
        }
        STWAIT();
        __syncthreads();
        STORE_C0();
        __syncthreads();
      }
      float it_[4];
#pragma unroll
      for (int j = 0; j < 4; ++j) it_[j] = __shfl(inter, 4 * q + j, 64);
#pragma unroll
      for (int n = 0; n < 16; ++n)
#pragma unroll
        for (int j = 0; j < 4; ++j) acc[n][j] *= it_[j];
      den = inter * sdot;
    }
    __syncthreads();
    ISSUE_KV(kb_lo);
    STWAIT();
    STORE_KV();
    __syncthreads();
#pragma unroll 1
    for (int kb = kb_lo; kb <= kb_hi; ++kb) {
      const int kbn = kb < kb_hi ? kb + 1 : kb_hi;
      ISSUE_KV(kbn);
      const float bb0[4] = {__uint_as_float(bt[0].x), __uint_as_float(bt[0].y), __uint_as_float(bt[0].z), __uint_as_float(bt[0].w)};
      const float bb1[4] = {__uint_as_float(bt[1].x), __uint_as_float(bt[1].y), __uint_as_float(bt[1].z), __uint_as_float(bt[1].w)};
      f32x4 x0 = (f32x4){0.f, 0.f, 0.f, 0.f}, x1 = (f32x4){0.f, 0.f, 0.f, 0.f};
      {
        bf16x8 fa0[2], fa1[2];
        const unsigned char* k0_ = sK + c * 528 + q * 16;
        fa0[0] = *(const bf16x8*)(k0_); fa1[0] = *(const bf16x8*)(k0_ + 16 * 528);
#pragma unroll
        for (int kk = 0; kk < 8; ++kk) {
          if (kk < 7) {
            fa0[(kk + 1) & 1] = *(const bf16x8*)(k0_ + (kk + 1) * 64);
            fa1[(kk + 1) & 1] = *(const bf16x8*)(k0_ + 16 * 528 + (kk + 1) * 64);
          }
          x0 = MFMA16(fa0[kk & 1], qf[kk], x0);
          x1 = MFMA16(fa1[kk & 1], qf[kk], x1);
          __builtin_amdgcn_sched_barrier(0);
        }
      }
      float p0[4], p1[4];
      const bool diag = (kb >> 1) == qb;
      if (diag) {
#pragma unroll
        for (int j = 0; j < 4; ++j) {
          const int s0 = kb * 32 + 4 * q + j, s1 = s0 + 16;
          const bool ok0 = dir == 0 ? (s0 <= t_loc) : (s0 >= t_loc);
          const bool ok1 = dir == 0 ? (s1 <= t_loc) : (s1 >= t_loc);
          p0[j] = ok0 ? x0[j] * __expf(bb0[j] - Mt) : 0.f;
          p1[j] = ok1 ? x1[j] * __expf(bb1[j] - Mt) : 0.f;
          den += p0[j] + p1[j];
        }
      } else {
#pragma unroll
        for (int j = 0; j < 4; ++j) {
          p0[j] = x0[j] * __expf(bb0[j] - Mt);
          p1[j] = x1[j] * __expf(bb1[j] - Mt);
          den += p0[j] + p1[j];
        }
      }
      uint4 pu;
      pu.x = pack2(p0[0], p0[1]); pu.y = pack2(p0[2], p0[3]); pu.z = pack2(p1[0], p1[1]); pu.w = pack2(p1[2], p1[3]);
      const bf16x8 pa = __builtin_bit_cast(bf16x8, pu);
      {
        bf16x8 fv[2][4];
        const unsigned char* vb_ = sV + c * 96 + q * 16;
#pragma unroll
        for (int j = 0; j < 4; ++j) fv[0][j] = *(const bf16x8*)(vb_ + j * 16 * 96);
#pragma unroll
        for (int g = 0; g < 4; ++g) {
          if (g < 3) {
#pragma unroll
            for (int j = 0; j < 4; ++j) fv[(g + 1) & 1][j] = *(const bf16x8*)(vb_ + ((g + 1) * 4 + j) * 16 * 96);
          }
#pragma unroll
          for (int j = 0; j < 4; ++j) acc[g * 4 + j] = MFMA16(pa, fv[g & 1][j], acc[g * 4 + j]);
          __builtin_amdgcn_sched_barrier(0);
        }
      }
      STWAIT();
      __syncthreads();
      STORE_KV();
      __syncthreads();
    }
    den += __shfl_xor(den, 16, 64);
    den += __shfl_xor(den, 32, 64);
    const float rinv = 1.f / fmaxf(fabsf(den), emt);
    float rj[4];
#pragma unroll
    for (int j = 0; j < 4; ++j) rj[j] = __shfl(rinv, 4 * q + j, 64);
    bf16_t* HS = (bf16_t*)(P.ws + OFF_H0) + rowbase;
    asm volatile("" : "+v"(HS));
    bf16_t* h0p = HS; bf16_t* h1p = HS + 2048; bf16_t* h2p = HS + 4096; bf16_t* h3p = HS + 6144;
    asm volatile("" : "+v"(h1p));
    asm volatile("" : "+v"(h2p));
    asm volatile("" : "+v"(h3p));
    if (dir == 0) {
#pragma unroll
      for (int n = 0; n < 16; ++n) {
        h0p[n * 16] = (bf16_t)f2bf(acc[n][0] * rj[0]);
        h1p[n * 16] = (bf16_t)f2bf(acc[n][1] * rj[1]);
        h2p[n * 16] = (bf16_t)f2bf(acc[n][2] * rj[2]);
        h3p[n * 16] = (bf16_t)f2bf(acc[n][3] * rj[3]);
      }
    } else {
#pragma unroll
      for (int n = 0; n < 16; ++n) {
        h0p[n * 16] = (bf16_t)f2bf(acc[n][0] * rj[0] + bf2f(h0p[n * 16]));
        h1p[n * 16] = (bf16_t)f2bf(acc[n][1] * rj[1] + bf2f(h1p[n * 16]));
        h2p[n * 16] = (bf16_t)f2bf(acc[n][2] * rj[2] + bf2f(h2p[n * 16]));
        h3p[n * 16] = (bf16_t)f2bf(acc[n][3] * rj[3] + bf2f(h3p[n * 16]));
        if ((n & 3) == 3) __builtin_amdgcn_sched_barrier(0);
      }
    }
  }
}

#undef STWAIT
#undef ISSUE_KV
#undef ISSUE_C0
#undef STORE_KV
#undef STORE_C0

DI void phase_hn(const Params& P, int l) {
  const bf16_t* HS = (const bf16_t*)(P.ws + OFF_H0);
  const bf16_t* OG = (const bf16_t*)(P.ws + OFF_OG);
  bf16_t* HN = (bf16_t*)(P.ws + OFF_HN);
  const int tidl_ = tid_(), lane = tidl_ & 63, w = tidl_ >> 6;
  const int stride = (int)gridDim.x * 4;
  for (int pr0 = bid_() * 4 + w; pr0 < NTOK * 4; pr0 += 4 * stride) {
    uint4 hv[4], ov[4];
#pragma unroll
    for (int r = 0; r < 4; ++r) {
      const int pr = pr0 + r * stride < NTOK * 4 ? pr0 + r * stride : pr0;
      const size_t base = (size_t)pr * 512 + lane * 8;
      hv[r] = *(const uint4*)(HS + base);
      ov[r] = *(const uint4*)(OG + base);
    }
#pragma unroll
    for (int r = 0; r < 4; ++r) {
      const int pr = pr0 + r * stride;
      if (pr >= NTOK * 4) continue;
      const size_t base = (size_t)pr * 512 + lane * 8;
      const unsigned hu[4] = {hv[r].x, hv[r].y, hv[r].z, hv[r].w}, ou[4] = {ov[r].x, ov[r].y, ov[r].z, ov[r].w};
      float x[8];
      float s = 0.f;
#pragma unroll
      for (int i = 0; i < 4; ++i) { x[2 * i] = bf2f(hu[i] & 0xffffu); x[2 * i + 1] = bf2f(hu[i] >> 16); s += x[2 * i] + x[2 * i + 1]; }
#pragma unroll
      for (int o = 1; o < 64; o <<= 1) s += __shfl_xor(s, o, 64);
      const float mu = s * (1.f / 512.f);
      float vs = 0.f;
#pragma unroll
      for (int i = 0; i < 8; ++i) { const float d = x[i] - mu; vs += d * d; }
#pragma unroll
      for (int o = 1; o < 64; o <<= 1) vs += __shfl_xor(vs, o, 64);
      const float rs = rsqrtf(vs * (1.f / 512.f) + LN_EPS);
      const float* gp = P.mh_gain + l * 2048 + (pr & 3) * 512 + lane * 8;
      const float4 g0 = *(const float4*)gp, g1 = *(const float4*)(gp + 4);
      const float g[8] = {g0.x, g0.y, g0.z, g0.w, g1.x, g1.y, g1.z, g1.w};
      unsigned rr[4];
#pragma unroll
      for (int i = 0; i < 4; ++i)
        rr[i] = pack2((x[2 * i] - mu) * rs * g[2 * i] * bf2f(ou[i] & 0xffffu), (x[2 * i + 1] - mu) * rs * g[2 * i + 1] * bf2f(ou[i] >> 16));
      *(uint4*)(HN + base) = make_uint4(rr[0], rr[1], rr[2], rr[3]);
    }
  }
}

DI void phase_mixers(const Params& P, int l, unsigned char* smem) {
  const bf16_t* VTC = (const bf16_t*)(P.ws + OFF_VTC);
  const bf16_t* KT = (const bf16_t*)(P.ws + OFF_KT);
  const bf16_t* Kn = (const bf16_t*)(P.ws + OFF_K);
  const bf16_t* TT = (const bf16_t*)(P.ws + OFF_TT);
  const bf16_t* A256 = (const bf16_t*)(P.ws + OFF_A256);
  const bf16_t* A1024 = (const bf16_t*)(P.ws + OFF_A1024);
  const float* WFIN = (const float*)(P.ws + OFF_WFIN);
  bf16_t* FB = (bf16_t*)(P.ws + OFF_FB);
  for (int it0 = bid_(); it0 < 1024 + 2304; it0 += gridDim.x) {
    if (it0 < 1024) { mlstm_item(P, l, 16 + (it0 >> 7), (it0 >> 5) & 3, (it0 >> 1) & 15, it0 & 1, smem); continue; }
    const int r = it0 - 1024;
    if (r >= 512 && r < 1024) { const int j = r - 512; mlstm_item(P, l, j >> 5, (j >> 3) & 3, (j >> 1) & 3, j & 1, smem); continue; }
    f32x16 acc[2][2];
    acc_zero(acc);
    if (r < 512) {
      const int j = r, sg = j >> 4, mtile = (j >> 1) & 7, ntile = j & 1;
      gemm_mainloop<false>(acc, A1024 + (size_t)mtile * 128 * 2048, 2048, TT + TT_LAT + ((size_t)sg * 256 + ntile * 128) * 2048, 2048, 2048, nullptr, smem);
      EPI_VARS;
      const int seq = sg >> 2, g = sg & 3;
#pragma unroll
      for (int mt = 0; mt < 2; ++mt)
#pragma unroll
        for (int nt = 0; nt < 2; ++nt)
#pragma unroll
          for (int i = 0; i < 16; ++i)
            FB[(size_t)(NCTX + seq * 1024 + mtile * 128 + RW(mt, i)) * 1024 + g * 256 + ntile * 128 + CL(nt)] = (bf16_t)f2bf(acc[mt][nt][i] * (1.f / 512.f));
    } else if (r >= 2048) {
      const int j = r - 2048, sg = j >> 2, mtile = (j >> 1) & 1, ntile = j & 1;
      gemm_mainloop<false>(acc, A256 + (size_t)mtile * 128 * 512, 512, TT + ((size_t)sg * 256 + ntile * 128) * 512, 512, 512, nullptr, smem);
      EPI_VARS;
      const int seq = sg >> 2, g = sg & 3;
#pragma unroll
      for (int mt = 0; mt < 2; ++mt)
#pragma unroll
        for (int nt = 0; nt < 2; ++nt)
#pragma unroll
          for (int i = 0; i < 16; ++i)
            FB[(size_t)(seq * 256 + mtile * 128 + RW(mt, i)) * 1024 + g * 256 + ntile * 128 + CL(nt)] = (bf16_t)f2bf(acc[mt][nt][i] * (1.f / 256.f));
    } else {
      const int j = r - 1024, bhd = j >> 3, mtile = (j >> 1) & 3, ntile = j & 1;
      const int b = bhd >> 3, hd = (bhd >> 1) & 3, dir = bhd & 1;
      const float* wf = WFIN + (size_t)(dir * 4 + hd) * NTOK + b * 256;
      gemm_mainloop<true>(acc, VTC + ((size_t)b * 2048 + hd * 512 + mtile * 128) * 256, 256, KT + ((size_t)(b * 4 + hd) * 256 + ntile * 128) * 256, 256, 256, wf, smem);
      EPI_VARS;
      const size_t sidx = (size_t)(((b * 4 + l) * 2 + dir) * 4 + hd);
      float* Co = P.out + OUT_NEWC + sidx * 512 * 256;
#pragma unroll
      for (int mt = 0; mt < 2; ++mt)
#pragma unroll
        for (int nt = 0; nt < 2; ++nt)
#pragma unroll
          for (int i = 0; i < 16; ++i) Co[(size_t)(mtile * 128 + RW(mt, i)) * 256 + ntile * 128 + CL(nt)] = acc[mt][nt][i];
      if (mtile == 0) {
        const int d = ntile * 128 + (tid_e_ & 127), half = tid_e_ >> 7;
        const bf16_t* kp = Kn + ((size_t)((b * 256 + half * 128) >> 5) * 4 + hd) * 8192 + d;
        const float* wp = wf + half * 128;
        float s = 0.f;
#pragma unroll 1
        for (int kb4 = 0; kb4 < 4; ++kb4) {
#pragma unroll 8
          for (int sp = 0; sp < 32; ++sp) s += wp[kb4 * 32 + sp] * bf2f(kp[(size_t)kb4 * 4 * 8192 + sp * 256]);
        }
        float* red = (float*)smem;
        __syncthreads();
        red[tid_e_] = s;
        __syncthreads();
        if (tid_e_ < 128) P.out[OUT_NEWN + sidx * 256 + d] = red[tid_e_] + red[tid_e_ + 128];
        __syncthreads();
      }
    }
  }
}

DI void phase_branch(const Params& P, int l, unsigned char* smem) {
  const unsigned char* slot = P.ws + (size_t)(l & 1) * SZ_SLOT;
  const bf16_t* HN = (const bf16_t*)(P.ws + OFF_HN);
  const bf16_t* FB = (const bf16_t*)(P.ws + OFF_FB);
  const bf16_t* WA = (const bf16_t*)(slot + WS_WA);
  const bf16_t* WB = (const bf16_t*)(slot + WS_WB);
  const bf16_t* GA = (const bf16_t*)(P.ws + OFF_GA);
  const bf16_t* GB = (const bf16_t*)(P.ws + OFF_GB);
  bf16_t* MG = (bf16_t*)(P.ws + OFF_MERGED);
  for (int t = vblock(); t < 64 * 8; t += gridDim.x) {
    int mtile, ntile;
    tile_decode(t, 64, 8, mtile, ntile);
    const int m0 = mtile * 192, n0 = ntile * 128;
    f32x16 acc[3][2];
    acc_zero3(acc);
    gemm192_mainloop(acc, HN + (size_t)m0 * 2048, 2048, WA + (size_t)n0 * 2048, 2048, 2048, smem);
    const bf16_t* GAb = GA + (size_t)m0 * 1024 + n0;
    const bf16_t* GBb = GB + (size_t)m0 * 1024 + n0;
    bf16_t* MGb = MG + (size_t)m0 * 1024 + n0;
    {
      EPI_VARS;
#pragma unroll
      for (int mt = 0; mt < 3; ++mt)
#pragma unroll
        for (int nt = 0; nt < 2; ++nt)
#pragma unroll
          for (int i = 0; i < 16; ++i) {
            const unsigned o = (unsigned)RW3(mt, i) * 1024u + CL(nt);
            MGb[o] = (bf16_t)f2bf(bf2f(GAb[o]) * acc[mt][nt][i]);
          }
    }
    acc_zero3(acc);
    gemm192_mainloop(acc, FB + (size_t)m0 * 1024, 1024, WB + (size_t)n0 * 1024, 1024, 1024, smem);
    EPI_VARS;
#pragma unroll
    for (int mt = 0; mt < 3; ++mt)
#pragma unroll
      for (int nt = 0; nt < 2; ++nt)
#pragma unroll
        for (int i = 0; i < 16; ++i) {
          const unsigned o = (unsigned)RW3(mt, i) * 1024u + CL(nt);
          MGb[o] = (bf16_t)f2bf(bf2f(MGb[o]) + bf2f(GBb[o]) * acc[mt][nt][i]);
        }
  }
}

DI void phase_resid_gemm(const Params& P, int l, const bf16_t* A, int K, const bf16_t* W, int goff, unsigned char* smem) {
  const float* X = (const float*)(P.ws + OFF_XRES);
  const float* MOD = (const float*)(P.ws + OFF_MOD) + (size_t)l * 9 * 6144;
  float* PRE = (float*)(P.ws + OFF_PRELN);
  for (int t = vblock(); t < 64 * 8; t += gridDim.x) {
    int mtile, ntile;
    tile_decode(t, 64, 8, mtile, ntile);
    const int m0 = mtile * 192, n0 = ntile * 128;
    f32x16 acc[3][2];
    acc_zero3(acc);
    gemm192_mainloop(acc, A + (size_t)m0 * K, K, W + (size_t)n0 * K, K, K, smem);
    EPI_VARS;
    const float* Xb = X + (size_t)m0 * 1024 + n0;
    float* PREb = PRE + (size_t)m0 * 1024 + n0;
#pragma unroll
    for (int mt = 0; mt < 3; ++mt)
#pragma unroll
      for (int nt = 0; nt < 2; ++nt)
#pragma unroll
        for (int i = 0; i < 16; ++i) {
          const int row = RW3(mt, i);
          const unsigned o = (unsigned)row * 1024u + CL(nt);
          const float gv = MOD[(size_t)mod_index(m0 + row) * 6144 + goff + n0 + CL(nt)];
          PREb[o] = ALPHA * Xb[o] + gv * acc[mt][nt][i];
        }
  }
}

DI void phase_ln(const Params& P, const float* gain, const float* bias, float* xdst, const float* modn, int shoff, int scoff) {
  const float* PRE = (const float*)(P.ws + OFF_PRELN);
  bf16_t* H = (bf16_t*)(P.ws + OFF_HMOD);
  const int tidl_ = tid_(), lane = tidl_ & 63, w = tidl_ >> 6;
  for (int tok = bid_() * 4 + w; tok < NTOK; tok += gridDim.x * 4) {
    float4 v[4];
    float s = 0.f;
#pragma unroll
    for (int i = 0; i < 4; ++i) {
      v[i] = *(const float4*)(PRE + (size_t)tok * 1024 + (i * 64 + lane) * 4);
      s += v[i].x + v[i].y + v[i].z + v[i].w;
    }
#pragma unroll
    for (int o = 1; o < 64; o <<= 1) s += __shfl_xor(s, o, 64);
    const float mu = s * (1.f / 1024.f);
    float vs = 0.f;
#pragma unroll
    for (int i = 0; i < 4; ++i) {
      const float a = v[i].x - mu, b = v[i].y - mu, c = v[i].z - mu, d = v[i].w - mu;
      vs += a * a + b * b + c * c + d * d;
    }
#pragma unroll
    for (int o = 1; o < 64; o <<= 1) vs += __shfl_xor(vs, o, 64);
    const float rs = rsqrtf(vs * (1.f / 1024.f) + LN_EPS);
    const float* m = modn ? modn + (size_t)mod_index(tok) * 6144 : nullptr;
#pragma unroll
    for (int i = 0; i < 4; ++i) {
      const int n = (i * 64 + lane) * 4;
      const float4 g = *(const float4*)(gain + n), b = *(const float4*)(bias + n);
      float4 x;
      x.x = (v[i].x - mu) * rs * g.x + b.x; x.y = (v[i].y - mu) * rs * g.y + b.y;
      x.z = (v[i].z - mu) * rs * g.z + b.z; x.w = (v[i].w - mu) * rs * g.w + b.w;
      *(float4*)(xdst + (size_t)tok * 1024 + n) = x;
      if (m) {
        const float4 sh = *(const float4*)(m + shoff + n), sc = *(const float4*)(m + scoff + n);
        uint2 o;
        o.x = pack2(x.x * (1.f + sc.x) + sh.x, x.y * (1.f + sc.y) + sh.y);
        o.y = pack2(x.z * (1.f + sc.z) + sh.z, x.w * (1.f + sc.w) + sh.w);
        *(uint2*)(H + (size_t)tok * 1024 + n) = o;
      }
    }
  }
}

DI void phase_ffn_in(const Params& P, int l, unsigned char* smem) {
  const bf16_t* H = (const bf16_t*)(P.ws + OFF_HMOD);
  const bf16_t* W = (const bf16_t*)(P.ws + (size_t)(l & 1) * SZ_SLOT + WS_WF1);
  bf16_t* FF = (bf16_t*)(P.ws + OFF_FF);
  for (int t = vblock(); t < 96 * 44; t += gridDim.x) {
    int mtile, ntile;
    tile_decode(t, 96, 44, mtile, ntile);
    const int m0 = mtile * 128, n0 = ntile * 128;
    f32x16 acc[2][2];
    acc_zero(acc);
    gemm_mainloop<false>(acc, H + (size_t)m0 * 1024, 1024, W + (size_t)n0 * 1024, 1024, 1024, nullptr, smem);
    EPI_VARS;
#pragma unroll
    for (int mt = 0; mt < 2; ++mt)
#pragma unroll
      for (int i = 0; i < 16; ++i) {
        const float a = acc[mt][0][i], u = acc[mt][1][i];
        *(unsigned short*)(smem + RW(mt, i) * 144 + (wn_ * 32 + rr_) * 2) = (unsigned short)f2bf(a * sigmoidf_(a) * u);
      }
    __syncthreads();
#pragma unroll
    for (int i = 0; i < 4; ++i) {
      const int row = (tid_e_ >> 3) + 32 * i, ch = tid_e_ & 7;
      const u32x4 x = *(const u32x4*)(smem + row * 144 + ch * 16);
      *(u32x4*)(FF + (size_t)(m0 + row) * DFF + ntile * 64 + ch * 8) = x;
    }
    __syncthreads();
  }
}

template <int S>
DI void run_phase(const Params& P, int l, unsigned char* smem) {
  const unsigned char* slot = P.ws + (size_t)(l & 1) * SZ_SLOT;
  const float* MOD = (const float*)(P.ws + OFF_MOD);
  if constexpr (S == 0) phase_setup(P, smem);
  else if constexpr (S == 1) phase_modreduce(P);
  else if constexpr (S == 2) phase_modulate0(P);
  else if constexpr (S == 3) phase_gemm_in(P, l, smem);
  else if constexpr (S == 4) phase_scan_four1(P, l, smem);
  else if constexpr (S == 5) phase_mixers(P, l, smem);
  else if constexpr (S == 6) phase_hn(P, l);
  else if constexpr (S == 7) phase_branch(P, l, smem);
  else if constexpr (S == 8) phase_resid_gemm(P, l, (const bf16_t*)(P.ws + OFF_MERGED), 1024, (const bf16_t*)(slot + WS_WO), 2048, smem);
  else if constexpr (S == 9) {
    phase_ln(P, P.ln_gain + (l * 2 + 0) * 1024, P.ln_bias + (l * 2 + 0) * 1024, (float*)(P.ws + OFF_XRES), MOD + (size_t)l * 9 * 6144, 3072, 4096);
    if (l + 1 < 4) convert_layer(P, l + 1, smem);
  } else if constexpr (S == 10) phase_ffn_in(P, l, smem);
  else if constexpr (S == 11) phase_resid_gemm(P, l, (const bf16_t*)(P.ws + OFF_FF), DFF, (const bf16_t*)(slot + WS_WF2), 5120, smem);
  else {
    if (l == 3) phase_ln(P, P.ln_gain + (l * 2 + 1) * 1024, P.ln_bias + (l * 2 + 1) * 1024, P.out, nullptr, 0, 0);
    else phase_ln(P, P.ln_gain + (l * 2 + 1) * 1024, P.ln_bias + (l * 2 + 1) * 1024, (float*)(P.ws + OFF_XRES), MOD + (size_t)(l + 1) * 9 * 6144, 0, 1024);
  }
}

#if !ONE_LAUNCH
template <int S>
__global__ void __launch_bounds__(256, 2) k_phase(Params P, int l) {
  __shared__ __attribute__((aligned(16))) unsigned char smem[SMEM_BYTES];
  run_phase<S>(P, l, smem);
}

#endif
#define XB_TMO      128
#define XB_XCNT(j)  (256  + 64 * (j))
#define XB_XSUB(j)  (1280 + 64 * (j))
#define XB_XGEN(j)  (2304 + 64 * (j))
#define XB_TOP      3328
#define XB_TOPGEN   3392
#define XCD_BAR_WORDS 3456
#define XB_SPIN_CAP (1u << 20)
#define LAS __attribute__((address_space(3)))
DI unsigned xb_ld(unsigned* p) { return __hip_atomic_load(p, __ATOMIC_RELAXED, __HIP_MEMORY_SCOPE_AGENT); }
DI unsigned xb_add(unsigned* p, unsigned v) { return __hip_atomic_fetch_add(p, v, __ATOMIC_RELAXED, __HIP_MEMORY_SCOPE_AGENT); }
DI unsigned xb_xcc_id() { return (unsigned)__builtin_amdgcn_s_getreg((3 << 11) | 20) & 0xFu; }
#define XB_SPIN(cond, bar) do { unsigned _sp = 0; while (cond) { __builtin_amdgcn_s_sleep(1); \
    if ((++_sp & 255u) == 0u) { if (xb_ld(&(bar)[XB_TMO])) break; if (_sp > XB_SPIN_CAP) { atomicAdd(&(bar)[XB_TMO], 1u); break; } } } } while (0)
DI void xcd_barrier_complete(unsigned* bar, unsigned x, unsigned& nloc, unsigned& nx) {
  const unsigned G = gridDim.x;
  unsigned sum, cnt, mine, sp = 0u;
  for (;;) {
    sum = 0u; cnt = 0u; mine = 0u;
#pragma unroll
    for (unsigned j = 0; j < 16; ++j) { const unsigned c = xb_ld(&bar[XB_XCNT(j)]); sum += c; cnt += (c > 0u) ? 1u : 0u; mine = (j == x) ? c : mine; }
    if (sum == G) break;
    __builtin_amdgcn_s_sleep(1);
    if ((++sp & 255u) == 0u) { if (xb_ld(&bar[XB_TMO])) break; if (sp > XB_SPIN_CAP) { atomicAdd(&bar[XB_TMO], 1u); break; } }
  }
  nloc = mine > 0u ? mine : 1u; nx = cnt > 0u ? cnt : 1u;
}
DI void xcd_barrier(unsigned* bar, volatile LAS unsigned* st) {
  asm volatile("s_waitcnt vmcnt(0)" ::: "memory");
  __syncthreads();
  if (threadIdx.x == 0) {
    const unsigned x = xb_xcc_id();
    __builtin_amdgcn_s_waitcnt(0);
    unsigned nloc = st[0], nx = st[1];
    if (nloc == 0u) { xcd_barrier_complete(bar, x, nloc, nx); st[0] = nloc; st[1] = nx; }
    const unsigned old = xb_add(&bar[XB_XSUB(x)], 1u);
    const unsigned gen = old / nloc;
    if (old + 1u == (gen + 1u) * nloc) {
      __builtin_amdgcn_fence(__ATOMIC_RELEASE, "agent");
      asm volatile("s_waitcnt vmcnt(0)" ::: "memory");
      const unsigned og = xb_add(&bar[XB_TOP], 1u);
      const unsigned tg = og / nx;
      if (og + 1u == (tg + 1u) * nx) xb_add(&bar[XB_TOPGEN], 1u);
      else XB_SPIN(xb_ld(&bar[XB_TOPGEN]) == tg, bar);
      __builtin_amdgcn_fence(__ATOMIC_ACQUIRE, "agent");
      xb_add(&bar[XB_XGEN(x)], 1u);
      asm volatile("s_waitcnt vmcnt(0)" ::: "memory");
    } else {
      XB_SPIN(xb_ld(&bar[XB_XGEN(x)]) == gen, bar);
      __builtin_amdgcn_fence(__ATOMIC_ACQUIRE, "agent");
      asm volatile("s_waitcnt vmcnt(0)" ::: "memory");
    }
  }
  __syncthreads();
}

#define GSYNC() xcd_barrier((unsigned*)(load_params().ws + OFF_BAR), xb_st)
DI Params load_params() {
  Params P{};
#if defined(__HIP_DEVICE_COMPILE__)
  typedef const unsigned long long __attribute__((address_space(4)))* KP;
  typedef float __attribute__((address_space(1)))* GF;
  KP kp = (KP)__builtin_amdgcn_kernarg_segment_ptr();
  asm volatile("" : "+s"(kp));
  P.x_prompt = (const float*)(GF)kp[0];
  P.x_sample = (const float*)(GF)kp[1];
  P.c = (const float*)(GF)kp[2];
  P.state_C = (const float*)(GF)kp[3];
  P.state_n = (const float*)(GF)kp[4];
  P.state_m = (const float*)(GF)kp[5];
  P.c_ctx = (const float*)(GF)kp[6];
  P.w_mod = (const float*)(GF)kp[7];
  P.b_mod = (const float*)(GF)kp[8];
  P.w_in = (const float*)(GF)kp[9];
  P.b_gate = (const float*)(GF)kp[10];
  P.mh_gain = (const float*)(GF)kp[11];
  P.w_a = (const float*)(GF)kp[12];
  P.w_b = (const float*)(GF)kp[13];
  P.w_out = (const float*)(GF)kp[14];
  P.ln_gain = (const float*)(GF)kp[15];
  P.ln_bias = (const float*)(GF)kp[16];
  P.w_f1 = (const float*)(GF)kp[17];
  P.w_f2 = (const float*)(GF)kp[18];
  P.out = (float*)(GF)kp[19];
  P.ws = (unsigned char*)(GF)kp[20];
#endif
  return P;
}
__global__ void __launch_bounds__(256, 2) fwd_kernel(Params Pk) {
  __shared__ __attribute__((aligned(16))) unsigned char smem[SMEM_BYTES];
  __shared__ uint4 xb_words;
  {
    unsigned* bar0 = (unsigned*)(load_params().ws + OFF_BAR);
    const unsigned x0 = xb_xcc_id();
    if (threadIdx.x == 0) {
      xb_words = make_uint4(0u, 0u, 0u, 0u);
      (void)xb_add(&bar0[XB_XCNT(x0)], 1u);
    }
  }
  __syncthreads();
  volatile LAS unsigned* xb_st = (volatile LAS unsigned*)&xb_words;
  run_phase<0>(load_params(), 0, smem);
  if (load_params().ws == nullptr) cg::this_grid().sync();
  GSYNC();
  run_phase<1>(load_params(), 0, smem); GSYNC();
  run_phase<2>(load_params(), 0, smem); GSYNC();
#pragma unroll 1
  for (int l = 0; l < 4; ++l) {
    run_phase<3>(load_params(), l, smem); GSYNC();
    run_phase<4>(load_params(), l, smem); GSYNC();
    run_phase<5>(load_params(), l, smem); GSYNC();
    run_phase<6>(load_params(), l, smem); GSYNC();
    run_phase<7>(load_params(), l, smem); GSYNC();
    run_phase<8>(load_params(), l, smem); GSYNC();
    run_phase<9>(load_params(), l, smem); GSYNC();
    run_phase<10>(load_params(), l, smem); GSYNC();
    run_phase<11>(load_params(), l, smem); GSYNC();
    run_phase<12>(load_params(), l, smem);
    if (l < 3) GSYNC();
  }
}

#if !ONE_LAUNCH
template <int S>
static void launch_phase(const Params& P, int l, int cus, hipStream_t stream) {
  int per_cu = 0;
  if (hipOccupancyMaxActiveBlocksPerMultiprocessor(&per_cu, k_phase<S>, 256, 0) != hipSuccess) per_cu = 1;
  if (per_cu > 2) per_cu = 2;
  if (per_cu < 1) per_cu = 1;
  int grid = cus * per_cu;
  grid -= grid % 8;
  hipLaunchKernelGGL(k_phase<S>, dim3(grid), dim3(256), 0, stream, P, l);
}

#endif
extern "C" void kernel_launch(void* const* d_in, const int* in_sizes, int n_in, void* d_out, int out_size, void* d_ws, size_t ws_size,
                              hipStream_t stream) {
  if (ws_size < WS_TOTAL) { fprintf(stderr, "workspace too small: %zu < %zu\n", ws_size, (size_t)WS_TOTAL); return; }
  Params P{};
  const float** pp = (const float**)&P;
  for (int i = 0; i < 19; ++i) pp[i] = (const float*)d_in[i];
  P.out = (float*)d_out;
  P.ws = (unsigned char*)d_ws;
  int dev = 0, cus = 256;
  if (hipGetDevice(&dev) != hipSuccess) dev = 0;
  if (hipDeviceGetAttribute(&cus, hipDeviceAttributeMultiprocessorCount, dev) != hipSuccess) cus = 256;
#if ONE_LAUNCH
  {
    static int grid_blocks = 0;
    if (!grid_blocks) {
      int per_cu = 0;
      if (hipOccupancyMaxActiveBlocksPerMultiprocessor(&per_cu, fwd_kernel, 256, 0) != hipSuccess) per_cu = 1;
      if (per_cu > 2) per_cu = 2;
      if (per_cu < 1) per_cu = 1;
      grid_blocks = cus * per_cu;
      grid_blocks -= grid_blocks % 8;
    }
    if (hipMemsetAsync((unsigned char*)d_ws + OFF_BAR, 0, 16384, stream) != hipSuccess) { fprintf(stderr, "memset of barrier words failed\n"); return; }
    void* args[] = {&P};
    hipError_t err = hipLaunchCooperativeKernel((void*)fwd_kernel, dim3(grid_blocks), dim3(256), args, 0, stream);
    if (err != hipSuccess) fprintf(stderr, "cooperative launch failed: %s (grid %d)\n", hipGetErrorString(err), grid_blocks);
    return;
  }
#endif
#if !ONE_LAUNCH
  launch_phase<0>(P, 0, cus, stream);
  launch_phase<1>(P, 0, cus, stream);
  launch_phase<2>(P, 0, cus, stream);
  for (int l = 0; l < 4; ++l) {
    launch_phase<3>(P, l, cus, stream);
    launch_phase<4>(P, l, cus, stream);
    launch_phase<5>(P, l, cus, stream);
    launch_phase<6>(P, l, cus, stream);
    launch_phase<7>(P, l, cus, stream);
    launch_phase<8>(P, l, cus, stream);
    launch_phase<9>(P, l, cus, stream);
    launch_phase<10>(P, l, cus, stream);
    launch_phase<11>(P, l, cus, stream);
    launch_phase<12>(P, l, cus, stream);
  }
#endif
}
```

```cpp
#include <hip/hip_runtime.h>
#include <hip/hip_cooperative_groups.h>
#include <cstdio>
#ifndef ONE_LAUNCH
#define ONE_LAUNCH 1
#endif
namespace cg = cooperative_groups;

typedef unsigned short bf16_t;
using bf16x8 = __attribute__((ext_vector_type(8))) short;
using f32x16 = __attribute__((ext_vector_type(16))) float;
using f32x4 = __attribute__((ext_vector_type(4))) float;
#define DI __device__ __forceinline__
#define MFMA32(a, b, c) __builtin_amdgcn_mfma_f32_32x32x16_bf16((a), (b), (c), 0, 0, 0)
#define MFMA16(a, b, c) __builtin_amdgcn_mfma_f32_16x16x32_bf16((a), (b), (c), 0, 0, 0)

constexpr int NTOK = 12288, NCTX = 4096;
constexpr int NINP = 9344;
constexpr int DFF = 2816;
constexpr float ALPHA = 1.6817928305074290f;
constexpr float LN_EPS = 1e-5f;

constexpr size_t SZ_WIN = (size_t)NINP * 1024 * 2, SZ_WA = 1024ull * 2048 * 2, SZ_WB = 1024ull * 1024 * 2, SZ_WO = SZ_WB,
                 SZ_WF1 = 5632ull * 1024 * 2, SZ_WF2 = 1024ull * 2816 * 2;
constexpr size_t WS_WIN = 0, WS_WA = WS_WIN + SZ_WIN, WS_WB = WS_WA + SZ_WA, WS_WO = WS_WB + SZ_WB, WS_WF1 = WS_WO + SZ_WO,
                 WS_WF2 = WS_WF1 + SZ_WF1, SZ_SLOT = WS_WF2 + SZ_WF2;
constexpr size_t OFF_BC = 2 * SZ_SLOT;
constexpr size_t OFF_A256 = OFF_BC + 512 * 256 * 2;
constexpr size_t OFF_A1024 = OFF_A256 + 256 * 512 * 2;
constexpr size_t OFF_MODP = OFF_A1024 + 1024ull * 2048 * 2;
constexpr size_t OFF_MOD = OFF_MODP + 8ull * 4 * 9 * 6144 * 4;
constexpr size_t OFF_XRES = OFF_MOD + 4ull * 9 * 6144 * 4;
constexpr size_t OFF_HMOD = OFF_XRES + (size_t)NTOK * 1024 * 4;
constexpr size_t OFF_FB = OFF_HMOD;
constexpr size_t OFF_Q = OFF_HMOD + (size_t)NTOK * 1024 * 2;
constexpr size_t OFF_MERGED = OFF_Q;
constexpr size_t OFF_K = OFF_Q + (size_t)NTOK * 1024 * 2;
constexpr size_t OFF_KT = OFF_K + (size_t)NTOK * 1024 * 2;
constexpr size_t OFF_VT = OFF_KT + 16ull * 4 * 256 * 256 * 2;
constexpr size_t OFF_OG = OFF_VT + (size_t)NTOK * 2048 * 2;
constexpr size_t OFF_FF = OFF_OG;
constexpr size_t OFF_UF = OFF_OG + (size_t)NTOK * 2048 * 2;
constexpr size_t OFF_GA = OFF_UF + (size_t)NTOK * 1024 * 2;
constexpr size_t OFF_GB = OFF_GA + (size_t)NTOK * 1024 * 2;
constexpr size_t OFF_GATES = OFF_GB + (size_t)NTOK * 1024 * 2;
constexpr size_t SZ_SC = 2ull * 4 * NTOK * 4;
constexpr size_t OFF_BETA = OFF_GATES + (size_t)NTOK * 16 * 4;
constexpr size_t OFF_MM = OFF_BETA + SZ_SC;
constexpr size_t OFF_EMT = OFF_MM + SZ_SC;
constexpr size_t OFF_WFIN = OFF_EMT + SZ_SC;
constexpr size_t OFF_H0 = OFF_WFIN + SZ_SC;
constexpr size_t OFF_TT = OFF_H0 + (size_t)NTOK * 2048 * 2;
constexpr size_t OFF_PRELN = OFF_TT;
constexpr size_t OFF_HN = OFF_TT + (size_t)NTOK * 2048 * 2;
constexpr size_t OFF_VTC = OFF_HN + (size_t)NTOK * 2048 * 2;
constexpr size_t OFF_C0T = OFF_VTC + 16ull * 2048 * 256 * 2;
constexpr size_t OFF_BAR = OFF_C0T + 64ull * 512 * 256 * 2;
constexpr size_t WS_TOTAL = OFF_BAR + 16384;
constexpr size_t VT_LAT = 16ull * 2048 * 256;
constexpr size_t TT_LAT = 16ull * 4 * 256 * 512;

constexpr size_t OUT_NEWC = (size_t)NTOK * 1024;
constexpr size_t OUT_NEWN = OUT_NEWC + 16ull * 4 * 2 * 4 * 512 * 256;
constexpr size_t OUT_NEWM = OUT_NEWN + 16ull * 4 * 2 * 4 * 256;

constexpr int SMEM_BYTES = 73728 + 1024;

struct Params {
  const float *x_prompt, *x_sample, *c, *state_C, *state_n, *state_m, *c_ctx, *w_mod, *b_mod, *w_in, *b_gate, *mh_gain,
      *w_a, *w_b, *w_out, *ln_gain, *ln_bias, *w_f1, *w_f2;
  float* out;
  unsigned char* ws;
};

typedef unsigned u32x4 __attribute__((ext_vector_type(4)));
DI u32x4 gld16(const void* p) { u32x4 r; asm volatile("global_load_dwordx4 %0, %1, off" : "=&v"(r) : "v"(p) : "memory"); return r; }
DI unsigned f2bf(float x) { unsigned r; asm("v_cvt_pk_bf16_f32 %0, %1, %1" : "=v"(r) : "v"(x)); return r & 0xffffu; }
DI unsigned pack2(float a, float b) { unsigned r; asm("v_cvt_pk_bf16_f32 %0, %1, %2\n\ts_nop 1" : "=v"(r) : "v"(a), "v"(b)); return r; }
DI float bf2f(unsigned h) { return __uint_as_float(h << 16); }
DI float sigmoidf_(float x) { return 1.f / (1.f + __expf(-x)); }
DI float logsigmoidf_(float x) { return fminf(x, 0.f) - log1pf(__expf(-fabsf(x))); }
DI int mod_index(int tok) { return tok < NCTX ? 0 : 1 + ((tok - NCTX) >> 10); }
DI int tid_() { int t = threadIdx.x; asm volatile("" : "+v"(t)); return t; }
DI int bid_() { int b = blockIdx.x; asm volatile("" : "+s"(b)); return b; }
DI int vblock() { return bid_(); }

DI void tile_decode(int t, int MT, int NT, int& mt, int& nt) {
  const int per_sc = MT * 8;
  const int sc = t / per_sc;
  const int w = t - sc * per_sc;
  int ncols = NT - sc * 8; ncols = ncols > 8 ? 8 : ncols;
  const int per_sr = 8 * ncols;
  const int sr = w / per_sr;
  const int j = w - sr * per_sr;
  mt = sr * 8 + (j & 7);
  nt = sc * 8 + (j >> 3);
}

template <bool KSCALE>
DI void gemm_mainloop(f32x16 (&acc)[2][2], const bf16_t* __restrict__ A, int lda, const bf16_t* __restrict__ B, int ldb, int K,
                      const float* __restrict__ kscale, unsigned char* smem) {
  const int tid = tid_(), lane = tid & 63, wave = tid >> 6;
  const int wm = wave >> 1, wn = wave & 1, r = lane & 31, h = lane >> 5;
  const int lrow = tid >> 3, lkc = tid & 7;
  const bf16_t* ga = A + (size_t)lrow * lda + lkc * 8;
  const bf16_t* gb = B + (size_t)lrow * ldb + lkc * 8;
  u32x4 a0[4], b0[4], a1[4], b1[4];
  const int KT = K >> 6;
#define GL(sa_, sb_, k0)                                                                            \
  {                                                                                                 \
    _Pragma("unroll") for (int i = 0; i < 4; ++i) {                                                 \
      sa_[i] = gld16(ga + (size_t)(32 * i) * lda + (k0));                                           \
      sb_[i] = gld16(gb + (size_t)(32 * i) * ldb + (k0));                                           \
    }                                                                                               \
  }
#define GW8(sa_, sb_) asm volatile("s_waitcnt vmcnt(8)" : "+v"(sa_[0]), "+v"(sa_[1]), "+v"(sa_[2]), "+v"(sa_[3]), "+v"(sb_[0]), "+v"(sb_[1]), "+v"(sb_[2]), "+v"(sb_[3]) : : "memory")
#define GW0(sa_, sb_) asm volatile("s_waitcnt vmcnt(0)" : "+v"(sa_[0]), "+v"(sa_[1]), "+v"(sa_[2]), "+v"(sa_[3]), "+v"(sb_[0]), "+v"(sb_[1]), "+v"(sb_[2]), "+v"(sb_[3]) : : "memory")
#define ST(sa_, sb_, buf, k0)                                                                       \
  {                                                                                                 \
    if (KSCALE) {                                                                                   \
      const float4 s0 = *(const float4*)((const float*)(smem + 73728) + (k0) + lkc * 8);            \
      const float4 s1 = *(const float4*)((const float*)(smem + 73728) + (k0) + lkc * 8 + 4);        \
      _Pragma("unroll") for (int i = 0; i < 4; ++i) {                                               \
        u32x4 v = sb_[i];                                                                           \
        v.x = pack2(bf2f(v.x & 0xffffu) * s0.x, bf2f(v.x >> 16) * s0.y);                            \
        v.y = pack2(bf2f(v.y & 0xffffu) * s0.z, bf2f(v.y >> 16) * s0.w);                            \
        v.z = pack2(bf2f(v.z & 0xffffu) * s1.x, bf2f(v.z >> 16) * s1.y);                            \
        v.w = pack2(bf2f(v.w & 0xffffu) * s1.z, bf2f(v.w >> 16) * s1.w);                            \
        sb_[i] = v;                                                                                 \
      }                                                                                             \
    }                                                                                               \
    unsigned char* sa__ = smem + (buf) * 36864;                                                     \
    unsigned char* sb__ = sa__ + 18432;                                                             \
    _Pragma("unroll") for (int i = 0; i < 4; ++i) {                                                 \
      *(u32x4*)(sa__ + (lrow + 32 * i) * 144 + lkc * 16) = sa_[i];                                  \
      *(u32x4*)(sb__ + (lrow + 32 * i) * 144 + lkc * 16) = sb_[i];                                  \
    }                                                                                               \
  }
#define COMPUTE(buf)                                                                                                          \
  {                                                                                                                           \
    const unsigned char* sa = smem + (buf) * 36864;                                                                           \
    const unsigned char* sb = sa + 18432;                                                                                     \
    _Pragma("unroll") for (int ks = 0; ks < 4; ++ks) {                                                                        \
      bf16x8 af[2], bfr[2];                                                                                                   \
      _Pragma("unroll") for (int mt = 0; mt < 2; ++mt) af[mt] = *(const bf16x8*)(sa + (wm * 64 + mt * 32 + r) * 144 + ks * 32 + h * 16);  \
      _Pragma("unroll") for (int nt = 0; nt < 2; ++nt) bfr[nt] = *(const bf16x8*)(sb + (wn * 64 + nt * 32 + r) * 144 + ks * 32 + h * 16); \
      _Pragma("unroll") for (int mt = 0; mt < 2; ++mt)                                                                        \
        _Pragma("unroll") for (int nt = 0; nt < 2; ++nt) acc[mt][nt] = MFMA32(af[mt], bfr[nt], acc[mt][nt]);                  \
    }                                                                                                                         \
  }
  if (KSCALE) {
    if (tid < 64) ((float4*)(smem + 73728))[tid] = ((const float4*)kscale)[tid];
    __syncthreads();
  }
  GL(a0, b0, 0);
  GL(a1, b1, 64);
  GW8(a0, b0);
  ST(a0, b0, 0, 0);
  __syncthreads();
  for (int kt = 0; kt < KT; kt += 2) {
    { const int kn = kt + 2 < KT ? kt + 2 : KT - 1; GL(a0, b0, kn * 64); }
    COMPUTE(0);
    GW8(a1, b1);
    ST(a1, b1, 1, (kt + 1) * 64);
    __syncthreads();
    { const int kn = kt + 3 < KT ? kt + 3 : KT - 1; GL(a1, b1, kn * 64); }
    COMPUTE(1);
    GW8(a0, b0);
    { const int kn = kt + 2 < KT ? kt + 2 : KT - 1; ST(a0, b0, 0, kn * 64); }
    __syncthreads();
  }
  GW0(a1, b1);
#undef GL
#undef GW8
#undef GW0
#undef ST
#undef COMPUTE
}

DI void gemm192_mainloop(f32x16 (&acc)[3][2], const bf16_t* __restrict__ A, int lda, const bf16_t* __restrict__ B, int ldb, int K,
                         unsigned char* smem) {
  const int tid = tid_(), lane = tid & 63, wave = tid >> 6;
  const int wm = wave >> 1, wn = wave & 1, r = lane & 31, h = lane >> 5;
  const int lrow = tid >> 3, lkc = tid & 7;
  const bf16_t* ga = A + (size_t)lrow * lda + lkc * 8;
  const bf16_t* gb = B + (size_t)lrow * ldb + lkc * 8;
  u32x4 a0[6], b0[4], a1[6], b1[4];
  const int KT = K >> 6;
#define GL(sa_, sb_, k0)                                                                            \
  {                                                                                                 \
    _Pragma("unroll") for (int i = 0; i < 6; ++i) sa_[i] = gld16(ga + (size_t)(32 * i) * lda + (k0));  \
    _Pragma("unroll") for (int i = 0; i < 4; ++i) sb_[i] = gld16(gb + (size_t)(32 * i) * ldb + (k0));  \
  }
#define GW10(sa_, sb_) asm volatile("s_waitcnt vmcnt(10)" : "+v"(sa_[0]), "+v"(sa_[1]), "+v"(sa_[2]), "+v"(sa_[3]), "+v"(sa_[4]), "+v"(sa_[5]), "+v"(sb_[0]), "+v"(sb_[1]), "+v"(sb_[2]), "+v"(sb_[3]) : : "memory")
#define GW0(sa_, sb_) asm volatile("s_waitcnt vmcnt(0)" : "+v"(sa_[0]), "+v"(sa_[1]), "+v"(sa_[2]), "+v"(sa_[3]), "+v"(sa_[4]), "+v"(sa_[5]), "+v"(sb_[0]), "+v"(sb_[1]), "+v"(sb_[2]), "+v"(sb_[3]) : : "memory")
#define ST(sa_, sb_)                                                                                \
  {                                                                                                 \
    unsigned char* sa__ = smem;                                                                     \
    unsigned char* sb__ = smem + 27648;                                                             \
    _Pragma("unroll") for (int i = 0; i < 6; ++i) *(u32x4*)(sa__ + (lrow + 32 * i) * 144 + lkc * 16) = sa_[i];  \
    _Pragma("unroll") for (int i = 0; i < 4; ++i) *(u32x4*)(sb__ + (lrow + 32 * i) * 144 + lkc * 16) = sb_[i];  \
  }
#define COMPUTE()                                                                                                             \
  {                                                                                                                           \
    const unsigned char* sa = smem;                                                                                           \
    const unsigned char* sb = smem + 27648;                                                                                   \
    _Pragma("unroll") for (int ks = 0; ks < 4; ++ks) {                                                                        \
      bf16x8 af[3], bfr[2];                                                                                                   \
      _Pragma("unroll") for (int mt = 0; mt < 3; ++mt) af[mt] = *(const bf16x8*)(sa + (wm * 96 + mt * 32 + r) * 144 + ks * 32 + h * 16);  \
      _Pragma("unroll") for (int nt = 0; nt < 2; ++nt) bfr[nt] = *(const bf16x8*)(sb + (wn * 64 + nt * 32 + r) * 144 + ks * 32 + h * 16); \
      _Pragma("unroll") for (int mt = 0; mt < 3; ++mt)                                                                        \
        _Pragma("unroll") for (int nt = 0; nt < 2; ++nt) acc[mt][nt] = MFMA32(af[mt], bfr[nt], acc[mt][nt]);                  \
    }                                                                                                                         \
  }
  GL(a0, b0, 0);
  GL(a1, b1, 64);
  GW10(a0, b0);
  ST(a0, b0);
  __syncthreads();
  for (int kt = 0; kt < KT; kt += 2) {
    { const int kn = kt + 2 < KT ? kt + 2 : KT - 1; GL(a0, b0, kn * 64); }
    COMPUTE();
    GW10(a1, b1);
    __syncthreads();
    ST(a1, b1);
    __syncthreads();
    { const int kn = kt + 3 < KT ? kt + 3 : KT - 1; GL(a1, b1, kn * 64); }
    COMPUTE();
    GW10(a0, b0);
    __syncthreads();
    ST(a0, b0);
    __syncthreads();
  }
  GW0(a1, b1);
#undef GL
#undef GW10
#undef GW0
#undef ST
#undef COMPUTE
}
DI void acc_zero3(f32x16 (&acc)[3][2]) {
#pragma unroll
  for (int a = 0; a < 3; ++a)
#pragma unroll
    for (int b = 0; b < 2; ++b)
#pragma unroll
      for (int i = 0; i < 16; ++i) acc[a][b][i] = 0.f;
}
#define RW3(mt, i) (wm_ * 96 + (mt) * 32 + ((i) & 3) + 8 * ((i) >> 2) + 4 * hh_)

DI void acc_zero(f32x16 (&acc)[2][2]) {
#pragma unroll
  for (int a = 0; a < 2; ++a)
#pragma unroll
    for (int b = 0; b < 2; ++b)
#pragma unroll
      for (int i = 0; i < 16; ++i) acc[a][b][i] = 0.f;
}

#define EPI_VARS const int tid_e_ = tid_(), lane_ = tid_e_ & 63, wave_ = tid_e_ >> 6, wm_ = wave_ >> 1, wn_ = wave_ & 1, rr_ = lane_ & 31, hh_ = lane_ >> 5
#define RW(mt, i) (wm_ * 64 + (mt) * 32 + ((i) & 3) + 8 * ((i) >> 2) + 4 * hh_)
#define CL(nt) (wn_ * 64 + (nt) * 32 + rr_)

template <int MODE>
DI void store_tile_bf16(const f32x16 (&acc)[2][2], bf16_t* __restrict__ dst, int ld, unsigned char* smem) {
  EPI_VARS;
#pragma unroll
  for (int mt = 0; mt < 2; ++mt)
#pragma unroll
    for (int nt = 0; nt < 2; ++nt)
#pragma unroll
      for (int i = 0; i < 16; ++i) {
        float v = acc[mt][nt][i];
        if (MODE == 1) v = sigmoidf_(v);
        *(unsigned short*)(smem + RW(mt, i) * 272 + CL(nt) * 2) = (unsigned short)f2bf(v);
      }
  __syncthreads();
#pragma unroll
  for (int i = 0; i < 8; ++i) {
    const int row = (tid_e_ >> 4) + 16 * i, ch = tid_e_ & 15;
    const u32x4 x = *(const u32x4*)(smem + row * 272 + ch * 16);
    *(u32x4*)(dst + (size_t)row * ld + ch * 8) = x;
  }
  __syncthreads();
}

DI void convert_tile(const float* __restrict__ src, int nsrc, int K, bf16_t* __restrict__ dst, int kt, int ntile, int maptype, unsigned char* smem) {
  float* tile = (float*)smem;
  const int tid = tid_(), tx4 = (tid & 15) * 4, ty = tid >> 4;
  const int np = ntile * 64 + tx4;
  int sc;
  if (maptype == 0) sc = np;
  else if (maptype == 1) sc = np < 6144 ? np : (np < 9216 ? np + 16 : (np < 9232 ? 6144 + (np - 9216) : -1));
  else { const int g = np >> 6, w = np & 63; sc = w < 32 ? g * 32 + w : 2816 + g * 32 + (w - 32); }
  __syncthreads();
#pragma unroll
  for (int i = 0; i < 4; ++i) {
    const int ky = ty + 16 * i;
    float4 v = make_float4(0.f, 0.f, 0.f, 0.f);
    if (sc >= 0) v = *(const float4*)(src + (size_t)(kt * 64 + ky) * nsrc + sc);
    tile[ky * 65 + tx4] = v.x; tile[ky * 65 + tx4 + 1] = v.y; tile[ky * 65 + tx4 + 2] = v.z; tile[ky * 65 + tx4 + 3] = v.w;
  }
  __syncthreads();
#pragma unroll
  for (int i = 0; i < 2; ++i) {
    const int id = tid + 256 * i, nrow = id >> 3, kc = id & 7;
    uint4 v;
    v.x = pack2(tile[(kc * 8 + 0) * 65 + nrow], tile[(kc * 8 + 1) * 65 + nrow]);
    v.y = pack2(tile[(kc * 8 + 2) * 65 + nrow], tile[(kc * 8 + 3) * 65 + nrow]);
    v.z = pack2(tile[(kc * 8 + 4) * 65 + nrow], tile[(kc * 8 + 5) * 65 + nrow]);
    v.w = pack2(tile[(kc * 8 + 6) * 65 + nrow], tile[(kc * 8 + 7) * 65 + nrow]);
    *(uint4*)(dst + (size_t)(ntile * 64 + nrow) * K + kt * 64 + kc * 8) = v;
  }
}

DI void convert_layer(const Params& P, int l, unsigned char* smem) {
  unsigned char* slot = P.ws + (size_t)(l & 1) * SZ_SLOT;
  constexpr int T0 = 146 * 16, T1 = T0 + 16 * 32, T2 = T1 + 16 * 16, T3 = T2 + 16 * 16, T4 = T3 + 88 * 16, T5 = T4 + 16 * 44;
  for (int it = bid_(); it < T5; it += gridDim.x) {
    if (it < T0) convert_tile(P.w_in + (size_t)l * 1024 * 9232, 9232, 1024, (bf16_t*)(slot + WS_WIN), it & 15, it >> 4, 1, smem);
    else if (it < T1) { const int j = it - T0; convert_tile(P.w_a + (size_t)l * 2048 * 1024, 1024, 2048, (bf16_t*)(slot + WS_WA), j & 31, j >> 5, 0, smem); }
    else if (it < T2) { const int j = it - T1; convert_tile(P.w_b + (size_t)l * 1024 * 1024, 1024, 1024, (bf16_t*)(slot + WS_WB), j & 15, j >> 4, 0, smem); }
    else if (it < T3) { const int j = it - T2; convert_tile(P.w_out + (size_t)l * 1024 * 1024, 1024, 1024, (bf16_t*)(slot + WS_WO), j & 15, j >> 4, 0, smem); }
    else if (it < T4) { const int j = it - T3; convert_tile(P.w_f1 + (size_t)l * 1024 * 5632, 5632, 1024, (bf16_t*)(slot + WS_WF1), j & 15, j >> 4, 2, smem); }
    else { const int j = it - T4; convert_tile(P.w_f2 + (size_t)l * 2816 * 1024, 1024, 2816, (bf16_t*)(slot + WS_WF2), j % 44, j / 44, 0, smem); }
  }
}

DI void phase_setup(const Params& P, unsigned char* smem) {
  const int tid = tid_();
  convert_layer(P, 0, smem);
  {
    bf16_t* BC = (bf16_t*)(P.ws + OFF_BC);
    bf16_t* A256 = (bf16_t*)(P.ws + OFF_A256);
    bf16_t* A1024 = (bf16_t*)(P.ws + OFF_A1024);
    const int total = 131072 + 131072 + 2097152;
    for (int e = bid_() * 256 + tid; e < total; e += gridDim.x * 256) {
      if (e < 131072) {
        const int n = e >> 8, k = e & 255, cs = n >> 8, ch = n & 255;
        const float ph = (float)((ch * k) & 255) * (1.f / 128.f);
        BC[e] = (bf16_t)f2bf(cs ? sinpif(ph) : cospif(ph));
      } else if (e < 262144) {
        const int e2 = e - 131072, m = e2 >> 9, k = e2 & 511, cs = k >> 8, p = k & 255;
        const float ph = (float)((m * p) & 255) * (1.f / 128.f);
        A256[e2] = (bf16_t)f2bf(cs ? -sinpif(ph) : cospif(ph));
      } else {
        const int e2 = e - 262144, m = e2 >> 11, k = e2 & 2047, cs = k >> 10, p = k & 1023;
        const int r1 = m >> 6, c1 = m & 63, r2 = p >> 6, c2 = p & 63;
        const float ph = (float)((4 * r1 * r2 + c1 * c2) & 63) * (1.f / 32.f);
        A1024[e2] = (bf16_t)f2bf(cs ? -sinpif(ph) : cospif(ph));
      }
    }
  }
  {
    float4* X = (float4*)(P.ws + OFF_XRES);
    const float4* xp = (const float4*)P.x_prompt;
    const float4* xs = (const float4*)P.x_sample;
    const int n4p = NCTX * 256, n4 = NTOK * 256;
    for (int e = bid_() * 256 + tid; e < n4; e += gridDim.x * 256) X[e] = e < n4p ? xp[e] : xs[e - n4p];
  }
  {
    float* MODP = (float*)(P.ws + OFF_MODP);
    float* red = (float*)smem;
    const int lane = tid & 63, w = tid >> 6;
    for (int it = bid_(); it < 8 * 4 * 24; it += gridDim.x) {
      const int nc = it % 24, l = (it / 24) & 3, ks = it / 96;
      float4 a[9];
#pragma unroll
      for (int j = 0; j < 9; ++j) a[j] = make_float4(0.f, 0.f, 0.f, 0.f);
      const int kb = ks * 128 + w * 32;
      const float* wp = P.w_mod + ((size_t)l * 1024 + kb) * 6144 + nc * 256 + lane * 4;
      for (int k = 0; k < 32; ++k) {
        const float4 wv = *(const float4*)(wp + (size_t)k * 6144);
#pragma unroll
        for (int j = 0; j < 9; ++j) {
          float cv = j == 0 ? P.c_ctx[kb + k] : P.c[(j - 1) * 1024 + kb + k];
          cv = cv * sigmoidf_(cv);
          a[j].x += cv * wv.x; a[j].y += cv * wv.y; a[j].z += cv * wv.z; a[j].w += cv * wv.w;
        }
      }
      __syncthreads();
#pragma unroll
      for (int j = 0; j < 9; ++j) *(float4*)(red + (w * 9 + j) * 256 + lane * 4) = a[j];
      __syncthreads();
      for (int e = tid; e < 9 * 256; e += 256) {
        const int j = e >> 8, n = e & 255;
        const float s = red[(0 * 9 + j) * 256 + n] + red[(1 * 9 + j) * 256 + n] + red[(2 * 9 + j) * 256 + n] + red[(3 * 9 + j) * 256 + n];
        MODP[((size_t)(ks * 4 + l) * 9 + j) * 6144 + nc * 256 + n] = s;
      }
    }
  }
}

DI void phase_modreduce(const Params& P) {
  const float* MODP = (const float*)(P.ws + OFF_MODP);
  float* MOD = (float*)(P.ws + OFF_MOD);
  const int total = 4 * 9 * 6144;
  for (int e = bid_() * 256 + tid_(); e < total; e += gridDim.x * 256) {
    const int n = e % 6144, l = e / (9 * 6144);
    float s = P.b_mod[l * 6144 + n];
#pragma unroll
    for (int ks = 0; ks < 8; ++ks) s += MODP[(size_t)ks * total + e];
    MOD[e] = s;
  }
}

DI void phase_modulate0(const Params& P) {
  const float* MOD = (const float*)(P.ws + OFF_MOD);
  const float4* X = (const float4*)(P.ws + OFF_XRES);
  uint2* H = (uint2*)(P.ws + OFF_HMOD);
  for (int e = bid_() * 256 + tid_(); e < NTOK * 256; e += gridDim.x * 256) {
    const int tok = e >> 8, n = (e & 255) * 4;
    const float* m = MOD + (size_t)mod_index(tok) * 6144;
    const float4 x = X[e];
    const float4 sh = *(const float4*)(m + n), sc = *(const float4*)(m + 1024 + n);
    uint2 o;
    o.x = pack2(x.x * (1.f + sc.x) + sh.x, x.y * (1.f + sc.y) + sh.y);
    o.y = pack2(x.z * (1.f + sc.z) + sh.z, x.w * (1.f + sc.w) + sh.w);
    H[e] = o;
  }
}

DI void phase_gemm_in(const Params& P, int l, unsigned char* smem) {
  const bf16_t* H = (const bf16_t*)(P.ws + OFF_HMOD);
  const bf16_t* W = (const bf16_t*)(P.ws + (size_t)(l & 1) * SZ_SLOT + WS_WIN);
  bf16_t* Q = (bf16_t*)(P.ws + OFF_Q);
  bf16_t* Kn = (bf16_t*)(P.ws + OFF_K);
  bf16_t* KT = (bf16_t*)(P.ws + OFF_KT);
  bf16_t* VT = (bf16_t*)(P.ws + OFF_VT);
  bf16_t* VTC = (bf16_t*)(P.ws + OFF_VTC);
  bf16_t* OG = (bf16_t*)(P.ws + OFF_OG);
  bf16_t* UF = (bf16_t*)(P.ws + OFF_UF);
  bf16_t* GA = (bf16_t*)(P.ws + OFF_GA);
  bf16_t* GB = (bf16_t*)(P.ws + OFF_GB);
  float* GATES = (float*)(P.ws + OFF_GATES);
  for (int t = vblock(); t < 96 * 73; t += gridDim.x) {
    int mtile, ntile;
    tile_decode(t, 96, 73, mtile, ntile);
    const int m0 = mtile * 128, n0 = ntile * 128;
    f32x16 acc[2][2];
    acc_zero(acc);
    gemm_mainloop<false>(acc, H + (size_t)m0 * 1024, 1024, W + (size_t)n0 * 1024, 1024, 1024, nullptr, smem);
    EPI_VARS;
    if (ntile < 8 || (ntile >= 32 && ntile < 72)) {
      bf16_t* dst; int ld, cb; bool sg;
      if (ntile < 8) { dst = Q; ld = 1024; cb = n0; sg = false; }
      else if (ntile < 48) { dst = OG; ld = 2048; cb = n0 - 4096; sg = true; }
      else if (ntile < 56) { dst = UF; ld = 1024; cb = n0 - 6144; sg = false; }
      else if (ntile < 64) { dst = GA; ld = 1024; cb = n0 - 7168; sg = true; }
      else { dst = GB; ld = 1024; cb = n0 - 8192; sg = true; }
      if (sg) store_tile_bf16<1>(acc, dst + (size_t)m0 * ld + cb, ld, smem);
      else store_tile_bf16<0>(acc, dst + (size_t)m0 * ld + cb, ld, smem);
    } else if (ntile < 16) {
      const int cb = n0 - 1024;
#pragma unroll
      for (int mt = 0; mt < 2; ++mt)
#pragma unroll
        for (int nt = 0; nt < 2; ++nt) {
#pragma unroll
          for (int i = 0; i < 16; ++i) { const int tk = m0 + RW(mt, i), kc2 = cb + CL(nt); Kn[((size_t)(tk >> 5) * 4 + (kc2 >> 8)) * 8192 + (tk & 31) * 256 + (kc2 & 255)] = (bf16_t)f2bf(acc[mt][nt][i] * 0.0625f); }
          if (m0 < NCTX) {
            const int kc = cb + CL(nt), hd = kc >> 8, d = kc & 255;
#pragma unroll
            for (int i4 = 0; i4 < 4; ++i4) {
              const int tok0 = m0 + RW(mt, 4 * i4), b = tok0 >> 8, s = tok0 & 255;
              uint2 v;
              v.x = pack2(acc[mt][nt][4 * i4] * 0.0625f, acc[mt][nt][4 * i4 + 1] * 0.0625f);
              v.y = pack2(acc[mt][nt][4 * i4 + 2] * 0.0625f, acc[mt][nt][4 * i4 + 3] * 0.0625f);
              *(uint2*)(KT + ((size_t)((b * 4 + hd) * 256 + d)) * 256 + s) = v;
            }
          }
        }
    } else if (ntile < 32) {
      const int cb = n0 - 2048;
#pragma unroll
      for (int mt = 0; mt < 2; ++mt)
#pragma unroll
        for (int nt = 0; nt < 2; ++nt) {
          const int vc = cb + CL(nt);
#pragma unroll
          for (int i4 = 0; i4 < 4; ++i4) {
            const int tok0 = m0 + RW(mt, 4 * i4);
            uint2 v;
            v.x = pack2(acc[mt][nt][4 * i4], acc[mt][nt][4 * i4 + 1]);
            v.y = pack2(acc[mt][nt][4 * i4 + 2], acc[mt][nt][4 * i4 + 3]);
            { const int cq = (tok0 & 31) >> 2; *(uint2*)(VT + ((size_t)(tok0 >> 5) * 2048 + vc) * 32 + (((cq & 3) * 2 + (cq >> 2)) * 4)) = v; }
            if (tok0 < NCTX) *(uint2*)(VTC + ((size_t)(tok0 >> 8) * 2048 + vc) * 256 + (tok0 & 255)) = v;
          }
        }
    } else {
      if (wn_ == 0 && rr_ < 16) {
        const int g = rr_;
        const float bg = P.b_gate[l * 16 + g];
        const bool isf = (g >> 2) & 1;
#pragma unroll
        for (int mt = 0; mt < 2; ++mt)
#pragma unroll
          for (int i = 0; i < 16; ++i) {
            float v = acc[mt][0][i] + bg;
            if (isf) v = logsigmoidf_(v);
            GATES[(size_t)(m0 + RW(mt, i)) * 16 + g] = v;
          }
      }
    }
  }
}

DI float wave_excl_sum(float v, int lane) {
  float x = v;
#pragma unroll
  for (int o = 1; o < 64; o <<= 1) { const float y = __shfl_up(x, o, 64); if (lane >= o) x += y; }
  return x - v;
}
DI float wave_excl_max(float v, int lane, float init) {
  float x = v;
#pragma unroll
  for (int o = 1; o < 64; o <<= 1) { const float y = __shfl_up(x, o, 64); if (lane >= o) x = fmaxf(x, y); }
  const float p = __shfl_up(x, 1, 64);
  return lane == 0 ? init : fmaxf(init, p);
}

template <int E>
DI void scan_wave(const Params& P, int l, int sid) {
  const int lane = tid_() & 63;
  const int dir = sid & 1, hd = (sid >> 1) & 3, seq = sid >> 3;
  const bool lat = seq >= 16;
  const int S = E * 64;
  const int tok0 = lat ? NCTX + (seq - 16) * 1024 : seq * 256;
  const float* G = (const float*)(P.ws + OFF_GATES);
  const size_t gi = (size_t)(dir * 4 + hd) * NTOK;
  float* BETA = (float*)(P.ws + OFF_BETA) + gi;
  float* MM = (float*)(P.ws + OFF_MM) + gi;
  float* EMT = (float*)(P.ws + OFF_EMT) + gi;
  float* WFIN = (float*)(P.ws + OFF_WFIN) + gi;
  const int gi_i = dir * 8 + hd, gi_f = dir * 8 + 4 + hd;
  const float m0 = lat ? P.state_m[(((seq - 16) * 4 + l) * 2 + dir) * 4 + hd] : 0.f;
  float tot = 0.f;
#pragma unroll
  for (int e = 0; e < E; ++e) {
    const int j = lane * E + e, tok = dir == 0 ? tok0 + j : tok0 + S - 1 - j;
    tot += G[(size_t)tok * 16 + gi_f];
  }
  const float boff = wave_excl_sum(tot, lane);
  float b = boff, cmax = -3.0e38f;
#pragma unroll
  for (int e = 0; e < E; ++e) {
    const int j = lane * E + e, tok = dir == 0 ? tok0 + j : tok0 + S - 1 - j;
    b += G[(size_t)tok * 16 + gi_f];
    const float be = G[(size_t)tok * 16 + gi_i] - b;
    BETA[tok] = be;
    cmax = fmaxf(cmax, be);
  }
  float M = wave_excl_max(cmax, lane, m0);
  b = boff;
#pragma unroll
  for (int e = 0; e < E; ++e) {
    const int j = lane * E + e, tok = dir == 0 ? tok0 + j : tok0 + S - 1 - j;
    b += G[(size_t)tok * 16 + gi_f];
    const float be = G[(size_t)tok * 16 + gi_i] - b;
    M = fmaxf(M, be);
    MM[tok] = M;
    EMT[tok] = __expf(-b - M);
  }
  if (!lat) {
    const float Mlast = __shfl(M, 63, 64);
    const float Blast = __shfl(b, 63, 64);
    if (lane == 0) P.out[OUT_NEWM + (((seq * 4 + l) * 2 + dir) * 4 + hd)] = Blast + Mlast;
    b = boff;
  #pragma unroll
  for (int e = 0; e < E; ++e) {
      const int j = lane * E + e, tok = dir == 0 ? tok0 + j : tok0 + S - 1 - j;
      b += G[(size_t)tok * 16 + gi_f];
      const float be = G[(size_t)tok * 16 + gi_i] - b;
      WFIN[tok] = __expf(be - Mlast);
    }
  }
}

DI void convert_c0(const Params& P, int l) {
  bf16_t* C0T = (bf16_t*)(P.ws + OFF_C0T);
  const int total = 64 * 512 * 32;
  for (int e = bid_() * 256 + tid_(); e < total; e += gridDim.x * 256) {
    const int j = e & 31, v = (e >> 5) & 511, sp = e >> 14;
    const int b = sp >> 3, dir = (sp >> 2) & 1, hd = sp & 3;
    const float* src = P.state_C + ((size_t)((((b * 4 + l) * 2 + dir) * 4 + hd) * 512 + v)) * 256 + j * 8;
    const float4 x0 = *(const float4*)src, x1 = *(const float4*)(src + 4);
    uint4 o;
    o.x = pack2(x0.x, x0.y); o.y = pack2(x0.z, x0.w); o.z = pack2(x1.x, x1.y); o.w = pack2(x1.z, x1.w);
    *(uint4*)(C0T + ((size_t)((sp * 2 + (v >> 8)) * 8 + (j >> 2)) * 256 + (v & 255)) * 32 + (j & 3) * 8) = o;
  }
}

DI void phase_scan_four1(const Params& P, int l, unsigned char* smem) {
  convert_c0(P, l);
  const bf16_t* UF = (const bf16_t*)(P.ws + OFF_UF);
  const bf16_t* BC = (const bf16_t*)(P.ws + OFF_BC);
  bf16_t* TT = (bf16_t*)(P.ws + OFF_TT);
  for (int it = bid_(); it < 48 + 1536; it += gridDim.x) {
    if (it < 48) { const int sid = it * 4 + (tid_() >> 6); if (sid < 128) scan_wave<4>(P, l, sid); else scan_wave<16>(P, l, sid); continue; }
    const int t = it - 48, g = t / 384, rem = t - g * 384;
    int mtile, ntile;
    tile_decode(rem, 96, 4, mtile, ntile);
    const int m0 = mtile * 128, n0 = ntile * 128;
    f32x16 acc[2][2];
    acc_zero(acc);
    gemm_mainloop<false>(acc, UF + (size_t)m0 * 1024 + g * 256, 1024, BC + (size_t)n0 * 256, 256, 256, nullptr, smem);
    EPI_VARS;
#pragma unroll
    for (int mt = 0; mt < 2; ++mt)
#pragma unroll
      for (int nt = 0; nt < 2; ++nt) {
        const int n = n0 + CL(nt), cs = n >> 8, ch = n & 255;
#pragma unroll
        for (int i4 = 0; i4 < 4; ++i4) {
          const int tok0 = m0 + RW(mt, 4 * i4);
          uint2 v;
          v.x = pack2(acc[mt][nt][4 * i4], acc[mt][nt][4 * i4 + 1]);
          v.y = pack2(acc[mt][nt][4 * i4 + 2], acc[mt][nt][4 * i4 + 3]);
          size_t idx;
          if (tok0 < NCTX) idx = ((size_t)(((tok0 >> 8) * 4 + g) * 256 + ch)) * 512 + cs * 256 + (tok0 & 255);
          else { const int tl = tok0 - NCTX; idx = TT_LAT + ((size_t)(((tl >> 10) * 4 + g) * 256 + ch)) * 2048 + cs * 1024 + (tl & 1023); }
          *(uint2*)(TT + idx) = v;
        }
      }
  }
}

DI void mlstm_item(const Params& P, int l, int seq, int hd, int qb, int vh, unsigned char* smem) {
  const int tid = tid_(), lane = tid & 63, w = tid >> 6, c = lane & 15, q = lane >> 4;
  const bool lat = seq >= 16;
  const int S = lat ? 1024 : 256;
  const int tok0 = lat ? NCTX + (seq - 16) * 1024 : seq * 256;
  const int bl = seq - 16;
  const bf16_t* Qg = (const bf16_t*)(P.ws + OFF_Q);
  const bf16_t* Kg = (const bf16_t*)(P.ws + OFF_K);
  const bf16_t* VT = (const bf16_t*)(P.ws + OFF_VT) + ((size_t)(tok0 >> 5) * 2048 + hd * 512 + vh * 256) * 32;
  unsigned char* sK = smem;
  unsigned char* sV = smem + 16896;
  const int t_loc = qb * 64 + w * 16 + c;
  const int tokq = tok0 + t_loc;
  bf16x8 qf[8];
  {
    const bf16_t* qp = Qg + (size_t)tokq * 1024 + hd * 256 + q * 8;
#pragma unroll
    for (int kk = 0; kk < 8; ++kk) qf[kk] = *(const bf16x8*)(qp + kk * 32);
#pragma unroll
    for (int kk = 0; kk < 8; ++kk) asm volatile("" : "+v"(qf[kk]));
  }
  __syncthreads();
  const int nkb = S >> 5;
  const size_t rowbase = (size_t)(tok0 + qb * 64 + w * 16 + 4 * q) * 2048 + hd * 512 + vh * 256 + c;
  const bf16_t* kld = Kg + ((size_t)(tok0 >> 5) * 4 + hd) * 8192 + tid * 8;
  unsigned char* ksd = sK + (tid >> 5) * 528 + (tid & 31) * 16;
  const bf16_t* vld = VT + tid * 8;
  unsigned char* vsd = sV + (tid >> 2) * 96 + (tid & 3) * 16;
  u32x4 st[8], bt[2], btn[2];
#define STWAIT() asm volatile("s_waitcnt vmcnt(0)" : "+v"(st[0]), "+v"(st[1]), "+v"(st[2]), "+v"(st[3]), "+v"(st[4]), "+v"(st[5]), "+v"(st[6]), "+v"(st[7]), "+v"(btn[0]), "+v"(btn[1]) : : "memory")
#define ISSUE_KV(kb_)                                                                      \
  {                                                                                        \
    const bf16_t* kp_ = kld + (size_t)(kb_) * 4 * 8192;                                    \
    const bf16_t* vp_ = vld + (size_t)(kb_) * 2048 * 32;                                   \
    _Pragma("unroll") for (int i = 0; i < 4; ++i) st[i] = gld16(kp_ + i * 2048);           \
    _Pragma("unroll") for (int i = 0; i < 4; ++i) st[4 + i] = gld16(vp_ + i * 2048);       \
    btn[0] = gld16(BETA + (kb_) * 32);                                                     \
    btn[1] = gld16(BETA + (kb_) * 32 + 16);                                                \
  }
#define STORE_KV()                                                                         \
  {                                                                                        \
    _Pragma("unroll") for (int i = 0; i < 4; ++i) *(u32x4*)(ksd + i * 8 * 528) = st[i];    \
    _Pragma("unroll") for (int i = 0; i < 4; ++i) *(u32x4*)(vsd + i * 64 * 96) = st[4 + i];\
    bt[0] = btn[0]; bt[1] = btn[1];                                                        \
  }
#define ISSUE_C0(kk_) { _Pragma("unroll") for (int i = 0; i < 4; ++i) st[4 + i] = gld16(C0 + (kk_) * 8192 + i * 2048); }
#define STORE_C0() { _Pragma("unroll") for (int i = 0; i < 4; ++i) *(u32x4*)(vsd + i * 64 * 96) = st[4 + i]; }
#pragma unroll 1
  for (int dir = 0; dir < 2; ++dir) {
    f32x4 acc[16];
#pragma unroll
    for (int n = 0; n < 16; ++n) acc[n] = (f32x4){0.f, 0.f, 0.f, 0.f};
    float den = 0.f;
    const size_t gi = (size_t)(dir * 4 + hd) * NTOK;
    const float* BETA = (const float*)(P.ws + OFF_BETA) + gi + tok0 + 4 * q;
    const float Mt = ((const float*)(P.ws + OFF_MM))[gi + tokq];
    const float emt = ((const float*)(P.ws + OFF_EMT))[gi + tokq];
    const int kb_lo = dir == 0 ? 0 : 2 * qb;
    const int kb_hi = dir == 0 ? 2 * qb + 1 : nkb - 1;
    asm volatile("" : : "v"(Mt), "v"(emt));
    btn[0] = btn[1] = (u32x4){0u, 0u, 0u, 0u};
    st[0] = st[1] = st[2] = st[3] = (u32x4){0u, 0u, 0u, 0u};
    if (lat) {
      const int sidx = ((bl * 4 + l) * 2 + dir) * 4 + hd;
      const float inter = __expf(P.state_m[sidx] - Mt);
      const bf16_t* C0 = (const bf16_t*)(P.ws + OFF_C0T) + ((size_t)(((bl * 2 + dir) * 4 + hd) * 2 + vh) * 8) * 8192 + tid * 8;
      float* sN = (float*)(smem + 71168);
      float sdot = 0.f;
      __syncthreads();
      {
        const float nv = P.state_n[(size_t)sidx * 256 + tid];
        sN[tid] = nv;
      }
      asm volatile("" : : "v"(inter));
      const float* n0p = sN + q * 8;
      ISSUE_C0(0);
      STWAIT();
      STORE_C0();
      __syncthreads();
#pragma unroll
      for (int kk = 0; kk < 8; ++kk) {
        const int kn = kk < 7 ? kk + 1 : 7;
        ISSUE_C0(kn);
        const bf16x8 qk = qf[kk];
#pragma unroll
        for (int e = 0; e < 8; ++e) sdot += bf2f((unsigned)(unsigned short)qk[e]) * n0p[kk * 32 + e];
        {
          bf16x8 fb[2][4];
          const unsigned char* vb_ = sV + c * 96 + q * 16;
#pragma unroll
          for (int j = 0; j < 4; ++j) fb[0][j] = *(const bf16x8*)(vb_ + j * 16 * 96);
#pragma unroll
          for (int g = 0; g < 4; ++g) {
            if (g < 3) {
#pragma unroll
              for (int j = 0; j < 4; ++j) fb[(g + 1) & 1][j] = *(const bf16x8*)(vb_ + ((g + 1) * 4 + j) * 16 * 96);
            }
#pragma unroll
            for (int j = 0; j < 4; ++j) acc[g * 4 + j] = MFMA16(qk, fb[g & 1][j], acc[g * 4 + j]);
            __builtin_amdgcn_sched_barrier(0);
          }
        }
        STWAIT();
        __syncthreads();
        STORE_C0();
        __syncthreads();
      }
      float it_[4];
#pragma unroll
      for (int j = 0; j < 4; ++j) it_[j] = __shfl(inter, 4 * q + j, 64);
#pragma unroll
      for (int n = 0; n < 16; ++n)
#pragma unroll
        for (int j = 0; j < 4; ++j) acc[n][j] *= it_[j];
      den = inter * sdot;
    }
    __syncthreads();
    ISSUE_KV(kb_lo);
    STWAIT();
    STORE_KV();
    __syncthreads();
#pragma unroll 1
    for (int kb = kb_lo; kb <= kb_hi; ++kb) {
      const int kbn = kb < kb_hi ? kb + 1 : kb_hi;
      ISSUE_KV(kbn);
      const float bb0[4] = {__uint_as_float(bt[0].x), __uint_as_float(bt[0].y), __uint_as_float(bt[0].z), __uint_as_float(bt[0].w)};
      const float bb1[4] = {__uint_as_float(bt[1].x), __uint_as_float(bt[1].y), __uint_as_float(bt[1].z), __uint_as_float(bt[1].w)};
      f32x4 x0 = (f32x4){0.f, 0.f, 0.f, 0.f}, x1 = (f32x4){0.f, 0.f, 0.f, 0.f};
      {
        bf16x8 fa0[2], fa1[2];
        const unsigned char* k0_ = sK + c * 528 + q * 16;
        fa0[0] = *(const bf16x8*)(k0_); fa1[0] = *(const bf16x8*)(k0_ + 16 * 528);
#pragma unroll
        for (int kk = 0; kk < 8; ++kk) {
          if (kk < 7) {
            fa0[(kk + 1) & 1] = *(const bf16x8*)(k0_ + (kk + 1) * 64);
            fa1[(kk + 1) & 1] = *(const bf16x8*)(k0_ + 16 * 528 + (kk + 1) * 64);
          }
          x0 = MFMA16(fa0[kk & 1], qf[kk], x0);
          x1 = MFMA16(fa1[kk & 1], qf[kk], x1);
          __builtin_amdgcn_sched_barrier(0);
        }
      }
      float p0[4], p1[4];
      const bool diag = (kb >> 1) == qb;
      if (diag) {
#pragma unroll
        for (int j = 0; j < 4; ++j) {
          const int s0 = kb * 32 + 4 * q + j, s1 = s0 + 16;
          const bool ok0 = dir == 0 ? (s0 <= t_loc) : (s0 >= t_loc);
          const bool ok1 = dir == 0 ? (s1 <= t_loc) : (s1 >= t_loc);
          p0[j] = ok0 ? x0[j] * __expf(bb0[j] - Mt) : 0.f;
          p1[j] = ok1 ? x1[j] * __expf(bb1[j] - Mt) : 0.f;
          den += p0[j] + p1[j];
        }
      } else {
#pragma unroll
        for (int j = 0; j < 4; ++j) {
          p0[j] = x0[j] * __expf(bb0[j] - Mt);
          p1[j] = x1[j] * __expf(bb1[j] - Mt);
          den += p0[j] + p1[j];
        }
      }
      uint4 pu;
      pu.x = pack2(p0[0], p0[1]); pu.y = pack2(p0[2], p0[3]); pu.z = pack2(p1[0], p1[1]); pu.w = pack2(p1[2], p1[3]);
      const bf16x8 pa = __builtin_bit_cast(bf16x8, pu);
      {
        bf16x8 fv[2][4];
        const unsigned char* vb_ = sV + c * 96 + q * 16;
#pragma unroll
        for (int j = 0; j < 4; ++j) fv[0][j] = *(const bf16x8*)(vb_ + j * 16 * 96);
#pragma unroll
        for (int g = 0; g < 4; ++g) {
          if (g < 3) {
#pragma unroll
            for (int j = 0; j < 4; ++j) fv[(g + 1) & 1][j] = *(const bf16x8*)(vb_ + ((g + 1) * 4 + j) * 16 * 96);
          }
#pragma unroll
          for (int j = 0; j < 4; ++j) acc[g * 4 + j] = MFMA16(pa, fv[g & 1][j], acc[g * 4 + j]);
          __builtin_amdgcn_sched_barrier(0);
        }
      }
      STWAIT();
      __syncthreads();
      STORE_KV();
      __syncthreads();
    }
    den += __shfl_xor(den, 16, 64);
    den += __shfl_xor(den, 32, 64);
    const float rinv = 1.f / fmaxf(fabsf(den), emt);
    float rj[4];
#pragma unroll
    for (int j = 0; j < 4; ++j) rj[j] = __shfl(rinv, 4 * q + j, 64);
    bf16_t* HS = (bf16_t*)(P.ws + OFF_H0) + rowbase;
    asm volatile("" : "+v"(HS));
    bf16_t* h0p = HS; bf16_t* h1p = HS + 2048; bf16_t* h2p = HS + 4096; bf16_t* h3p = HS + 6144;
    asm volatile("" : "+v"(h1p));
    asm volatile("" : "+v"(h2p));
    asm volatile("" : "+v"(h3p));
    if (dir == 0) {
#pragma unroll
      for (int n = 0; n < 16; ++n) {
        h0p[n * 16] = (bf16_t)f2bf(acc[n][0] * rj[0]);
        h1p[n * 16] = (bf16_t)f2bf(acc[n][1] * rj[1]);
        h2p[n * 16] = (bf16_t)f2bf(acc[n][2] * rj[2]);
        h3p[n * 16] = (bf16_t)f2bf(acc[n][3] * rj[3]);
      }
    } else {
#pragma unroll
      for (int n = 0; n < 16; ++n) {
        h0p[n * 16] = (bf16_t)f2bf(acc[n][0] * rj[0] + bf2f(h0p[n * 16]));
        h1p[n * 16] = (bf16_t)f2bf(acc[n][1] * rj[1] + bf2f(h1p[n * 16]));
        h2p[n * 16] = (bf16_t)f2bf(acc[n][2] * rj[2] + bf2f(h2p[n * 16]));
        h3p[n * 16] = (bf16_t)f2bf(acc[n][3] * rj[3] + bf2f(h3p[n * 16]));
        if ((n & 3) == 3) __builtin_amdgcn_sched_barrier(0);
      }
    }
  }
}

#undef STWAIT
#undef ISSUE_KV
#undef ISSUE_C0
#undef STORE_KV
#undef STORE_C0

DI void phase_hn(const Params& P, int l) {
  const bf16_t* HS = (const bf16_t*)(P.ws + OFF_H0);
  const bf16_t* OG = (const bf16_t*)(P.ws + OFF_OG);
  bf16_t* HN = (bf16_t*)(P.ws + OFF_HN);
  const int tidl_ = tid_(), lane = tidl_ & 63, w = tidl_ >> 6;
  const int stride = (int)gridDim.x * 4;
  for (int pr0 = bid_() * 4 + w; pr0 < NTOK * 4; pr0 += 4 * stride) {
    uint4 hv[4], ov[4];
#pragma unroll
    for (int r = 0; r < 4; ++r) {
      const int pr = pr0 + r * stride < NTOK * 4 ? pr0 + r * stride : pr0;
      const size_t base = (size_t)pr * 512 + lane * 8;
      hv[r] = *(const uint4*)(HS + base);
      ov[r] = *(const uint4*)(OG + base);
    }
#pragma unroll
    for (int r = 0; r < 4; ++r) {
      const int pr = pr0 + r * stride;
      if (pr >= NTOK * 4) continue;
      const size_t base = (size_t)pr * 512 + lane * 8;
      const unsigned hu[4] = {hv[r].x, hv[r].y, hv[r].z, hv[r].w}, ou[4] = {ov[r].x, ov[r].y, ov[r].z, ov[r].w};
      float x[8];
      float s = 0.f;
#pragma unroll
      for (int i = 0; i < 4; ++i) { x[2 * i] = bf2f(hu[i] & 0xffffu); x[2 * i + 1] = bf2f(hu[i] >> 16); s += x[2 * i] + x[2 * i + 1]; }
#pragma unroll
      for (int o = 1; o < 64; o <<= 1) s += __shfl_xor(s, o, 64);
      const float mu = s * (1.f / 512.f);
      float vs = 0.f;
#pragma unroll
      for (int i = 0; i < 8; ++i) { const float d = x[i] - mu; vs += d * d; }
#pragma unroll
      for (int o = 1; o < 64; o <<= 1) vs += __shfl_xor(vs, o, 64);
      const float rs = rsqrtf(vs * (1.f / 512.f) + LN_EPS);
      const float* gp = P.mh_gain + l * 2048 + (pr & 3) * 512 + lane * 8;
      const float4 g0 = *(const float4*)gp, g1 = *(const float4*)(gp + 4);
      const float g[8] = {g0.x, g0.y, g0.z, g0.w, g1.x, g1.y, g1.z, g1.w};
      unsigned rr[4];
#pragma unroll
      for (int i = 0; i < 4; ++i)
        rr[i] = pack2((x[2 * i] - mu) * rs * g[2 * i] * bf2f(ou[i] & 0xffffu), (x[2 * i + 1] - mu) * rs * g[2 * i + 1] * bf2f(ou[i] >> 16));
      *(uint4*)(HN + base) = make_uint4(rr[0], rr[1], rr[2], rr[3]);
    }
  }
}

DI void phase_mixers(const Params& P, int l, unsigned char* smem) {
  const bf16_t* VTC = (const bf16_t*)(P.ws + OFF_VTC);
  const bf16_t* KT = (const bf16_t*)(P.ws + OFF_KT);
  const bf16_t* Kn = (const bf16_t*)(P.ws + OFF_K);
  const bf16_t* TT = (const bf16_t*)(P.ws + OFF_TT);
  const bf16_t* A256 = (const bf16_t*)(P.ws + OFF_A256);
  const bf16_t* A1024 = (const bf16_t*)(P.ws + OFF_A1024);
  const float* WFIN = (const float*)(P.ws + OFF_WFIN);
  bf16_t* FB = (bf16_t*)(P.ws + OFF_FB);
  for (int it0 = bid_(); it0 < 1024 + 2304; it0 += gridDim.x) {
    if (it0 < 1024) { mlstm_item(P, l, 16 + (it0 >> 7), (it0 >> 5) & 3, (it0 >> 1) & 15, it0 & 1, smem); continue; }
    const int r = it0 - 1024;
    if (r >= 512 && r < 1024) { const int j = r - 512; mlstm_item(P, l, j >> 5, (j >> 3) & 3, (j >> 1) & 3, j & 1, smem); continue; }
    f32x16 acc[2][2];
    acc_zero(acc);
    if (r < 512) {
      const int j = r, sg = j >> 4, mtile = (j >> 1) & 7, ntile = j & 1;
      gemm_mainloop<false>(acc, A1024 + (size_t)mtile * 128 * 2048, 2048, TT + TT_LAT + ((size_t)sg * 256 + ntile * 128) * 2048, 2048, 2048, nullptr, smem);
      EPI_VARS;
      const int seq = sg >> 2, g = sg & 3;
#pragma unroll
      for (int mt = 0; mt < 2; ++mt)
#pragma unroll
        for (int nt = 0; nt < 2; ++nt)
#pragma unroll
          for (int i = 0; i < 16; ++i)
            FB[(size_t)(NCTX + seq * 1024 + mtile * 128 + RW(mt, i)) * 1024 + g * 256 + ntile * 128 + CL(nt)] = (bf16_t)f2bf(acc[mt][nt][i] * (1.f / 512.f));
    } else if (r >= 2048) {
      const int j = r - 2048, sg = j >> 2, mtile = (j >> 1) & 1, ntile = j & 1;
      gemm_mainloop<false>(acc, A256 + (size_t)mtile * 128 * 512, 512, TT + ((size_t)sg * 256 + ntile * 128) * 512, 512, 512, nullptr, smem);
      EPI_VARS;
      const int seq = sg >> 2, g = sg & 3;
#pragma unroll
      for (int mt = 0; mt < 2; ++mt)
#pragma unroll
        for (int nt = 0; nt < 2; ++nt)
#pragma unroll
          for (int i = 0; i < 16; ++i)
            FB[(size_t)(seq * 256 + mtile * 128 + RW(mt, i)) * 1024 + g * 256 + ntile * 128 + CL(nt)] = (bf16_t)f2bf(acc[mt][nt][i] * (1.f / 256.f));
    } else {
      const int j = r - 1024, bhd = j >> 3, mtile = (j >> 1) & 3, ntile = j & 1;
      const int b = bhd >> 3, hd = (bhd >> 1) & 3, dir = bhd & 1;
      const float* wf = WFIN + (size_t)(dir * 4 + hd) * NTOK + b * 256;
      gemm_mainloop<true>(acc, VTC + ((size_t)b * 2048 + hd * 512 + mtile * 128) * 256, 256, KT + ((size_t)(b * 4 + hd) * 256 + ntile * 128) * 256, 256, 256, wf, smem);
      EPI_VARS;
      const size_t sidx = (size_t)(((b * 4 + l) * 2 + dir) * 4 + hd);
      float* Co = P.out + OUT_NEWC + sidx * 512 * 256;
#pragma unroll
      for (int mt = 0; mt < 2; ++mt)
#pragma unroll
        for (int nt = 0; nt < 2; ++nt)
#pragma unroll
          for (int i = 0; i < 16; ++i) Co[(size_t)(mtile * 128 + RW(mt, i)) * 256 + ntile * 128 + CL(nt)] = acc[mt][nt][i];
      if (mtile == 0) {
        const int d = ntile * 128 + (tid_e_ & 127), half = tid_e_ >> 7;
        const bf16_t* kp = Kn + ((size_t)((b * 256 + half * 128) >> 5) * 4 + hd) * 8192 + d;
        const float* wp = wf + half * 128;
        float s = 0.f;
#pragma unroll 1
        for (int kb4 = 0; kb4 < 4; ++kb4) {
#pragma unroll 8
          for (int sp = 0; sp < 32; ++sp) s += wp[kb4 * 32 + sp] * bf2f(kp[(size_t)kb4 * 4 * 8192 + sp * 256]);
        }
        float* red = (float*)smem;
        __syncthreads();
        red[tid_e_] = s;
        __syncthreads();
        if (tid_e_ < 128) P.out[OUT_NEWN + sidx * 256 + d] = red[tid_e_] + red[tid_e_ + 128];
        __syncthreads();
      }
    }
  }
}

DI void phase_branch(const Params& P, int l, unsigned char* smem) {
  const unsigned char* slot = P.ws + (size_t)(l & 1) * SZ_SLOT;
  const bf16_t* HN = (const bf16_t*)(P.ws + OFF_HN);
  const bf16_t* FB = (const bf16_t*)(P.ws + OFF_FB);
  const bf16_t* WA = (const bf16_t*)(slot + WS_WA);
  const bf16_t* WB = (const bf16_t*)(slot + WS_WB);
  const bf16_t* GA = (const bf16_t*)(P.ws + OFF_GA);
  const bf16_t* GB = (const bf16_t*)(P.ws + OFF_GB);
  bf16_t* MG = (bf16_t*)(P.ws + OFF_MERGED);
  for (int t = vblock(); t < 64 * 8; t += gridDim.x) {
    int mtile, ntile;
    tile_decode(t, 64, 8, mtile, ntile);
    const int m0 = mtile * 192, n0 = ntile * 128;
    f32x16 acc[3][2];
    acc_zero3(acc);
    gemm192_mainloop(acc, HN + (size_t)m0 * 2048, 2048, WA + (size_t)n0 * 2048, 2048, 2048, smem);
    const bf16_t* GAb = GA + (size_t)m0 * 1024 + n0;
    const bf16_t* GBb = GB + (size_t)m0 * 1024 + n0;
    bf16_t* MGb = MG + (size_t)m0 * 1024 + n0;
    {
      EPI_VARS;
#pragma unroll
      for (int mt = 0; mt < 3; ++mt)
#pragma unroll
        for (int nt = 0; nt < 2; ++nt)
#pragma unroll
          for (int i = 0; i < 16; ++i) {
            const unsigned o = (unsigned)RW3(mt, i) * 1024u + CL(nt);
            MGb[o] = (bf16_t)f2bf(bf2f(GAb[o]) * acc[mt][nt][i]);
          }
    }
    acc_zero3(acc);
    gemm192_mainloop(acc, FB + (size_t)m0 * 1024, 1024, WB + (size_t)n0 * 1024, 1024, 1024, smem);
    EPI_VARS;
#pragma unroll
    for (int mt = 0; mt < 3; ++mt)
#pragma unroll
      for (int nt = 0; nt < 2; ++nt)
#pragma unroll
        for (int i = 0; i < 16; ++i) {
          const unsigned o = (unsigned)RW3(mt, i) * 1024u + CL(nt);
          MGb[o] = (bf16_t)f2bf(bf2f(MGb[o]) + bf2f(GBb[o]) * acc[mt][nt][i]);
        }
  }
}

DI void phase_resid_gemm(const Params& P, int l, const bf16_t* A, int K, const bf16_t* W, int goff, unsigned char* smem) {
  const float* X = (const float*)(P.ws + OFF_XRES);
  const float* MOD = (const float*)(P.ws + OFF_MOD) + (size_t)l * 9 * 6144;
  float* PRE = (float*)(P.ws + OFF_PRELN);
  for (int t = vblock(); t < 64 * 8; t += gridDim.x) {
    int mtile, ntile;
    tile_decode(t, 64, 8, mtile, ntile);
    const int m0 = mtile * 192, n0 = ntile * 128;
    f32x16 acc[3][2];
    acc_zero3(acc);
    gemm192_mainloop(acc, A + (size_t)m0 * K, K, W + (size_t)n0 * K, K, K, smem);
    EPI_VARS;
    const float* Xb = X + (size_t)m0 * 1024 + n0;
    float* PREb = PRE + (size_t)m0 * 1024 + n0;
#pragma unroll
    for (int mt = 0; mt < 3; ++mt)
#pragma unroll
      for (int nt = 0; nt < 2; ++nt)
#pragma unroll
        for (int i = 0; i < 16; ++i) {
          const int row = RW3(mt, i);
          const unsigned o = (unsigned)row * 1024u + CL(nt);
          const float gv = MOD[(size_t)mod_index(m0 + row) * 6144 + goff + n0 + CL(nt)];
          PREb[o] = ALPHA * Xb[o] + gv * acc[mt][nt][i];
        }
  }
}

DI void phase_ln(const Params& P, const float* gain, const float* bias, float* xdst, const float* modn, int shoff, int scoff) {
  const float* PRE = (const float*)(P.ws + OFF_PRELN);
  bf16_t* H = (bf16_t*)(P.ws + OFF_HMOD);
  const int tidl_ = tid_(), lane = tidl_ & 63, w = tidl_ >> 6;
  for (int tok = bid_() * 4 + w; tok < NTOK; tok += gridDim.x * 4) {
    float4 v[4];
    float s = 0.f;
#pragma unroll
    for (int i = 0; i < 4; ++i) {
      v[i] = *(const float4*)(PRE + (size_t)tok * 1024 + (i * 64 + lane) * 4);
      s += v[i].x + v[i].y + v[i].z + v[i].w;
    }
#pragma unroll
    for (int o = 1; o < 64; o <<= 1) s += __shfl_xor(s, o, 64);
    const float mu = s * (1.f / 1024.f);
    float vs = 0.f;
#pragma unroll
    for (int i = 0; i < 4; ++i) {
      const float a = v[i].x - mu, b = v[i].y - mu, c = v[i].z - mu, d = v[i].w - mu;
      vs += a * a + b * b + c * c + d * d;
    }
#pragma unroll
    for (int o = 1; o < 64; o <<= 1) vs += __shfl_xor(vs, o, 64);
    const float rs = rsqrtf(vs * (1.f / 1024.f) + LN_EPS);
    const float* m = modn ? modn + (size_t)mod_index(tok) * 6144 : nullptr;
#pragma unroll
    for (int i = 0; i < 4; ++i) {
      const int n = (i * 64 + lane) * 4;
      const float4 g = *(const float4*)(gain + n), b = *(const float4*)(bias + n);
      float4 x;
      x.x = (v[i].x - mu) * rs * g.x + b.x; x.y = (v[i].y - mu) * rs * g.y + b.y;
      x.z = (v[i].z - mu) * rs * g.z + b.z; x.w = (v[i].w - mu) * rs * g.w + b.w;
      *(float4*)(xdst + (size_t)tok * 1024 + n) = x;
      if (m) {
        const float4 sh = *(const float4*)(m + shoff + n), sc = *(const float4*)(m + scoff + n);
        uint2 o;
        o.x = pack2(x.x * (1.f + sc.x) + sh.x, x.y * (1.f + sc.y) + sh.y);
        o.y = pack2(x.z * (1.f + sc.z) + sh.z, x.w * (1.f + sc.w) + sh.w);
        *(uint2*)(H + (size_t)tok * 1024 + n) = o;
      }
    }
  }
}

DI void phase_ffn_in(const Params& P, int l, unsigned char* smem) {
  const bf16_t* H = (const bf16_t*)(P.ws + OFF_HMOD);
  const bf16_t* W = (const bf16_t*)(P.ws + (size_t)(l & 1) * SZ_SLOT + WS_WF1);
  bf16_t* FF = (bf16_t*)(P.ws + OFF_FF);
  for (int t = vblock(); t < 96 * 44; t += gridDim.x) {
    int mtile, ntile;
    tile_decode(t, 96, 44, mtile, ntile);
    const int m0 = mtile * 128, n0 = ntile * 128;
    f32x16 acc[2][2];
    acc_zero(acc);
    gemm_mainloop<false>(acc, H + (size_t)m0 * 1024, 1024, W + (size_t)n0 * 1024, 1024, 1024, nullptr, smem);
    EPI_VARS;
#pragma unroll
    for (int mt = 0; mt < 2; ++mt)
#pragma unroll
      for (int i = 0; i < 16; ++i) {
        const float a = acc[mt][0][i], u = acc[mt][1][i];
        *(unsigned short*)(smem + RW(mt, i) * 144 + (wn_ * 32 + rr_) * 2) = (unsigned short)f2bf(a * sigmoidf_(a) * u);
      }
    __syncthreads();
#pragma unroll
    for (int i = 0; i < 4; ++i) {
      const int row = (tid_e_ >> 3) + 32 * i, ch = tid_e_ & 7;
      const u32x4 x = *(const u32x4*)(smem + row * 144 + ch * 16);
      *(u32x4*)(FF + (size_t)(m0 + row) * DFF + ntile * 64 + ch * 8) = x;
    }
    __syncthreads();
  }
}

template <int S>
DI void run_phase(const Params& P, int l, unsigned char* smem) {
  const unsigned char* slot = P.ws + (size_t)(l & 1) * SZ_SLOT;
  const float* MOD = (const float*)(P.ws + OFF_MOD);
  if constexpr (S == 0) phase_setup(P, smem);
  else if constexpr (S == 1) phase_modreduce(P);
  else if constexpr (S == 2) phase_modulate0(P);
  else if constexpr (S == 3) phase_gemm_in(P, l, smem);
  else if constexpr (S == 4) phase_scan_four1(P, l, smem);
  else if constexpr (S == 5) phase_mixers(P, l, smem);
  else if constexpr (S == 6) phase_hn(P, l);
  else if constexpr (S == 7) phase_branch(P, l, smem);
  else if constexpr (S == 8) phase_resid_gemm(P, l, (const bf16_t*)(P.ws + OFF_MERGED), 1024, (const bf16_t*)(slot + WS_WO), 2048, smem);
  else if constexpr (S == 9) {
    phase_ln(P, P.ln_gain + (l * 2 + 0) * 1024, P.ln_bias + (l * 2 + 0) * 1024, (float*)(P.ws + OFF_XRES), MOD + (size_t)l * 9 * 6144, 3072, 4096);
    if (l + 1 < 4) convert_layer(P, l + 1, smem);
  } else if constexpr (S == 10) phase_ffn_in(P, l, smem);
  else if constexpr (S == 11) phase_resid_gemm(P, l, (const bf16_t*)(P.ws + OFF_FF), DFF, (const bf16_t*)(slot + WS_WF2), 5120, smem);
  else {
    if (l == 3) phase_ln(P, P.ln_gain + (l * 2 + 1) * 1024, P.ln_bias + (l * 2 + 1) * 1024, P.out, nullptr, 0, 0);
    else phase_ln(P, P.ln_gain + (l * 2 + 1) * 1024, P.ln_bias + (l * 2 + 1) * 1024, (float*)(P.ws + OFF_XRES), MOD + (size_t)(l + 1) * 9 * 6144, 0, 1024);
  }
}

#if !ONE_LAUNCH
template <int S>
__global__ void __launch_bounds__(256, 2) k_phase(Params P, int l) {
  __shared__ __attribute__((aligned(16))) unsigned char smem[SMEM_BYTES];
  run_phase<S>(P, l, smem);
}

#endif
#define XB_TMO      128
#define XB_XCNT(j)  (256  + 64 * (j))
#define XB_XSUB(j)  (1280 + 64 * (j))
#define XB_XGEN(j)  (2304 + 64 * (j))
#define XB_TOP      3328
#define XB_TOPGEN   3392
#define XCD_BAR_WORDS 3456
#define XB_SPIN_CAP (1u << 20)
#define LAS __attribute__((address_space(3)))
DI unsigned xb_ld(unsigned* p) { return __hip_atomic_load(p, __ATOMIC_RELAXED, __HIP_MEMORY_SCOPE_AGENT); }
DI unsigned xb_add(unsigned* p, unsigned v) { return __hip_atomic_fetch_add(p, v, __ATOMIC_RELAXED, __HIP_MEMORY_SCOPE_AGENT); }
DI unsigned xb_xcc_id() { return (unsigned)__builtin_amdgcn_s_getreg((3 << 11) | 20) & 0xFu; }
#define XB_SPIN(cond, bar) do { unsigned _sp = 0; while (cond) { __builtin_amdgcn_s_sleep(1); \
    if ((++_sp & 255u) == 0u) { if (xb_ld(&(bar)[XB_TMO])) break; if (_sp > XB_SPIN_CAP) { atomicAdd(&(bar)[XB_TMO], 1u); break; } } } } while (0)
DI void xcd_barrier_complete(unsigned* bar, unsigned x, unsigned& nloc, unsigned& nx) {
  const unsigned G = gridDim.x;
  unsigned sum, cnt, mine, sp = 0u;
  for (;;) {
    sum = 0u; cnt = 0u; mine = 0u;
#pragma unroll
    for (unsigned j = 0; j < 16; ++j) { const unsigned c = xb_ld(&bar[XB_XCNT(j)]); sum += c; cnt += (c > 0u) ? 1u : 0u; mine = (j == x) ? c : mine; }
    if (sum == G) break;
    __builtin_amdgcn_s_sleep(1);
    if ((++sp & 255u) == 0u) { if (xb_ld(&bar[XB_TMO])) break; if (sp > XB_SPIN_CAP) { atomicAdd(&bar[XB_TMO], 1u); break; } }
  }
  nloc = mine > 0u ? mine : 1u; nx = cnt > 0u ? cnt : 1u;
}
DI void xcd_barrier(unsigned* bar, volatile LAS unsigned* st) {
  asm volatile("s_waitcnt vmcnt(0)" ::: "memory");
  __syncthreads();
  if (threadIdx.x == 0) {
    const unsigned x = xb_xcc_id();
    __builtin_amdgcn_s_waitcnt(0);
    unsigned nloc = st[0], nx = st[1];
    if (nloc == 0u) { xcd_barrier_complete(bar, x, nloc, nx); st[0] = nloc; st[1] = nx; }
    const unsigned old = xb_add(&bar[XB_XSUB(x)], 1u);
    const unsigned gen = old / nloc;
    if (old + 1u == (gen + 1u) * nloc) {
      __builtin_amdgcn_fence(__ATOMIC_RELEASE, "agent");
      asm volatile("s_waitcnt vmcnt(0)" ::: "memory");
      const unsigned og = xb_add(&bar[XB_TOP], 1u);
      const unsigned tg = og / nx;
      if (og + 1u == (tg + 1u) * nx) xb_add(&bar[XB_TOPGEN], 1u);
      else XB_SPIN(xb_ld(&bar[XB_TOPGEN]) == tg, bar);
      __builtin_amdgcn_fence(__ATOMIC_ACQUIRE, "agent");
      xb_add(&bar[XB_XGEN(x)], 1u);
      asm volatile("s_waitcnt vmcnt(0)" ::: "memory");
    } else {
      XB_SPIN(xb_ld(&bar[XB_XGEN(x)]) == gen, bar);
      __builtin_amdgcn_fence(__ATOMIC_ACQUIRE, "agent");
      asm volatile("s_waitcnt vmcnt(0)" ::: "memory");
    }
  }
  __syncthreads();
}

#define GSYNC() xcd_barrier((unsigned*)(load_params().ws + OFF_BAR), xb_st)
DI Params load_params() {
  Params P{};
#if defined(__HIP_DEVICE_COMPILE__)
  typedef const unsigned long long __attribute__((address_space(4)))* KP;
  typedef float __attribute__((address_space(1)))* GF;
  KP kp = (KP)__builtin_amdgcn_kernarg_segment_ptr();
  asm volatile("" : "+s"(kp));
  P.x_prompt = (const float*)(GF)kp[0];
  P.x_sample = (const float*)(GF)kp[1];
  P.c = (const float*)(GF)kp[2];
  P.state_C = (const float*)(GF)kp[3];
  P.state_n = (const float*)(GF)kp[4];
  P.state_m = (const float*)(GF)kp[5];
  P.c_ctx = (const float*)(GF)kp[6];
  P.w_mod = (const float*)(GF)kp[7];
  P.b_mod = (const float*)(GF)kp[8];
  P.w_in = (const float*)(GF)kp[9];
  P.b_gate = (const float*)(GF)kp[10];
  P.mh_gain = (const float*)(GF)kp[11];
  P.w_a = (const float*)(GF)kp[12];
  P.w_b = (const float*)(GF)kp[13];
  P.w_out = (const float*)(GF)kp[14];
  P.ln_gain = (const float*)(GF)kp[15];
  P.ln_bias = (const float*)(GF)kp[16];
  P.w_f1 = (const float*)(GF)kp[17];
  P.w_f2 = (const float*)(GF)kp[18];
  P.out = (float*)(GF)kp[19];
  P.ws = (unsigned char*)(GF)kp[20];
#endif
  return P;
}
__global__ void __launch_bounds__(256, 2) fwd_kernel(Params Pk) {
  __shared__ __attribute__((aligned(16))) unsigned char smem[SMEM_BYTES];
  __shared__ uint4 xb_words;
  {
    unsigned* bar0 = (unsigned*)(load_params().ws + OFF_BAR);
    const unsigned x0 = xb_xcc_id();
    if (threadIdx.x == 0) {
      xb_words = make_uint4(0u, 0u, 0u, 0u);
      (void)xb_add(&bar0[XB_XCNT(x0)], 1u);
    }
  }
  __syncthreads();
  volatile LAS unsigned* xb_st = (volatile LAS unsigned*)&xb_words;
  run_phase<0>(load_params(), 0, smem);
  if (load_params().ws == nullptr) cg::this_grid().sync();
  GSYNC();
  run_phase<1>(load_params(), 0, smem); GSYNC();
  run_phase<2>(load_params(), 0, smem); GSYNC();
#pragma unroll 1
  for (int l = 0; l < 4; ++l) {
    run_phase<3>(load_params(), l, smem); GSYNC();
    run_phase<4>(load_params(), l, smem); GSYNC();
    run_phase<5>(load_params(), l, smem); GSYNC();
    run_phase<6>(load_params(), l, smem); GSYNC();
    run_phase<7>(load_params(), l, smem); GSYNC();
    run_phase<8>(load_params(), l, smem); GSYNC();
    run_phase<9>(load_params(), l, smem); GSYNC();
    run_phase<10>(load_params(), l, smem); GSYNC();
    run_phase<11>(load_params(), l, smem); GSYNC();
    run_phase<12>(load_params(), l, smem);
    if (l < 3) GSYNC();
  }
}

#if !ONE_LAUNCH
template <int S>
static void launch_phase(const Params& P, int l, int cus, hipStream_t stream) {
  int per_cu = 0;
  if (hipOccupancyMaxActiveBlocksPerMultiprocessor(&per_cu, k_phase<S>, 256, 0) != hipSuccess) per_cu = 1;
  if (per_cu > 2) per_cu = 2;
  if (per_cu < 1) per_cu = 1;
  int grid = cus * per_cu;
  grid -= grid % 8;
  hipLaunchKernelGGL(k_phase<S>, dim3(grid), dim3(256), 0, stream, P, l);
}

#endif
extern "C" void kernel_launch(void* const* d_in, const int* in_sizes, int n_in, void* d_out, int out_size, void* d_ws, size_t ws_size,
                              hipStream_t stream) {
  if (ws_size < WS_TOTAL) { fprintf(stderr, "workspace too small: %zu < %zu\n", ws_size, (size_t)WS_TOTAL); return; }
  Params P{};
  const float** pp = (const float**)&P;
  for (int i = 0; i < 19; ++i) pp[i] = (const float*)d_in[i];
  P.out = (float*)d_out;
  P.ws = (unsigned char*)d_ws;
  int dev = 0, cus = 256;
  if (hipGetDevice(&dev) != hipSuccess) dev = 0;
  if (hipDeviceGetAttribute(&cus, hipDeviceAttributeMultiprocessorCount, dev) != hipSuccess) cus = 256;
#if ONE_LAUNCH
  {
    static int grid_blocks = 0;
    if (!grid_blocks) {
      int per_cu = 0;
      if (hipOccupancyMaxActiveBlocksPerMultiprocessor(&per_cu, fwd_kernel, 256, 0) != hipSuccess) per_cu = 1;
      if (per_cu > 2) per_cu = 2;
      if (per_cu < 1) per_cu = 1;
      grid_blocks = cus * per_cu;
      grid_blocks -= grid_blocks % 8;
    }
    if (hipMemsetAsync((unsigned char*)d_ws + OFF_BAR, 0, 16384, stream) != hipSuccess) { fprintf(stderr, "memset of barrier words failed\n"); return; }
    void* args[] = {&P};
    hipError_t err = hipLaunchCooperativeKernel((void*)fwd_kernel, dim3(grid_blocks), dim3(256), args, 0, stream);
    if (err != hipSuccess) fprintf(stderr, "cooperative launch failed: %s (grid %d)\n", hipGetErrorString(err), grid_blocks);
    return;
  }
#endif
#if !ONE_LAUNCH
  launch_phase<0>(P, 0, cus, stream);
  launch_phase<1>(P, 0, cus, stream);
  launch_phase<2>(P, 0, cus, stream);
  for (int l = 0; l < 4; ++l) {
    launch_phase<3>(P, l, cus, stream);
    launch_phase<4>(P, l, cus, stream);
    launch_phase<5>(P, l, cus, stream);
    launch_phase<6>(P, l, cus, stream);
    launch_phase<7>(P, l, cus, stream);
    launch_phase<8>(P, l, cus, stream);
    launch_phase<9>(P, l, cus, stream);
    launch_phase<10>(P, l, cus, stream);
    launch_phase<11>(P, l, cus, stream);
    launch_phase<12>(P, l, cus, stream);
  }
#endif
}
```
